# Optimizing an MI355X kernel written in HIP

```python
import math
import jax, jax.numpy as jnp
from jax import lax
import numpy as np

D_MODEL = 1024
BATCH = 8
SEQ = 2048
DEPTH = 2

GRID_W = 64
CTX_LEN = 256
N_EVEN = (DEPTH + 1) // 2
N_ODD = DEPTH // 2

DIFF_HEADS = 4
DIFF_HEAD_DIM = 64
DIFF_V_DIM = 2 * DIFF_HEAD_DIM
DIFF_QK_W = DIFF_HEADS * 2 * DIFF_HEAD_DIM
DIFF_V_W = DIFF_HEADS * DIFF_V_DIM
DIFF_IN_W = 2 * DIFF_QK_W + DIFF_V_W
HGRN_HEADS = 4
HGRN_K_DIM = 128
HGRN_V_DIM = 128
HGRN_CHUNK = 16
HGRN_KW = HGRN_HEADS * HGRN_K_DIM
HGRN_VW = HGRN_HEADS * HGRN_V_DIM
HGRN_IN_W = 3 * HGRN_KW + 2 * HGRN_VW
EVEN_IN_W = DIFF_IN_W + HGRN_IN_W
EVEN_OUT_W = DIFF_V_W + HGRN_VW
MLA_HEADS = 8
MLA_NOPE = 128
MLA_ROPE = 64
MLA_V = 128
MLA_Q_LORA = 384
MLA_KV_LORA = 256
ODD_IN_W = MLA_Q_LORA + MLA_KV_LORA + MLA_ROPE
ODD_OUT_W = MLA_HEADS * MLA_V
N_EXPERTS = 16
N_GROUPS = 4
EXPERTS_PER_GROUP = N_EXPERTS // N_GROUPS
TOP_K = 2
EXPERT_FF = 512
SHARED_FF = 512

ROPE_BASE = 10000.0
Q_BLOCK = 128
EPS = 1e-6

kernel_name = 'hybrid_diffattn_hgrn2_mla_grouped_moe_dit'


def rmsnorm(x, gain):
    xf = x.astype(jnp.float32)
    y = xf * lax.rsqrt(jnp.mean(xf * xf, axis=-1, keepdims=True) + EPS)
    return y.astype(x.dtype) * gain


def axial_rope_tables(n_tokens, rot_dim):
    rows = n_tokens // GRID_W
    row = jnp.repeat(jnp.arange(rows, dtype=jnp.int32), GRID_W)
    col = jnp.tile(jnp.arange(GRID_W, dtype=jnp.int32), rows)
    axis_dim = rot_dim // 2
    inv_freq = ROPE_BASE ** (-jnp.arange(0, axis_dim, 2, dtype=jnp.float32) / axis_dim)
    ang_r = row.astype(jnp.float32)[:, None] * inv_freq
    ang_c = col.astype(jnp.float32)[:, None] * inv_freq
    return (jnp.cos(ang_r), jnp.sin(ang_r), jnp.cos(ang_c), jnp.sin(ang_c))


def _rope_1d(x, cos, sin):
    x1, x2 = jnp.split(x, 2, axis=-1)
    cos = cos.astype(x.dtype)
    sin = sin.astype(x.dtype)
    return jnp.concatenate([x1 * cos - x2 * sin, x1 * sin + x2 * cos], axis=-1)


def apply_axial_rope(x, tables):
    cos_r, sin_r, cos_c, sin_c = tables
    xr, xc = jnp.split(x, 2, axis=-1)
    return jnp.concatenate([_rope_1d(xr, cos_r, sin_r), _rope_1d(xc, cos_c, sin_c)], axis=-1)


def sweep_query_blocks(fn, qs, axis):
    n_q = qs[0].shape[axis]
    n_blocks = n_q // Q_BLOCK

    def split(q):
        q = q.reshape(q.shape[:axis] + (n_blocks, Q_BLOCK) + q.shape[axis + 1:])
        return jnp.moveaxis(q, axis, 0)

    out = lax.map(fn, tuple(split(q) for q in qs))
    out = jnp.moveaxis(out, 0, 2)
    return out.reshape(out.shape[:2] + (n_q, out.shape[-1]))


def merge_heads(o):
    b, h, t, dv = o.shape
    return o.transpose(0, 2, 1, 3).reshape(b, t, h * dv)


def diff_heads(p, q_gain, k_gain):
    b, t, _ = p.shape
    q, k, v = jnp.split(p, [DIFF_QK_W, 2 * DIFF_QK_W], axis=-1)
    q = rmsnorm(q.reshape(b, t, DIFF_HEADS, 2, DIFF_HEAD_DIM), q_gain).transpose(0, 2, 3, 1, 4)
    k = rmsnorm(k.reshape(b, t, DIFF_HEADS, 2, DIFF_HEAD_DIM), k_gain).transpose(0, 2, 3, 1, 4)
    v = v.reshape(b, t, DIFF_HEADS, DIFF_V_DIM).transpose(0, 2, 1, 3)
    return q, k, v


def diff_attention(q, k, v, lam):
    scale = DIFF_HEAD_DIM ** -0.5

    def block(qs):
        (qb,) = qs
        s = jnp.einsum('bhcqd,bhckd->bhcqk', qb, k).astype(jnp.float32) * scale
        p = jax.nn.softmax(s, axis=-1)
        a = p[:, :, 0] - lam * p[:, :, 1]
        return jnp.einsum('bhqk,bhkv->bhqv', a.astype(v.dtype), v)

    return sweep_query_blocks(block, (q,), axis=3)


def diff_output(o, subln, lam_init):
    return merge_heads(rmsnorm(o, subln) * (1.0 - lam_init))


def gla_chunked(q, k, v, log_f, s0):
    b, h, t, dk = q.shape
    dv = v.shape[-1]
    c = HGRN_CHUNK
    n = t // c
    f32 = jnp.float32
    q = q.astype(f32).reshape(b, h, n, c, dk) * (dk ** -0.5)
    k = k.astype(f32).reshape(b, h, n, c, dk)
    v = v.astype(f32).reshape(b, h, n, c, dv)
    cum = jnp.cumsum(log_f.astype(f32).reshape(b, h, n, c, dk), axis=3)
    lower = jnp.tril(jnp.ones((c, c), dtype=bool))[:, :, None]
    decay = jnp.exp(jnp.where(lower, cum[:, :, :, :, None, :] - cum[:, :, :, None, :, :], -jnp.inf))
    scores = jnp.einsum('bhntk,bhnsk,bhntsk->bhnts', q, k, decay)
    o_intra = jnp.einsum('bhnts,bhnsv->bhntv', scores, v)
    last = cum[:, :, :, -1:, :]
    d_state = jnp.einsum('bhnsk,bhnsv->bhnkv', k * jnp.exp(last - cum), v)
    chunk_decay = jnp.exp(last[:, :, :, 0, :])

    def step(state, inp):
        a, ds = inp
        return a[..., None] * state + ds, state

    s_final, s_before = lax.scan(step, s0.astype(f32), (jnp.moveaxis(chunk_decay, 2, 0), jnp.moveaxis(d_state, 2, 0)))
    s_before = jnp.moveaxis(s_before, 0, 2)
    o_inter = jnp.einsum('bhntk,bhnkv->bhntv', q * jnp.exp(cum), s_before)
    return (o_intra + o_inter).reshape(b, h, t, dv), s_final


def hgrn_parse(p, lb_fwd, lb_bwd):
    b, t, _ = p.shape
    q, f_fw, f_bw, i, g = jnp.split(p, [HGRN_KW, 2 * HGRN_KW, 3 * HGRN_KW, 3 * HGRN_KW + HGRN_VW], axis=-1)

    def heads(z):
        return z.reshape(b, t, HGRN_HEADS, -1).transpose(0, 2, 1, 3)

    def forget(z, lb):
        lb = lb.reshape(HGRN_HEADS, 1, HGRN_K_DIM)
        f = lb + (1.0 - lb) * jax.nn.sigmoid(heads(z).astype(jnp.float32))
        return jnp.log(f), 1.0 - f

    return heads(jax.nn.silu(q)), heads(i), forget(f_fw, lb_fwd), forget(f_bw, lb_bwd), g


def hgrn_bidir(q, v, fwd, bwd, s_fwd0, s_bwd0):
    log_f_fw, k_fw = fwd
    log_f_bw, k_bw = bwd
    o_fw, s_fw = gla_chunked(q, k_fw, v, log_f_fw, s_fwd0)

    def rev(z):
        return jnp.flip(z, axis=2)

    o_bw, s_bw = gla_chunked(rev(q), rev(k_bw), rev(v), rev(log_f_bw), s_bwd0)
    return o_fw + rev(o_bw), s_fw, s_bw


def hgrn_output(o, g, gain):
    b, h, t, dv = o.shape
    o = rmsnorm(o.transpose(0, 2, 1, 3).astype(g.dtype), gain)
    return (o * jax.nn.silu(g).reshape(b, t, h, dv)).reshape(b, t, h * dv)


def even_mixer(h_ctx, h_lat, w_in, w_out, q_gain, k_gain, lam_vecs, subln, lam_init, lb_fwd, lb_bwd, o_gain, rope, with_ctx_out):
    p_ctx = h_ctx @ w_in
    p_lat = h_lat @ w_in
    qa_c, ka_c, va_c = diff_heads(p_ctx[..., :DIFF_IN_W], q_gain, k_gain)
    qa_l, ka_l, va_l = diff_heads(p_lat[..., :DIFF_IN_W], q_gain, k_gain)
    qa_l = apply_axial_rope(qa_l, rope)
    ka_l = apply_axial_rope(ka_l, rope)
    lv = lam_vecs.astype(jnp.float32)
    lam = jnp.exp(jnp.sum(lv[0] * lv[1])) - jnp.exp(jnp.sum(lv[2] * lv[3])) + lam_init
    oa_l = diff_attention(qa_l, jnp.concatenate([ka_c, ka_l], axis=3), jnp.concatenate([va_c, va_l], axis=2), lam)
    qb_c, vb_c, fw_c, bw_c, g_c = hgrn_parse(p_ctx[..., DIFF_IN_W:], lb_fwd, lb_bwd)
    qb_l, vb_l, fw_l, bw_l, g_l = hgrn_parse(p_lat[..., DIFF_IN_W:], lb_fwd, lb_bwd)
    s0 = jnp.zeros((h_ctx.shape[0], HGRN_HEADS, HGRN_K_DIM, HGRN_V_DIM), jnp.float32)
    ob_c, s_fw, s_bw = hgrn_bidir(qb_c, vb_c, fw_c, bw_c, s0, s0)
    ob_l, _, _ = hgrn_bidir(qb_l, vb_l, fw_l, bw_l, s_fw, s_bw)
    out_lat = jnp.concatenate([diff_output(oa_l, subln, lam_init), hgrn_output(ob_l, g_l, o_gain)], axis=-1) @ w_out
    out_ctx = None
    if with_ctx_out:
        oa_c = diff_attention(qa_c, ka_c, va_c, lam)
        out_ctx = jnp.concatenate([diff_output(oa_c, subln, lam_init), hgrn_output(ob_c, g_c, o_gain)], axis=-1) @ w_out
    return out_ctx, out_lat


def mla_queries(c_q, q_a_gain, w_uq, qn_gain, qr_gain):
    b, t, _ = c_q.shape
    q = (rmsnorm(c_q, q_a_gain) @ w_uq).reshape(b, t, MLA_HEADS, MLA_NOPE + MLA_ROPE).transpose(0, 2, 1, 3)
    return rmsnorm(q[..., :MLA_NOPE], qn_gain), rmsnorm(q[..., MLA_NOPE:], qr_gain)


def mla_keys_values(c_kv, k_rope, kv_a_gain, w_ukv, kn_gain, kr_gain):
    b, t, _ = c_kv.shape
    kv = (rmsnorm(c_kv, kv_a_gain) @ w_ukv).reshape(b, t, MLA_HEADS, MLA_NOPE + MLA_V).transpose(0, 2, 1, 3)
    return rmsnorm(kv[..., :MLA_NOPE], kn_gain), rmsnorm(k_rope, kr_gain), kv[..., MLA_NOPE:]


def mla_attention(q_nope, q_rope, k_nope, k_rope, v):
    scale = (MLA_NOPE + MLA_ROPE) ** -0.5

    def block(qs):
        qn, qr = qs
        s = jnp.einsum('bhqd,bhkd->bhqk', qn, k_nope) + jnp.einsum('bhqd,bkd->bhqk', qr, k_rope)
        p = jax.nn.softmax(s.astype(jnp.float32) * scale, axis=-1)
        return jnp.einsum('bhqk,bhkv->bhqv', p.astype(v.dtype), v)

    return sweep_query_blocks(block, (q_nope, q_rope), axis=2)


def odd_mixer(h_ctx, h_lat, w_in, q_a_gain, kv_a_gain, w_uq, w_ukv, qn_gain, qr_gain, kn_gain, kr_gain, w_out, rope, with_ctx_out):
    ckv_c, kr_c = jnp.split(h_ctx @ w_in[:, MLA_Q_LORA:], [MLA_KV_LORA], axis=-1)
    kn_c, kr_c, v_c = mla_keys_values(ckv_c, kr_c, kv_a_gain, w_ukv, kn_gain, kr_gain)
    cq_l, ckv_l, kr_l = jnp.split(h_lat @ w_in, [MLA_Q_LORA, MLA_Q_LORA + MLA_KV_LORA], axis=-1)
    kn_l, kr_l, v_l = mla_keys_values(ckv_l, kr_l, kv_a_gain, w_ukv, kn_gain, kr_gain)
    kr_l = apply_axial_rope(kr_l, rope)
    qn_l, qr_l = mla_queries(cq_l, q_a_gain, w_uq, qn_gain, qr_gain)
    qr_l = apply_axial_rope(qr_l, rope)
    o_l = mla_attention(qn_l, qr_l, jnp.concatenate([kn_c, kn_l], axis=2), jnp.concatenate([kr_c, kr_l], axis=1), jnp.concatenate([v_c, v_l], axis=2))
    out_lat = merge_heads(o_l) @ w_out
    out_ctx = None
    if with_ctx_out:
        qn_c, qr_c = mla_queries(h_ctx @ w_in[:, :MLA_Q_LORA], q_a_gain, w_uq, qn_gain, qr_gain)
        out_ctx = merge_heads(mla_attention(qn_c, qr_c, kn_c, kr_c, v_c)) @ w_out
    return out_ctx, out_lat


def swiglu(t, w_gate, w_up, w_down):
    return (jax.nn.silu(t @ w_gate) * (t @ w_up)) @ w_down


def moe_ffn(h, router_w, router_bias, w_gate, w_up, w_down, sw_gate, sw_up, sw_down):
    shape = h.shape
    t = h.reshape(-1, shape[-1])
    scores = jax.nn.sigmoid((t @ router_w).astype(jnp.float32))
    biased = scores + router_bias.astype(jnp.float32)
    grouped = biased.reshape(-1, N_GROUPS, EXPERTS_PER_GROUP)
    group_score = jnp.sum(lax.top_k(grouped, TOP_K)[0], axis=-1)
    best_group = jnp.argmax(group_score, axis=-1)
    in_group = (jnp.arange(N_GROUPS) == best_group[:, None])[:, :, None]
    masked = jnp.where(in_group, grouped, -jnp.inf).reshape(-1, N_EXPERTS)
    _, top_idx = lax.top_k(masked, TOP_K)
    top_w = jnp.take_along_axis(scores, top_idx, axis=-1)
    top_w = top_w / jnp.sum(top_w, axis=-1, keepdims=True)
    gates = jnp.sum(jax.nn.one_hot(top_idx, N_EXPERTS, dtype=jnp.float32) * top_w[..., None], axis=1).astype(t.dtype)
    out = swiglu(t, sw_gate, sw_up, sw_down)
    for e in range(N_EXPERTS):
        out = out + gates[:, e:e + 1] * swiglu(t, w_gate[e], w_up[e], w_down[e])
    return out.reshape(shape)


def setup_inputs(seed: int = 0) -> dict:
    key = jax.random.key(seed)
    ks = jax.random.split(key, 40)
    f32 = jnp.float32

    def nrm(k, shape, scale=1.0):
        return jax.random.normal(k, shape, f32) * scale

    def gain(k, shape):
        return 1.0 + 0.05 * jax.random.normal(k, shape, f32)

    D = D_MODEL
    return {
        'x': nrm(ks[0], (BATCH, SEQ, D)),
        'c': nrm(ks[1], (BATCH, D)),
        'ctx': nrm(ks[2], (BATCH, CTX_LEN, D)),
        'c_ctx': nrm(ks[3], (D,)),
        'mod_w': nrm(ks[4], (DEPTH, D, 6 * D), 0.5 * D ** -0.5),
        'mod_b': nrm(ks[5], (DEPTH, 6 * D), 0.02),
        'norm_mix': gain(ks[6], (DEPTH, D)),
        'norm_ffn': gain(ks[7], (DEPTH, D)),
        'even_w_in': nrm(ks[8], (N_EVEN, D, EVEN_IN_W), D ** -0.5),
        'even_w_out': nrm(ks[9], (N_EVEN, EVEN_OUT_W, D), EVEN_OUT_W ** -0.5),
        'diff_q_gain': gain(ks[10], (N_EVEN, DIFF_HEAD_DIM)),
        'diff_k_gain': gain(ks[11], (N_EVEN, DIFF_HEAD_DIM)),
        'diff_lambda': nrm(ks[12], (N_EVEN, 4, DIFF_HEAD_DIM), 0.1),
        'diff_subln': gain(ks[13], (N_EVEN, DIFF_V_DIM)),
        'hgrn_lb_logits': nrm(ks[14], (N_EVEN + 1, 2, HGRN_KW), 0.5),
        'hgrn_out_gain': gain(ks[15], (N_EVEN, HGRN_V_DIM)),
        'odd_w_in': nrm(ks[16], (N_ODD, D, ODD_IN_W), D ** -0.5),
        'mla_q_a_gain': gain(ks[17], (N_ODD, MLA_Q_LORA)),
        'mla_kv_a_gain': gain(ks[18], (N_ODD, MLA_KV_LORA)),
        'mla_w_uq': nrm(ks[19], (N_ODD, MLA_Q_LORA, MLA_HEADS * (MLA_NOPE + MLA_ROPE)), MLA_Q_LORA ** -0.5),
        'mla_w_ukv': nrm(ks[20], (N_ODD, MLA_KV_LORA, MLA_HEADS * (MLA_NOPE + MLA_V)), MLA_KV_LORA ** -0.5),
        'mla_q_nope_gain': gain(ks[21], (N_ODD, MLA_NOPE)),
        'mla_q_rope_gain': gain(ks[22], (N_ODD, MLA_ROPE)),
        'mla_k_nope_gain': gain(ks[23], (N_ODD, MLA_NOPE)),
        'mla_k_rope_gain': gain(ks[24], (N_ODD, MLA_ROPE)),
        'odd_w_out': nrm(ks[25], (N_ODD, ODD_OUT_W, D), ODD_OUT_W ** -0.5),
        'router_w': nrm(ks[26], (D, N_EXPERTS), D ** -0.5),
        'router_bias': nrm(ks[27], (N_EXPERTS,), 0.01),
        'expert_w_gate': nrm(ks[28], (DEPTH, N_EXPERTS, D, EXPERT_FF), D ** -0.5),
        'expert_w_up': nrm(ks[29], (DEPTH, N_EXPERTS, D, EXPERT_FF), D ** -0.5),
        'expert_w_down': nrm(ks[30], (DEPTH, N_EXPERTS, EXPERT_FF, D), EXPERT_FF ** -0.5),
        'shared_w_gate': nrm(ks[31], (DEPTH, D, SHARED_FF), D ** -0.5),
        'shared_w_up': nrm(ks[32], (DEPTH, D, SHARED_FF), D ** -0.5),
        'shared_w_down': nrm(ks[33], (DEPTH, SHARED_FF, D), SHARED_FF ** -0.5),
    }


def reference(x, c, ctx, c_ctx, mod_w, mod_b, norm_mix, norm_ffn,
              even_w_in, even_w_out, diff_q_gain, diff_k_gain, diff_lambda, diff_subln, hgrn_lb_logits, hgrn_out_gain,
              odd_w_in, mla_q_a_gain, mla_kv_a_gain, mla_w_uq, mla_w_ukv, mla_q_nope_gain, mla_q_rope_gain,
              mla_k_nope_gain, mla_k_rope_gain, odd_w_out,
              router_w, router_bias, expert_w_gate, expert_w_up, expert_w_down, shared_w_gate, shared_w_up, shared_w_down):
    n_lat = x.shape[1]
    rope = axial_rope_tables(n_lat, DIFF_HEAD_DIM)
    lb_all = jnp.cumsum(jax.nn.softmax(hgrn_lb_logits.astype(jnp.float32), axis=0), axis=0)
    s_c = jax.nn.silu(c)
    s_ctx = jax.nn.silu(c_ctx)
    for layer in range(DEPTH):
        with_ctx_out = layer < DEPTH - 1
        j = layer // 2
        mod_lat = (s_c @ mod_w[layer] + mod_b[layer])[:, None, :]
        mod_ctx = s_ctx @ mod_w[layer] + mod_b[layer]
        sh_m, sc_m, g_m, sh_f, sc_f, g_f = jnp.split(mod_lat, 6, axis=-1)
        csh_m, csc_m, cg_m, csh_f, csc_f, cg_f = jnp.split(mod_ctx, 6, axis=-1)
        h_lat = rmsnorm(x, norm_mix[layer]) * (1.0 + sc_m) + sh_m
        h_ctx = rmsnorm(ctx, norm_mix[layer]) * (1.0 + csc_m) + csh_m
        if layer % 2 == 0:
            lam_init = 0.8 - 0.6 * math.exp(-0.3 * layer)
            mix_ctx, mix_lat = even_mixer(h_ctx, h_lat, even_w_in[j], even_w_out[j], diff_q_gain[j], diff_k_gain[j],
                                          diff_lambda[j], diff_subln[j], lam_init, lb_all[j, 0], lb_all[j, 1],
                                          hgrn_out_gain[j], rope, with_ctx_out)
        else:
            mix_ctx, mix_lat = odd_mixer(h_ctx, h_lat, odd_w_in[j], mla_q_a_gain[j], mla_kv_a_gain[j], mla_w_uq[j],
                                         mla_w_ukv[j], mla_q_nope_gain[j], mla_q_rope_gain[j], mla_k_nope_gain[j],
                                         mla_k_rope_gain[j], odd_w_out[j], rope, with_ctx_out)
        x = x + g_m * mix_lat
        hf = rmsnorm(x, norm_ffn[layer]) * (1.0 + sc_f) + sh_f
        x = x + g_f * moe_ffn(hf, router_w, router_bias, expert_w_gate[layer], expert_w_up[layer], expert_w_down[layer],
                              shared_w_gate[layer], shared_w_up[layer], shared_w_down[layer])
        if with_ctx_out:
            ctx = ctx + cg_m * mix_ctx
            hfc = rmsnorm(ctx, norm_ffn[layer]) * (1.0 + csc_f) + csh_f
            ctx = ctx + cg_f * moe_ffn(hfc, router_w, router_bias, expert_w_gate[layer], expert_w_up[layer],
                                       expert_w_down[layer], shared_w_gate[layer], shared_w_up[layer], shared_w_down[layer])
    return x
```

```cpp
#include <hip/hip_runtime.h>
#include <cstdio>
#include <cstdint>

#ifndef MK_N_LAUNCHES
#define MK_N_LAUNCHES 0
#endif

#define GAS __attribute__((address_space(1)))
#define LAS __attribute__((address_space(3)))
typedef unsigned short bf16;
typedef _Float16 f16;
typedef short bf16x8 __attribute__((ext_vector_type(8)));
typedef float f32x4 __attribute__((ext_vector_type(4)));
typedef float f32x2 __attribute__((ext_vector_type(2)));
typedef float f32x16 __attribute__((ext_vector_type(16)));
typedef unsigned v4u __attribute__((ext_vector_type(4)));
typedef unsigned v2u __attribute__((ext_vector_type(2)));
typedef GAS unsigned gu32;
#define RLX_AGENT __ATOMIC_RELAXED, __HIP_MEMORY_SCOPE_AGENT
#define LDS_WAIT() asm volatile("s_waitcnt lgkmcnt(0)" ::: "memory")
#define VM_WAIT() asm volatile("s_waitcnt vmcnt(0)" ::: "memory")

constexpr int NB = 8, SEQ = 2048, CTXL = 256, RPB = 2304  , NR = NB * RPB  , D = 1024;
constexpr int NT_ALL = NR / 256  , NT_LAT = 64;
constexpr int NEXP = 16, FF = 512;
constexpr int MP_MAX = 41216;
constexpr float EPS = 1e-6f;
constexpr float LOG2E = 1.4426950408889634f;
constexpr int NWAVES = 8, NTHREADS = 512;

constexpr size_t MiB = 1u << 20;
constexpr size_t WS_CTL = 0, CTL_ZERO_BYTES = 1 * MiB;
constexpr int CW_TMO = 0, CW_CODE = 1, CW_BAR = 4096, CW_CNT = 8192;
constexpr size_t WS_SMALL = 1 * MiB;
constexpr size_t SM_MODV = 0;
constexpr size_t SM_ROPER = 448 * 1024;
constexpr size_t SM_ROPEC = 452 * 1024;
constexpr size_t SM_LBV = 460 * 1024;
constexpr size_t SM_LAM = 464 * 1024;
constexpr size_t SM_ROUTE_E = 512 * 1024;
constexpr size_t SM_ROUTE_W = 584 * 1024;
constexpr size_t SM_ROUTE_S = 728 * 1024;
constexpr size_t SM_POS = 872 * 1024;
constexpr size_t SM_ROWIDX = 1016 * 1024;
constexpr size_t SM_SSQ = 1280 * 1024;
static_assert(SM_ROUTE_E + (size_t)NR * 4 <= SM_ROUTE_W && SM_ROUTE_W + (size_t)NR * 8 <= SM_ROUTE_S && SM_ROUTE_S + (size_t)NR * 8 <= SM_POS && SM_POS + (size_t)NR * 8 <= SM_ROWIDX &&
              SM_ROWIDX + (size_t)MP_MAX * 4 <= SM_SSQ && SM_SSQ + (size_t)NR * 48 <= 3 * MiB, "small map");
constexpr size_t WS_WIN0 = 4 * MiB, WS_WOUT0 = 12 * MiB, WS_WIN1 = 14 * MiB, WS_WUQ = 16 * MiB, WS_WUKV = 18 * MiB, WS_WOUT1 = 19 * MiB;
constexpr size_t WS_WGU = 22 * MiB;
constexpr size_t WS_WD = 90 * MiB;
constexpr size_t WS_XC = 124 * MiB;
constexpr size_t WS_H = 132 * MiB;
constexpr size_t WS_BIG = 168 * MiB;
constexpr size_t WS_END = 348 * MiB;
constexpr size_t SZ18 = 18 * MiB;
constexpr size_t B_QD = 0, B_KD = SZ18, B_VD = 2 * SZ18, B_HQ = 3 * SZ18, B_LF0 = 4 * SZ18, B_LF1 = 5 * SZ18, B_HV = 6 * SZ18, B_HG = 7 * SZ18, B_HO0 = 8 * SZ18, B_HO1 = 9 * SZ18;
constexpr size_t B_HS = 0, B_HE = 18 * MiB, B_YE = 60 * MiB;
static_assert(B_HE + (size_t)MP_MAX * 512 * 2 <= B_YE && B_YE + (size_t)MP_MAX * 1024 * 2 <= 180 * MiB, "moe map");
constexpr size_t B_CKV = 0, B_CQ = 9 * MiB, B_KR = 23 * MiB, B_Q1 = 26 * MiB, B_KN = 80 * MiB, B_V1 = 116 * MiB;

constexpr int LDS_BYTES = 155648;
constexpr int LDS_MISC = 131072;
constexpr int LDS_XCH = 132096;

__device__ __forceinline__ unsigned f2bf(float f) { unsigned u = __builtin_bit_cast(unsigned, f); return (u + 0x7fffu + ((u >> 16) & 1u)) >> 16; }
__device__ __forceinline__ unsigned pk2(float lo, float hi) { return f2bf(lo) | (f2bf(hi) << 16); }
__device__ __forceinline__ float bf2f(bf16 h) { return __builtin_bit_cast(float, (unsigned)h << 16); }
__device__ __forceinline__ float bflo(unsigned w) { return __builtin_bit_cast(float, w << 16); }
__device__ __forceinline__ float bfhi(unsigned w) { return __builtin_bit_cast(float, w & 0xffff0000u); }
__device__ __forceinline__ unsigned pkh2(float lo, float hi) { f16 a = (f16)lo, b = (f16)hi; return (unsigned)__builtin_bit_cast(unsigned short, a) | ((unsigned)__builtin_bit_cast(unsigned short, b) << 16); }
__device__ __forceinline__ float fexp(float x) { return __builtin_amdgcn_exp2f(x * LOG2E); }
__device__ __forceinline__ float sigmoidf_(float x) { return 1.0f / (1.0f + fexp(-x)); }
__device__ __forceinline__ float siluf_(float x) { return x / (1.0f + fexp(-x)); }
__device__ __forceinline__ float wave_sum(float v) {
#pragma unroll
    for (int o = 1; o < 64; o <<= 1) v += __shfl_xor(v, o);
    return v;
}
__host__ __device__ __forceinline__ int perm32(int rho) { const int n = rho >> 4, i = rho & 15; return 8 * (i >> 2) + 4 * n + (i & 3); }
__host__ __device__ __forceinline__ int ddmap(int j) { return 16 * ((j >> 2) & 1) + 4 * (j >> 3) + (j & 3); }
__device__ __forceinline__ int opaque(int x) { asm volatile("" : "+v"(x)); return x; }
__device__ __forceinline__ int crow(int r, int hi) { return (r & 3) + 8 * (r >> 2) + 4 * hi; }

#define XB_TMO      128
#define XB_XCNT(j)  (256  + 64 * (j))
#define XB_XSUB(j)  (1280 + 64 * (j))
#define XB_XGEN(j)  (2304 + 64 * (j))
#define XB_TOP      3328
#define XB_TOPGEN   3392
#define XCD_BAR_WORDS 3456
#define XB_SPIN_CAP (1u << 18)
__device__ __forceinline__ unsigned xb_ld(unsigned* p)              { return __hip_atomic_load(p, __ATOMIC_RELAXED, __HIP_MEMORY_SCOPE_AGENT); }
__device__ __forceinline__ unsigned xb_add(unsigned* p, unsigned v) { return __hip_atomic_fetch_add(p, v, __ATOMIC_RELAXED, __HIP_MEMORY_SCOPE_AGENT); }
__device__ __forceinline__ unsigned xb_xcc_id() { return (unsigned)__builtin_amdgcn_s_getreg((3 << 11) | 20) & 0xFu; }
#define XB_SPIN(cond, bar) do { unsigned _sp = 0; while (cond) { __builtin_amdgcn_s_sleep(1); \
    if ((++_sp & 255u) == 0u) { if (xb_ld(&(bar)[XB_TMO])) break; if (_sp > XB_SPIN_CAP) { atomicAdd(&(bar)[XB_TMO], 1u); break; } } } } while (0)
struct XcdBarrier { unsigned* bar; unsigned x; volatile LAS unsigned* st; };
__device__ __forceinline__ XcdBarrier xcd_barrier_post(unsigned* bar, volatile LAS unsigned* st) {
    XcdBarrier b; b.bar = bar; b.x = xb_xcc_id(); b.st = st;
    if (threadIdx.x == 0) (void)xb_add(&bar[XB_XCNT(b.x)], 1u);
    return b;
}
__device__ __forceinline__ void xcd_barrier_complete(unsigned* bar, unsigned x, unsigned& nloc, unsigned& nx) {
    const unsigned G = gridDim.x * gridDim.y * gridDim.z;
    unsigned sum, cnt, mine, sp = 0u;
    for (;;) {
        sum = 0u; cnt = 0u; mine = 0u;
#pragma unroll
        for (unsigned j = 0; j < 16; ++j) { const unsigned c = xb_ld(&bar[XB_XCNT(j)]); sum += c; cnt += (c > 0u) ? 1u : 0u; mine = (j == x) ? c : mine; }
        if (sum == G) break;
        __builtin_amdgcn_s_sleep(1);
        if ((++sp & 255u) == 0u) { if (xb_ld(&bar[XB_TMO])) break; if (sp > XB_SPIN_CAP) { atomicAdd(&bar[XB_TMO], 1u); break; } }
    }
    nloc = mine > 0u ? mine : 1u; nx = cnt > 0u ? cnt : 1u;
}
__device__ __forceinline__ void xcd_barrier(const XcdBarrier& b) {
    asm volatile("s_waitcnt vmcnt(0)" ::: "memory");
    __syncthreads();
    if (threadIdx.x == 0) {
        unsigned* bar = b.bar;
        __builtin_amdgcn_s_waitcnt(0);
        unsigned nloc = b.st[0], nx = b.st[1];
        if (nloc == 0u) { xcd_barrier_complete(bar, b.x, nloc, nx); b.st[0] = nloc; b.st[1] = nx; }
        const unsigned old = xb_add(&bar[XB_XSUB(b.x)], 1u);
        const unsigned gen = old / nloc;
        if (old + 1u == (gen + 1u) * nloc) {
            __builtin_amdgcn_fence(__ATOMIC_RELEASE, "agent");
            asm volatile("s_waitcnt vmcnt(0)" ::: "memory");
            const unsigned og = xb_add(&bar[XB_TOP], 1u);
            const unsigned tg = og / nx;
            if (og + 1u == (tg + 1u) * nx) xb_add(&bar[XB_TOPGEN], 1u);
            else XB_SPIN(xb_ld(&bar[XB_TOPGEN]) == tg, bar);
            __builtin_amdgcn_fence(__ATOMIC_ACQUIRE, "agent");
            xb_add(&bar[XB_XGEN(b.x)], 1u);
            asm volatile("s_waitcnt vmcnt(0)" ::: "memory");
        } else {
            XB_SPIN(xb_ld(&bar[XB_XGEN(b.x)]) == gen, bar);
            __builtin_amdgcn_fence(__ATOMIC_ACQUIRE, "agent");
            asm volatile("s_waitcnt vmcnt(0)" ::: "memory");
        }
    }
    __syncthreads();
}

struct Args { const float* in[34]; float* out; unsigned char* ws; int ph_lo, ph_hi; };

struct Frame {
    LAS unsigned char* lds;
    int tid, lane, wave, G, bid;
    const float* in[34];
    float* out; unsigned char* ws;
    gu32* ctl;
    float* modv; f32x2* ropeR; f32x2* ropeC; float* lbv; float* lamv;
    int* route_e; float* route_w; int* route_s; int* pos; int* rowidx; float* ssq;
    bf16 *Win0, *Wout0, *Win1, *Wuq, *Wukv, *Wout1, *Wgu, *Wd;
    float* xc; bf16* H; unsigned char* big;
};
enum { I_X = 0, I_C, I_CTX, I_CCTX, I_MODW, I_MODB, I_NMIX, I_NFFN, I_EWIN, I_EWOUT, I_DQG, I_DKG, I_DLAM, I_DSUBLN, I_LBL, I_HOG, I_OWIN, I_QAG, I_KVAG, I_WUQ, I_WUKV,
       I_QNG, I_QRG, I_KNG, I_KRG, I_OWOUT, I_RW, I_RB, I_EG, I_EU, I_ED, I_SG, I_SU, I_SD };

__device__ __forceinline__ float* xrow_ptr(const Frame& F, int b, int s) { return s < CTXL ? F.xc + (size_t)(b * CTXL + s) * D : F.out + (size_t)(b * SEQ + s - CTXL) * D; }
__device__ __forceinline__ const float* xin_ptr(const Frame& F, int b, int s) { return s < CTXL ? F.in[I_CTX] + (size_t)(b * CTXL + s) * D : F.in[I_X] + (size_t)(b * SEQ + s - CTXL) * D; }

__device__ __forceinline__ void p0_transpose_item(const float* W, int ldn, int srccol0, bool perm, const float* kscale, bf16* WT  , int K, int k0, LAS float* scr, int lane) {
    if (srccol0 >= 0) {
#pragma unroll 8
        for (int i = 0; i < 32; ++i) { const int kk = 2 * i + (lane >> 5); float v = W[(size_t)(k0 + kk) * ldn + srccol0 + (lane & 31)]; if (kscale) v *= kscale[k0 + kk]; scr[kk * 33 + (lane & 31)] = v; }
    } else {
#pragma unroll 8
        for (int i = 0; i < 32; ++i) { const int kk = 2 * i + (lane >> 5); scr[kk * 33 + (lane & 31)] = 0.f; }
    }
    LDS_WAIT(); asm volatile("" ::: "memory");
    const int c = lane & 7;
#pragma unroll
    for (int j = 0; j < 4; ++j) { const int n = (lane >> 3) + 8 * j; const int sn = perm ? ddmap(n) : n; const LAS float* s = scr + (8 * c) * 33 + sn;
        v4u o; o.x = pk2(s[0 * 33], s[1 * 33]); o.y = pk2(s[2 * 33], s[3 * 33]); o.z = pk2(s[4 * 33], s[5 * 33]); o.w = pk2(s[6 * 33], s[7 * 33]);
        *(GAS v4u*)(WT + (size_t)n * K + k0 + 8 * c) = o; }
    LDS_WAIT(); asm volatile("" ::: "memory");
}

__device__ __forceinline__ void p0_convert_item(Frame& F, int it, LAS float* scr) {
    const int lane = F.lane;
    if (it < 2048) {
        const int kb = it >> 7, tb = it & 127, pn = tb >> 3, blk = tb & 7, bj = blk >> 2, wc = blk & 3;
        int sb; bool perm = false;
        if (pn < 4) { sb = pn * 8 + 2 * wc + bj; perm = true; } else sb = tb;
        p0_transpose_item(F.in[I_EWIN], 4096, sb * 32, perm, nullptr, F.Win0 + (size_t)tb * 32 * 1024, 1024, kb * 64, scr, lane); return; }
    it -= 2048;
    if (it < 512) { const int kb = it >> 5, tb = it & 31; p0_transpose_item(F.in[I_EWOUT], 1024, tb * 32, false, nullptr, F.Wout0 + (size_t)tb * 32 * 1024, 1024, kb * 64, scr, lane); return; }
    it -= 512;
    if (it < 384) {
        const int kb = it / 24, tb = it % 24; int sc; bool perm = false;
        if (tb < 8) sc = 384 + tb * 32;
        else if (tb < 16) sc = (tb - 8) * 32;
        else { const int blk = tb - 16, bj = blk >> 2, wc = blk & 3;
            if (bj == 0) { if (wc < 3) sc = 256 + wc * 32; else { sc = 640; perm = true; } }
            else { if (wc == 0) sc = 352; else if (wc == 3) { sc = 672; perm = true; } else sc = -1; } }
        p0_transpose_item(F.in[I_OWIN], 704, sc, perm, nullptr, F.Win1 + (size_t)tb * 32 * 1024, 1024, kb * 64, scr, lane); return; }
    it -= 384;
    if (it < 288) {
        const int kb = it / 48, tb = it % 48, t = tb >> 3, blk = tb & 7, bj = blk >> 2, wc = blk & 3; int sc; bool perm = false;
        if (t < 4) { const int h = 2 * t + bj; sc = h * 192 + 32 * wc; }
        else { const int h = 4 * (t - 4) + wc; sc = h * 192 + 128 + 32 * bj; perm = true; }
        p0_transpose_item(F.in[I_WUQ], 1536, sc, perm, F.in[I_QAG], F.Wuq + (size_t)tb * 32 * 384, 384, kb * 64, scr, lane); return; }
    it -= 288;
    if (it < 256) { const int kb = it >> 6, tb = it & 63; p0_transpose_item(F.in[I_WUKV], 2048, tb * 32, false, F.in[I_KVAG], F.Wukv + (size_t)tb * 32 * 256, 256, kb * 64, scr, lane); return; }
    it -= 256;
    if (it < 512) { const int kb = it >> 5, tb = it & 31; p0_transpose_item(F.in[I_OWOUT], 1024, tb * 32, false, nullptr, F.Wout1 + (size_t)tb * 32 * 1024, 1024, kb * 64, scr, lane); return; }
    it -= 512;
    {
        const int le = it / 768, r2 = it % 768, l = le / 17, e = le % 17;
        if (r2 < 512) { const int kb = r2 >> 5, tb = r2 & 31, pnl = tb >> 3, blk = tb & 7, bj = blk >> 2, wcb = blk & 3;
            const float* src = (e < 16) ? (bj ? F.in[I_EU] : F.in[I_EG]) + (size_t)(l * 16 + e) * 1024 * 512 : (bj ? F.in[I_SU] : F.in[I_SG]) + (size_t)l * 1024 * 512;
            p0_transpose_item(src, 512, (pnl * 4 + wcb) * 32, false, nullptr, F.Wgu + ((size_t)(l * 17 + e) * 1024 + tb * 32) * 1024, 1024, kb * 64, scr, lane); }
        else { const int r3 = r2 - 512, kb = r3 >> 5, tb = r3 & 31;
            const float* src = (e < 16) ? F.in[I_ED] + (size_t)(l * 16 + e) * 512 * 1024 : F.in[I_SD] + (size_t)l * 512 * 1024;
            p0_transpose_item(src, 1024, tb * 32, false, nullptr, F.Wd + ((size_t)(l * 17 + e) * 1024 + tb * 32) * 512, 512, kb * 64, scr, lane); }
    }
}
constexpr int P0_NITEMS = 2048 + 512 + 384 + 288 + 256 + 512 + 2 * 17 * 768;

__device__ __forceinline__ void p0_prologue(Frame& F) {
    LAS float* ldsf = (LAS float*)F.lds;
    for (int it = F.bid; it < 192; it += F.G) {
        const int l = it / 96, n0 = (it % 96) * 64;
        LAS float* sc = ldsf;
        LAS float* red = ldsf + 9 * 1024;
        for (int e = F.tid; e < 9 * 1024; e += NTHREADS) { const int r = e >> 10, k = e & 1023; const float v = (r < 8) ? F.in[I_C][r * 1024 + k] : F.in[I_CCTX][k]; sc[e] = siluf_(v); }
        __syncthreads();
        float a[9];
#pragma unroll
        for (int r = 0; r < 9; ++r) a[r] = 0.f;
        const float* w = F.in[I_MODW] + (size_t)l * 1024 * 6144 + n0 + F.lane;
        const int kbeg = F.wave * 128;
#pragma unroll 4
        for (int k = kbeg; k < kbeg + 128; ++k) { const float wv = w[(size_t)k * 6144];
#pragma unroll
            for (int r = 0; r < 9; ++r) a[r] += sc[r * 1024 + k] * wv; }
#pragma unroll
        for (int r = 0; r < 9; ++r) red[(F.wave * 9 + r) * 64 + F.lane] = a[r];
        __syncthreads();
        for (int e = F.tid; e < 9 * 64; e += NTHREADS) { const int r = e >> 6, c = e & 63; float s = 0.f;
#pragma unroll
            for (int w8 = 0; w8 < 8; ++w8) s += red[(w8 * 9 + r) * 64 + c];
            F.modv[(size_t)(l * 9 + r) * 6144 + n0 + c] = s + F.in[I_MODB][l * 6144 + n0 + c]; }
        __syncthreads();
    }
    if (F.bid == F.G - 1) {
        for (int e = F.tid; e < 96 * 16; e += NTHREADS) { const int p = e >> 4, i = e & 15;
            const float inv = __builtin_amdgcn_exp2f(-(float)(2 * i) * (1.0f / 32.0f) * 13.287712379549449f);
            const float pos = (p < 32) ? (float)p : (float)(p - 32); const float ang = pos * inv;
            const f32x2 cs = {__cosf(ang), __sinf(ang)};
            if (p < 32) F.ropeR[p * 16 + i] = cs; else F.ropeC[(p - 32) * 16 + i] = cs; }
        for (int e = F.tid; e < 1024; e += NTHREADS) { const float l0 = F.in[I_LBL][e], l1 = F.in[I_LBL][1024 + e]; F.lbv[e] = 1.0f / (1.0f + fexp(l1 - l0)); }
        if (F.wave == 0) { const float* lv = F.in[I_DLAM]; float s1 = wave_sum(lv[F.lane] * lv[64 + F.lane]), s2 = wave_sum(lv[128 + F.lane] * lv[192 + F.lane]);
            if (F.lane == 0) { F.lamv[0] = fexp(s1) - fexp(s2) + 0.2f; } }
    }
    __syncthreads();
    LAS float* scr = (LAS float*)(F.lds + F.wave * 8704);
    const int gw = F.bid * NWAVES + F.wave, NGW = F.G * NWAVES;
    for (int it = gw; it < P0_NITEMS; it += NGW) p0_convert_item(F, it, scr);
}

__device__ __forceinline__ void modnorm_store(const f32x4 (&v)[4], const float* gain, const float* sh, const float* sc, bf16* orow, int lane) {
    float s = 0.f;
#pragma unroll
    for (int j = 0; j < 4; ++j) s += (v[j].x * v[j].x + v[j].y * v[j].y) + (v[j].z * v[j].z + v[j].w * v[j].w);
    const float rstd = 1.0f / sqrtf(wave_sum(s) * (1.0f / D) + EPS);
#pragma unroll
    for (int j = 0; j < 4; ++j) { const int c = 4 * (lane + 64 * j);
        const f32x4 g = *(const f32x4*)(gain + c), a = *(const f32x4*)(sc + c), b = *(const f32x4*)(sh + c);
        const f32x4 y = (v[j] * rstd) * g * (1.0f + a) + b;
        v2u o; o.x = pk2(y.x, y.y); o.y = pk2(y.z, y.w); *(v2u*)(orow + c) = o; }
}

__device__ __forceinline__ void p_norm0(Frame& F) {
    const int gw = F.bid * NWAVES + F.wave, NGW = F.G * NWAVES;
    for (int R = gw; R < NR; R += NGW) {
        const int b = R / RPB, s = R - b * RPB, r = s < CTXL ? 8 : b;
        const f32x4* src = (const f32x4*)xin_ptr(F, b, s) + F.lane;
        f32x4 v[4];
#pragma unroll
        for (int j = 0; j < 4; ++j) v[j] = src[64 * j];
        const float* mv = F.modv + (size_t)(0 * 9 + r) * 6144;
        modnorm_store(v, F.in[I_NMIX], mv + 0, mv + 1024, F.H + (size_t)R * D, F.lane);
    }
}

__device__ __forceinline__ void p_hgrn_post(Frame& F) {
    const int gw = F.bid * NWAVES + F.wave, NGW = F.G * NWAVES;
    const bf16* Ho0 = (const bf16*)(F.big + B_HO0); const bf16* Ho1 = (const bf16*)(F.big + B_HO1); const bf16* Hg = (const bf16*)(F.big + B_HG);
    for (int R = gw; R < NR; R += NGW) {
        const int c = F.lane * 8;
        const v4u a = *(const v4u*)(Ho0 + (size_t)R * 512 + c), bq = *(const v4u*)(Ho1 + (size_t)R * 512 + c), g = *(const v4u*)(Hg + (size_t)R * 512 + c);
        float o[8];
        o[0] = bflo(a.x) + bflo(bq.x); o[1] = bfhi(a.x) + bfhi(bq.x); o[2] = bflo(a.y) + bflo(bq.y); o[3] = bfhi(a.y) + bfhi(bq.y);
        o[4] = bflo(a.z) + bflo(bq.z); o[5] = bfhi(a.z) + bfhi(bq.z); o[6] = bflo(a.w) + bflo(bq.w); o[7] = bfhi(a.w) + bfhi(bq.w);
        float s = 0.f;
#pragma unroll
        for (int i = 0; i < 8; ++i) s += o[i] * o[i];
        s += __shfl_xor(s, 1); s += __shfl_xor(s, 2); s += __shfl_xor(s, 4); s += __shfl_xor(s, 8);
        const float rstd = 1.0f / sqrtf(s * (1.0f / 128.0f) + EPS);
        const float* og = F.in[I_HOG] + (c & 127);
        const float gg[8] = {bflo(g.x), bfhi(g.x), bflo(g.y), bfhi(g.y), bflo(g.z), bfhi(g.z), bflo(g.w), bfhi(g.w)};
        float y[8];
#pragma unroll
        for (int i = 0; i < 8; ++i) y[i] = o[i] * rstd * og[i] * gg[i];
        v4u w; w.x = pk2(y[0], y[1]); w.y = pk2(y[2], y[3]); w.z = pk2(y[4], y[5]); w.w = pk2(y[6], y[7]);
        *(v4u*)(F.H + (size_t)R * D + 512 + c) = w;
    }
}

__device__ __forceinline__ void p_norm_route(Frame& F, int layer, bool lat_only) {
    const int gw = F.bid * NWAVES + F.wave, NGW = F.G * NWAVES;
    const float* rw = F.in[I_RW];
    unsigned* cnt = (unsigned*)(F.ctl + CW_CNT + 64 * layer);
    for (int R = gw; R < NR; R += NGW) {
        const int b = R / RPB, s = R - b * RPB, r = s < CTXL ? 8 : b;
        if (lat_only && s < CTXL) continue;
        const f32x4* src = (const f32x4*)xrow_ptr(F, b, s) + F.lane;
        f32x4 v[4];
#pragma unroll
        for (int j = 0; j < 4; ++j) v[j] = src[64 * j];
        const float* mv = F.modv + (size_t)(layer * 9 + r) * 6144;
        const float* gain = F.in[I_NFFN] + layer * 1024; const float* sh = mv + 3072; const float* sc = mv + 4096;
        float ss = 0.f;
#pragma unroll
        for (int j = 0; j < 4; ++j) ss += (v[j].x * v[j].x + v[j].y * v[j].y) + (v[j].z * v[j].z + v[j].w * v[j].w);
        const float rstd = 1.0f / sqrtf(wave_sum(ss) * (1.0f / D) + EPS);
        float lg[16];
#pragma unroll
        for (int e = 0; e < 16; ++e) lg[e] = 0.f;
#pragma unroll
        for (int j = 0; j < 4; ++j) { const int c = 4 * (F.lane + 64 * j);
            const f32x4 g = *(const f32x4*)(gain + c), a = *(const f32x4*)(sc + c), bb = *(const f32x4*)(sh + c);
            const f32x4 y = (v[j] * rstd) * g * (1.0f + a) + bb;
            v2u o; o.x = pk2(y.x, y.y); o.y = pk2(y.z, y.w); *(v2u*)(F.H + (size_t)R * D + c) = o;
#pragma unroll
            for (int q = 0; q < 4; ++q) { const float yv = y[q]; const f32x4* wr = (const f32x4*)(rw + (size_t)(c + q) * 16);
                const f32x4 w0 = wr[0], w1 = wr[1], w2 = wr[2], w3 = wr[3];
                lg[0] += yv * w0.x; lg[1] += yv * w0.y; lg[2] += yv * w0.z; lg[3] += yv * w0.w;
                lg[4] += yv * w1.x; lg[5] += yv * w1.y; lg[6] += yv * w1.z; lg[7] += yv * w1.w;
                lg[8] += yv * w2.x; lg[9] += yv * w2.y; lg[10] += yv * w2.z; lg[11] += yv * w2.w;
                lg[12] += yv * w3.x; lg[13] += yv * w3.y; lg[14] += yv * w3.z; lg[15] += yv * w3.w; } }
#pragma unroll
        for (int e = 0; e < 16; ++e) lg[e] = wave_sum(lg[e]);
        float scv[16], bi[16];
#pragma unroll
        for (int e = 0; e < 16; ++e) { scv[e] = sigmoidf_(lg[e]); bi[e] = scv[e] + F.in[I_RB][e]; }
        float bestgs = -3.0e38f; int e1 = 0, e2 = 1; float w1 = 0.f, w2 = 0.f;
#pragma unroll
        for (int g = 0; g < 4; ++g) {
            const float x0 = bi[4 * g], x1 = bi[4 * g + 1], x2 = bi[4 * g + 2], x3 = bi[4 * g + 3];
            const float gs = fmaxf(fmaxf(fmaxf(x0 + x1, x0 + x2), fmaxf(x0 + x3, x1 + x2)), fmaxf(x1 + x3, x2 + x3));
            int i1 = 0; float m1 = x0;
            if (x1 > m1) { m1 = x1; i1 = 1; } if (x2 > m1) { m1 = x2; i1 = 2; } if (x3 > m1) { m1 = x3; i1 = 3; }
            int i2 = -1; float m2 = -3.0e38f;
            if (i1 != 0 && x0 > m2) { m2 = x0; i2 = 0; } if (i1 != 1 && x1 > m2) { m2 = x1; i2 = 1; } if (i1 != 2 && x2 > m2) { m2 = x2; i2 = 2; } if (i1 != 3 && x3 > m2) { m2 = x3; i2 = 3; }
            const float s0 = scv[4 * g], s1 = scv[4 * g + 1], s2 = scv[4 * g + 2], s3 = scv[4 * g + 3];
            const float wa = i1 == 0 ? s0 : i1 == 1 ? s1 : i1 == 2 ? s2 : s3;
            const float wb = i2 == 0 ? s0 : i2 == 1 ? s1 : i2 == 2 ? s2 : s3;
            if (gs > bestgs) { bestgs = gs; e1 = 4 * g + i1; e2 = 4 * g + i2; w1 = wa; w2 = wb; }
        }
        const float wn = 1.0f / (w1 + w2); w1 *= wn; w2 *= wn;
        if (F.lane == 0) {
            const unsigned s1 = __hip_atomic_fetch_add(cnt + e1, 1u, RLX_AGENT), s2 = __hip_atomic_fetch_add(cnt + e2, 1u, RLX_AGENT);
            F.route_e[R] = e1 | (e2 << 8); F.route_w[2 * R] = w1; F.route_w[2 * R + 1] = w2; F.route_s[2 * R] = (int)s1; F.route_s[2 * R + 1] = (int)s2;
        }
    }
}

struct ExpOff { int off[17]; };
__device__ __forceinline__ void load_expoff(Frame& F, int layer, ExpOff& eo) {
    const unsigned* cnt = (const unsigned*)(F.ctl + CW_CNT + 64 * layer); int a = 0;
#pragma unroll
    for (int e = 0; e < 16; ++e) { eo.off[e] = a; const int c = (int)__hip_atomic_load(cnt + e, RLX_AGENT); a += (c + 255) & ~255; }
    eo.off[16] = a;
}
__device__ __forceinline__ int expoff_sel(const ExpOff& eo, int e) { int r = 0;
#pragma unroll
    for (int i = 0; i < 16; ++i) r = (e == i) ? eo.off[i] : r;
    return r; }

__device__ __forceinline__ void p_lists(Frame& F, int layer, bool lat_only) {
    ExpOff eo; load_expoff(F, layer, eo);
    const unsigned* cnt = (const unsigned*)(F.ctl + CW_CNT + 64 * layer);
    const int gt = F.bid * NTHREADS + F.tid, NGT = F.G * NTHREADS;
    for (int R = gt; R < NR; R += NGT) {
        const int s = R % RPB; if (lat_only && s < CTXL) continue;
        const int ee = F.route_e[R], e1 = ee & 255, e2 = ee >> 8;
        const int p1 = expoff_sel(eo, e1) + F.route_s[2 * R], p2 = expoff_sel(eo, e2) + F.route_s[2 * R + 1];
        F.rowidx[p1] = R; F.rowidx[p2] = R; F.pos[2 * R] = p1; F.pos[2 * R + 1] = p2;
    }
    if (F.bid < 16) { const int e = F.bid; const int c = (int)__hip_atomic_load(cnt + e, RLX_AGENT); const int o = expoff_sel(eo, e);
        for (int p = o + c + F.tid; p < o + ((c + 255) & ~255); p += NTHREADS) F.rowidx[p] = lat_only ? CTXL : 0; }
}

__device__ __forceinline__ void p_combine(Frame& F, int layer, bool lat_only, bool do_norm) {
    const int gw = F.bid * NWAVES + F.wave, NGW = F.G * NWAVES;
    const bf16* Ye = (const bf16*)(F.big + B_YE);
    for (int R = gw; R < NR; R += NGW) {
        const int b = R / RPB, s = R - b * RPB, r = s < CTXL ? 8 : b;
        if (lat_only && s < CTXL) continue;
        float* xr = xrow_ptr(F, b, s);
        const float* gf = F.modv + (size_t)(layer * 9 + r) * 6144 + 5120;
        const int p1 = F.pos[2 * R], p2 = F.pos[2 * R + 1]; const float w1 = F.route_w[2 * R], w2 = F.route_w[2 * R + 1];
        f32x4 v[4];
#pragma unroll
        for (int j = 0; j < 4; ++j) { const int c = 4 * (F.lane + 64 * j);
            const f32x4 x = *(const f32x4*)(xr + c), g = *(const f32x4*)(gf + c);
            const v2u a = *(const v2u*)(Ye + (size_t)p1 * D + c), bq = *(const v2u*)(Ye + (size_t)p2 * D + c);
            f32x4 m; m.x = w1 * bflo(a.x) + w2 * bflo(bq.x); m.y = w1 * bfhi(a.x) + w2 * bfhi(bq.x); m.z = w1 * bflo(a.y) + w2 * bflo(bq.y); m.w = w1 * bfhi(a.y) + w2 * bfhi(bq.y);
            v[j] = x + g * m; *(f32x4*)(xr + c) = v[j]; }
        if (do_norm) { const float* mv = F.modv + (size_t)((layer + 1) * 9 + r) * 6144;
            modnorm_store(v, F.in[I_NMIX] + (layer + 1) * 1024, mv + 0, mv + 1024, F.H + (size_t)R * D, F.lane); }
    }
}

struct Unit { int pm, pn; };
struct Gemm { const bf16* A; const bf16* Bt; int K; const int* gather; };
template <class Epi, class Sched>
__device__ __forceinline__ void gemm_v0(const Gemm g, const Sched& S, const Epi& E) {
    const int tid = threadIdx.x, wid = __builtin_amdgcn_readfirstlane(tid >> 6), lane = tid & 63, wr = wid >> 2, wc = wid & 3, fr = lane & 15, fq = lane >> 4;
    const int K = g.K;
    Unit u;
    for (int i = 0; S.next(i, u); ++i) {
        f32x4 acc[2][2][4][2];
#pragma unroll
        for (int a = 0; a < 2; ++a)
#pragma unroll
            for (int b = 0; b < 2; ++b)
#pragma unroll
                for (int m = 0; m < 4; ++m)
#pragma unroll
                    for (int n = 0; n < 2; ++n) acc[a][b][m][n] = (f32x4){0.f, 0.f, 0.f, 0.f};
        unsigned aoff[2][4], boff[2][2];
#pragma unroll
        for (int ai = 0; ai < 2; ++ai)
#pragma unroll
            for (int m = 0; m < 4; ++m) { const int rr = u.pm * 256 + ai * 128 + wr * 64 + m * 16 + fr; const int arow = g.gather ? g.gather[rr] : rr; aoff[ai][m] = (unsigned)arow * (unsigned)K * 2u + fq * 16u; }
#pragma unroll
        for (int bj = 0; bj < 2; ++bj)
#pragma unroll
            for (int n = 0; n < 2; ++n) { const int rho = 16 * n + fr; const int brow = u.pn * 256 + bj * 128 + wc * 32 + (Epi::PERM ? perm32(rho) : rho); boff[bj][n] = (unsigned)brow * (unsigned)K * 2u + fq * 16u; }
        const char* Ab = (const char*)g.A; const char* Bb = (const char*)g.Bt;
        for (int kt = 0; kt < K; kt += 32) {
            bf16x8 b[2][2];
#pragma unroll
            for (int bj = 0; bj < 2; ++bj)
#pragma unroll
                for (int n = 0; n < 2; ++n) b[bj][n] = *(const bf16x8*)(Bb + boff[bj][n] + kt * 2);
#pragma unroll
            for (int ai = 0; ai < 2; ++ai) {
                bf16x8 a[4];
#pragma unroll
                for (int m = 0; m < 4; ++m) a[m] = *(const bf16x8*)(Ab + aoff[ai][m] + kt * 2);
#pragma unroll
                for (int bj = 0; bj < 2; ++bj)
#pragma unroll
                    for (int m = 0; m < 4; ++m)
#pragma unroll
                        for (int n = 0; n < 2; ++n) acc[ai][bj][m][n] = __builtin_amdgcn_mfma_f32_16x16x32_bf16(b[bj][n], a[m], acc[ai][bj][m][n], 0, 0, 0);
                asm volatile("" ::: "memory");
            }
        }
        E(acc, u, wr, wc, fr, fq);
    }
}

struct SchedGrid {
    int nm, nn, G, c; bool lat;
    __device__ __forceinline__ bool next(int i, Unit& u) const { const int L = i * G + c; if (L >= nm * nn) return false; int pm = L / nn; u.pn = L - pm * nn; if (lat) pm = (pm >> 3) * 9 + 1 + (pm & 7); u.pm = pm; return true; }
};
struct SchedRouted {
    ExpOff eo; int G, c;
    __device__ __forceinline__ bool next(int i, Unit& u) const { const int L = i * G + c; const int nt = eo.off[16] >> 8; if (L >= nt * 4) return false; const int pm = L >> 2, pnl = L & 3; int e = 0;
#pragma unroll
        for (int k = 1; k < 16; ++k) e += (pm * 256 >= eo.off[k]) ? 1 : 0;
        u.pm = pm; u.pn = e * 4 + pnl; return true; }
};

__device__ __forceinline__ v4u pack8(const f32x4 a, const f32x4 b) { v4u w; w.x = pk2(a[0], a[1]); w.y = pk2(a[2], a[3]); w.z = pk2(b[0], b[1]); w.w = pk2(b[2], b[3]); return w; }

struct EpiIn0 {
    static constexpr bool PERM = true;
    unsigned char* big; const float *qg, *kg, *lbv; const f32x2 *ropeR, *ropeC;
    __device__ __forceinline__ void operator()(const f32x4 (&acc)[2][2][4][2], const Unit& u, int wr, int wc, int fr, int fq) const {
        const int pn = u.pn, type = pn >> 1, j9 = u.pm % 9; const bool lat = j9 > 0;
        if (type < 2) {
            const float* gain = type ? kg : qg; bf16* dst = (bf16*)(big + (type ? B_KD : B_QD));
            const int h = 2 * (pn & 1) + (wc >> 1), c = wc & 1;
            f32x4 g[2][2];
#pragma unroll
            for (int bj = 0; bj < 2; ++bj)
#pragma unroll
                for (int n = 0; n < 2; ++n) g[bj][n] = *(const f32x4*)(gain + 32 * bj + 16 * n + 4 * fq);
#pragma unroll
            for (int ai = 0; ai < 2; ++ai)
#pragma unroll
                for (int m = 0; m < 4; ++m) {
                    const int rr = opaque(ai * 128 + wr * 64 + m * 16 + fr); const size_t R = (size_t)u.pm * 256 + rr;
                    float s = 0.f;
#pragma unroll
                    for (int bj = 0; bj < 2; ++bj)
#pragma unroll
                        for (int n = 0; n < 2; ++n) { const f32x4 x = acc[ai][bj][m][n]; s += (x[0] * x[0] + x[1] * x[1]) + (x[2] * x[2] + x[3] * x[3]); }
                    s += __shfl_xor(s, 16); s += __shfl_xor(s, 32);
                    const float rstd = 1.0f / sqrtf(s * (1.0f / 64.0f) + EPS);
                    f32x4 y[2][2];
#pragma unroll
                    for (int bj = 0; bj < 2; ++bj)
#pragma unroll
                        for (int n = 0; n < 2; ++n) y[bj][n] = acc[ai][bj][m][n] * rstd * g[bj][n];
                    if (lat) { const int t = (j9 - 1) * 256 + rr, grow = t >> 6, gcol = t & 63;
#pragma unroll
                        for (int bj = 0; bj < 2; ++bj) { const f32x2* tab = bj ? (ropeC + gcol * 16 + 4 * fq) : (ropeR + grow * 16 + 4 * fq);
                            const f32x4 t0 = *(const f32x4*)tab, t1 = *(const f32x4*)(tab + 2);
                            const float cs[4] = {t0[0], t0[2], t1[0], t1[2]}, sn[4] = {t0[1], t0[3], t1[1], t1[3]};
#pragma unroll
                            for (int e = 0; e < 4; ++e) { const float x1 = y[bj][0][e], x2 = y[bj][1][e]; y[bj][0][e] = x1 * cs[e] - x2 * sn[e]; y[bj][1][e] = x1 * sn[e] + x2 * cs[e]; } } }
#pragma unroll
                    for (int bj = 0; bj < 2; ++bj) *(v4u*)(dst + R * 512 + h * 128 + c * 64 + 32 * bj + 8 * fq) = pack8(y[bj][0], y[bj][1]);
                    asm volatile("" ::: "memory");
                }
        } else {
            const int colt = (pn & 1) * 256;
            size_t boffs; if (type == 2) boffs = B_VD; else if (type == 3) boffs = B_HQ; else if (type == 4) boffs = B_LF0; else if (type == 5) boffs = B_LF1; else if (type == 6) boffs = B_HV; else boffs = B_HG;
            bf16* dst = (bf16*)(big + boffs);
#pragma unroll
            for (int bj = 0; bj < 2; ++bj) { const int col = colt + bj * 128 + wc * 32 + 8 * fq;
                f32x4 lb0 = {0.f, 0.f, 0.f, 0.f}, lb1 = lb0;
                if (type == 4 || type == 5) { const float* lp = lbv + (type - 4) * 512 + col; lb0 = *(const f32x4*)lp; lb1 = *(const f32x4*)(lp + 4); }
#pragma unroll
                for (int ai = 0; ai < 2; ++ai)
#pragma unroll
                    for (int m = 0; m < 4; ++m) { const size_t R = (size_t)u.pm * 256 + opaque(ai * 128 + wr * 64 + m * 16 + fr);
                        f32x4 a = acc[ai][bj][m][0], b = acc[ai][bj][m][1]; v4u w;
                        if (type == 3 || type == 7) {
#pragma unroll
                            for (int e = 0; e < 4; ++e) { a[e] = siluf_(a[e]); b[e] = siluf_(b[e]); }
                            w = pack8(a, b);
                        } else if (type == 4 || type == 5) {
#pragma unroll
                            for (int e = 0; e < 4; ++e) { a[e] = __logf(lb0[e] + (1.0f - lb0[e]) * sigmoidf_(a[e])); b[e] = __logf(lb1[e] + (1.0f - lb1[e]) * sigmoidf_(b[e])); }
                            w.x = pkh2(a[0], a[1]); w.y = pkh2(a[2], a[3]); w.z = pkh2(b[0], b[1]); w.w = pkh2(b[2], b[3]);
                        } else w = pack8(a, b);
                        *(v4u*)(dst + R * 512 + col) = w; asm volatile("" ::: "memory"); } }
        }
    }
};

struct EpiOut {
    static constexpr bool PERM = false;
    const Frame* F; int layer; bool from_input;
    __device__ __forceinline__ void operator()(const f32x4 (&acc)[2][2][4][2], const Unit& u, int wr, int wc, int fr, int fq) const {
        const int b = u.pm / 9, j9 = u.pm % 9, r = j9 ? b : 8;
        const float* gm = F->modv + (size_t)(layer * 9 + r) * 6144 + 2048;
#pragma unroll
        for (int ai = 0; ai < 2; ++ai)
#pragma unroll
            for (int m = 0; m < 4; ++m) { const int s = j9 * 256 + opaque(ai * 128 + wr * 64 + m * 16 + fr);
                float* xo = xrow_ptr(*F, b, s); const float* xb = from_input ? xin_ptr(*F, b, s) : xo;
#pragma unroll
                for (int bj = 0; bj < 2; ++bj)
#pragma unroll
                    for (int n = 0; n < 2; ++n) { const int col = u.pn * 256 + bj * 128 + wc * 32 + 16 * n + 4 * fq;
                        *(f32x4*)(xo + col) = *(const f32x4*)(xb + col) + *(const f32x4*)(gm + col) * acc[ai][bj][m][n]; } asm volatile("" ::: "memory"); }
    }
};

struct EpiGU {
    static constexpr bool PERM = true;
    bf16* Hout;
    __device__ __forceinline__ void operator()(const f32x4 (&acc)[2][2][4][2], const Unit& u, int wr, int wc, int fr, int fq) const {
        const int pnl = u.pn & 3;
#pragma unroll
        for (int ai = 0; ai < 2; ++ai)
#pragma unroll
            for (int m = 0; m < 4; ++m) { const size_t row = (size_t)u.pm * 256 + opaque(ai * 128 + wr * 64 + m * 16 + fr);
                f32x4 h[2];
#pragma unroll
                for (int n = 0; n < 2; ++n)
#pragma unroll
                    for (int e = 0; e < 4; ++e) h[n][e] = siluf_(acc[ai][0][m][n][e]) * acc[ai][1][m][n][e];
                *(v4u*)(Hout + row * 512 + pnl * 128 + wc * 32 + 8 * fq) = pack8(h[0], h[1]); }
    }
};

struct EpiDownS {
    static constexpr bool PERM = false;
    const Frame* F; int layer;
    __device__ __forceinline__ void operator()(const f32x4 (&acc)[2][2][4][2], const Unit& u, int wr, int wc, int fr, int fq) const {
        const int b = u.pm / 9, j9 = u.pm % 9, r = j9 ? b : 8;
        const float* gf = F->modv + (size_t)(layer * 9 + r) * 6144 + 5120;
#pragma unroll
        for (int ai = 0; ai < 2; ++ai)
#pragma unroll
            for (int m = 0; m < 4; ++m) { const int s = j9 * 256 + opaque(ai * 128 + wr * 64 + m * 16 + fr); float* xo = xrow_ptr(*F, b, s);
#pragma unroll
                for (int bj = 0; bj < 2; ++bj)
#pragma unroll
                    for (int n = 0; n < 2; ++n) { const int col = u.pn * 256 + bj * 128 + wc * 32 + 16 * n + 4 * fq;
                        *(f32x4*)(xo + col) = *(const f32x4*)(xo + col) + *(const f32x4*)(gf + col) * acc[ai][bj][m][n]; } asm volatile("" ::: "memory"); }
    }
};

struct EpiDownR {
    static constexpr bool PERM = true;
    bf16* Ye;
    __device__ __forceinline__ void operator()(const f32x4 (&acc)[2][2][4][2], const Unit& u, int wr, int wc, int fr, int fq) const {
        const int pnl = u.pn & 3;
#pragma unroll
        for (int ai = 0; ai < 2; ++ai)
#pragma unroll
            for (int m = 0; m < 4; ++m) { const size_t row = (size_t)u.pm * 256 + opaque(ai * 128 + wr * 64 + m * 16 + fr);
#pragma unroll
                for (int bj = 0; bj < 2; ++bj) *(v4u*)(Ye + row * 1024 + pnl * 256 + bj * 128 + wc * 32 + 8 * fq) = pack8(acc[ai][bj][m][0], acc[ai][bj][m][1]); }
    }
};

struct EpiIn1 {
    static constexpr bool PERM = true;
    unsigned char* big; float* ssq; const float* krg; const f32x2 *ropeR, *ropeC;
    __device__ __forceinline__ void operator()(const f32x4 (&acc)[2][2][4][2], const Unit& u, int wr, int wc, int fr, int fq) const {
        const int pn = u.pn, j9 = u.pm % 9; const bool lat = j9 > 0;
        bf16* Ckv = (bf16*)(big + B_CKV); bf16* Cq = (bf16*)(big + B_CQ); bf16* Kr = (bf16*)(big + B_KR);
        if (pn == 2 && wc == 3) {
#pragma unroll
            for (int ai = 0; ai < 2; ++ai)
#pragma unroll
                for (int m = 0; m < 4; ++m) {
                    const int rr = opaque(ai * 128 + wr * 64 + m * 16 + fr); const size_t R = (size_t)u.pm * 256 + rr;
                    float s = 0.f;
#pragma unroll
                    for (int bj = 0; bj < 2; ++bj)
#pragma unroll
                        for (int n = 0; n < 2; ++n) { const f32x4 x = acc[ai][bj][m][n]; s += (x[0] * x[0] + x[1] * x[1]) + (x[2] * x[2] + x[3] * x[3]); }
                    s += __shfl_xor(s, 16); s += __shfl_xor(s, 32);
                    const float rstd = 1.0f / sqrtf(s * (1.0f / 64.0f) + EPS);
                    f32x4 y[2][2];
#pragma unroll
                    for (int bj = 0; bj < 2; ++bj)
#pragma unroll
                        for (int n = 0; n < 2; ++n) y[bj][n] = acc[ai][bj][m][n] * rstd * *(const f32x4*)(krg + 32 * bj + 16 * n + 4 * fq);
                    if (lat) { const int t = (j9 - 1) * 256 + rr, grow = t >> 6, gcol = t & 63;
#pragma unroll
                        for (int bj = 0; bj < 2; ++bj) { const f32x2* tab = bj ? (ropeC + gcol * 16 + 4 * fq) : (ropeR + grow * 16 + 4 * fq);
                            const f32x4 t0 = *(const f32x4*)tab, t1 = *(const f32x4*)(tab + 2);
                            const float cs[4] = {t0[0], t0[2], t1[0], t1[2]}, sn[4] = {t0[1], t0[3], t1[1], t1[3]};
#pragma unroll
                            for (int e = 0; e < 4; ++e) { const float x1 = y[bj][0][e], x2 = y[bj][1][e]; y[bj][0][e] = x1 * cs[e] - x2 * sn[e]; y[bj][1][e] = x1 * sn[e] + x2 * cs[e]; } } }
#pragma unroll
                    for (int bj = 0; bj < 2; ++bj) *(v4u*)(Kr + R * 64 + 32 * bj + 8 * fq) = pack8(y[bj][0], y[bj][1]);
                    asm volatile("" ::: "memory");
                }
            return;
        }
#pragma unroll
        for (int ai = 0; ai < 2; ++ai)
#pragma unroll
            for (int m = 0; m < 4; ++m) {
                const size_t R = (size_t)u.pm * 256 + opaque(ai * 128 + wr * 64 + m * 16 + fr);
                float s = 0.f;
#pragma unroll
                for (int bj = 0; bj < 2; ++bj) { const f32x4 a = acc[ai][bj][m][0], b = acc[ai][bj][m][1];
                    s += (a[0] * a[0] + a[1] * a[1]) + (a[2] * a[2] + a[3] * a[3]) + (b[0] * b[0] + b[1] * b[1]) + (b[2] * b[2] + b[3] * b[3]);
                    const v4u w = pack8(a, b);
                    if (pn == 0) *(v4u*)(Ckv + R * 256 + bj * 128 + wc * 32 + 8 * fq) = w;
                    else if (pn == 1) *(v4u*)(Cq + R * 384 + bj * 128 + wc * 32 + 8 * fq) = w;
                    else { if (bj == 0) *(v4u*)(Cq + R * 384 + 256 + wc * 32 + 8 * fq) = w; else if (wc == 0) *(v4u*)(Cq + R * 384 + 352 + 8 * fq) = w; } }
                s += __shfl_xor(s, 16); s += __shfl_xor(s, 32);
                if (fq == 0) ssq[R * 12 + pn * 4 + wc] = s;
                asm volatile("" ::: "memory");
            }
    }
};

struct EpiUq {
    static constexpr bool PERM = true;
    bf16* Q1; const float* ssq; const float *qng, *qrg; const f32x2 *ropeR, *ropeC; LAS float* xl;
    __device__ __forceinline__ float rq_of(size_t R) const { const float* sp = ssq + R * 12; const f32x4 s1 = *(const f32x4*)(sp + 4), s2 = *(const f32x4*)(sp + 8);
        return 1.0f / sqrtf(((s1[0] + s1[1]) + (s1[2] + s1[3]) + (s2[0] + s2[1]) + s2[2]) * (1.0f / 384.0f) + EPS); }
    __device__ __forceinline__ void operator()(const f32x4 (&acc)[2][2][4][2], const Unit& u, int wr, int wc, int fr, int fq) const {
        const int pn = u.pn, j9 = u.pm % 9;
        if (pn < 4) {
#pragma unroll
            for (int ai = 0; ai < 2; ++ai)
#pragma unroll
                for (int m = 0; m < 4; ++m)
#pragma unroll
                    for (int bj = 0; bj < 2; ++bj) { float s = 0.f;
#pragma unroll
                        for (int n = 0; n < 2; ++n) { const f32x4 x = acc[ai][bj][m][n]; s += (x[0] * x[0] + x[1] * x[1]) + (x[2] * x[2] + x[3] * x[3]); }
                        s += __shfl_xor(s, 16); s += __shfl_xor(s, 32);
                        if (fq == 0) xl[(ai * 128 + wr * 64 + m * 16 + fr) * 8 + bj * 4 + wc] = s; }
            __syncthreads();
            f32x4 g[2];
#pragma unroll
            for (int n = 0; n < 2; ++n) g[n] = *(const f32x4*)(qng + wc * 32 + 8 * fq + 4 * n);
#pragma unroll
            for (int ai = 0; ai < 2; ++ai)
#pragma unroll
                for (int m = 0; m < 4; ++m) { const int rr = opaque(ai * 128 + wr * 64 + m * 16 + fr); const size_t R = (size_t)u.pm * 256 + rr; const float rq = rq_of(R);
#pragma unroll
                    for (int bj = 0; bj < 2; ++bj) { const f32x4 p = *(const LAS f32x4*)(xl + rr * 8 + bj * 4);
                        const float rstd = rq / sqrtf(((p[0] + p[1]) + (p[2] + p[3])) * (rq * rq) * (1.0f / 128.0f) + EPS);
                        const int h = 2 * pn + bj;
                        *(v4u*)(Q1 + R * 1536 + h * 192 + wc * 32 + 8 * fq) = pack8(acc[ai][bj][m][0] * rstd * g[0], acc[ai][bj][m][1] * rstd * g[1]); } asm volatile("" ::: "memory"); }
            __syncthreads();
        } else {
            const int h = 4 * (pn - 4) + wc;
#pragma unroll
            for (int ai = 0; ai < 2; ++ai)
#pragma unroll
                for (int m = 0; m < 4; ++m) {
                    const int rr = opaque(ai * 128 + wr * 64 + m * 16 + fr); const size_t R = (size_t)u.pm * 256 + rr; const float rq = rq_of(R);
                    float s = 0.f; f32x4 y[2][2];
#pragma unroll
                    for (int bj = 0; bj < 2; ++bj)
#pragma unroll
                        for (int n = 0; n < 2; ++n) { const f32x4 x = acc[ai][bj][m][n] * rq; y[bj][n] = x; s += (x[0] * x[0] + x[1] * x[1]) + (x[2] * x[2] + x[3] * x[3]); }
                    s += __shfl_xor(s, 16); s += __shfl_xor(s, 32);
                    const float rstd = 1.0f / sqrtf(s * (1.0f / 64.0f) + EPS);
#pragma unroll
                    for (int bj = 0; bj < 2; ++bj)
#pragma unroll
                        for (int n = 0; n < 2; ++n) y[bj][n] = y[bj][n] * rstd * *(const f32x4*)(qrg + 32 * bj + 16 * n + 4 * fq);
                    { const int t = (j9 - 1) * 256 + rr, grow = t >> 6, gcol = t & 63;
#pragma unroll
                        for (int bj = 0; bj < 2; ++bj) { const f32x2* tab = bj ? (ropeC + gcol * 16 + 4 * fq) : (ropeR + grow * 16 + 4 * fq);
                            const f32x4 t0 = *(const f32x4*)tab, t1 = *(const f32x4*)(tab + 2);
                            const float cs[4] = {t0[0], t0[2], t1[0], t1[2]}, sn[4] = {t0[1], t0[3], t1[1], t1[3]};
#pragma unroll
                            for (int e = 0; e < 4; ++e) { const float x1 = y[bj][0][e], x2 = y[bj][1][e]; y[bj][0][e] = x1 * cs[e] - x2 * sn[e]; y[bj][1][e] = x1 * sn[e] + x2 * cs[e]; } } }
#pragma unroll
                    for (int bj = 0; bj < 2; ++bj) *(v4u*)(Q1 + R * 1536 + h * 192 + 128 + 32 * bj + 8 * fq) = pack8(y[bj][0], y[bj][1]);
                    asm volatile("" ::: "memory");
                }
        }
    }
};

struct EpiUkv {
    static constexpr bool PERM = true;
    bf16 *Kn, *V1; const float* ssq; const float* kng; LAS float* xl;
    __device__ __forceinline__ void operator()(const f32x4 (&acc)[2][2][4][2], const Unit& u, int wr, int wc, int fr, int fq) const {
        const int h = u.pn;
#pragma unroll
        for (int ai = 0; ai < 2; ++ai)
#pragma unroll
            for (int m = 0; m < 4; ++m) { float s = 0.f;
#pragma unroll
                for (int n = 0; n < 2; ++n) { const f32x4 x = acc[ai][0][m][n]; s += (x[0] * x[0] + x[1] * x[1]) + (x[2] * x[2] + x[3] * x[3]); }
                s += __shfl_xor(s, 16); s += __shfl_xor(s, 32);
                if (fq == 0) xl[(ai * 128 + wr * 64 + m * 16 + fr) * 4 + wc] = s; }
        __syncthreads();
        f32x4 g[2];
#pragma unroll
        for (int n = 0; n < 2; ++n) g[n] = *(const f32x4*)(kng + wc * 32 + 8 * fq + 4 * n);
#pragma unroll
        for (int ai = 0; ai < 2; ++ai)
#pragma unroll
            for (int m = 0; m < 4; ++m) { const int rr = opaque(ai * 128 + wr * 64 + m * 16 + fr); const size_t R = (size_t)u.pm * 256 + rr;
                const f32x4 s0 = *(const f32x4*)(ssq + R * 12);
                const float rk = 1.0f / sqrtf(((s0[0] + s0[1]) + (s0[2] + s0[3])) * (1.0f / 256.0f) + EPS);
                const f32x4 p = *(const LAS f32x4*)(xl + rr * 4);
                const float rstd = rk / sqrtf(((p[0] + p[1]) + (p[2] + p[3])) * (rk * rk) * (1.0f / 128.0f) + EPS);
                *(v4u*)(Kn + R * 1024 + h * 128 + wc * 32 + 8 * fq) = pack8(acc[ai][0][m][0] * rstd * g[0], acc[ai][0][m][1] * rstd * g[1]);
                *(v4u*)(V1 + R * 1024 + h * 128 + wc * 32 + 8 * fq) = pack8(acc[ai][1][m][0] * rk, acc[ai][1][m][1] * rk); asm volatile("" ::: "memory"); }
        __syncthreads();
    }
};

__device__ __forceinline__ bf16x8 pack_p(const f32x16& p, int s) { v4u w; w.x = pk2(p[8 * s + 0], p[8 * s + 1]); w.y = pk2(p[8 * s + 2], p[8 * s + 3]); w.z = pk2(p[8 * s + 4], p[8 * s + 5]); w.w = pk2(p[8 * s + 6], p[8 * s + 7]); return __builtin_bit_cast(bf16x8, w); }
__device__ __forceinline__ bf16x8 load_vfrag(const bf16* vp, int ld, int s) {
    bf16x8 r;
#pragma unroll
    for (int j = 0; j < 8; ++j) r[j] = (short)vp[(size_t)(16 * s + 8 * (j >> 2) + (j & 3)) * ld];
    return r;
}

__device__ __forceinline__ void diff_attn_unit_v0(Frame& F, int a) {
    const int lane = F.lane, r32 = lane & 31, hh = lane >> 5, wid = F.wave;
    int b, h, q0, nkeys;
    if (a < 256) { b = a >> 5; h = (a >> 3) & 3; q0 = b * RPB + CTXL + (a & 7) * 256; nkeys = RPB; } else { const int a2 = a - 256; b = a2 >> 2; h = a2 & 3; q0 = b * RPB; nkeys = CTXL; }
    const int kbase = b * RPB;
    const bf16* Qd = (const bf16*)(F.big + B_QD); const bf16* Kd = (const bf16*)(F.big + B_KD); const bf16* Vd = (const bf16*)(F.big + B_VD);
    const float lam = F.lamv[0];
    const float sc2 = 0.125f * LOG2E;
    const bf16* qp = Qd + (size_t)(q0 + wid * 32 + r32) * 512 + h * 128 + hh * 8;
    f32x16 O[2][4];
#pragma unroll
    for (int c = 0; c < 2; ++c)
#pragma unroll
        for (int d = 0; d < 4; ++d)
#pragma unroll
            for (int r = 0; r < 16; ++r) O[c][d][r] = 0.f;
    float l0 = 0.f, l1 = 0.f;
    for (int kt = 0; kt < nkeys; kt += 32) {
        bf16x8 pf[2][2];
        const bf16* kp = Kd + (size_t)(kbase + kt + r32) * 512 + h * 128 + hh * 8;
#pragma unroll
        for (int c = 0; c < 2; ++c) {
            f32x16 S;
#pragma unroll
            for (int r = 0; r < 16; ++r) S[r] = 0.f;
#pragma unroll
            for (int ks = 0; ks < 4; ++ks) { const bf16x8 kf = *(const bf16x8*)(kp + c * 64 + ks * 16); const bf16x8 qv = *(const bf16x8*)(qp + c * 64 + ks * 16); S = __builtin_amdgcn_mfma_f32_32x32x16_bf16(kf, qv, S, 0, 0, 0); }
            float ls = 0.f;
#pragma unroll
            for (int r = 0; r < 16; ++r) { S[r] = __builtin_amdgcn_exp2f(S[r] * sc2); ls += S[r]; }
            if (c == 0) l0 += ls; else l1 += ls;
            pf[c][0] = pack_p(S, 0); pf[c][1] = pack_p(S, 1);
        }
        const bf16* vp = Vd + (size_t)(kbase + kt + 4 * hh) * 512 + h * 128 + r32;
#pragma unroll
        for (int d = 0; d < 4; ++d)
#pragma unroll
            for (int s = 0; s < 2; ++s) { const bf16x8 vf = load_vfrag(vp + d * 32, 512, s);
                O[0][d] = __builtin_amdgcn_mfma_f32_32x32x16_bf16(pf[0][s], vf, O[0][d], 0, 0, 0);
                O[1][d] = __builtin_amdgcn_mfma_f32_32x32x16_bf16(pf[1][s], vf, O[1][d], 0, 0, 0); asm volatile("" ::: "memory"); }
    }
    l0 += __shfl_xor(l0, 32); l1 += __shfl_xor(l1, 32);
    const float* sg = F.in[I_DSUBLN];
    float gsub[4];
#pragma unroll
    for (int d = 0; d < 4; ++d) gsub[d] = sg[d * 32 + r32] * 0.8f;
#pragma unroll
    for (int r = 0; r < 16; ++r) {
        const int qi = crow(r, hh);
        const float i0 = 1.0f / __shfl(l0, qi), i1 = lam / __shfl(l1, qi);
        float o[4]; float s = 0.f;
#pragma unroll
        for (int d = 0; d < 4; ++d) { o[d] = O[0][d][r] * i0 - O[1][d][r] * i1; s += o[d] * o[d]; }
        s += __shfl_xor(s, 1); s += __shfl_xor(s, 2); s += __shfl_xor(s, 4); s += __shfl_xor(s, 8); s += __shfl_xor(s, 16);
        const float rstd = 1.0f / sqrtf(s * (1.0f / 128.0f) + EPS);
        bf16* op = F.H + (size_t)(q0 + wid * 32 + qi) * D + h * 128 + r32;
#pragma unroll
        for (int d = 0; d < 4; ++d) op[d * 32] = (bf16)f2bf(o[d] * rstd * gsub[d]);
    }
}

__device__ __forceinline__ void mla_attn_unit_v0(Frame& F, int a) {
    const int lane = F.lane, r32 = lane & 31, hh = lane >> 5, wid = F.wave;
    const int b = a >> 6, h = (a >> 3) & 7, q0 = b * RPB + CTXL + (a & 7) * 256, kbase = b * RPB;
    const bf16* Q1 = (const bf16*)(F.big + B_Q1); const bf16* Kn = (const bf16*)(F.big + B_KN); const bf16* Kr = (const bf16*)(F.big + B_KR); const bf16* V1 = (const bf16*)(F.big + B_V1);
    const float sc2 = 0.07216878364870323f * LOG2E;
    bf16x8 qf[12];
    { const bf16* qp = Q1 + (size_t)(q0 + wid * 32 + r32) * 1536 + h * 192 + hh * 8;
#pragma unroll
        for (int ks = 0; ks < 12; ++ks) qf[ks] = *(const bf16x8*)(qp + ks * 16); }
    f32x16 O[4];
#pragma unroll
    for (int d = 0; d < 4; ++d)
#pragma unroll
        for (int r = 0; r < 16; ++r) O[d][r] = 0.f;
    float l0 = 0.f;
    for (int kt = 0; kt < RPB; kt += 32) {
        const bf16* knp = Kn + (size_t)(kbase + kt + r32) * 1024 + h * 128 + hh * 8;
        const bf16* krp = Kr + (size_t)(kbase + kt + r32) * 64 + hh * 8;
        f32x16 S;
#pragma unroll
        for (int r = 0; r < 16; ++r) S[r] = 0.f;
#pragma unroll
        for (int ks = 0; ks < 8; ++ks) { const bf16x8 kf = *(const bf16x8*)(knp + ks * 16); S = __builtin_amdgcn_mfma_f32_32x32x16_bf16(kf, qf[ks], S, 0, 0, 0); }
#pragma unroll
        for (int ks = 0; ks < 4; ++ks) { const bf16x8 kf = *(const bf16x8*)(krp + ks * 16); S = __builtin_amdgcn_mfma_f32_32x32x16_bf16(kf, qf[8 + ks], S, 0, 0, 0); }
        float ls = 0.f;
#pragma unroll
        for (int r = 0; r < 16; ++r) { S[r] = __builtin_amdgcn_exp2f(S[r] * sc2); ls += S[r]; }
        l0 += ls;
        const bf16x8 p0 = pack_p(S, 0), p1 = pack_p(S, 1);
        const bf16* vp = V1 + (size_t)(kbase + kt + 4 * hh) * 1024 + h * 128 + r32;
#pragma unroll
        for (int d = 0; d < 4; ++d) { const bf16x8 v0 = load_vfrag(vp + d * 32, 1024, 0), v1 = load_vfrag(vp + d * 32, 1024, 1);
            O[d] = __builtin_amdgcn_mfma_f32_32x32x16_bf16(p0, v0, O[d], 0, 0, 0);
            O[d] = __builtin_amdgcn_mfma_f32_32x32x16_bf16(p1, v1, O[d], 0, 0, 0); }
    }
    l0 += __shfl_xor(l0, 32);
#pragma unroll
    for (int r = 0; r < 16; ++r) { const int qi = crow(r, hh); const float i0 = 1.0f / __shfl(l0, qi);
        bf16* op = F.H + (size_t)(q0 + wid * 32 + qi) * D + h * 128 + r32;
#pragma unroll
        for (int d = 0; d < 4; ++d) op[d * 32] = (bf16)f2bf(O[d][r] * i0); }
}

__device__ __forceinline__ void hgrn_unit_v0(Frame& F, int a) {
    const int dvq = a & 3, dir = (a >> 2) & 1, h = (a >> 3) & 3, b = a >> 5;
    const bf16* Hq = (const bf16*)(F.big + B_HQ); const f16* Lf = (const f16*)(F.big + (dir ? B_LF1 : B_LF0)); const bf16* Hv = (const bf16*)(F.big + B_HV);
    bf16* Ho = (bf16*)(F.big + (dir ? B_HO1 : B_HO0));
    LAS float* lq = (LAS float*)F.lds;
    LAS float* lf = lq + 2048;
    LAS float* lk = lf + 2048;
    LAS float* lv = lk + 2048;
    LAS float* part = lv + 512;
    const int tid = F.tid, v = tid & 31, kg = tid >> 5;
    float S[8];
#pragma unroll
    for (int j = 0; j < 8; ++j) S[j] = 0.f;
    for (int ch = 0; ch < RPB / 16; ++ch) {
        for (int e = tid; e < 2048; e += NTHREADS) { const int tok = e >> 7, k = e & 127, n = ch * 16 + tok;
            const int s = dir ? (n < CTXL ? CTXL - 1 - n : RPB + CTXL - 1 - n) : n; const size_t R = (size_t)b * RPB + s;
            lq[e] = bf2f(Hq[R * 512 + h * 128 + k]) * 0.08838834764831845f;
            const float f = fexp((float)Lf[R * 512 + h * 128 + k]); lf[e] = f; lk[e] = 1.0f - f; }
        { const int tok = tid >> 5, n = ch * 16 + tok; const int s = dir ? (n < CTXL ? CTXL - 1 - n : RPB + CTXL - 1 - n) : n; const size_t R = (size_t)b * RPB + s;
            lv[tid] = bf2f(Hv[R * 512 + h * 128 + dvq * 32 + v]); }
        __syncthreads();
#pragma unroll 4
        for (int tok = 0; tok < 16; ++tok) {
            const f32x4 q0 = *(const LAS f32x4*)(lq + tok * 128 + kg * 8), q1 = *(const LAS f32x4*)(lq + tok * 128 + kg * 8 + 4);
            const f32x4 f0 = *(const LAS f32x4*)(lf + tok * 128 + kg * 8), f1 = *(const LAS f32x4*)(lf + tok * 128 + kg * 8 + 4);
            const f32x4 k0 = *(const LAS f32x4*)(lk + tok * 128 + kg * 8), k1 = *(const LAS f32x4*)(lk + tok * 128 + kg * 8 + 4);
            const float vv = lv[tok * 32 + v];
            float po = 0.f;
#pragma unroll
            for (int j = 0; j < 4; ++j) { S[j] = f0[j] * S[j] + k0[j] * vv; po += S[j] * q0[j]; S[4 + j] = f1[j] * S[4 + j] + k1[j] * vv; po += S[4 + j] * q1[j]; }
            part[(tok * 16 + kg) * 32 + v] = po;
        }
        __syncthreads();
        { const int tok = tid >> 5, n = ch * 16 + tok; const int s = dir ? (n < CTXL ? CTXL - 1 - n : RPB + CTXL - 1 - n) : n; const size_t R = (size_t)b * RPB + s;
            float o = 0.f;
#pragma unroll
            for (int g = 0; g < 16; ++g) o += part[(tok * 16 + g) * 32 + v];
            Ho[R * 512 + h * 128 + dvq * 32 + v] = (bf16)f2bf(o); }
        __syncthreads();
    }
}

constexpr int NPHASES = 20;
__global__ void __launch_bounds__(NTHREADS, 2) mk_fwd(Args args) {
    extern __shared__ __attribute__((aligned(16))) unsigned char lds[];
    Frame F;
    F.lds = (LAS unsigned char*)lds;
    F.tid = threadIdx.x; F.lane = F.tid & 63; F.wave = __builtin_amdgcn_readfirstlane(F.tid >> 6); F.G = gridDim.x; F.bid = blockIdx.x;
#pragma unroll
    for (int i = 0; i < 34; ++i) F.in[i] = args.in[i];
    F.out = args.out; F.ws = args.ws;
    unsigned char* ws = args.ws;
    F.ctl = (gu32*)(ws + WS_CTL);
    unsigned char* sm = ws + WS_SMALL;
    F.modv = (float*)(sm + SM_MODV); F.ropeR = (f32x2*)(sm + SM_ROPER); F.ropeC = (f32x2*)(sm + SM_ROPEC); F.lbv = (float*)(sm + SM_LBV); F.lamv = (float*)(sm + SM_LAM);
    F.route_e = (int*)(sm + SM_ROUTE_E); F.route_w = (float*)(sm + SM_ROUTE_W); F.route_s = (int*)(sm + SM_ROUTE_S); F.pos = (int*)(sm + SM_POS); F.rowidx = (int*)(sm + SM_ROWIDX); F.ssq = (float*)(sm + SM_SSQ);
    F.Win0 = (bf16*)(ws + WS_WIN0); F.Wout0 = (bf16*)(ws + WS_WOUT0); F.Win1 = (bf16*)(ws + WS_WIN1); F.Wuq = (bf16*)(ws + WS_WUQ); F.Wukv = (bf16*)(ws + WS_WUKV); F.Wout1 = (bf16*)(ws + WS_WOUT1);
    F.Wgu = (bf16*)(ws + WS_WGU); F.Wd = (bf16*)(ws + WS_WD);
    F.xc = (float*)(ws + WS_XC); F.H = (bf16*)(ws + WS_H); F.big = ws + WS_BIG;

    volatile LAS unsigned* MISC = (volatile LAS unsigned*)(F.lds + LDS_MISC);
    for (int u = F.tid; u < 256; u += NTHREADS) MISC[u] = 0u;
    __syncthreads();
    XcdBarrier bar; bar.bar = (unsigned*)(F.ctl + CW_BAR); bar.x = 0; bar.st = nullptr;
    if (MK_N_LAUNCHES == 1) bar = xcd_barrier_post((unsigned*)(F.ctl + CW_BAR), MISC + 8);
    LAS float* xl = (LAS float*)(F.lds + LDS_XCH);

    const int lo = args.ph_lo, hi = args.ph_hi;
#ifdef DBG_ONLY
#define IN(k) ((k) == DBG_ONLY && lo <= (k) && (k) < hi)
#else
#define IN(k) (lo <= (k) && (k) < hi)
#endif
#define SEAM(k) do { if (IN(k) && IN((k) + 1)) xcd_barrier(bar); } while (0)

    if (IN(0)) { p0_prologue(F); } SEAM(0);
    if (IN(1)) { p_norm0(F); } SEAM(1);
    if (IN(2)) { Gemm g{F.H, F.Win0, 1024, nullptr}; SchedGrid S{NT_ALL, 16, F.G, F.bid, false};
        EpiIn0 E{F.big, F.in[I_DQG], F.in[I_DKG], F.lbv, F.ropeR, F.ropeC}; gemm_v0(g, S, E); } SEAM(2);
    if (IN(3)) { for (int a = F.bid; a < 256; a += F.G) hgrn_unit_v0(F, a);
        for (int a = F.bid; a < 288; a += F.G) diff_attn_unit_v0(F, a); } SEAM(3);
    if (IN(4)) { p_hgrn_post(F); } SEAM(4);
    if (IN(5)) { Gemm g{F.H, F.Wout0, 1024, nullptr}; SchedGrid S{NT_ALL, 4, F.G, F.bid, false}; EpiOut E{&F, 0, true}; gemm_v0(g, S, E); } SEAM(5);
    if (IN(6)) { p_norm_route(F, 0, false); } SEAM(6);
    if (IN(7)) { p_lists(F, 0, false);
        Gemm g{F.H, F.Wgu + (size_t)(0 * 17 + 16) * 1024 * 1024, 1024, nullptr}; SchedGrid S{NT_ALL, 4, F.G, F.bid, false}; EpiGU E{(bf16*)(F.big + B_HS)}; gemm_v0(g, S, E); } SEAM(7);
    if (IN(8)) { { SchedRouted S; load_expoff(F, 0, S.eo); S.G = F.G; S.c = F.bid; Gemm g{F.H, F.Wgu + (size_t)(0 * 17) * 1024 * 1024, 1024, F.rowidx}; EpiGU E{(bf16*)(F.big + B_HE)}; gemm_v0(g, S, E); }
        { Gemm g{(const bf16*)(F.big + B_HS), F.Wd + (size_t)(0 * 17 + 16) * 1024 * 512, 512, nullptr}; SchedGrid S{NT_ALL, 4, F.G, F.bid, false}; EpiDownS E{&F, 0}; gemm_v0(g, S, E); } } SEAM(8);
    if (IN(9)) { SchedRouted S; load_expoff(F, 0, S.eo); S.G = F.G; S.c = F.bid; Gemm g{(const bf16*)(F.big + B_HE), F.Wd + (size_t)(0 * 17) * 1024 * 512, 512, nullptr}; EpiDownR E{(bf16*)(F.big + B_YE)}; gemm_v0(g, S, E); } SEAM(9);
    if (IN(10)) { p_combine(F, 0, false, true); } SEAM(10);
    if (IN(11)) { Gemm g{F.H, F.Win1, 1024, nullptr}; SchedGrid S{NT_ALL, 3, F.G, F.bid, false}; EpiIn1 E{F.big, F.ssq, F.in[I_KRG], F.ropeR, F.ropeC}; gemm_v0(g, S, E); } SEAM(11);
    if (IN(12)) { { Gemm g{(const bf16*)(F.big + B_CQ), F.Wuq, 384, nullptr}; SchedGrid S{NT_LAT, 6, F.G, F.bid, true};
            EpiUq E{(bf16*)(F.big + B_Q1), F.ssq, F.in[I_QNG], F.in[I_QRG], F.ropeR, F.ropeC, xl}; gemm_v0(g, S, E); }
        { Gemm g{(const bf16*)(F.big + B_CKV), F.Wukv, 256, nullptr}; SchedGrid S{NT_ALL, 8, F.G, F.bid, false};
            EpiUkv E{(bf16*)(F.big + B_KN), (bf16*)(F.big + B_V1), F.ssq, F.in[I_KNG], xl}; gemm_v0(g, S, E); } } SEAM(12);
    if (IN(13)) { for (int a = F.bid; a < 512; a += F.G) mla_attn_unit_v0(F, a); } SEAM(13);
    if (IN(14)) { Gemm g{F.H, F.Wout1, 1024, nullptr}; SchedGrid S{NT_LAT, 4, F.G, F.bid, true}; EpiOut E{&F, 1, false}; gemm_v0(g, S, E); } SEAM(14);
    if (IN(15)) { p_norm_route(F, 1, true); } SEAM(15);
    if (IN(16)) { p_lists(F, 1, true);
        Gemm g{F.H, F.Wgu + (size_t)(1 * 17 + 16) * 1024 * 1024, 1024, nullptr}; SchedGrid S{NT_LAT, 4, F.G, F.bid, true}; EpiGU E{(bf16*)(F.big + B_HS)}; gemm_v0(g, S, E); } SEAM(16);
    if (IN(17)) { { SchedRouted S; load_expoff(F, 1, S.eo); S.G = F.G; S.c = F.bid; Gemm g{F.H, F.Wgu + (size_t)(1 * 17) * 1024 * 1024, 1024, F.rowidx}; EpiGU E{(bf16*)(F.big + B_HE)}; gemm_v0(g, S, E); }
        { Gemm g{(const bf16*)(F.big + B_HS), F.Wd + (size_t)(1 * 17 + 16) * 1024 * 512, 512, nullptr}; SchedGrid S{NT_LAT, 4, F.G, F.bid, true}; EpiDownS E{&F, 1}; gemm_v0(g, S, E); } } SEAM(17);
    if (IN(18)) { SchedRouted S; load_expoff(F, 1, S.eo); S.G = F.G; S.c = F.bid; Gemm g{(const bf16*)(F.big + B_HE), F.Wd + (size_t)(1 * 17) * 1024 * 512, 512, nullptr}; EpiDownR E{(bf16*)(F.big + B_YE)}; gemm_v0(g, S, E); } SEAM(18);
    if (IN(19)) { p_combine(F, 1, true, false); }
#undef IN
#undef SEAM
}

extern "C" void kernel_launch(void* const* d_in, const int* in_sizes, int n_in, void* d_out, int out_size, void* d_ws, size_t ws_size, hipStream_t stream) {
    static int grid = 0;
    if (grid == 0) {
        if (n_in != 34 || in_sizes[0] != NB * SEQ * D || out_size != NB * SEQ * D || ws_size < WS_END) {
            fprintf(stderr, "kernel_launch: unexpected problem: n_in %d in0 %d out %d ws %zu (need %zu); nothing launched\n", n_in, n_in > 0 ? in_sizes[0] : -1, out_size, ws_size, (size_t)WS_END); grid = -1; return; }
        int dev = 0, cus = 0;
        if (hipGetDevice(&dev) != hipSuccess || hipDeviceGetAttribute(&cus, hipDeviceAttributeMultiprocessorCount, dev) != hipSuccess) { grid = -1; return; }
        if (hipFuncSetAttribute((const void*)mk_fwd, hipFuncAttributeMaxDynamicSharedMemorySize, LDS_BYTES) != hipSuccess) { fprintf(stderr, "kernel_launch: hipFuncSetAttribute failed\n"); grid = -1; return; }
        int per_cu = 0;
        if (hipOccupancyMaxActiveBlocksPerMultiprocessor(&per_cu, (const void*)mk_fwd, NTHREADS, LDS_BYTES) != hipSuccess || per_cu < 1) fprintf(stderr, "kernel_launch: note: occupancy query reports %d\n", per_cu);
        (void)hipGetLastError();
        grid = cus;
    }
    if (grid < 0) return;
    if (hipMemsetAsync((char*)d_ws + WS_CTL, 0, CTL_ZERO_BYTES, stream) != hipSuccess) { fprintf(stderr, "kernel_launch: memset failed\n"); return; }
    Args a{};
    for (int i = 0; i < 34; ++i) a.in[i] = (const float*)d_in[i];
    a.out = (float*)d_out; a.ws = (unsigned char*)d_ws;
    if (MK_N_LAUNCHES == 1) { a.ph_lo = 0; a.ph_hi = NPHASES; hipLaunchKernelGGL(mk_fwd, dim3(grid), dim3(NTHREADS), LDS_BYTES, stream, a); }
    else for (int p = 0; p < NPHASES; ++p) { a.ph_lo = p; a.ph_hi = p + 1; hipLaunchKernelGGL(mk_fwd, dim3(grid), dim3(NTHREADS), LDS_BYTES, stream, a); }
    const hipError_t le = hipPeekAtLastError();
    if (le != hipSuccess) fprintf(stderr, "kernel_launch: launch failed: %s\n", hipGetErrorName(le));
}
```

```cpp
#include <hip/hip_runtime.h>
#include <cstdio>
#include <cstdint>

#ifndef MK_N_LAUNCHES
#define MK_N_LAUNCHES 1
#endif

#define GAS __attribute__((address_space(1)))
#define LAS __attribute__((address_space(3)))
typedef unsigned short bf16;
typedef _Float16 f16;
typedef short bf16x8 __attribute__((ext_vector_type(8)));
typedef float f32x4 __attribute__((ext_vector_type(4)));
typedef float f32x2 __attribute__((ext_vector_type(2)));
typedef float f32x16 __attribute__((ext_vector_type(16)));
typedef unsigned v4u __attribute__((ext_vector_type(4)));
typedef unsigned v2u __attribute__((ext_vector_type(2)));
typedef GAS unsigned gu32;
#define RLX_AGENT __ATOMIC_RELAXED, __HIP_MEMORY_SCOPE_AGENT
#define LDS_WAIT() asm volatile("s_waitcnt lgkmcnt(0)" ::: "memory")
#define VM_WAIT() asm volatile("s_waitcnt vmcnt(0)" ::: "memory")

constexpr int NB = 8, SEQ = 2048, CTXL = 256, RPB = 2304  , NR = NB * RPB  , D = 1024;
constexpr int NT_ALL = NR / 256  , NT_LAT = 64;
constexpr int NEXP = 16, FF = 512;
constexpr int MP_MAX = 41216;
constexpr float EPS = 1e-6f;
constexpr float LOG2E = 1.4426950408889634f;
constexpr int NWAVES = 8, NTHREADS = 512;

constexpr size_t MiB = 1u << 20;
constexpr size_t WS_CTL = 0, CTL_ZERO_BYTES = 1 * MiB;
constexpr int CW_TMO = 0, CW_CODE = 1, CW_BAR = 4096, CW_CNT = 8192;
constexpr size_t WS_SMALL = 1 * MiB;
constexpr size_t SM_MODV = 0;
constexpr size_t SM_ROPER = 448 * 1024;
constexpr size_t SM_ROPEC = 452 * 1024;
constexpr size_t SM_LBV = 460 * 1024;
constexpr size_t SM_LAM = 464 * 1024;
constexpr size_t SM_ROUTE_E = 512 * 1024;
constexpr size_t SM_ROUTE_W = 584 * 1024;
constexpr size_t SM_ROUTE_S = 728 * 1024;
constexpr size_t SM_POS = 872 * 1024;
constexpr size_t SM_ROWIDX = 1016 * 1024;
constexpr size_t SM_SSQ = 1280 * 1024;
static_assert(SM_ROUTE_E + (size_t)NR * 4 <= SM_ROUTE_W && SM_ROUTE_W + (size_t)NR * 8 <= SM_ROUTE_S && SM_ROUTE_S + (size_t)NR * 8 <= SM_POS && SM_POS + (size_t)NR * 8 <= SM_ROWIDX &&
              SM_ROWIDX + (size_t)MP_MAX * 4 <= SM_SSQ && SM_SSQ + (size_t)NR * 48 <= 3 * MiB, "small map");
constexpr size_t WS_WIN0 = 4 * MiB, WS_WOUT0 = 12 * MiB, WS_WIN1 = 14 * MiB, WS_WUQ = 16 * MiB, WS_WUKV = 18 * MiB, WS_WOUT1 = 19 * MiB;
constexpr size_t WS_WGU = 22 * MiB;
constexpr size_t WS_WD = 90 * MiB;
constexpr size_t WS_XC = 124 * MiB;
constexpr size_t WS_H = 132 * MiB;
constexpr size_t WS_BIG = 168 * MiB;
constexpr size_t WS_END = 348 * MiB;
constexpr size_t SZ18 = 18 * MiB;
constexpr size_t B_QD = 0, B_KD = SZ18, B_VD = 2 * SZ18, B_HQ = 3 * SZ18, B_LF0 = 4 * SZ18, B_LF1 = 5 * SZ18, B_HV = 6 * SZ18, B_HG = 7 * SZ18, B_HO0 = 8 * SZ18, B_HO1 = 9 * SZ18;
constexpr size_t B_HS = 0, B_HE = 18 * MiB, B_YE = 60 * MiB;
static_assert(B_HE + (size_t)MP_MAX * 512 * 2 <= B_YE && B_YE + (size_t)MP_MAX * 1024 * 2 <= 180 * MiB, "moe map");
constexpr size_t B_CKV = 0, B_CQ = 9 * MiB, B_KR = 23 * MiB, B_Q1 = 26 * MiB, B_KN = 80 * MiB, B_V1 = 116 * MiB;

constexpr int LDS_BYTES = 155648;
constexpr int LDS_MISC = 131072;
constexpr int LDS_XCH = 132096;

__device__ __forceinline__ unsigned f2bf(float f) { unsigned u = __builtin_bit_cast(unsigned, f); return (u + 0x7fffu + ((u >> 16) & 1u)) >> 16; }
__device__ __forceinline__ unsigned pk2(float lo, float hi) { return f2bf(lo) | (f2bf(hi) << 16); }
__device__ __forceinline__ float bf2f(bf16 h) { return __builtin_bit_cast(float, (unsigned)h << 16); }
__device__ __forceinline__ float bflo(unsigned w) { return __builtin_bit_cast(float, w << 16); }
__device__ __forceinline__ float bfhi(unsigned w) { return __builtin_bit_cast(float, w & 0xffff0000u); }
__device__ __forceinline__ unsigned pkh2(float lo, float hi) { f16 a = (f16)lo, b = (f16)hi; return (unsigned)__builtin_bit_cast(unsigned short, a) | ((unsigned)__builtin_bit_cast(unsigned short, b) << 16); }
__device__ __forceinline__ float fexp(float x) { return __builtin_amdgcn_exp2f(x * LOG2E); }
__device__ __forceinline__ float sigmoidf_(float x) { return 1.0f / (1.0f + fexp(-x)); }
__device__ __forceinline__ float siluf_(float x) { return x / (1.0f + fexp(-x)); }
__device__ __forceinline__ float wave_sum(float v) {
#pragma unroll
    for (int o = 1; o < 64; o <<= 1) v += __shfl_xor(v, o);
    return v;
}
__host__ __device__ __forceinline__ int perm32(int rho) { const int n = rho >> 4, i = rho & 15; return 8 * (i >> 2) + 4 * n + (i & 3); }
__host__ __device__ __forceinline__ int ddmap(int j) { return 16 * ((j >> 2) & 1) + 4 * (j >> 3) + (j & 3); }
__device__ __forceinline__ int opaque(int x) { asm volatile("" : "+v"(x)); return x; }
__device__ __forceinline__ int crow(int r, int hi) { return (r & 3) + 8 * (r >> 2) + 4 * hi; }

#define XB_TMO      128
#define XB_XCNT(j)  (256  + 64 * (j))
#define XB_XSUB(j)  (1280 + 64 * (j))
#define XB_XGEN(j)  (2304 + 64 * (j))
#define XB_TOP      3328
#define XB_TOPGEN   3392
#define XCD_BAR_WORDS 3456
#define XB_SPIN_CAP (1u << 18)
__device__ __forceinline__ unsigned xb_ld(unsigned* p)              { return __hip_atomic_load(p, __ATOMIC_RELAXED, __HIP_MEMORY_SCOPE_AGENT); }
__device__ __forceinline__ unsigned xb_add(unsigned* p, unsigned v) { return __hip_atomic_fetch_add(p, v, __ATOMIC_RELAXED, __HIP_MEMORY_SCOPE_AGENT); }
__device__ __forceinline__ unsigned xb_xcc_id() { return (unsigned)__builtin_amdgcn_s_getreg((3 << 11) | 20) & 0xFu; }
#define XB_SPIN(cond, bar) do { unsigned _sp = 0; while (cond) { __builtin_amdgcn_s_sleep(1); \
    if ((++_sp & 255u) == 0u) { if (xb_ld(&(bar)[XB_TMO])) break; if (_sp > XB_SPIN_CAP) { atomicAdd(&(bar)[XB_TMO], 1u); break; } } } } while (0)
struct XcdBarrier { unsigned* bar; unsigned x; volatile LAS unsigned* st; };
__device__ __forceinline__ XcdBarrier xcd_barrier_post(unsigned* bar, volatile LAS unsigned* st) {
    XcdBarrier b; b.bar = bar; b.x = xb_xcc_id(); b.st = st;
    if (threadIdx.x == 0) (void)xb_add(&bar[XB_XCNT(b.x)], 1u);
    return b;
}
__device__ __forceinline__ void xcd_barrier_complete(unsigned* bar, unsigned x, unsigned& nloc, unsigned& nx) {
    const unsigned G = gridDim.x * gridDim.y * gridDim.z;
    unsigned sum, cnt, mine, sp = 0u;
    for (;;) {
        sum = 0u; cnt = 0u; mine = 0u;
#pragma unroll
        for (unsigned j = 0; j < 16; ++j) { const unsigned c = xb_ld(&bar[XB_XCNT(j)]); sum += c; cnt += (c > 0u) ? 1u : 0u; mine = (j == x) ? c : mine; }
        if (sum == G) break;
        __builtin_amdgcn_s_sleep(1);
        if ((++sp & 255u) == 0u) { if (xb_ld(&bar[XB_TMO])) break; if (sp > XB_SPIN_CAP) { atomicAdd(&bar[XB_TMO], 1u); break; } }
    }
    nloc = mine > 0u ? mine : 1u; nx = cnt > 0u ? cnt : 1u;
}
__device__ __forceinline__ void xcd_barrier(const XcdBarrier& b) {
    asm volatile("s_waitcnt vmcnt(0)" ::: "memory");
    __syncthreads();
    if (threadIdx.x == 0) {
        unsigned* bar = b.bar;
        __builtin_amdgcn_s_waitcnt(0);
        unsigned nloc = b.st[0], nx = b.st[1];
        if (nloc == 0u) { xcd_barrier_complete(bar, b.x, nloc, nx); b.st[0] = nloc; b.st[1] = nx; }
        const unsigned old = xb_add(&bar[XB_XSUB(b.x)], 1u);
        const unsigned gen = old / nloc;
        if (old + 1u == (gen + 1u) * nloc) {
            __builtin_amdgcn_fence(__ATOMIC_RELEASE, "agent");
            asm volatile("s_waitcnt vmcnt(0)" ::: "memory");
            const unsigned og = xb_add(&bar[XB_TOP], 1u);
            const unsigned tg = og / nx;
            if (og + 1u == (tg + 1u) * nx) xb_add(&bar[XB_TOPGEN], 1u);
            else XB_SPIN(xb_ld(&bar[XB_TOPGEN]) == tg, bar);
            __builtin_amdgcn_fence(__ATOMIC_ACQUIRE, "agent");
            xb_add(&bar[XB_XGEN(b.x)], 1u);
            asm volatile("s_waitcnt vmcnt(0)" ::: "memory");
        } else {
            XB_SPIN(xb_ld(&bar[XB_XGEN(b.x)]) == gen, bar);
            __builtin_amdgcn_fence(__ATOMIC_ACQUIRE, "agent");
            asm volatile("s_waitcnt vmcnt(0)" ::: "memory");
        }
    }
    __syncthreads();
}

struct Args { const float* in[34]; float* out; unsigned char* ws; int ph_lo, ph_hi; };

struct Frame {
    LAS unsigned char* lds;
    int tid, lane, wave, G, bid;
    const float* in[34];
    float* out; unsigned char* ws;
    gu32* ctl;
    float* modv; f32x2* ropeR; f32x2* ropeC; float* lbv; float* lamv;
    int* route_e; float* route_w; int* route_s; int* pos; int* rowidx; float* ssq;
    bf16 *Win0, *Wout0, *Win1, *Wuq, *Wukv, *Wout1, *Wgu, *Wd;
    float* xc; bf16* H; unsigned char* big;
};
enum { I_X = 0, I_C, I_CTX, I_CCTX, I_MODW, I_MODB, I_NMIX, I_NFFN, I_EWIN, I_EWOUT, I_DQG, I_DKG, I_DLAM, I_DSUBLN, I_LBL, I_HOG, I_OWIN, I_QAG, I_KVAG, I_WUQ, I_WUKV,
       I_QNG, I_QRG, I_KNG, I_KRG, I_OWOUT, I_RW, I_RB, I_EG, I_EU, I_ED, I_SG, I_SU, I_SD };

__device__ __forceinline__ float* xrow_ptr(const Frame& F, int b, int s) { return s < CTXL ? F.xc + (size_t)(b * CTXL + s) * D : F.out + (size_t)(b * SEQ + s - CTXL) * D; }
__device__ __forceinline__ const float* xin_ptr(const Frame& F, int b, int s) { return s < CTXL ? F.in[I_CTX] + (size_t)(b * CTXL + s) * D : F.in[I_X] + (size_t)(b * SEQ + s - CTXL) * D; }

__device__ __forceinline__ void p0_transpose_item(const float* W, int ldn, int srccol0, bool perm, const float* kscale, bf16* WT  , int K, int k0, LAS float* scr, int lane) {
    if (srccol0 >= 0) {
#pragma unroll 8
        for (int i = 0; i < 32; ++i) { const int kk = 2 * i + (lane >> 5); float v = W[(size_t)(k0 + kk) * ldn + srccol0 + (lane & 31)]; if (kscale) v *= kscale[k0 + kk]; scr[kk * 33 + (lane & 31)] = v; }
    } else {
#pragma unroll 8
        for (int i = 0; i < 32; ++i) { const int kk = 2 * i + (lane >> 5); scr[kk * 33 + (lane & 31)] = 0.f; }
    }
    LDS_WAIT(); asm volatile("" ::: "memory");
    const int c = lane & 7;
#pragma unroll
    for (int j = 0; j < 4; ++j) { const int n = (lane >> 3) + 8 * j; const int sn = perm ? ddmap(n) : n; const LAS float* s = scr + (8 * c) * 33 + sn;
        v4u o; o.x = pk2(s[0 * 33], s[1 * 33]); o.y = pk2(s[2 * 33], s[3 * 33]); o.z = pk2(s[4 * 33], s[5 * 33]); o.w = pk2(s[6 * 33], s[7 * 33]);
        *(GAS v4u*)(WT + (size_t)n * K + k0 + 8 * c) = o; }
    LDS_WAIT(); asm volatile("" ::: "memory");
}

__device__ __forceinline__ void p0_convert_item(Frame& F, int it, LAS float* scr) {
    const int lane = F.lane;
    if (it < 2048) {
        const int kb = it >> 7, tb = it & 127, pn = tb >> 3, blk = tb & 7, bj = blk >> 2, wc = blk & 3;
        int sb; bool perm = false;
        if (pn < 4) { sb = pn * 8 + 2 * wc + bj; perm = true; } else sb = tb;
        p0_transpose_item(F.in[I_EWIN], 4096, sb * 32, perm, nullptr, F.Win0 + (size_t)tb * 32 * 1024, 1024, kb * 64, scr, lane); return; }
    it -= 2048;
    if (it < 512) { const int kb = it >> 5, tb = it & 31; p0_transpose_item(F.in[I_EWOUT], 1024, tb * 32, false, nullptr, F.Wout0 + (size_t)tb * 32 * 1024, 1024, kb * 64, scr, lane); return; }
    it -= 512;
    if (it < 384) {
        const int kb = it / 24, tb = it % 24; int sc; bool perm = false;
        if (tb < 8) sc = 384 + tb * 32;
        else if (tb < 16) sc = (tb - 8) * 32;
        else { const int blk = tb - 16, bj = blk >> 2, wc = blk & 3;
            if (bj == 0) { if (wc < 3) sc = 256 + wc * 32; else { sc = 640; perm = true; } }
            else { if (wc == 0) sc = 352; else if (wc == 3) { sc = 672; perm = true; } else sc = -1; } }
        p0_transpose_item(F.in[I_OWIN], 704, sc, perm, nullptr, F.Win1 + (size_t)tb * 32 * 1024, 1024, kb * 64, scr, lane); return; }
    it -= 384;
    if (it < 288) {
        const int kb = it / 48, tb = it % 48, t = tb >> 3, blk = tb & 7, bj = blk >> 2, wc = blk & 3; int sc; bool perm = false;
        if (t < 4) { const int h = 2 * t + bj; sc = h * 192 + 32 * wc; }
        else { const int h = 4 * (t - 4) + wc; sc = h * 192 + 128 + 32 * bj; perm = true; }
        p0_transpose_item(F.in[I_WUQ], 1536, sc, perm, F.in[I_QAG], F.Wuq + (size_t)tb * 32 * 384, 384, kb * 64, scr, lane); return; }
    it -= 288;
    if (it < 256) { const int kb = it >> 6, tb = it & 63; p0_transpose_item(F.in[I_WUKV], 2048, tb * 32, false, F.in[I_KVAG], F.Wukv + (size_t)tb * 32 * 256, 256, kb * 64, scr, lane); return; }
    it -= 256;
    if (it < 512) { const int kb = it >> 5, tb = it & 31; p0_transpose_item(F.in[I_OWOUT], 1024, tb * 32, false, nullptr, F.Wout1 + (size_t)tb * 32 * 1024, 1024, kb * 64, scr, lane); return; }
    it -= 512;
    {
        const int le = it / 768, r2 = it % 768, l = le / 17, e = le % 17;
        if (r2 < 512) { const int kb = r2 >> 5, tb = r2 & 31, pnl = tb >> 3, blk = tb & 7, bj = blk >> 2, wcb = blk & 3;
            const float* src = (e < 16) ? (bj ? F.in[I_EU] : F.in[I_EG]) + (size_t)(l * 16 + e) * 1024 * 512 : (bj ? F.in[I_SU] : F.in[I_SG]) + (size_t)l * 1024 * 512;
            p0_transpose_item(src, 512, (pnl * 4 + wcb) * 32, false, nullptr, F.Wgu + ((size_t)(l * 17 + e) * 1024 + tb * 32) * 1024, 1024, kb * 64, scr, lane); }
        else { const int r3 = r2 - 512, kb = r3 >> 5, tb = r3 & 31;
            const float* src = (e < 16) ? F.in[I_ED] + (size_t)(l * 16 + e) * 512 * 1024 : F.in[I_SD] + (size_t)l * 512 * 1024;
            p0_transpose_item(src, 1024, tb * 32, false, nullptr, F.Wd + ((size_t)(l * 17 + e) * 1024 + tb * 32) * 512, 512, kb * 64, scr, lane); }
    }
}
constexpr int P0_NITEMS = 2048 + 512 + 384 + 288 + 256 + 512 + 2 * 17 * 768;

__device__ __forceinline__ void p0_prologue(Frame& F) {
    LAS float* ldsf = (LAS float*)F.lds;
    for (int it = F.bid; it < 192; it += F.G) {
        const int l = it / 96, n0 = (it % 96) * 64;
        LAS float* sc = ldsf;
        LAS float* red = ldsf + 9 * 1024;
        for (int e = F.tid; e < 9 * 1024; e += NTHREADS) { const int r = e >> 10, k = e & 1023; const float v = (r < 8) ? F.in[I_C][r * 1024 + k] : F.in[I_CCTX][k]; sc[e] = siluf_(v); }
        __syncthreads();
        float a[9];
#pragma unroll
        for (int r = 0; r < 9; ++r) a[r] = 0.f;
        const float* w = F.in[I_MODW] + (size_t)l * 1024 * 6144 + n0 + F.lane;
        const int kbeg = F.wave * 128;
#pragma unroll 4
        for (int k = kbeg; k < kbeg + 128; ++k) { const float wv = w[(size_t)k * 6144];
#pragma unroll
            for (int r = 0; r < 9; ++r) a[r] += sc[r * 1024 + k] * wv; }
#pragma unroll
        for (int r = 0; r < 9; ++r) red[(F.wave * 9 + r) * 64 + F.lane] = a[r];
        __syncthreads();
        for (int e = F.tid; e < 9 * 64; e += NTHREADS) { const int r = e >> 6, c = e & 63; float s = 0.f;
#pragma unroll
            for (int w8 = 0; w8 < 8; ++w8) s += red[(w8 * 9 + r) * 64 + c];
            F.modv[(size_t)(l * 9 + r) * 6144 + n0 + c] = s + F.in[I_MODB][l * 6144 + n0 + c]; }
        __syncthreads();
    }
    if (F.bid == F.G - 1) {
        for (int e = F.tid; e < 96 * 16; e += NTHREADS) { const int p = e >> 4, i = e & 15;
            const float inv = __builtin_amdgcn_exp2f(-(float)(2 * i) * (1.0f / 32.0f) * 13.287712379549449f);
            const float pos = (p < 32) ? (float)p : (float)(p - 32); const float ang = pos * inv;
            const f32x2 cs = {__cosf(ang), __sinf(ang)};
            if (p < 32) F.ropeR[p * 16 + i] = cs; else F.ropeC[(p - 32) * 16 + i] = cs; }
        for (int e = F.tid; e < 1024; e += NTHREADS) { const float l0 = F.in[I_LBL][e], l1 = F.in[I_LBL][1024 + e]; F.lbv[e] = 1.0f / (1.0f + fexp(l1 - l0)); }
        if (F.wave == 0) { const float* lv = F.in[I_DLAM]; float s1 = wave_sum(lv[F.lane] * lv[64 + F.lane]), s2 = wave_sum(lv[128 + F.lane] * lv[192 + F.lane]);
            if (F.lane == 0) { F.lamv[0] = fexp(s1) - fexp(s2) + 0.2f; } }
    }
    __syncthreads();
    LAS float* scr = (LAS float*)(F.lds + F.wave * 8704);
    const int gw = F.bid * NWAVES + F.wave, NGW = F.G * NWAVES;
    for (int it = gw; it < P0_NITEMS; it += NGW) p0_convert_item(F, it, scr);
}

__device__ __forceinline__ void modnorm_store(const f32x4 (&v)[4], const float* gain, const float* sh, const float* sc, bf16* orow, int lane) {
    float s = 0.f;
#pragma unroll
    for (int j = 0; j < 4; ++j) s += (v[j].x * v[j].x + v[j].y * v[j].y) + (v[j].z * v[j].z + v[j].w * v[j].w);
    const float rstd = 1.0f / sqrtf(wave_sum(s) * (1.0f / D) + EPS);
#pragma unroll
    for (int j = 0; j < 4; ++j) { const int c = 4 * (lane + 64 * j);
        const f32x4 g = *(const f32x4*)(gain + c), a = *(const f32x4*)(sc + c), b = *(const f32x4*)(sh + c);
        const f32x4 y = (v[j] * rstd) * g * (1.0f + a) + b;
        v2u o; o.x = pk2(y.x, y.y); o.y = pk2(y.z, y.w); *(v2u*)(orow + c) = o; }
}

__device__ __forceinline__ void p_norm0(Frame& F) {
    const int gw = F.bid * NWAVES + F.wave, NGW = F.G * NWAVES;
    for (int R = gw; R < NR; R += NGW) {
        const int b = R / RPB, s = R - b * RPB, r = s < CTXL ? 8 : b;
        const f32x4* src = (const f32x4*)xin_ptr(F, b, s) + F.lane;
        f32x4 v[4];
#pragma unroll
        for (int j = 0; j < 4; ++j) v[j] = src[64 * j];
        const float* mv = F.modv + (size_t)(0 * 9 + r) * 6144;
        modnorm_store(v, F.in[I_NMIX], mv + 0, mv + 1024, F.H + (size_t)R * D, F.lane);
    }
}

__device__ __forceinline__ void p_hgrn_post(Frame& F) {
    const int gw = F.bid * NWAVES + F.wave, NGW = F.G * NWAVES;
    const bf16* Ho0 = (const bf16*)(F.big + B_HO0); const bf16* Ho1 = (const bf16*)(F.big + B_HO1); const bf16* Hg = (const bf16*)(F.big + B_HG);
    for (int R = gw; R < NR; R += NGW) {
        const int c = F.lane * 8;
        const v4u a = *(const v4u*)(Ho0 + (size_t)R * 512 + c), bq = *(const v4u*)(Ho1 + (size_t)R * 512 + c), g = *(const v4u*)(Hg + (size_t)R * 512 + c);
        float o[8];
        o[0] = bflo(a.x) + bflo(bq.x); o[1] = bfhi(a.x) + bfhi(bq.x); o[2] = bflo(a.y) + bflo(bq.y); o[3] = bfhi(a.y) + bfhi(bq.y);
        o[4] = bflo(a.z) + bflo(bq.z); o[5] = bfhi(a.z) + bfhi(bq.z); o[6] = bflo(a.w) + bflo(bq.w); o[7] = bfhi(a.w) + bfhi(bq.w);
        float s = 0.f;
#pragma unroll
        for (int i = 0; i < 8; ++i) s += o[i] * o[i];
        s += __shfl_xor(s, 1); s += __shfl_xor(s, 2); s += __shfl_xor(s, 4); s += __shfl_xor(s, 8);
        const float rstd = 1.0f / sqrtf(s * (1.0f / 128.0f) + EPS);
        const float* og = F.in[I_HOG] + (c & 127);
        const float gg[8] = {bflo(g.x), bfhi(g.x), bflo(g.y), bfhi(g.y), bflo(g.z), bfhi(g.z), bflo(g.w), bfhi(g.w)};
        float y[8];
#pragma unroll
        for (int i = 0; i < 8; ++i) y[i] = o[i] * rstd * og[i] * gg[i];
        v4u w; w.x = pk2(y[0], y[1]); w.y = pk2(y[2], y[3]); w.z = pk2(y[4], y[5]); w.w = pk2(y[6], y[7]);
        *(v4u*)(F.H + (size_t)R * D + 512 + c) = w;
    }
}

__device__ __forceinline__ void p_norm_route(Frame& F, int layer, bool lat_only) {
    const int gw = F.bid * NWAVES + F.wave, NGW = F.G * NWAVES;
    const float* rw = F.in[I_RW];
    unsigned* cnt = (unsigned*)(F.ctl + CW_CNT + 64 * layer);
    for (int R = gw; R < NR; R += NGW) {
        const int b = R / RPB, s = R - b * RPB, r = s < CTXL ? 8 : b;
        if (lat_only && s < CTXL) continue;
        const f32x4* src = (const f32x4*)xrow_ptr(F, b, s) + F.lane;
        f32x4 v[4];
#pragma unroll
        for (int j = 0; j < 4; ++j) v[j] = src[64 * j];
        const float* mv = F.modv + (size_t)(layer * 9 + r) * 6144;
        const float* gain = F.in[I_NFFN] + layer * 1024; const float* sh = mv + 3072; const float* sc = mv + 4096;
        float ss = 0.f;
#pragma unroll
        for (int j = 0; j < 4; ++j) ss += (v[j].x * v[j].x + v[j].y * v[j].y) + (v[j].z * v[j].z + v[j].w * v[j].w);
        const float rstd = 1.0f / sqrtf(wave_sum(ss) * (1.0f / D) + EPS);
        float lg[16];
#pragma unroll
        for (int e = 0; e < 16; ++e) lg[e] = 0.f;
#pragma unroll
        for (int j = 0; j < 4; ++j) { const int c = 4 * (F.lane + 64 * j);
            const f32x4 g = *(const f32x4*)(gain + c), a = *(const f32x4*)(sc + c), bb = *(const f32x4*)(sh + c);
            const f32x4 y = (v[j] * rstd) * g * (1.0f + a) + bb;
            v2u o; o.x = pk2(y.x, y.y); o.y = pk2(y.z, y.w); *(v2u*)(F.H + (size_t)R * D + c) = o;
#pragma unroll
            for (int q = 0; q < 4; ++q) { const float yv = y[q]; const f32x4* wr = (const f32x4*)(rw + (size_t)(c + q) * 16);
                const f32x4 w0 = wr[0], w1 = wr[1], w2 = wr[2], w3 = wr[3];
                lg[0] += yv * w0.x; lg[1] += yv * w0.y; lg[2] += yv * w0.z; lg[3] += yv * w0.w;
                lg[4] += yv * w1.x; lg[5] += yv * w1.y; lg[6] += yv * w1.z; lg[7] += yv * w1.w;
                lg[8] += yv * w2.x; lg[9] += yv * w2.y; lg[10] += yv * w2.z; lg[11] += yv * w2.w;
                lg[12] += yv * w3.x; lg[13] += yv * w3.y; lg[14] += yv * w3.z; lg[15] += yv * w3.w; } }
#pragma unroll
        for (int e = 0; e < 16; ++e) lg[e] = wave_sum(lg[e]);
        float scv[16], bi[16];
#pragma unroll
        for (int e = 0; e < 16; ++e) { scv[e] = sigmoidf_(lg[e]); bi[e] = scv[e] + F.in[I_RB][e]; }
        float bestgs = -3.0e38f; int e1 = 0, e2 = 1; float w1 = 0.f, w2 = 0.f;
#pragma unroll
        for (int g = 0; g < 4; ++g) {
            const float x0 = bi[4 * g], x1 = bi[4 * g + 1], x2 = bi[4 * g + 2], x3 = bi[4 * g + 3];
            const float gs = fmaxf(fmaxf(fmaxf(x0 + x1, x0 + x2), fmaxf(x0 + x3, x1 + x2)), fmaxf(x1 + x3, x2 + x3));
            int i1 = 0; float m1 = x0;
            if (x1 > m1) { m1 = x1; i1 = 1; } if (x2 > m1) { m1 = x2; i1 = 2; } if (x3 > m1) { m1 = x3; i1 = 3; }
            int i2 = -1; float m2 = -3.0e38f;
            if (i1 != 0 && x0 > m2) { m2 = x0; i2 = 0; } if (i1 != 1 && x1 > m2) { m2 = x1; i2 = 1; } if (i1 != 2 && x2 > m2) { m2 = x2; i2 = 2; } if (i1 != 3 && x3 > m2) { m2 = x3; i2 = 3; }
            const float s0 = scv[4 * g], s1 = scv[4 * g + 1], s2 = scv[4 * g + 2], s3 = scv[4 * g + 3];
            const float wa = i1 == 0 ? s0 : i1 == 1 ? s1 : i1 == 2 ? s2 : s3;
            const float wb = i2 == 0 ? s0 : i2 == 1 ? s1 : i2 == 2 ? s2 : s3;
            if (gs > bestgs) { bestgs = gs; e1 = 4 * g + i1; e2 = 4 * g + i2; w1 = wa; w2 = wb; }
        }
        const float wn = 1.0f / (w1 + w2); w1 *= wn; w2 *= wn;
        if (F.lane == 0) {
            const unsigned s1 = __hip_atomic_fetch_add(cnt + e1, 1u, RLX_AGENT), s2 = __hip_atomic_fetch_add(cnt + e2, 1u, RLX_AGENT);
            F.route_e[R] = e1 | (e2 << 8); F.route_w[2 * R] = w1; F.route_w[2 * R + 1] = w2; F.route_s[2 * R] = (int)s1; F.route_s[2 * R + 1] = (int)s2;
        }
    }
}

struct ExpOff { int off[17]; };
__device__ __forceinline__ void load_expoff(Frame& F, int layer, ExpOff& eo) {
    const unsigned* cnt = (const unsigned*)(F.ctl + CW_CNT + 64 * layer); int a = 0;
#pragma unroll
    for (int e = 0; e < 16; ++e) { eo.off[e] = a; const int c = (int)__hip_atomic_load(cnt + e, RLX_AGENT); a += (c + 255) & ~255; }
    eo.off[16] = a;
}
__device__ __forceinline__ int expoff_sel(const ExpOff& eo, int e) { int r = 0;
#pragma unroll
    for (int i = 0; i < 16; ++i) r = (e == i) ? eo.off[i] : r;
    return r; }

__device__ __forceinline__ void p_lists(Frame& F, int layer, bool lat_only) {
    ExpOff eo; load_expoff(F, layer, eo);
    const unsigned* cnt = (const unsigned*)(F.ctl + CW_CNT + 64 * layer);
    const int gt = F.bid * NTHREADS + F.tid, NGT = F.G * NTHREADS;
    for (int R = gt; R < NR; R += NGT) {
        const int s = R % RPB; if (lat_only && s < CTXL) continue;
        const int ee = F.route_e[R], e1 = ee & 255, e2 = ee >> 8;
        const int p1 = expoff_sel(eo, e1) + F.route_s[2 * R], p2 = expoff_sel(eo, e2) + F.route_s[2 * R + 1];
        F.rowidx[p1] = R; F.rowidx[p2] = R; F.pos[2 * R] = p1; F.pos[2 * R + 1] = p2;
    }
    if (F.bid < 16) { const int e = F.bid; const int c = (int)__hip_atomic_load(cnt + e, RLX_AGENT); const int o = expoff_sel(eo, e);
        for (int p = o + c + F.tid; p < o + ((c + 255) & ~255); p += NTHREADS) F.rowidx[p] = lat_only ? CTXL : 0; }
}

__device__ __forceinline__ void p_combine(Frame& F, int layer, bool lat_only, bool do_norm) {
    const int gw = F.bid * NWAVES + F.wave, NGW = F.G * NWAVES;
    const bf16* Ye = (const bf16*)(F.big + B_YE);
    for (int R = gw; R < NR; R += NGW) {
        const int b = R / RPB, s = R - b * RPB, r = s < CTXL ? 8 : b;
        if (lat_only && s < CTXL) continue;
        float* xr = xrow_ptr(F, b, s);
        const float* gf = F.modv + (size_t)(layer * 9 + r) * 6144 + 5120;
        const int p1 = F.pos[2 * R], p2 = F.pos[2 * R + 1]; const float w1 = F.route_w[2 * R], w2 = F.route_w[2 * R + 1];
        f32x4 v[4];
#pragma unroll
        for (int j = 0; j < 4; ++j) { const int c = 4 * (F.lane + 64 * j);
            const f32x4 x = *(const f32x4*)(xr + c), g = *(const f32x4*)(gf + c);
            const v2u a = *(const v2u*)(Ye + (size_t)p1 * D + c), bq = *(const v2u*)(Ye + (size_t)p2 * D + c);
            f32x4 m; m.x = w1 * bflo(a.x) + w2 * bflo(bq.x); m.y = w1 * bfhi(a.x) + w2 * bfhi(bq.x); m.z = w1 * bflo(a.y) + w2 * bflo(bq.y); m.w = w1 * bfhi(a.y) + w2 * bfhi(bq.y);
            v[j] = x + g * m; *(f32x4*)(xr + c) = v[j]; }
        if (do_norm) { const float* mv = F.modv + (size_t)((layer + 1) * 9 + r) * 6144;
            modnorm_store(v, F.in[I_NMIX] + (layer + 1) * 1024, mv + 0, mv + 1024, F.H + (size_t)R * D, F.lane); }
    }
}

struct Unit { int pm, pn; };
struct Gemm { const bf16* A; const bf16* Bt; int K; const int* gather; };
template <class Epi, class Sched>
__device__ __forceinline__ void gemm_v0(const Gemm g, const Sched& S, const Epi& E) {
    const int tid = threadIdx.x, wid = __builtin_amdgcn_readfirstlane(tid >> 6), lane = tid & 63, wr = wid >> 2, wc = wid & 3, fr = lane & 15, fq = lane >> 4;
    const int K = g.K;
    Unit u;
    for (int i = 0; S.next(i, u); ++i) {
        f32x4 acc[2][2][4][2];
#pragma unroll
        for (int a = 0; a < 2; ++a)
#pragma unroll
            for (int b = 0; b < 2; ++b)
#pragma unroll
                for (int m = 0; m < 4; ++m)
#pragma unroll
                    for (int n = 0; n < 2; ++n) acc[a][b][m][n] = (f32x4){0.f, 0.f, 0.f, 0.f};
        unsigned aoff[2][4], boff[2][2];
#pragma unroll
        for (int ai = 0; ai < 2; ++ai)
#pragma unroll
            for (int m = 0; m < 4; ++m) { const int rr = u.pm * 256 + ai * 128 + wr * 64 + m * 16 + fr; const int arow = g.gather ? g.gather[rr] : rr; aoff[ai][m] = (unsigned)arow * (unsigned)K * 2u + fq * 16u; }
#pragma unroll
        for (int bj = 0; bj < 2; ++bj)
#pragma unroll
            for (int n = 0; n < 2; ++n) { const int rho = 16 * n + fr; const int brow = u.pn * 256 + bj * 128 + wc * 32 + (Epi::PERM ? perm32(rho) : rho); boff[bj][n] = (unsigned)brow * (unsigned)K * 2u + fq * 16u; }
        const char* Ab = (const char*)g.A; const char* Bb = (const char*)g.Bt;
        for (int kt = 0; kt < K; kt += 32) {
            bf16x8 b[2][2];
#pragma unroll
            for (int bj = 0; bj < 2; ++bj)
#pragma unroll
                for (int n = 0; n < 2; ++n) b[bj][n] = *(const bf16x8*)(Bb + boff[bj][n] + kt * 2);
#pragma unroll
            for (int ai = 0; ai < 2; ++ai) {
                bf16x8 a[4];
#pragma unroll
                for (int m = 0; m < 4; ++m) a[m] = *(const bf16x8*)(Ab + aoff[ai][m] + kt * 2);
#pragma unroll
                for (int bj = 0; bj < 2; ++bj)
#pragma unroll
                    for (int m = 0; m < 4; ++m)
#pragma unroll
                        for (int n = 0; n < 2; ++n) acc[ai][bj][m][n] = __builtin_amdgcn_mfma_f32_16x16x32_bf16(b[bj][n], a[m], acc[ai][bj][m][n], 0, 0, 0);
                asm volatile("" ::: "memory");
            }
        }
        E(acc, u, wr, wc, fr, fq);
    }
}

struct SchedGrid {
    int nm, nn, G, c; bool lat;
    __device__ __forceinline__ bool next(int i, Unit& u) const { const int L = i * G + c; if (L >= nm * nn) return false; int pm = L / nn; u.pn = L - pm * nn; if (lat) pm = (pm >> 3) * 9 + 1 + (pm & 7); u.pm = pm; return true; }
};
struct SchedRouted {
    ExpOff eo; int G, c;
    __device__ __forceinline__ bool next(int i, Unit& u) const { const int L = i * G + c; const int nt = eo.off[16] >> 8; if (L >= nt * 4) return false; const int pm = L >> 2, pnl = L & 3; int e = 0;
#pragma unroll
        for (int k = 1; k < 16; ++k) e += (pm * 256 >= eo.off[k]) ? 1 : 0;
        u.pm = pm; u.pn = e * 4 + pnl; return true; }
};

__device__ __forceinline__ v4u pack8(const f32x4 a, const f32x4 b) { v4u w; w.x = pk2(a[0], a[1]); w.y = pk2(a[2], a[3]); w.z = pk2(b[0], b[1]); w.w = pk2(b[2], b[3]); return w; }

struct EpiIn0 {
    static constexpr bool PERM = true;
    unsigned char* big; const float *qg, *kg, *lbv; const f32x2 *ropeR, *ropeC;
    __device__ __forceinline__ void operator()(const f32x4 (&acc)[2][2][4][2], const Unit& u, int wr, int wc, int fr, int fq) const {
        const int pn = u.pn, type = pn >> 1, j9 = u.pm % 9; const bool lat = j9 > 0;
        if (type < 2) {
            const float* gain = type ? kg : qg; bf16* dst = (bf16*)(big + (type ? B_KD : B_QD));
            const int h = 2 * (pn & 1) + (wc >> 1), c = wc & 1;
            f32x4 g[2][2];
#pragma unroll
            for (int bj = 0; bj < 2; ++bj)
#pragma unroll
                for (int n = 0; n < 2; ++n) g[bj][n] = *(const f32x4*)(gain + 32 * bj + 16 * n + 4 * fq);
#pragma unroll
            for (int ai = 0; ai < 2; ++ai)
#pragma unroll
                for (int m = 0; m < 4; ++m) {
                    const int rr = opaque(ai * 128 + wr * 64 + m * 16 + fr); const size_t R = (size_t)u.pm * 256 + rr;
                    float s = 0.f;
#pragma unroll
                    for (int bj = 0; bj < 2; ++bj)
#pragma unroll
                        for (int n = 0; n < 2; ++n) { const f32x4 x = acc[ai][bj][m][n]; s += (x[0] * x[0] + x[1] * x[1]) + (x[2] * x[2] + x[3] * x[3]); }
                    s += __shfl_xor(s, 16); s += __shfl_xor(s, 32);
                    const float rstd = 1.0f / sqrtf(s * (1.0f / 64.0f) + EPS);
                    f32x4 y[2][2];
#pragma unroll
                    for (int bj = 0; bj < 2; ++bj)
#pragma unroll
                        for (int n = 0; n < 2; ++n) y[bj][n] = acc[ai][bj][m][n] * rstd * g[bj][n];
                    if (lat) { const int t = (j9 - 1) * 256 + rr, grow = t >> 6, gcol = t & 63;
#pragma unroll
                        for (int bj = 0; bj < 2; ++bj) { const f32x2* tab = bj ? (ropeC + gcol * 16 + 4 * fq) : (ropeR + grow * 16 + 4 * fq);
                            const f32x4 t0 = *(const f32x4*)tab, t1 = *(const f32x4*)(tab + 2);
                            const float cs[4] = {t0[0], t0[2], t1[0], t1[2]}, sn[4] = {t0[1], t0[3], t1[1], t1[3]};
#pragma unroll
                            for (int e = 0; e < 4; ++e) { const float x1 = y[bj][0][e], x2 = y[bj][1][e]; y[bj][0][e] = x1 * cs[e] - x2 * sn[e]; y[bj][1][e] = x1 * sn[e] + x2 * cs[e]; } } }
#pragma unroll
                    for (int bj = 0; bj < 2; ++bj) *(v4u*)(dst + R * 512 + h * 128 + c * 64 + 32 * bj + 8 * fq) = pack8(y[bj][0], y[bj][1]);
                    asm volatile("" ::: "memory");
                }
        } else {
            const int colt = (pn & 1) * 256;
            size_t boffs; if (type == 2) boffs = B_VD; else if (type == 3) boffs = B_HQ; else if (type == 4) boffs = B_LF0; else if (type == 5) boffs = B_LF1; else if (type == 6) boffs = B_HV; else boffs = B_HG;
            bf16* dst = (bf16*)(big + boffs);
#pragma unroll
            for (int bj = 0; bj < 2; ++bj) { const int col = colt + bj * 128 + wc * 32 + 8 * fq;
                f32x4 lb0 = {0.f, 0.f, 0.f, 0.f}, lb1 = lb0;
                if (type == 4 || type == 5) { const float* lp = lbv + (type - 4) * 512 + col; lb0 = *(const f32x4*)lp; lb1 = *(const f32x4*)(lp + 4); }
#pragma unroll
                for (int ai = 0; ai < 2; ++ai)
#pragma unroll
                    for (int m = 0; m < 4; ++m) { const size_t R = (size_t)u.pm * 256 + opaque(ai * 128 + wr * 64 + m * 16 + fr);
                        f32x4 a = acc[ai][bj][m][0], b = acc[ai][bj][m][1]; v4u w;
                        if (type == 3 || type == 7) {
#pragma unroll
                            for (int e = 0; e < 4; ++e) { a[e] = siluf_(a[e]); b[e] = siluf_(b[e]); }
                            w = pack8(a, b);
                        } else if (type == 4 || type == 5) {
#pragma unroll
                            for (int e = 0; e < 4; ++e) { a[e] = __logf(lb0[e] + (1.0f - lb0[e]) * sigmoidf_(a[e])); b[e] = __logf(lb1[e] + (1.0f - lb1[e]) * sigmoidf_(b[e])); }
                            w.x = pkh2(a[0], a[1]); w.y = pkh2(a[2], a[3]); w.z = pkh2(b[0], b[1]); w.w = pkh2(b[2], b[3]);
                        } else w = pack8(a, b);
                        *(v4u*)(dst + R * 512 + col) = w; asm volatile("" ::: "memory"); } }
        }
    }
};

struct EpiOut {
    static constexpr bool PERM = false;
    const Frame* F; int layer; bool from_input;
    __device__ __forceinline__ void operator()(const f32x4 (&acc)[2][2][4][2], const Unit& u, int wr, int wc, int fr, int fq) const {
        const int b = u.pm / 9, j9 = u.pm % 9, r = j9 ? b : 8;
        const float* gm = F->modv + (size_t)(layer * 9 + r) * 6144 + 2048;
#pragma unroll
        for (int ai = 0; ai < 2; ++ai)
#pragma unroll
            for (int m = 0; m < 4; ++m) { const int s = j9 * 256 + opaque(ai * 128 + wr * 64 + m * 16 + fr);
                float* xo = xrow_ptr(*F, b, s); const float* xb = from_input ? xin_ptr(*F, b, s) : xo;
#pragma unroll
                for (int bj = 0; bj < 2; ++bj)
#pragma unroll
                    for (int n = 0; n < 2; ++n) { const int col = u.pn * 256 + bj * 128 + wc * 32 + 16 * n + 4 * fq;
                        *(f32x4*)(xo + col) = *(const f32x4*)(xb + col) + *(const f32x4*)(gm + col) * acc[ai][bj][m][n]; } asm volatile("" ::: "memory"); }
    }
};

struct EpiGU {
    static constexpr bool PERM = true;
    bf16* Hout;
    __device__ __forceinline__ void operator()(const f32x4 (&acc)[2][2][4][2], const Unit& u, int wr, int wc, int fr, int fq) const {
        const int pnl = u.pn & 3;
#pragma unroll
        for (int ai = 0; ai < 2; ++ai)
#pragma unroll
            for (int m = 0; m < 4; ++m) { const size_t row = (size_t)u.pm * 256 + opaque(ai * 128 + wr * 64 + m * 16 + fr);
                f32x4 h[2];
#pragma unroll
                for (int n = 0; n < 2; ++n)
#pragma unroll
                    for (int e = 0; e < 4; ++e) h[n][e] = siluf_(acc[ai][0][m][n][e]) * acc[ai][1][m][n][e];
                *(v4u*)(Hout + row * 512 + pnl * 128 + wc * 32 + 8 * fq) = pack8(h[0], h[1]); }
    }
};

struct EpiDownS {
    static constexpr bool PERM = false;
    const Frame* F; int layer;
    __device__ __forceinline__ void operator()(const f32x4 (&acc)[2][2][4][2], const Unit& u, int wr, int wc, int fr, int fq) const {
        const int b = u.pm / 9, j9 = u.pm % 9, r = j9 ? b : 8;
        const float* gf = F->modv + (size_t)(layer * 9 + r) * 6144 + 5120;
#pragma unroll
        for (int ai = 0; ai < 2; ++ai)
#pragma unroll
            for (int m = 0; m < 4; ++m) { const int s = j9 * 256 + opaque(ai * 128 + wr * 64 + m * 16 + fr); float* xo = xrow_ptr(*F, b, s);
#pragma unroll
                for (int bj = 0; bj < 2; ++bj)
#pragma unroll
                    for (int n = 0; n < 2; ++n) { const int col = u.pn * 256 + bj * 128 + wc * 32 + 16 * n + 4 * fq;
                        *(f32x4*)(xo + col) = *(const f32x4*)(xo + col) + *(const f32x4*)(gf + col) * acc[ai][bj][m][n]; } asm volatile("" ::: "memory"); }
    }
};

struct EpiDownR {
    static constexpr bool PERM = true;
    bf16* Ye;
    __device__ __forceinline__ void operator()(const f32x4 (&acc)[2][2][4][2], const Unit& u, int wr, int wc, int fr, int fq) const {
        const int pnl = u.pn & 3;
#pragma unroll
        for (int ai = 0; ai < 2; ++ai)
#pragma unroll
            for (int m = 0; m < 4; ++m) { const size_t row = (size_t)u.pm * 256 + opaque(ai * 128 + wr * 64 + m * 16 + fr);
#pragma unroll
                for (int bj = 0; bj < 2; ++bj) *(v4u*)(Ye + row * 1024 + pnl * 256 + bj * 128 + wc * 32 + 8 * fq) = pack8(acc[ai][bj][m][0], acc[ai][bj][m][1]); }
    }
};

struct EpiIn1 {
    static constexpr bool PERM = true;
    unsigned char* big; float* ssq; const float* krg; const f32x2 *ropeR, *ropeC;
    __device__ __forceinline__ void operator()(const f32x4 (&acc)[2][2][4][2], const Unit& u, int wr, int wc, int fr, int fq) const {
        const int pn = u.pn, j9 = u.pm % 9; const bool lat = j9 > 0;
        bf16* Ckv = (bf16*)(big + B_CKV); bf16* Cq = (bf16*)(big + B_CQ); bf16* Kr = (bf16*)(big + B_KR);
        if (pn == 2 && wc == 3) {
#pragma unroll
            for (int ai = 0; ai < 2; ++ai)
#pragma unroll
                for (int m = 0; m < 4; ++m) {
                    const int rr = opaque(ai * 128 + wr * 64 + m * 16 + fr); const size_t R = (size_t)u.pm * 256 + rr;
                    float s = 0.f;
#pragma unroll
                    for (int bj = 0; bj < 2; ++bj)
#pragma unroll
                        for (int n = 0; n < 2; ++n) { const f32x4 x = acc[ai][bj][m][n]; s += (x[0] * x[0] + x[1] * x[1]) + (x[2] * x[2] + x[3] * x[3]); }
                    s += __shfl_xor(s, 16); s += __shfl_xor(s, 32);
                    const float rstd = 1.0f / sqrtf(s * (1.0f / 64.0f) + EPS);
                    f32x4 y[2][2];
#pragma unroll
                    for (int bj = 0; bj < 2; ++bj)
#pragma unroll
                        for (int n = 0; n < 2; ++n) y[bj][n] = acc[ai][bj][m][n] * rstd * *(const f32x4*)(krg + 32 * bj + 16 * n + 4 * fq);
                    if (lat) { const int t = (j9 - 1) * 256 + rr, grow = t >> 6, gcol = t & 63;
#pragma unroll
                        for (int bj = 0; bj < 2; ++bj) { const f32x2* tab = bj ? (ropeC + gcol * 16 + 4 * fq) : (ropeR + grow * 16 + 4 * fq);
                            const f32x4 t0 = *(const f32x4*)tab, t1 = *(const f32x4*)(tab + 2);
                            const float cs[4] = {t0[0], t0[2], t1[0], t1[2]}, sn[4] = {t0[1], t0[3], t1[1], t1[3]};
#pragma unroll
                            for (int e = 0; e < 4; ++e) { const float x1 = y[bj][0][e], x2 = y[bj][1][e]; y[bj][0][e] = x1 * cs[e] - x2 * sn[e]; y[bj][1][e] = x1 * sn[e] + x2 * cs[e]; } } }
#pragma unroll
                    for (int bj = 0; bj < 2; ++bj) *(v4u*)(Kr + R * 64 + 32 * bj + 8 * fq) = pack8(y[bj][0], y[bj][1]);
                    asm volatile("" ::: "memory");
                }
            return;
        }
#pragma unroll
        for (int ai = 0; ai < 2; ++ai)
#pragma unroll
            for (int m = 0; m < 4; ++m) {
                const size_t R = (size_t)u.pm * 256 + opaque(ai * 128 + wr * 64 + m * 16 + fr);
                float s = 0.f;
#pragma unroll
                for (int bj = 0; bj < 2; ++bj) { const f32x4 a = acc[ai][bj][m][0], b = acc[ai][bj][m][1];
                    s += (a[0] * a[0] + a[1] * a[1]) + (a[2] * a[2] + a[3] * a[3]) + (b[0] * b[0] + b[1] * b[1]) + (b[2] * b[2] + b[3] * b[3]);
                    const v4u w = pack8(a, b);
                    if (pn == 0) *(v4u*)(Ckv + R * 256 + bj * 128 + wc * 32 + 8 * fq) = w;
                    else if (pn == 1) *(v4u*)(Cq + R * 384 + bj * 128 + wc * 32 + 8 * fq) = w;
                    else { if (bj == 0) *(v4u*)(Cq + R * 384 + 256 + wc * 32 + 8 * fq) = w; else if (wc == 0) *(v4u*)(Cq + R * 384 + 352 + 8 * fq) = w; } }
                s += __shfl_xor(s, 16); s += __shfl_xor(s, 32);
                if (fq == 0) ssq[R * 12 + pn * 4 + wc] = s;
                asm volatile("" ::: "memory");
            }
    }
};

struct EpiUq {
    static constexpr bool PERM = true;
    bf16* Q1; const float* ssq; const float *qng, *qrg; const f32x2 *ropeR, *ropeC; LAS float* xl;
    __device__ __forceinline__ float rq_of(size_t R) const { const float* sp = ssq + R * 12; const f32x4 s1 = *(const f32x4*)(sp + 4), s2 = *(const f32x4*)(sp + 8);
        return 1.0f / sqrtf(((s1[0] + s1[1]) + (s1[2] + s1[3]) + (s2[0] + s2[1]) + s2[2]) * (1.0f / 384.0f) + EPS); }
    __device__ __forceinline__ void operator()(const f32x4 (&acc)[2][2][4][2], const Unit& u, int wr, int wc, int fr, int fq) const {
        const int pn = u.pn, j9 = u.pm % 9;
        if (pn < 4) {
#pragma unroll
            for (int ai = 0; ai < 2; ++ai)
#pragma unroll
                for (int m = 0; m < 4; ++m)
#pragma unroll
                    for (int bj = 0; bj < 2; ++bj) { float s = 0.f;
#pragma unroll
                        for (int n = 0; n < 2; ++n) { const f32x4 x = acc[ai][bj][m][n]; s += (x[0] * x[0] + x[1] * x[1]) + (x[2] * x[2] + x[3] * x[3]); }
                        s += __shfl_xor(s, 16); s += __shfl_xor(s, 32);
                        if (fq == 0) xl[(ai * 128 + wr * 64 + m * 16 + fr) * 8 + bj * 4 + wc] = s; }
            __syncthreads();
            f32x4 g[2];
#pragma unroll
            for (int n = 0; n < 2; ++n) g[n] = *(const f32x4*)(qng + wc * 32 + 8 * fq + 4 * n);
#pragma unroll
            for (int ai = 0; ai < 2; ++ai)
#pragma unroll
                for (int m = 0; m < 4; ++m) { const int rr = opaque(ai * 128 + wr * 64 + m * 16 + fr); const size_t R = (size_t)u.pm * 256 + rr; const float rq = rq_of(R);
#pragma unroll
                    for (int bj = 0; bj < 2; ++bj) { const f32x4 p = *(const LAS f32x4*)(xl + rr * 8 + bj * 4);
                        const float rstd = rq / sqrtf(((p[0] + p[1]) + (p[2] + p[3])) * (rq * rq) * (1.0f / 128.0f) + EPS);
                        const int h = 2 * pn + bj;
                        *(v4u*)(Q1 + R * 1536 + h * 192 + wc * 32 + 8 * fq) = pack8(acc[ai][bj][m][0] * rstd * g[0], acc[ai][bj][m][1] * rstd * g[1]); } asm volatile("" ::: "memory"); }
            __syncthreads();
        } else {
            const int h = 4 * (pn - 4) + wc;
#pragma unroll
            for (int ai = 0; ai < 2; ++ai)
#pragma unroll
                for (int m = 0; m < 4; ++m) {
                    const int rr = opaque(ai * 128 + wr * 64 + m * 16 + fr); const size_t R = (size_t)u.pm * 256 + rr; const float rq = rq_of(R);
                    float s = 0.f; f32x4 y[2][2];
#pragma unroll
                    for (int bj = 0; bj < 2; ++bj)
#pragma unroll
                        for (int n = 0; n < 2; ++n) { const f32x4 x = acc[ai][bj][m][n] * rq; y[bj][n] = x; s += (x[0] * x[0] + x[1] * x[1]) + (x[2] * x[2] + x[3] * x[3]); }
                    s += __shfl_xor(s, 16); s += __shfl_xor(s, 32);
                    const float rstd = 1.0f / sqrtf(s * (1.0f / 64.0f) + EPS);
#pragma unroll
                    for (int bj = 0; bj < 2; ++bj)
#pragma unroll
                        for (int n = 0; n < 2; ++n) y[bj][n] = y[bj][n] * rstd * *(const f32x4*)(qrg + 32 * bj + 16 * n + 4 * fq);
                    { const int t = (j9 - 1) * 256 + rr, grow = t >> 6, gcol = t & 63;
#pragma unroll
                        for (int bj = 0; bj < 2; ++bj) { const f32x2* tab = bj ? (ropeC + gcol * 16 + 4 * fq) : (ropeR + grow * 16 + 4 * fq);
                            const f32x4 t0 = *(const f32x4*)tab, t1 = *(const f32x4*)(tab + 2);
                            const float cs[4] = {t0[0], t0[2], t1[0], t1[2]}, sn[4] = {t0[1], t0[3], t1[1], t1[3]};
#pragma unroll
                            for (int e = 0; e < 4; ++e) { const float x1 = y[bj][0][e], x2 = y[bj][1][e]; y[bj][0][e] = x1 * cs[e] - x2 * sn[e]; y[bj][1][e] = x1 * sn[e] + x2 * cs[e]; } } }
#pragma unroll
                    for (int bj = 0; bj < 2; ++bj) *(v4u*)(Q1 + R * 1536 + h * 192 + 128 + 32 * bj + 8 * fq) = pack8(y[bj][0], y[bj][1]);
                    asm volatile("" ::: "memory");
                }
        }
    }
};

struct EpiUkv {
    static constexpr bool PERM = true;
    bf16 *Kn, *V1; const float* ssq; const float* kng; LAS float* xl;
    __device__ __forceinline__ void operator()(const f32x4 (&acc)[2][2][4][2], const Unit& u, int wr, int wc, int fr, int fq) const {
        const int h = u.pn;
#pragma unroll
        for (int ai = 0; ai < 2; ++ai)
#pragma unroll
            for (int m = 0; m < 4; ++m) { float s = 0.f;
#pragma unroll
                for (int n = 0; n < 2; ++n) { const f32x4 x = acc[ai][0][m][n]; s += (x[0] * x[0] + x[1] * x[1]) + (x[2] * x[2] + x[3] * x[3]); }
                s += __shfl_xor(s, 16); s += __shfl_xor(s, 32);
                if (fq == 0) xl[(ai * 128 + wr * 64 + m * 16 + fr) * 4 + wc] = s; }
        __syncthreads();
        f32x4 g[2];
#pragma unroll
        for (int n = 0; n < 2; ++n) g[n] = *(const f32x4*)(kng + wc * 32 + 8 * fq + 4 * n);
#pragma unroll
        for (int ai = 0; ai < 2; ++ai)
#pragma unroll
            for (int m = 0; m < 4; ++m) { const int rr = opaque(ai * 128 + wr * 64 + m * 16 + fr); const size_t R = (size_t)u.pm * 256 + rr;
                const f32x4 s0 = *(const f32x4*)(ssq + R * 12);
                const float rk = 1.0f / sqrtf(((s0[0] + s0[1]) + (s0[2] + s0[3])) * (1.0f / 256.0f) + EPS);
                const f32x4 p = *(const LAS f32x4*)(xl + rr * 4);
                const float rstd = rk / sqrtf(((p[0] + p[1]) + (p[2] + p[3])) * (rk * rk) * (1.0f / 128.0f) + EPS);
                *(v4u*)(Kn + R * 1024 + h * 128 + wc * 32 + 8 * fq) = pack8(acc[ai][0][m][0] * rstd * g[0], acc[ai][0][m][1] * rstd * g[1]);
                *(v4u*)(V1 + R * 1024 + h * 128 + wc * 32 + 8 * fq) = pack8(acc[ai][1][m][0] * rk, acc[ai][1][m][1] * rk); asm volatile("" ::: "memory"); }
        __syncthreads();
    }
};

__device__ __forceinline__ bf16x8 pack_p(const f32x16& p, int s) { v4u w; w.x = pk2(p[8 * s + 0], p[8 * s + 1]); w.y = pk2(p[8 * s + 2], p[8 * s + 3]); w.z = pk2(p[8 * s + 4], p[8 * s + 5]); w.w = pk2(p[8 * s + 6], p[8 * s + 7]); return __builtin_bit_cast(bf16x8, w); }
__device__ __forceinline__ bf16x8 load_vfrag(const bf16* vp, int ld, int s) {
    bf16x8 r;
#pragma unroll
    for (int j = 0; j < 8; ++j) r[j] = (short)vp[(size_t)(16 * s + 8 * (j >> 2) + (j & 3)) * ld];
    return r;
}

__device__ __forceinline__ void diff_attn_unit_v0(Frame& F, int a) {
    const int lane = F.lane, r32 = lane & 31, hh = lane >> 5, wid = F.wave;
    int b, h, q0, nkeys;
    if (a < 256) { b = a >> 5; h = (a >> 3) & 3; q0 = b * RPB + CTXL + (a & 7) * 256; nkeys = RPB; } else { const int a2 = a - 256; b = a2 >> 2; h = a2 & 3; q0 = b * RPB; nkeys = CTXL; }
    const int kbase = b * RPB;
    const bf16* Qd = (const bf16*)(F.big + B_QD); const bf16* Kd = (const bf16*)(F.big + B_KD); const bf16* Vd = (const bf16*)(F.big + B_VD);
    const float lam = F.lamv[0];
    const float sc2 = 0.125f * LOG2E;
    const bf16* qp = Qd + (size_t)(q0 + wid * 32 + r32) * 512 + h * 128 + hh * 8;
    f32x16 O[2][4];
#pragma unroll
    for (int c = 0; c < 2; ++c)
#pragma unroll
        for (int d = 0; d < 4; ++d)
#pragma unroll
            for (int r = 0; r < 16; ++r) O[c][d][r] = 0.f;
    float l0 = 0.f, l1 = 0.f;
    for (int kt = 0; kt < nkeys; kt += 32) {
        bf16x8 pf[2][2];
        const bf16* kp = Kd + (size_t)(kbase + kt + r32) * 512 + h * 128 + hh * 8;
#pragma unroll
        for (int c = 0; c < 2; ++c) {
            f32x16 S;
#pragma unroll
            for (int r = 0; r < 16; ++r) S[r] = 0.f;
#pragma unroll
            for (int ks = 0; ks < 4; ++ks) { const bf16x8 kf = *(const bf16x8*)(kp + c * 64 + ks * 16); const bf16x8 qv = *(const bf16x8*)(qp + c * 64 + ks * 16); S = __builtin_amdgcn_mfma_f32_32x32x16_bf16(kf, qv, S, 0, 0, 0); }
            float ls = 0.f;
#pragma unroll
            for (int r = 0; r < 16; ++r) { S[r] = __builtin_amdgcn_exp2f(S[r] * sc2); ls += S[r]; }
            if (c == 0) l0 += ls; else l1 += ls;
            pf[c][0] = pack_p(S, 0); pf[c][1] = pack_p(S, 1);
        }
        const bf16* vp = Vd + (size_t)(kbase + kt + 4 * hh) * 512 + h * 128 + r32;
#pragma unroll
        for (int d = 0; d < 4; ++d)
#pragma unroll
            for (int s = 0; s < 2; ++s) { const bf16x8 vf = load_vfrag(vp + d * 32, 512, s);
                O[0][d] = __builtin_amdgcn_mfma_f32_32x32x16_bf16(pf[0][s], vf, O[0][d], 0, 0, 0);
                O[1][d] = __builtin_amdgcn_mfma_f32_32x32x16_bf16(pf[1][s], vf, O[1][d], 0, 0, 0); asm volatile("" ::: "memory"); }
    }
    l0 += __shfl_xor(l0, 32); l1 += __shfl_xor(l1, 32);
    const float* sg = F.in[I_DSUBLN];
    float gsub[4];
#pragma unroll
    for (int d = 0; d < 4; ++d) gsub[d] = sg[d * 32 + r32] * 0.8f;
#pragma unroll
    for (int r = 0; r < 16; ++r) {
        const int qi = crow(r, hh);
        const float i0 = 1.0f / __shfl(l0, qi), i1 = lam / __shfl(l1, qi);
        float o[4]; float s = 0.f;
#pragma unroll
        for (int d = 0; d < 4; ++d) { o[d] = O[0][d][r] * i0 - O[1][d][r] * i1; s += o[d] * o[d]; }
        s += __shfl_xor(s, 1); s += __shfl_xor(s, 2); s += __shfl_xor(s, 4); s += __shfl_xor(s, 8); s += __shfl_xor(s, 16);
        const float rstd = 1.0f / sqrtf(s * (1.0f / 128.0f) + EPS);
        bf16* op = F.H + (size_t)(q0 + wid * 32 + qi) * D + h * 128 + r32;
#pragma unroll
        for (int d = 0; d < 4; ++d) op[d * 32] = (bf16)f2bf(o[d] * rstd * gsub[d]);
    }
}

__device__ __forceinline__ void mla_attn_unit_v0(Frame& F, int a) {
    const int lane = F.lane, r32 = lane & 31, hh = lane >> 5, wid = F.wave;
    const int b = a >> 6, h = (a >> 3) & 7, q0 = b * RPB + CTXL + (a & 7) * 256, kbase = b * RPB;
    const bf16* Q1 = (const bf16*)(F.big + B_Q1); const bf16* Kn = (const bf16*)(F.big + B_KN); const bf16* Kr = (const bf16*)(F.big + B_KR); const bf16* V1 = (const bf16*)(F.big + B_V1);
    const float sc2 = 0.07216878364870323f * LOG2E;
    bf16x8 qf[12];
    { const bf16* qp = Q1 + (size_t)(q0 + wid * 32 + r32) * 1536 + h * 192 + hh * 8;
#pragma unroll
        for (int ks = 0; ks < 12; ++ks) qf[ks] = *(const bf16x8*)(qp + ks * 16); }
    f32x16 O[4];
#pragma unroll
    for (int d = 0; d < 4; ++d)
#pragma unroll
        for (int r = 0; r < 16; ++r) O[d][r] = 0.f;
    float l0 = 0.f;
    for (int kt = 0; kt < RPB; kt += 32) {
        const bf16* knp = Kn + (size_t)(kbase + kt + r32) * 1024 + h * 128 + hh * 8;
        const bf16* krp = Kr + (size_t)(kbase + kt + r32) * 64 + hh * 8;
        f32x16 S;
#pragma unroll
        for (int r = 0; r < 16; ++r) S[r] = 0.f;
#pragma unroll
        for (int ks = 0; ks < 8; ++ks) { const bf16x8 kf = *(const bf16x8*)(knp + ks * 16); S = __builtin_amdgcn_mfma_f32_32x32x16_bf16(kf, qf[ks], S, 0, 0, 0); }
#pragma unroll
        for (int ks = 0; ks < 4; ++ks) { const bf16x8 kf = *(const bf16x8*)(krp + ks * 16); S = __builtin_amdgcn_mfma_f32_32x32x16_bf16(kf, qf[8 + ks], S, 0, 0, 0); }
        float ls = 0.f;
#pragma unroll
        for (int r = 0; r < 16; ++r) { S[r] = __builtin_amdgcn_exp2f(S[r] * sc2); ls += S[r]; }
        l0 += ls;
        const bf16x8 p0 = pack_p(S, 0), p1 = pack_p(S, 1);
        const bf16* vp = V1 + (size_t)(kbase + kt + 4 * hh) * 1024 + h * 128 + r32;
#pragma unroll
        for (int d = 0; d < 4; ++d) { const bf16x8 v0 = load_vfrag(vp + d * 32, 1024, 0), v1 = load_vfrag(vp + d * 32, 1024, 1);
            O[d] = __builtin_amdgcn_mfma_f32_32x32x16_bf16(p0, v0, O[d], 0, 0, 0);
            O[d] = __builtin_amdgcn_mfma_f32_32x32x16_bf16(p1, v1, O[d], 0, 0, 0); }
    }
    l0 += __shfl_xor(l0, 32);
#pragma unroll
    for (int r = 0; r < 16; ++r) { const int qi = crow(r, hh); const float i0 = 1.0f / __shfl(l0, qi);
        bf16* op = F.H + (size_t)(q0 + wid * 32 + qi) * D + h * 128 + r32;
#pragma unroll
        for (int d = 0; d < 4; ++d) op[d * 32] = (bf16)f2bf(O[d][r] * i0); }
}

__device__ __forceinline__ void hgrn_unit_v0(Frame& F, int a) {
    const int dvq = a & 3, dir = (a >> 2) & 1, h = (a >> 3) & 3, b = a >> 5;
    const bf16* Hq = (const bf16*)(F.big + B_HQ); const f16* Lf = (const f16*)(F.big + (dir ? B_LF1 : B_LF0)); const bf16* Hv = (const bf16*)(F.big + B_HV);
    bf16* Ho = (bf16*)(F.big + (dir ? B_HO1 : B_HO0));
    LAS float* lq = (LAS float*)F.lds;
    LAS float* lf = lq + 2048;
    LAS float* lk = lf + 2048;
    LAS float* lv = lk + 2048;
    LAS float* part = lv + 512;
    const int tid = F.tid, v = tid & 31, kg = tid >> 5;
    float S[8];
#pragma unroll
    for (int j = 0; j < 8; ++j) S[j] = 0.f;
    for (int ch = 0; ch < RPB / 16; ++ch) {
        for (int e = tid; e < 2048; e += NTHREADS) { const int tok = e >> 7, k = e & 127, n = ch * 16 + tok;
            const int s = dir ? (n < CTXL ? CTXL - 1 - n : RPB + CTXL - 1 - n) : n; const size_t R = (size_t)b * RPB + s;
            lq[e] = bf2f(Hq[R * 512 + h * 128 + k]) * 0.08838834764831845f;
            const float f = fexp((float)Lf[R * 512 + h * 128 + k]); lf[e] = f; lk[e] = 1.0f - f; }
        { const int tok = tid >> 5, n = ch * 16 + tok; const int s = dir ? (n < CTXL ? CTXL - 1 - n : RPB + CTXL - 1 - n) : n; const size_t R = (size_t)b * RPB + s;
            lv[tid] = bf2f(Hv[R * 512 + h * 128 + dvq * 32 + v]); }
        __syncthreads();
#pragma unroll 4
        for (int tok = 0; tok < 16; ++tok) {
            const f32x4 q0 = *(const LAS f32x4*)(lq + tok * 128 + kg * 8), q1 = *(const LAS f32x4*)(lq + tok * 128 + kg * 8 + 4);
            const f32x4 f0 = *(const LAS f32x4*)(lf + tok * 128 + kg * 8), f1 = *(const LAS f32x4*)(lf + tok * 128 + kg * 8 + 4);
            const f32x4 k0 = *(const LAS f32x4*)(lk + tok * 128 + kg * 8), k1 = *(const LAS f32x4*)(lk + tok * 128 + kg * 8 + 4);
            const float vv = lv[tok * 32 + v];
            float po = 0.f;
#pragma unroll
            for (int j = 0; j < 4; ++j) { S[j] = f0[j] * S[j] + k0[j] * vv; po += S[j] * q0[j]; S[4 + j] = f1[j] * S[4 + j] + k1[j] * vv; po += S[4 + j] * q1[j]; }
            part[(tok * 16 + kg) * 32 + v] = po;
        }
        __syncthreads();
        { const int tok = tid >> 5, n = ch * 16 + tok; const int s = dir ? (n < CTXL ? CTXL - 1 - n : RPB + CTXL - 1 - n) : n; const size_t R = (size_t)b * RPB + s;
            float o = 0.f;
#pragma unroll
            for (int g = 0; g < 16; ++g) o += part[(tok * 16 + g) * 32 + v];
            Ho[R * 512 + h * 128 + dvq * 32 + v] = (bf16)f2bf(o); }
        __syncthreads();
    }
}

constexpr int NPHASES = 20;
__global__ void __launch_bounds__(NTHREADS, 2) mk_fwd(Args args) {
    extern __shared__ __attribute__((aligned(16))) unsigned char lds[];
    Frame F;
    F.lds = (LAS unsigned char*)lds;
    F.tid = threadIdx.x; F.lane = F.tid & 63; F.wave = __builtin_amdgcn_readfirstlane(F.tid >> 6); F.G = gridDim.x; F.bid = blockIdx.x;
#pragma unroll
    for (int i = 0; i < 34; ++i) F.in[i] = args.in[i];
    F.out = args.out; F.ws = args.ws;
    unsigned char* ws = args.ws;
    F.ctl = (gu32*)(ws + WS_CTL);
    unsigned char* sm = ws + WS_SMALL;
    F.modv = (float*)(sm + SM_MODV); F.ropeR = (f32x2*)(sm + SM_ROPER); F.ropeC = (f32x2*)(sm + SM_ROPEC); F.lbv = (float*)(sm + SM_LBV); F.lamv = (float*)(sm + SM_LAM);
    F.route_e = (int*)(sm + SM_ROUTE_E); F.route_w = (float*)(sm + SM_ROUTE_W); F.route_s = (int*)(sm + SM_ROUTE_S); F.pos = (int*)(sm + SM_POS); F.rowidx = (int*)(sm + SM_ROWIDX); F.ssq = (float*)(sm + SM_SSQ);
    F.Win0 = (bf16*)(ws + WS_WIN0); F.Wout0 = (bf16*)(ws + WS_WOUT0); F.Win1 = (bf16*)(ws + WS_WIN1); F.Wuq = (bf16*)(ws + WS_WUQ); F.Wukv = (bf16*)(ws + WS_WUKV); F.Wout1 = (bf16*)(ws + WS_WOUT1);
    F.Wgu = (bf16*)(ws + WS_WGU); F.Wd = (bf16*)(ws + WS_WD);
    F.xc = (float*)(ws + WS_XC); F.H = (bf16*)(ws + WS_H); F.big = ws + WS_BIG;

    volatile LAS unsigned* MISC = (volatile LAS unsigned*)(F.lds + LDS_MISC);
    for (int u = F.tid; u < 256; u += NTHREADS) MISC[u] = 0u;
    __syncthreads();
    XcdBarrier bar; bar.bar = (unsigned*)(F.ctl + CW_BAR); bar.x = 0; bar.st = nullptr;
    if (MK_N_LAUNCHES == 1) bar = xcd_barrier_post((unsigned*)(F.ctl + CW_BAR), MISC + 8);
    LAS float* xl = (LAS float*)(F.lds + LDS_XCH);

    const int lo = args.ph_lo, hi = args.ph_hi;
#ifdef DBG_ONLY
#define IN(k) ((k) == DBG_ONLY && lo <= (k) && (k) < hi)
#else
#define IN(k) (lo <= (k) && (k) < hi)
#endif
#define SEAM(k) do { if (IN(k) && IN((k) + 1)) xcd_barrier(bar); } while (0)

    if (IN(0)) { p0_prologue(F); } SEAM(0);
    if (IN(1)) { p_norm0(F); } SEAM(1);
    if (IN(2)) { Gemm g{F.H, F.Win0, 1024, nullptr}; SchedGrid S{NT_ALL, 16, F.G, F.bid, false};
        EpiIn0 E{F.big, F.in[I_DQG], F.in[I_DKG], F.lbv, F.ropeR, F.ropeC}; gemm_v0(g, S, E); } SEAM(2);
    if (IN(3)) { for (int a = F.bid; a < 256; a += F.G) hgrn_unit_v0(F, a);
        for (int a = F.bid; a < 288; a += F.G) diff_attn_unit_v0(F, a); } SEAM(3);
    if (IN(4)) { p_hgrn_post(F); } SEAM(4);
    if (IN(5)) { Gemm g{F.H, F.Wout0, 1024, nullptr}; SchedGrid S{NT_ALL, 4, F.G, F.bid, false}; EpiOut E{&F, 0, true}; gemm_v0(g, S, E); } SEAM(5);
    if (IN(6)) { p_norm_route(F, 0, false); } SEAM(6);
    if (IN(7)) { p_lists(F, 0, false);
        Gemm g{F.H, F.Wgu + (size_t)(0 * 17 + 16) * 1024 * 1024, 1024, nullptr}; SchedGrid S{NT_ALL, 4, F.G, F.bid, false}; EpiGU E{(bf16*)(F.big + B_HS)}; gemm_v0(g, S, E); } SEAM(7);
    if (IN(8)) { { SchedRouted S; load_expoff(F, 0, S.eo); S.G = F.G; S.c = F.bid; Gemm g{F.H, F.Wgu + (size_t)(0 * 17) * 1024 * 1024, 1024, F.rowidx}; EpiGU E{(bf16*)(F.big + B_HE)}; gemm_v0(g, S, E); }
        { Gemm g{(const bf16*)(F.big + B_HS), F.Wd + (size_t)(0 * 17 + 16) * 1024 * 512, 512, nullptr}; SchedGrid S{NT_ALL, 4, F.G, F.bid, false}; EpiDownS E{&F, 0}; gemm_v0(g, S, E); } } SEAM(8);
    if (IN(9)) { SchedRouted S; load_expoff(F, 0, S.eo); S.G = F.G; S.c = F.bid; Gemm g{(const bf16*)(F.big + B_HE), F.Wd + (size_t)(0 * 17) * 1024 * 512, 512, nullptr}; EpiDownR E{(bf16*)(F.big + B_YE)}; gemm_v0(g, S, E); } SEAM(9);
    if (IN(10)) { p_combine(F, 0, false, true); } SEAM(10);
    if (IN(11)) { Gemm g{F.H, F.Win1, 1024, nullptr}; SchedGrid S{NT_ALL, 3, F.G, F.bid, false}; EpiIn1 E{F.big, F.ssq, F.in[I_KRG], F.ropeR, F.ropeC}; gemm_v0(g, S, E); } SEAM(11);
    if (IN(12)) { { Gemm g{(const bf16*)(F.big + B_CQ), F.Wuq, 384, nullptr}; SchedGrid S{NT_LAT, 6, F.G, F.bid, true};
            EpiUq E{(bf16*)(F.big + B_Q1), F.ssq, F.in[I_QNG], F.in[I_QRG], F.ropeR, F.ropeC, xl}; gemm_v0(g, S, E); }
        { Gemm g{(const bf16*)(F.big + B_CKV), F.Wukv, 256, nullptr}; SchedGrid S{NT_ALL, 8, F.G, F.bid, false};
            EpiUkv E{(bf16*)(F.big + B_KN), (bf16*)(F.big + B_V1), F.ssq, F.in[I_KNG], xl}; gemm_v0(g, S, E); } } SEAM(12);
    if (IN(13)) { for (int a = F.bid; a < 512; a += F.G) mla_attn_unit_v0(F, a); } SEAM(13);
    if (IN(14)) { Gemm g{F.H, F.Wout1, 1024, nullptr}; SchedGrid S{NT_LAT, 4, F.G, F.bid, true}; EpiOut E{&F, 1, false}; gemm_v0(g, S, E); } SEAM(14);
    if (IN(15)) { p_norm_route(F, 1, true); } SEAM(15);
    if (IN(16)) { p_lists(F, 1, true);
        Gemm g{F.H, F.Wgu + (size_t)(1 * 17 + 16) * 1024 * 1024, 1024, nullptr}; SchedGrid S{NT_LAT, 4, F.G, F.bid, true}; EpiGU E{(bf16*)(F.big + B_HS)}; gemm_v0(g, S, E); } SEAM(16);
    if (IN(17)) { { SchedRouted S; load_expoff(F, 1, S.eo); S.G = F.G; S.c = F.bid; Gemm g{F.H, F.Wgu + (size_t)(1 * 17) * 1024 * 1024, 1024, F.rowidx}; EpiGU E{(bf16*)(F.big + B_HE)}; gemm_v0(g, S, E); }
        { Gemm g{(const bf16*)(F.big + B_HS), F.Wd + (size_t)(1 * 17 + 16) * 1024 * 512, 512, nullptr}; SchedGrid S{NT_LAT, 4, F.G, F.bid, true}; EpiDownS E{&F, 1}; gemm_v0(g, S, E); } } SEAM(17);
    if (IN(18)) { SchedRouted S; load_expoff(F, 1, S.eo); S.G = F.G; S.c = F.bid; Gemm g{(const bf16*)(F.big + B_HE), F.Wd + (size_t)(1 * 17) * 1024 * 512, 512, nullptr}; EpiDownR E{(bf16*)(F.big + B_YE)}; gemm_v0(g, S, E); } SEAM(18);
    if (IN(19)) { p_combine(F, 1, true, false); }
#undef IN
#undef SEAM
}

extern "C" void kernel_launch(void* const* d_in, const int* in_sizes, int n_in, void* d_out, int out_size, void* d_ws, size_t ws_size, hipStream_t stream) {
    static int grid = 0;
    if (grid == 0) {
        if (n_in != 34 || in_sizes[0] != NB * SEQ * D || out_size != NB * SEQ * D || ws_size < WS_END) {
            fprintf(stderr, "kernel_launch: unexpected problem: n_in %d in0 %d out %d ws %zu (need %zu); nothing launched\n", n_in, n_in > 0 ? in_sizes[0] : -1, out_size, ws_size, (size_t)WS_END); grid = -1; return; }
        int dev = 0, cus = 0;
        if (hipGetDevice(&dev) != hipSuccess || hipDeviceGetAttribute(&cus, hipDeviceAttributeMultiprocessorCount, dev) != hipSuccess) { grid = -1; return; }
        if (hipFuncSetAttribute((const void*)mk_fwd, hipFuncAttributeMaxDynamicSharedMemorySize, LDS_BYTES) != hipSuccess) { fprintf(stderr, "kernel_launch: hipFuncSetAttribute failed\n"); grid = -1; return; }
        int per_cu = 0;
        if (hipOccupancyMaxActiveBlocksPerMultiprocessor(&per_cu, (const void*)mk_fwd, NTHREADS, LDS_BYTES) != hipSuccess || per_cu < 1) fprintf(stderr, "kernel_launch: note: occupancy query reports %d\n", per_cu);
        (void)hipGetLastError();
        grid = cus;
    }
    if (grid < 0) return;
    if (hipMemsetAsync((char*)d_ws + WS_CTL, 0, CTL_ZERO_BYTES, stream) != hipSuccess) { fprintf(stderr, "kernel_launch: memset failed\n"); return; }
    Args a{};
    for (int i = 0; i < 34; ++i) a.in[i] = (const float*)d_in[i];
    a.out = (float*)d_out; a.ws = (unsigned char*)d_ws;
    if (MK_N_LAUNCHES == 1) { a.ph_lo = 0; a.ph_hi = NPHASES; hipLaunchKernelGGL(mk_fwd, dim3(grid), dim3(NTHREADS), LDS_BYTES, stream, a); }
    else for (int p = 0; p < NPHASES; ++p) { a.ph_lo = p; a.ph_hi = p + 1; hipLaunchKernelGGL(mk_fwd, dim3(grid), dim3(NTHREADS), LDS_BYTES, stream, a); }
    const hipError_t le = hipPeekAtLastError();
    if (le != hipSuccess) fprintf(stderr, "kernel_launch: launch failed: %s\n", hipGetErrorName(le));
}
```

```cpp
#include <hip/hip_runtime.h>
#include <cstdio>
#include <cstdint>

#ifndef MK_N_LAUNCHES
#define MK_N_LAUNCHES 1
#endif

#define GAS __attribute__((address_space(1)))
#define LAS __attribute__((address_space(3)))
typedef unsigned short bf16;
typedef _Float16 f16;
typedef short bf16x8 __attribute__((ext_vector_type(8)));
typedef float f32x4 __attribute__((ext_vector_type(4)));
typedef float f32x2 __attribute__((ext_vector_type(2)));
typedef float f32x16 __attribute__((ext_vector_type(16)));
typedef unsigned v4u __attribute__((ext_vector_type(4)));
typedef unsigned v2u __attribute__((ext_vector_type(2)));
typedef GAS unsigned gu32;
#define RLX_AGENT __ATOMIC_RELAXED, __HIP_MEMORY_SCOPE_AGENT
#define LDS_WAIT() asm volatile("s_waitcnt lgkmcnt(0)" ::: "memory")
#define VM_WAIT() asm volatile("s_waitcnt vmcnt(0)" ::: "memory")
#define EPI_BAR() do { asm volatile("s_waitcnt lgkmcnt(0)" ::: "memory"); __builtin_amdgcn_s_barrier(); asm volatile("" ::: "memory"); } while (0)

constexpr int NB = 8, SEQ = 2048, CTXL = 256, RPB = 2304  , NR = NB * RPB  , D = 1024;
constexpr int NT_ALL = NR / 256  , NT_LAT = 64;
constexpr int NEXP = 16, FF = 512;
constexpr int MP_MAX = 41216;
constexpr float EPS = 1e-6f;
constexpr float LOG2E = 1.4426950408889634f;
constexpr int NWAVES = 8, NTHREADS = 512;

constexpr size_t MiB = 1u << 20;
constexpr size_t WS_CTL = 0, CTL_ZERO_BYTES = 1 * MiB;
constexpr int CW_TMO = 0, CW_CODE = 1, CW_BAR = 4096, CW_CNT = 8192;
constexpr size_t WS_SMALL = 1 * MiB;
constexpr size_t SM_MODV = 0;
constexpr size_t SM_ROPER = 448 * 1024;
constexpr size_t SM_ROPEC = 452 * 1024;
constexpr size_t SM_LBV = 460 * 1024;
constexpr size_t SM_LAM = 464 * 1024;
constexpr size_t SM_ROUTE_E = 512 * 1024;
constexpr size_t SM_ROUTE_W = 584 * 1024;
constexpr size_t SM_ROUTE_S = 728 * 1024;
constexpr size_t SM_POS = 872 * 1024;
constexpr size_t SM_ROWIDX = 1016 * 1024;
constexpr size_t SM_SSQ = 1280 * 1024;
static_assert(SM_ROUTE_E + (size_t)NR * 4 <= SM_ROUTE_W && SM_ROUTE_W + (size_t)NR * 8 <= SM_ROUTE_S && SM_ROUTE_S + (size_t)NR * 8 <= SM_POS && SM_POS + (size_t)NR * 8 <= SM_ROWIDX &&
              SM_ROWIDX + (size_t)MP_MAX * 4 <= SM_SSQ && SM_SSQ + (size_t)NR * 48 <= 3 * MiB, "small map");
constexpr size_t WS_WIN0 = 4 * MiB, WS_WOUT0 = 12 * MiB, WS_WIN1 = 14 * MiB, WS_WUQ = 16 * MiB, WS_WUKV = 18 * MiB, WS_WOUT1 = 19 * MiB;
constexpr size_t WS_WGU = 22 * MiB;
constexpr size_t WS_WD = 90 * MiB;
constexpr size_t WS_XC = 124 * MiB;
constexpr size_t WS_H = 132 * MiB;
constexpr size_t WS_BIG = 168 * MiB;
constexpr size_t WS_END = 348 * MiB;
constexpr size_t SZ18 = 18 * MiB;
constexpr size_t B_QD = 0, B_KD = SZ18, B_VD = 2 * SZ18, B_HQ = 3 * SZ18, B_LF0 = 4 * SZ18, B_LF1 = 5 * SZ18, B_HV = 6 * SZ18, B_HG = 7 * SZ18, B_HO0 = 8 * SZ18, B_HO1 = 9 * SZ18;
constexpr size_t B_HS = 0, B_HE = 18 * MiB, B_YE = 60 * MiB, B_AP = 60 * MiB;
static_assert(B_HE + (size_t)MP_MAX * 512 * 2 <= B_YE && B_YE + (size_t)MP_MAX * 1024 * 2 <= 180 * MiB, "moe map");
constexpr size_t B_CKV = 0, B_CQ = 9 * MiB, B_KR = 23 * MiB, B_Q1 = 26 * MiB, B_KN = 80 * MiB, B_V1 = 116 * MiB;

constexpr int LDS_BYTES = 155648;
constexpr int LDS_MISC = 131072;
constexpr int LDS_XCH = 132096;

__device__ __forceinline__ unsigned f2bf(float f) { unsigned u = __builtin_bit_cast(unsigned, f); return (u + 0x7fffu + ((u >> 16) & 1u)) >> 16; }
__device__ __forceinline__ unsigned pk2(float lo, float hi) { return f2bf(lo) | (f2bf(hi) << 16); }
__device__ __forceinline__ float bf2f(bf16 h) { return __builtin_bit_cast(float, (unsigned)h << 16); }
__device__ __forceinline__ float bflo(unsigned w) { return __builtin_bit_cast(float, w << 16); }
__device__ __forceinline__ float bfhi(unsigned w) { return __builtin_bit_cast(float, w & 0xffff0000u); }
__device__ __forceinline__ unsigned pkh2(float lo, float hi) { f16 a = (f16)lo, b = (f16)hi; return (unsigned)__builtin_bit_cast(unsigned short, a) | ((unsigned)__builtin_bit_cast(unsigned short, b) << 16); }
__device__ __forceinline__ float fexp(float x) { return __builtin_amdgcn_exp2f(x * LOG2E); }
__device__ __forceinline__ float sigmoidf_(float x) { return 1.0f / (1.0f + fexp(-x)); }
__device__ __forceinline__ float siluf_(float x) { return x / (1.0f + fexp(-x)); }
__device__ __forceinline__ float wave_sum(float v) {
#pragma unroll
    for (int o = 1; o < 64; o <<= 1) v += __shfl_xor(v, o);
    return v;
}
__host__ __device__ __forceinline__ int perm32(int rho) { const int n = rho >> 4, i = rho & 15; return 8 * (i >> 2) + 4 * n + (i & 3); }
__host__ __device__ __forceinline__ int ddmap(int j) { return 16 * ((j >> 2) & 1) + 4 * (j >> 3) + (j & 3); }
__device__ __forceinline__ int opaque(int x) { asm volatile("" : "+v"(x)); return x; }
__device__ __forceinline__ int crow(int r, int hi) { return (r & 3) + 8 * (r >> 2) + 4 * hi; }

#define XB_TMO      128
#define XB_XCNT(j)  (256  + 64 * (j))
#define XB_XSUB(j)  (1280 + 64 * (j))
#define XB_XGEN(j)  (2304 + 64 * (j))
#define XB_TOP      3328
#define XB_TOPGEN   3392
#define XCD_BAR_WORDS 3456
#define XB_SPIN_CAP (1u << 18)
__device__ __forceinline__ unsigned xb_ld(unsigned* p)              { return __hip_atomic_load(p, __ATOMIC_RELAXED, __HIP_MEMORY_SCOPE_AGENT); }
__device__ __forceinline__ unsigned xb_add(unsigned* p, unsigned v) { return __hip_atomic_fetch_add(p, v, __ATOMIC_RELAXED, __HIP_MEMORY_SCOPE_AGENT); }
__device__ __forceinline__ unsigned xb_xcc_id() { return (unsigned)__builtin_amdgcn_s_getreg((3 << 11) | 20) & 0xFu; }
#define XB_SPIN(cond, bar) do { unsigned _sp = 0; while (cond) { __builtin_amdgcn_s_sleep(1); \
    if ((++_sp & 255u) == 0u) { if (xb_ld(&(bar)[XB_TMO])) break; if (_sp > XB_SPIN_CAP) { atomicAdd(&(bar)[XB_TMO], 1u); break; } } } } while (0)
struct XcdBarrier { unsigned* bar; unsigned x; volatile LAS unsigned* st; };
__device__ __forceinline__ XcdBarrier xcd_barrier_post(unsigned* bar, volatile LAS unsigned* st) {
    XcdBarrier b; b.bar = bar; b.x = xb_xcc_id(); b.st = st;
    if (threadIdx.x == 0) (void)xb_add(&bar[XB_XCNT(b.x)], 1u);
    return b;
}
__device__ __forceinline__ void xcd_barrier_complete(unsigned* bar, unsigned x, unsigned& nloc, unsigned& nx) {
    const unsigned G = gridDim.x * gridDim.y * gridDim.z;
    unsigned sum, cnt, mine, sp = 0u;
    for (;;) {
        sum = 0u; cnt = 0u; mine = 0u;
#pragma unroll
        for (unsigned j = 0; j < 16; ++j) { const unsigned c = xb_ld(&bar[XB_XCNT(j)]); sum += c; cnt += (c > 0u) ? 1u : 0u; mine = (j == x) ? c : mine; }
        if (sum == G) break;
        __builtin_amdgcn_s_sleep(1);
        if ((++sp & 255u) == 0u) { if (xb_ld(&bar[XB_TMO])) break; if (sp > XB_SPIN_CAP) { atomicAdd(&bar[XB_TMO], 1u); break; } }
    }
    nloc = mine > 0u ? mine : 1u; nx = cnt > 0u ? cnt : 1u;
}
__device__ __forceinline__ void xcd_barrier(const XcdBarrier& b) {
    asm volatile("s_waitcnt vmcnt(0)" ::: "memory");
    __syncthreads();
    if (threadIdx.x == 0) {
        unsigned* bar = b.bar;
        __builtin_amdgcn_s_waitcnt(0);
        unsigned nloc = b.st[0], nx = b.st[1];
        if (nloc == 0u) { xcd_barrier_complete(bar, b.x, nloc, nx); b.st[0] = nloc; b.st[1] = nx; }
        const unsigned old = xb_add(&bar[XB_XSUB(b.x)], 1u);
        const unsigned gen = old / nloc;
        if (old + 1u == (gen + 1u) * nloc) {
            __builtin_amdgcn_fence(__ATOMIC_RELEASE, "agent");
            asm volatile("s_waitcnt vmcnt(0)" ::: "memory");
            const unsigned og = xb_add(&bar[XB_TOP], 1u);
            const unsigned tg = og / nx;
            if (og + 1u == (tg + 1u) * nx) xb_add(&bar[XB_TOPGEN], 1u);
            else XB_SPIN(xb_ld(&bar[XB_TOPGEN]) == tg, bar);
            __builtin_amdgcn_fence(__ATOMIC_ACQUIRE, "agent");
            xb_add(&bar[XB_XGEN(b.x)], 1u);
            asm volatile("s_waitcnt vmcnt(0)" ::: "memory");
        } else {
            XB_SPIN(xb_ld(&bar[XB_XGEN(b.x)]) == gen, bar);
            __builtin_amdgcn_fence(__ATOMIC_ACQUIRE, "agent");
            asm volatile("s_waitcnt vmcnt(0)" ::: "memory");
        }
    }
    __syncthreads();
}

struct Args { const float* in[34]; float* out; unsigned char* ws; int ph_lo, ph_hi; };

struct Frame {
    LAS unsigned char* lds;
    int tid, lane, wave, G, bid;
    const Args* ar;
    float* out; unsigned char* ws;
    __device__ __forceinline__ gu32* ctl_() const { return (gu32*)(ws + WS_CTL); }
    __device__ __forceinline__ float* modv_() const { return (float*)(ws + WS_SMALL + SM_MODV); }
    __device__ __forceinline__ f32x2* ropeR_() const { return (f32x2*)(ws + WS_SMALL + SM_ROPER); }
    __device__ __forceinline__ f32x2* ropeC_() const { return (f32x2*)(ws + WS_SMALL + SM_ROPEC); }
    __device__ __forceinline__ float* lbv_() const { return (float*)(ws + WS_SMALL + SM_LBV); }
    __device__ __forceinline__ float* lamv_() const { return (float*)(ws + WS_SMALL + SM_LAM); }
    __device__ __forceinline__ int* route_e_() const { return (int*)(ws + WS_SMALL + SM_ROUTE_E); }
    __device__ __forceinline__ float* route_w_() const { return (float*)(ws + WS_SMALL + SM_ROUTE_W); }
    __device__ __forceinline__ int* route_s_() const { return (int*)(ws + WS_SMALL + SM_ROUTE_S); }
    __device__ __forceinline__ int* pos_() const { return (int*)(ws + WS_SMALL + SM_POS); }
    __device__ __forceinline__ float* ssq_() const { return (float*)(ws + WS_SMALL + SM_SSQ); }
    __device__ __forceinline__ bf16* Win0_() const { return (bf16*)(ws + WS_WIN0); }
    __device__ __forceinline__ bf16* Wout0_() const { return (bf16*)(ws + WS_WOUT0); }
    __device__ __forceinline__ bf16* Win1_() const { return (bf16*)(ws + WS_WIN1); }
    __device__ __forceinline__ bf16* Wuq_() const { return (bf16*)(ws + WS_WUQ); }
    __device__ __forceinline__ bf16* Wukv_() const { return (bf16*)(ws + WS_WUKV); }
    __device__ __forceinline__ bf16* Wout1_() const { return (bf16*)(ws + WS_WOUT1); }
    __device__ __forceinline__ bf16* Wgu_() const { return (bf16*)(ws + WS_WGU); }
    __device__ __forceinline__ bf16* Wd_() const { return (bf16*)(ws + WS_WD); }
    __device__ __forceinline__ float* xc_() const { return (float*)(ws + WS_XC); }
    __device__ __forceinline__ bf16* H_() const { return (bf16*)(ws + WS_H); }
    __device__ __forceinline__ unsigned char* big_() const { return ws + WS_BIG; }
};
enum { I_X = 0, I_C, I_CTX, I_CCTX, I_MODW, I_MODB, I_NMIX, I_NFFN, I_EWIN, I_EWOUT, I_DQG, I_DKG, I_DLAM, I_DSUBLN, I_LBL, I_HOG, I_OWIN, I_QAG, I_KVAG, I_WUQ, I_WUKV,
       I_QNG, I_QRG, I_KNG, I_KRG, I_OWOUT, I_RW, I_RB, I_EG, I_EU, I_ED, I_SG, I_SU, I_SD };

__device__ __forceinline__ float* xrow_ptr(const Frame& F, int b, int s) { return s < CTXL ? F.xc_() + (size_t)(b * CTXL + s) * D : F.out + (size_t)(b * SEQ + s - CTXL) * D; }
__device__ __forceinline__ const float* xin_ptr(const Frame& F, int b, int s) { return s < CTXL ? F.ar->in[I_CTX] + (size_t)(b * CTXL + s) * D : F.ar->in[I_X] + (size_t)(b * SEQ + s - CTXL) * D; }

__device__ __forceinline__ void p0_transpose_item(const float* W, int ldn, int srccol0, bool perm, const float* kscale, bf16* WT  , int K, int k0, LAS float* scr, int lane) {
    if (srccol0 >= 0) {
#pragma unroll 8
        for (int i = 0; i < 32; ++i) { const int kk = 2 * i + (lane >> 5); float v = W[(size_t)(k0 + kk) * ldn + srccol0 + (lane & 31)]; if (kscale) v *= kscale[k0 + kk]; scr[kk * 33 + (lane & 31)] = v; }
    } else {
#pragma unroll 8
        for (int i = 0; i < 32; ++i) { const int kk = 2 * i + (lane >> 5); scr[kk * 33 + (lane & 31)] = 0.f; }
    }
    LDS_WAIT(); asm volatile("" ::: "memory");
    const int c = lane & 7;
#pragma unroll
    for (int j = 0; j < 4; ++j) { const int n = (lane >> 3) + 8 * j; const int sn = perm ? ddmap(n) : n; const LAS float* s = scr + (8 * c) * 33 + sn;
        v4u o; o.x = pk2(s[0 * 33], s[1 * 33]); o.y = pk2(s[2 * 33], s[3 * 33]); o.z = pk2(s[4 * 33], s[5 * 33]); o.w = pk2(s[6 * 33], s[7 * 33]);
        *(GAS v4u*)(WT + (size_t)n * K + k0 + 8 * c) = o; }
    LDS_WAIT(); asm volatile("" ::: "memory");
}

__device__ __forceinline__ void p0_convert_item(Frame& F, int it, LAS float* scr) {
    const int lane = F.lane;
    if (it < 2048) {
        const int kb = it >> 7, tb = it & 127, pn = tb >> 3, blk = tb & 7, bj = blk >> 2, wc = blk & 3;
        int sb; bool perm = false;
        if (pn < 4) { sb = pn * 8 + 2 * wc + bj; perm = true; } else sb = tb;
        p0_transpose_item(F.ar->in[I_EWIN], 4096, sb * 32, perm, nullptr, F.Win0_() + (size_t)tb * 32 * 1024, 1024, kb * 64, scr, lane); return; }
    it -= 2048;
    if (it < 512) { const int kb = it >> 5, tb = it & 31; p0_transpose_item(F.ar->in[I_EWOUT], 1024, tb * 32, false, nullptr, F.Wout0_() + (size_t)tb * 32 * 1024, 1024, kb * 64, scr, lane); return; }
    it -= 512;
    if (it < 384) {
        const int kb = it / 24, tb = it % 24; int sc; bool perm = false;
        if (tb < 8) sc = 384 + tb * 32;
        else if (tb < 16) sc = (tb - 8) * 32;
        else { const int blk = tb - 16, bj = blk >> 2, wc = blk & 3;
            if (bj == 0) { if (wc < 3) sc = 256 + wc * 32; else { sc = 640; perm = true; } }
            else { if (wc == 0) sc = 352; else if (wc == 3) { sc = 672; perm = true; } else sc = -1; } }
        p0_transpose_item(F.ar->in[I_OWIN], 704, sc, perm, nullptr, F.Win1_() + (size_t)tb * 32 * 1024, 1024, kb * 64, scr, lane); return; }
    it -= 384;
    if (it < 288) {
        const int kb = it / 48, tb = it % 48, t = tb >> 3, blk = tb & 7, bj = blk >> 2, wc = blk & 3; int sc; bool perm = false;
        if (t < 4) { const int h = 2 * t + bj; sc = h * 192 + 32 * wc; }
        else { const int h = 4 * (t - 4) + wc; sc = h * 192 + 128 + 32 * bj; perm = true; }
        p0_transpose_item(F.ar->in[I_WUQ], 1536, sc, perm, F.ar->in[I_QAG], F.Wuq_() + (size_t)tb * 32 * 384, 384, kb * 64, scr, lane); return; }
    it -= 288;
    if (it < 256) { const int kb = it >> 6, tb = it & 63; p0_transpose_item(F.ar->in[I_WUKV], 2048, tb * 32, false, F.ar->in[I_KVAG], F.Wukv_() + (size_t)tb * 32 * 256, 256, kb * 64, scr, lane); return; }
    it -= 256;
    if (it < 512) { const int kb = it >> 5, tb = it & 31; p0_transpose_item(F.ar->in[I_OWOUT], 1024, tb * 32, false, nullptr, F.Wout1_() + (size_t)tb * 32 * 1024, 1024, kb * 64, scr, lane); return; }
    it -= 512;
    {
        const int le = it / 768, r2 = it % 768, l = le / 17, e = le % 17;
        if (r2 < 512) { const int kb = r2 >> 5, tb = r2 & 31, pnl = tb >> 3, blk = tb & 7, bj = blk >> 2, wcb = blk & 3;
            const float* src = (e < 16) ? (bj ? F.ar->in[I_EU] : F.ar->in[I_EG]) + (size_t)(l * 16 + e) * 1024 * 512 : (bj ? F.ar->in[I_SU] : F.ar->in[I_SG]) + (size_t)l * 1024 * 512;
            p0_transpose_item(src, 512, (pnl * 4 + wcb) * 32, false, nullptr, F.Wgu_() + ((size_t)(l * 17 + e) * 1024 + tb * 32) * 1024, 1024, kb * 64, scr, lane); }
        else { const int r3 = r2 - 512, kb = r3 >> 5, tb = r3 & 31;
            const float* src = (e < 16) ? F.ar->in[I_ED] + (size_t)(l * 16 + e) * 512 * 1024 : F.ar->in[I_SD] + (size_t)l * 512 * 1024;
            p0_transpose_item(src, 1024, tb * 32, false, nullptr, F.Wd_() + ((size_t)(l * 17 + e) * 1024 + tb * 32) * 512, 512, kb * 64, scr, lane); }
    }
}
constexpr int P0_NITEMS = 2048 + 512 + 384 + 288 + 256 + 512 + 2 * 17 * 768;

__device__ __forceinline__ void p0_prologue(Frame& F) {
    LAS float* ldsf = (LAS float*)F.lds;
    for (int it = F.bid; it < 192; it += F.G) {
        const int l = it / 96, n0 = (it % 96) * 64;
        LAS float* sc = ldsf;
        LAS float* red = ldsf + 9 * 1024;
        for (int e = F.tid; e < 9 * 1024; e += NTHREADS) { const int r = e >> 10, k = e & 1023; const float v = (r < 8) ? F.ar->in[I_C][r * 1024 + k] : F.ar->in[I_CCTX][k]; sc[e] = siluf_(v); }
        __syncthreads();
        float a[9];
#pragma unroll
        for (int r = 0; r < 9; ++r) a[r] = 0.f;
        const float* w = F.ar->in[I_MODW] + (size_t)l * 1024 * 6144 + n0 + F.lane;
        const int kbeg = F.wave * 128;
#pragma unroll 4
        for (int k = kbeg; k < kbeg + 128; ++k) { const float wv = w[(size_t)k * 6144];
#pragma unroll
            for (int r = 0; r < 9; ++r) a[r] += sc[r * 1024 + k] * wv; }
#pragma unroll
        for (int r = 0; r < 9; ++r) red[(F.wave * 9 + r) * 64 + F.lane] = a[r];
        __syncthreads();
        for (int e = F.tid; e < 9 * 64; e += NTHREADS) { const int r = e >> 6, c = e & 63; float s = 0.f;
#pragma unroll
            for (int w8 = 0; w8 < 8; ++w8) s += red[(w8 * 9 + r) * 64 + c];
            F.modv_()[(size_t)(l * 9 + r) * 6144 + n0 + c] = s + F.ar->in[I_MODB][l * 6144 + n0 + c]; }
        __syncthreads();
    }
    if (F.bid == F.G - 1) {
        for (int e = F.tid; e < 96 * 16; e += NTHREADS) { const int p = e >> 4, i = e & 15;
            const float inv = __builtin_amdgcn_exp2f(-(float)(2 * i) * (1.0f / 32.0f) * 13.287712379549449f);
            const float pos = (p < 32) ? (float)p : (float)(p - 32); const float ang = pos * inv;
            const f32x2 cs = {__cosf(ang), __sinf(ang)};
            if (p < 32) F.ropeR_()[p * 16 + i] = cs; else F.ropeC_()[(p - 32) * 16 + i] = cs; }
        for (int e = F.tid; e < 1024; e += NTHREADS) { const float l0 = F.ar->in[I_LBL][e], l1 = F.ar->in[I_LBL][1024 + e]; F.lbv_()[e] = 1.0f / (1.0f + fexp(l1 - l0)); }
        if (F.wave == 0) { const float* lv = F.ar->in[I_DLAM]; float s1 = wave_sum(lv[F.lane] * lv[64 + F.lane]), s2 = wave_sum(lv[128 + F.lane] * lv[192 + F.lane]);
            if (F.lane == 0) { F.lamv_()[0] = fexp(s1) - fexp(s2) + 0.2f; } }
    }
    __syncthreads();
    LAS float* scr = (LAS float*)(F.lds + F.wave * 8704);
    const int gw = F.bid * NWAVES + F.wave, NGW = F.G * NWAVES;
    for (int it = gw; it < P0_NITEMS; it += NGW) p0_convert_item(F, it, scr);
}

__device__ __forceinline__ void modnorm_store(const f32x4 (&v)[4], const float* gain, const float* sh, const float* sc, bf16* orow, int lane) {
    float s = 0.f;
#pragma unroll
    for (int j = 0; j < 4; ++j) s += (v[j].x * v[j].x + v[j].y * v[j].y) + (v[j].z * v[j].z + v[j].w * v[j].w);
    const float rstd = 1.0f / sqrtf(wave_sum(s) * (1.0f / D) + EPS);
#pragma unroll
    for (int j = 0; j < 4; ++j) { const int c = 4 * (lane + 64 * j);
        const f32x4 g = *(const f32x4*)(gain + c), a = *(const f32x4*)(sc + c), b = *(const f32x4*)(sh + c);
        const f32x4 y = (v[j] * rstd) * g * (1.0f + a) + b;
        v2u o; o.x = pk2(y.x, y.y); o.y = pk2(y.z, y.w); *(v2u*)(orow + c) = o; }
}

__device__ __forceinline__ void p_norm0(Frame& F) {
    const int gw = F.bid * NWAVES + F.wave, NGW = F.G * NWAVES;
    for (int R = gw; R < NR; R += NGW) {
        const int b = R / RPB, s = R - b * RPB, r = s < CTXL ? 8 : b;
        const f32x4* src = (const f32x4*)xin_ptr(F, b, s) + F.lane;
        f32x4 v[4];
#pragma unroll
        for (int j = 0; j < 4; ++j) v[j] = src[64 * j];
        const float* mv = F.modv_() + (size_t)(0 * 9 + r) * 6144;
        modnorm_store(v, F.ar->in[I_NMIX], mv + 0, mv + 1024, F.H_() + (size_t)R * D, F.lane);
    }
}

__device__ __forceinline__ void p_hgrn_post(Frame& F) {
    const int gw = F.bid * NWAVES + F.wave, NGW = F.G * NWAVES;
    const bf16* Ho0 = (const bf16*)(F.big_() + B_HO0); const bf16* Ho1 = (const bf16*)(F.big_() + B_HO1); const bf16* Hg = (const bf16*)(F.big_() + B_HG);
    for (int R = gw; R < NR; R += NGW) {
        const int c = F.lane * 8;
        const v4u a = *(const v4u*)(Ho0 + (size_t)R * 512 + c), bq = *(const v4u*)(Ho1 + (size_t)R * 512 + c), g = *(const v4u*)(Hg + (size_t)R * 512 + c);
        float o[8];
        o[0] = bflo(a.x) + bflo(bq.x); o[1] = bfhi(a.x) + bfhi(bq.x); o[2] = bflo(a.y) + bflo(bq.y); o[3] = bfhi(a.y) + bfhi(bq.y);
        o[4] = bflo(a.z) + bflo(bq.z); o[5] = bfhi(a.z) + bfhi(bq.z); o[6] = bflo(a.w) + bflo(bq.w); o[7] = bfhi(a.w) + bfhi(bq.w);
        float s = 0.f;
#pragma unroll
        for (int i = 0; i < 8; ++i) s += o[i] * o[i];
        s += __shfl_xor(s, 1); s += __shfl_xor(s, 2); s += __shfl_xor(s, 4); s += __shfl_xor(s, 8);
        const float rstd = 1.0f / sqrtf(s * (1.0f / 128.0f) + EPS);
        const float* og = F.ar->in[I_HOG] + (c & 127);
        const float gg[8] = {bflo(g.x), bfhi(g.x), bflo(g.y), bfhi(g.y), bflo(g.z), bfhi(g.z), bflo(g.w), bfhi(g.w)};
        float y[8];
#pragma unroll
        for (int i = 0; i < 8; ++i) y[i] = o[i] * rstd * og[i] * gg[i];
        v4u w; w.x = pk2(y[0], y[1]); w.y = pk2(y[2], y[3]); w.z = pk2(y[4], y[5]); w.w = pk2(y[6], y[7]);
        *(v4u*)(F.H_() + (size_t)R * D + 512 + c) = w;
    }
}

__device__ __forceinline__ void p_norm_route(Frame& F, int layer, bool lat_only) {
    const int gw = F.bid * NWAVES + F.wave, NGW = F.G * NWAVES;
    const float* rw = F.ar->in[I_RW];
    unsigned* cnt = (unsigned*)(F.ctl_() + CW_CNT + 64 * layer);
    for (int R = gw; R < NR; R += NGW) {
        const int b = R / RPB, s = R - b * RPB, r = s < CTXL ? 8 : b;
        if (lat_only && s < CTXL) continue;
        const f32x4* src = (const f32x4*)xrow_ptr(F, b, s) + F.lane;
        f32x4 v[4];
#pragma unroll
        for (int j = 0; j < 4; ++j) v[j] = src[64 * j];
        const float* mv = F.modv_() + (size_t)(layer * 9 + r) * 6144;
        const float* gain = F.ar->in[I_NFFN] + layer * 1024; const float* sh = mv + 3072; const float* sc = mv + 4096;
        float ss = 0.f;
#pragma unroll
        for (int j = 0; j < 4; ++j) ss += (v[j].x * v[j].x + v[j].y * v[j].y) + (v[j].z * v[j].z + v[j].w * v[j].w);
        const float rstd = 1.0f / sqrtf(wave_sum(ss) * (1.0f / D) + EPS);
        float lg[16];
#pragma unroll
        for (int e = 0; e < 16; ++e) lg[e] = 0.f;
#pragma unroll
        for (int j = 0; j < 4; ++j) { const int c = 4 * (F.lane + 64 * j);
            const f32x4 g = *(const f32x4*)(gain + c), a = *(const f32x4*)(sc + c), bb = *(const f32x4*)(sh + c);
            const f32x4 y = (v[j] * rstd) * g * (1.0f + a) + bb;
            v2u o; o.x = pk2(y.x, y.y); o.y = pk2(y.z, y.w); *(v2u*)(F.H_() + (size_t)R * D + c) = o;
#pragma unroll
            for (int q = 0; q < 4; ++q) { const float yv = y[q]; const f32x4* wr = (const f32x4*)(rw + (size_t)(c + q) * 16);
                const f32x4 w0 = wr[0], w1 = wr[1], w2 = wr[2], w3 = wr[3];
                lg[0] += yv * w0.x; lg[1] += yv * w0.y; lg[2] += yv * w0.z; lg[3] += yv * w0.w;
                lg[4] += yv * w1.x; lg[5] += yv * w1.y; lg[6] += yv * w1.z; lg[7] += yv * w1.w;
                lg[8] += yv * w2.x; lg[9] += yv * w2.y; lg[10] += yv * w2.z; lg[11] += yv * w2.w;
                lg[12] += yv * w3.x; lg[13] += yv * w3.y; lg[14] += yv * w3.z; lg[15] += yv * w3.w; } }
#pragma unroll
        for (int e = 0; e < 16; ++e) lg[e] = wave_sum(lg[e]);
        float scv[16], bi[16];
#pragma unroll
        for (int e = 0; e < 16; ++e) { scv[e] = sigmoidf_(lg[e]); bi[e] = scv[e] + F.ar->in[I_RB][e]; }
        float bestgs = -3.0e38f; int e1 = 0, e2 = 1; float w1 = 0.f, w2 = 0.f;
#pragma unroll
        for (int g = 0; g < 4; ++g) {
            const float x0 = bi[4 * g], x1 = bi[4 * g + 1], x2 = bi[4 * g + 2], x3 = bi[4 * g + 3];
            const float gs = fmaxf(fmaxf(fmaxf(x0 + x1, x0 + x2), fmaxf(x0 + x3, x1 + x2)), fmaxf(x1 + x3, x2 + x3));
            int i1 = 0; float m1 = x0;
            if (x1 > m1) { m1 = x1; i1 = 1; } if (x2 > m1) { m1 = x2; i1 = 2; } if (x3 > m1) { m1 = x3; i1 = 3; }
            int i2 = -1; float m2 = -3.0e38f;
            if (i1 != 0 && x0 > m2) { m2 = x0; i2 = 0; } if (i1 != 1 && x1 > m2) { m2 = x1; i2 = 1; } if (i1 != 2 && x2 > m2) { m2 = x2; i2 = 2; } if (i1 != 3 && x3 > m2) { m2 = x3; i2 = 3; }
            const float s0 = scv[4 * g], s1 = scv[4 * g + 1], s2 = scv[4 * g + 2], s3 = scv[4 * g + 3];
            const float wa = i1 == 0 ? s0 : i1 == 1 ? s1 : i1 == 2 ? s2 : s3;
            const float wb = i2 == 0 ? s0 : i2 == 1 ? s1 : i2 == 2 ? s2 : s3;
            if (gs > bestgs) { bestgs = gs; e1 = 4 * g + i1; e2 = 4 * g + i2; w1 = wa; w2 = wb; }
        }
        const float wn = 1.0f / (w1 + w2); w1 *= wn; w2 *= wn;
        if (F.lane == 0) {
            const unsigned s1 = __hip_atomic_fetch_add(cnt + e1, 1u, RLX_AGENT), s2 = __hip_atomic_fetch_add(cnt + e2, 1u, RLX_AGENT);
            F.route_e_()[R] = e1 | (e2 << 8); F.route_w_()[2 * R] = w1; F.route_w_()[2 * R + 1] = w2; F.route_s_()[2 * R] = (int)s1; F.route_s_()[2 * R + 1] = (int)s2;
        }
    }
}

struct ExpOff { int off[17]; };
__device__ __forceinline__ void load_expoff(Frame& F, int layer, ExpOff& eo) {
    const unsigned* cnt = (const unsigned*)(F.ctl_() + CW_CNT + 64 * layer); int a = 0;
#pragma unroll
    for (int e = 0; e < 16; ++e) { eo.off[e] = a; const int c = __builtin_amdgcn_readfirstlane((int)__hip_atomic_load(cnt + e, RLX_AGENT)); a += (c + 255) & ~255; }
    eo.off[16] = a;
}
__device__ __forceinline__ int expoff_sel(const ExpOff& eo, int e) { int r = 0;
#pragma unroll
    for (int i = 0; i < 16; ++i) r = (e == i) ? eo.off[i] : r;
    return r; }

__device__ __forceinline__ void p_permute(Frame& F, int layer, bool lat_only) {
    ExpOff eo; load_expoff(F, layer, eo);
    const int gw = F.bid * NWAVES + F.wave, NGW = F.G * NWAVES;
    bf16* AP = (bf16*)(F.big_() + B_AP);
    for (int R = gw; R < NR; R += NGW) {
        const int s = R % RPB; if (lat_only && s < CTXL) continue;
        const int ee = F.route_e_()[R], e1 = ee & 255, e2 = ee >> 8;
        const int p1 = expoff_sel(eo, e1) + F.route_s_()[2 * R], p2 = expoff_sel(eo, e2) + F.route_s_()[2 * R + 1];
        if (F.lane == 0) { F.pos_()[2 * R] = p1; F.pos_()[2 * R + 1] = p2; }
        const v4u* src = (const v4u*)(F.H_() + (size_t)R * D) + F.lane;
        const v4u a0 = src[0], a1 = src[64];
        v4u* d1 = (v4u*)(AP + (size_t)p1 * D) + F.lane; v4u* d2 = (v4u*)(AP + (size_t)p2 * D) + F.lane;
        d1[0] = a0; d1[64] = a1; d2[0] = a0; d2[64] = a1;
    }
}

__device__ __forceinline__ void p_combine(Frame& F, int layer, bool lat_only, bool do_norm) {
    const int gw = F.bid * NWAVES + F.wave, NGW = F.G * NWAVES;
    const bf16* Ye = (const bf16*)(F.big_() + B_YE);
    for (int R = gw; R < NR; R += NGW) {
        const int b = R / RPB, s = R - b * RPB, r = s < CTXL ? 8 : b;
        if (lat_only && s < CTXL) continue;
        float* xr = xrow_ptr(F, b, s);
        const float* gf = F.modv_() + (size_t)(layer * 9 + r) * 6144 + 5120;
        const int p1 = F.pos_()[2 * R], p2 = F.pos_()[2 * R + 1]; const float w1 = F.route_w_()[2 * R], w2 = F.route_w_()[2 * R + 1];
        f32x4 v[4];
#pragma unroll
        for (int j = 0; j < 4; ++j) { const int c = 4 * (F.lane + 64 * j);
            const f32x4 x = *(const f32x4*)(xr + c), g = *(const f32x4*)(gf + c);
            const v2u a = *(const v2u*)(Ye + (size_t)p1 * D + c), bq = *(const v2u*)(Ye + (size_t)p2 * D + c);
            f32x4 m; m.x = w1 * bflo(a.x) + w2 * bflo(bq.x); m.y = w1 * bfhi(a.x) + w2 * bfhi(bq.x); m.z = w1 * bflo(a.y) + w2 * bflo(bq.y); m.w = w1 * bfhi(a.y) + w2 * bfhi(bq.y);
            v[j] = x + g * m; *(f32x4*)(xr + c) = v[j]; }
        if (do_norm) { const float* mv = F.modv_() + (size_t)((layer + 1) * 9 + r) * 6144;
            modnorm_store(v, F.ar->in[I_NMIX] + (layer + 1) * 1024, mv + 0, mv + 1024, F.H_() + (size_t)R * D, F.lane); }
    }
}

struct Unit { int pm, pn; };
struct Gemm { const bf16* A; const bf16* Bt; int K; };
template <class Epi, class Sched>
__device__ __forceinline__ void gemm_v0(const Gemm g, const Sched& S, const Epi& E) {
    const int tid = opaque((int)threadIdx.x), wid = __builtin_amdgcn_readfirstlane(tid >> 6), lane = tid & 63, wr = wid >> 2, wc = wid & 3, fr = lane & 15, fq = lane >> 4;
    const int K = g.K;
    Unit u;
    for (int i = 0; S.next(i, u); ++i) {
        f32x4 acc[2][2][4][2];
#pragma unroll
        for (int a = 0; a < 2; ++a)
#pragma unroll
            for (int b = 0; b < 2; ++b)
#pragma unroll
                for (int m = 0; m < 4; ++m)
#pragma unroll
                    for (int n = 0; n < 2; ++n) acc[a][b][m][n] = (f32x4){0.f, 0.f, 0.f, 0.f};
        unsigned aoff[2][4], boff[2][2];
#pragma unroll
        for (int ai = 0; ai < 2; ++ai)
#pragma unroll
            for (int m = 0; m < 4; ++m) { const int rr = u.pm * 256 + ai * 128 + wr * 64 + m * 16 + fr; const int arow = rr; aoff[ai][m] = (unsigned)arow * (unsigned)K * 2u + fq * 16u; }
#pragma unroll
        for (int bj = 0; bj < 2; ++bj)
#pragma unroll
            for (int n = 0; n < 2; ++n) { const int rho = 16 * n + fr; const int brow = u.pn * 256 + bj * 128 + wc * 32 + (Epi::PERM ? perm32(rho) : rho); boff[bj][n] = (unsigned)brow * (unsigned)K * 2u + fq * 16u; }
        const char* Ab = (const char*)g.A; const char* Bb = (const char*)g.Bt;
        for (int kt = 0; kt < K; kt += 32) {
            bf16x8 b[2][2];
#pragma unroll
            for (int bj = 0; bj < 2; ++bj)
#pragma unroll
                for (int n = 0; n < 2; ++n) b[bj][n] = *(const bf16x8*)(Bb + boff[bj][n] + kt * 2);
#pragma unroll
            for (int ai = 0; ai < 2; ++ai) {
                bf16x8 a[4];
#pragma unroll
                for (int m = 0; m < 4; ++m) a[m] = *(const bf16x8*)(Ab + aoff[ai][m] + kt * 2);
#pragma unroll
                for (int bj = 0; bj < 2; ++bj)
#pragma unroll
                    for (int m = 0; m < 4; ++m)
#pragma unroll
                        for (int n = 0; n < 2; ++n) acc[ai][bj][m][n] = __builtin_amdgcn_mfma_f32_16x16x32_bf16(b[bj][n], a[m], acc[ai][bj][m][n], 0, 0, 0);
                asm volatile("" ::: "memory");
            }
        }
        E(acc, u, wr, wc, fr, fq);
    }
}


constexpr int BM = 256, BK = 64, HALF = 128, HTB = HALF * BK * 2, STAGE_BYTES = 8 * HTB, NXCD = 8, WGM = 8;
__host__ __device__ __forceinline__ int lds_byte(int r, int c) { const int st = (r >> 4) * 2 + (c >> 5), rr = r & 15, cc = c & 31, ob = rr * 64 + cc * 2; return st * 1024 + (ob ^ (((ob >> 9) & 1) << 5)); }
__host__ __device__ __forceinline__ void stage_rc(int b, int& R, int& C) { const int st = b / 1024, sb = b % 1024, swz = sb ^ (((sb >> 9) & 1) << 5); R = (st >> 1) * 16 + swz / 64; C = (st & 1) * 32 + (swz % 64) / 2; }
template <class Epi, class Sched, bool ALIGN_EPI = false, bool SP2 = false>
__device__ __forceinline__ void gemm_phase(LAS unsigned char* lds, const Gemm g, const Sched& S, const Epi& E) {
    const int tid = opaque((int)threadIdx.x), wid = __builtin_amdgcn_readfirstlane(tid >> 6), lane = tid & 63, wr = wid >> 2, wc = wid & 3, fr = lane & 15, fq = lane >> 4;
    const int K = g.K, nt = K / BK;
    unsigned voffA[2], voffB[2];
#pragma unroll
    for (int i = 0; i < 2; ++i) { int R, C; stage_rc(tid * 16 + i * 8192, R, C); const int Rb = Epi::PERM ? ((R & ~31) + perm32(R & 31)) : R;
        voffA[i] = (unsigned)(R * K + C) * 2u; voffB[i] = (unsigned)(Rb * K + C) * 2u; }
    const size_t kstep = (size_t)(BK * 2);
    const size_t hstep = (size_t)HALF * K * 2;
    const size_t tstep = 2 * hstep;
    const unsigned ldsw = (unsigned)wid * 1024u;
    const int aoff = lds_byte(wr * 64 + fr, fq * 8), boff = lds_byte(wc * 32 + fr, fq * 8);
#define PG8_SA(b, h) (((b) * 2 + (h)) * HTB)
#define PG8_SB(b, h) ((4 + (b) * 2 + (h)) * HTB)
#define PG8_STAGE(bufoff, gbase, voff) do { _Pragma("unroll") for (int _i = 0; _i < 2; ++_i) \
        __builtin_amdgcn_global_load_lds((const unsigned*)((const char*)(gbase) + (voff)[_i]), (LAS unsigned*)(lds + (bufoff) + ldsw + _i * 8192), 16, 0, 0); } while (0)
#define PG8_LDA(dst, b, h) do { _Pragma("unroll") for (int m = 0; m < 4; ++m) _Pragma("unroll") for (int k = 0; k < 2; ++k) dst[m][k] = *(const LAS bf16x8*)(lds + PG8_SA(b, h) + aoff + m * 2048 + k * 1024); } while (0)
#define PG8_LDB(dst, b, h) do { _Pragma("unroll") for (int n = 0; n < 2; ++n) _Pragma("unroll") for (int k = 0; k < 2; ++k) dst[n][k] = *(const LAS bf16x8*)(lds + PG8_SB(b, h) + boff + n * 2048 + k * 1024); } while (0)
#define PG8_MMA(ai, bj, At, Bt) do { __builtin_amdgcn_s_setprio(1); _Pragma("unroll") for (int m = 0; m < 4; ++m) _Pragma("unroll") for (int n = 0; n < 2; ++n) _Pragma("unroll") for (int k = 0; k < 2; ++k) \
        acc[ai][bj][m][n] = __builtin_amdgcn_mfma_f32_16x16x32_bf16(Bt[n][k], At[m][k], acc[ai][bj][m][n], 0, 0, 0); __builtin_amdgcn_s_setprio(0); } while (0)
#define PG8_WAIT_V(n) asm volatile("s_waitcnt vmcnt(" #n ")" ::: "memory")
#define PG8_WAIT_L(n) asm volatile("s_waitcnt lgkmcnt(" #n ")" ::: "memory")
#define PG8_BAR __builtin_amdgcn_s_barrier()
#define PG8_SCHED __builtin_amdgcn_sched_barrier(0)
    Unit cur, nxt; int ui = 0;
    if (!S.next(0, cur)) return;
    f32x4 acc[2][2][4][2];
#pragma unroll
    for (int a = 0; a < 2; ++a)
#pragma unroll
        for (int b = 0; b < 2; ++b)
#pragma unroll
            for (int m = 0; m < 4; ++m)
#pragma unroll
                for (int n = 0; n < 2; ++n) acc[a][b][m][n] = (f32x4){0.f, 0.f, 0.f, 0.f};
    bf16x8 At[4][2], B0[2][2], B1[2][2];
    const char* cA = (const char*)g.A + (size_t)cur.pm * tstep; const char* cB = (const char*)g.Bt + (size_t)cur.pn * tstep;
    S.a_ready(cur);
    if constexpr (SP2) {
        PG8_STAGE(PG8_SB(0, 0), cB, voffB); PG8_STAGE(PG8_SB(0, 1), cB + hstep, voffB); PG8_STAGE(PG8_SA(0, 0), cA, voffA); PG8_STAGE(PG8_SA(0, 1), cA + hstep, voffA);
        if (wr == 1) PG8_BAR;
        PG8_WAIT_V(2); PG8_BAR;
        PG8_STAGE(PG8_SB(1, 0), cB + kstep, voffB); PG8_STAGE(PG8_SA(1, 0), cA + kstep, voffA); PG8_STAGE(PG8_SB(1, 1), cB + hstep + kstep, voffB);
        PG8_WAIT_V(6); PG8_BAR;
    } else {
        PG8_STAGE(PG8_SB(0, 0), cB, voffB); PG8_STAGE(PG8_SA(0, 0), cA, voffA); PG8_STAGE(PG8_SB(0, 1), cB + hstep, voffB); PG8_STAGE(PG8_SA(0, 1), cA + hstep, voffA);
        if (wr == 1) PG8_BAR;
        PG8_WAIT_V(4); PG8_BAR;
        PG8_STAGE(PG8_SB(1, 0), cB + kstep, voffB); PG8_STAGE(PG8_SA(1, 0), cA + kstep, voffA); PG8_STAGE(PG8_SB(1, 1), cB + hstep + kstep, voffB);
        PG8_WAIT_V(6); PG8_BAR;
    }
    for (;;) {
        const bool has_next = S.next(ui + 1, nxt);
        const char* nA = has_next ? (const char*)g.A + (size_t)nxt.pm * tstep : cA; const char* nB = has_next ? (const char*)g.Bt + (size_t)nxt.pn * tstep : cB;
#pragma unroll 1
        for (int t = 0; t < nt; t += 2) {
            const bool last = (t == nt - 2);
            const char* a1 = cA + (size_t)(t + 1) * kstep;
            const char* a2 = last ? nA : cA + (size_t)(t + 2) * kstep; const char* b2 = last ? nB : cB + (size_t)(t + 2) * kstep;
            const char* a3 = a2 + kstep; const char* b3 = b2 + kstep;
            if (last && has_next) S.a_ready(nxt);
            if constexpr (SP2) {
            PG8_LDB(B0, 0, 0); PG8_LDB(B1, 0, 1); PG8_SCHED; PG8_LDA(At, 0, 0); PG8_STAGE(PG8_SA(1, 1), a1 + hstep, voffA);
            PG8_WAIT_V(8); PG8_WAIT_L(0); PG8_BAR; PG8_MMA(0, 0, At, B0); PG8_MMA(0, 1, At, B1); PG8_BAR; PG8_SCHED;
            PG8_LDA(At, 0, 1); PG8_STAGE(PG8_SB(0, 0), b2, voffB); PG8_STAGE(PG8_SB(0, 1), b2 + hstep, voffB); PG8_STAGE(PG8_SA(0, 0), a2, voffA);
            PG8_WAIT_V(8); PG8_WAIT_L(0); PG8_BAR; PG8_MMA(1, 0, At, B0); PG8_MMA(1, 1, At, B1); PG8_BAR; PG8_SCHED;
            PG8_LDB(B0, 1, 0); PG8_LDB(B1, 1, 1); PG8_SCHED; PG8_LDA(At, 1, 0); PG8_STAGE(PG8_SA(0, 1), a2 + hstep, voffA);
            PG8_WAIT_V(8); PG8_WAIT_L(0); PG8_BAR; PG8_MMA(0, 0, At, B0); PG8_MMA(0, 1, At, B1); PG8_BAR; PG8_SCHED;
            PG8_LDA(At, 1, 1); PG8_STAGE(PG8_SB(1, 0), b3, voffB); PG8_STAGE(PG8_SB(1, 1), b3 + hstep, voffB); PG8_STAGE(PG8_SA(1, 0), a3, voffA);
            PG8_WAIT_V(8); PG8_WAIT_L(0); PG8_BAR; PG8_MMA(1, 0, At, B0); PG8_MMA(1, 1, At, B1); PG8_BAR; PG8_SCHED;
            } else {
            PG8_LDB(B0, 0, 0); PG8_SCHED; PG8_LDA(At, 0, 0); PG8_STAGE(PG8_SA(1, 1), a1 + hstep, voffA);
            PG8_WAIT_L(8); PG8_BAR; PG8_WAIT_L(0); PG8_MMA(0, 0, At, B0); PG8_BAR; PG8_SCHED;
            PG8_LDB(B1, 0, 1); PG8_STAGE(PG8_SB(0, 0), b2, voffB);
            PG8_BAR; PG8_WAIT_L(0); PG8_MMA(0, 1, At, B1); PG8_BAR;
            PG8_LDA(At, 0, 1); PG8_STAGE(PG8_SA(0, 0), a2, voffA);
            PG8_BAR; PG8_WAIT_L(0); PG8_MMA(1, 0, At, B0); PG8_BAR; PG8_SCHED;
            PG8_STAGE(PG8_SB(0, 1), b2 + hstep, voffB);
            PG8_WAIT_V(6); PG8_BAR; PG8_MMA(1, 1, At, B1); PG8_BAR;
            PG8_LDB(B0, 1, 0); PG8_SCHED; PG8_LDA(At, 1, 0); PG8_STAGE(PG8_SA(0, 1), a2 + hstep, voffA);
            PG8_WAIT_L(8); PG8_BAR; PG8_WAIT_L(0); PG8_MMA(0, 0, At, B0); PG8_BAR; PG8_SCHED;
            PG8_LDB(B1, 1, 1); PG8_STAGE(PG8_SB(1, 0), b3, voffB);
            PG8_BAR; PG8_WAIT_L(0); PG8_MMA(0, 1, At, B1); PG8_BAR;
            PG8_LDA(At, 1, 1); PG8_STAGE(PG8_SA(1, 0), a3, voffA);
            PG8_BAR; PG8_WAIT_L(0); PG8_MMA(1, 0, At, B0); PG8_BAR; PG8_SCHED;
            PG8_STAGE(PG8_SB(1, 1), b3 + hstep, voffB);
            PG8_WAIT_V(6); PG8_BAR; PG8_MMA(1, 1, At, B1); PG8_BAR;
            }
        }
        if constexpr (ALIGN_EPI) { if (wr == 0) PG8_BAR; }
        if constexpr (!Epi::AFTER_DRAIN) { E(acc, cur, wr, wc, fr, fq); S.done(cur); }
        if (!has_next) break;
#pragma unroll
        for (int a = 0; a < 2; ++a)
#pragma unroll
            for (int b = 0; b < 2; ++b)
#pragma unroll
                for (int m = 0; m < 4; ++m)
#pragma unroll
                    for (int n = 0; n < 2; ++n) acc[a][b][m][n] = (f32x4){0.f, 0.f, 0.f, 0.f};
        cur = nxt; cA = nA; cB = nB; ++ui;
        if constexpr (ALIGN_EPI) { if (wr == 1) PG8_BAR; }
    }
    PG8_WAIT_V(0);
    if constexpr (!ALIGN_EPI) { if (wr == 0) PG8_BAR; }
    PG8_BAR;
    if constexpr (Epi::AFTER_DRAIN) { E.fused(acc, cur, wr, wc, fr, fq, lds, wid, lane); S.done(cur); }
#undef PG8_SA
#undef PG8_SB
#undef PG8_STAGE
#undef PG8_LDA
#undef PG8_LDB
#undef PG8_MMA
#undef PG8_WAIT_V
#undef PG8_WAIT_L
#undef PG8_BAR
#undef PG8_SCHED
}


__device__ __forceinline__ int xcd_remap(int L, int nwg) { const int q = nwg / NXCD, r = nwg % NXCD, xcd = L % NXCD, off = L / NXCD; return (xcd < r ? xcd * (q + 1) : r * (q + 1) + (xcd - r) * q) + off; }
struct SchedGrid {
    int nm, nn, G, c; bool lat;
    __device__ __forceinline__ bool next(int i, Unit& u) const { const int nwg = nm * nn; const int L = i * G + c; if (L >= nwg) return false;
        const int wgid = xcd_remap(L, nwg); const int nig = WGM * nn, gid = wgid / nig, fm = gid * WGM, gsz = (nm - fm) < WGM ? (nm - fm) : WGM;
        int pm = fm + ((wgid % nig) % gsz); u.pn = (wgid % nig) / gsz; if (lat) pm = (pm >> 3) * 9 + 1 + (pm & 7); u.pm = pm; return true; }
    __device__ __forceinline__ void a_ready(const Unit&) const {}
    __device__ __forceinline__ void done(const Unit&) const {}
};
struct SchedRouted {
    ExpOff eo; int G, c;
    __device__ __forceinline__ bool next(int i, Unit& u) const { const int nt = eo.off[16] >> 8, nwg = nt * 4; const int L = i * G + c; if (L >= nwg) return false;
        const int wgid = xcd_remap(L, nwg); const int pm = wgid >> 2, pnl = wgid & 3; int e = 0;
#pragma unroll
        for (int k = 1; k < 16; ++k) e += (pm * 256 >= eo.off[k]) ? 1 : 0;
        u.pm = pm; u.pn = e * 4 + pnl; return true; }
    __device__ __forceinline__ void a_ready(const Unit&) const {}
    __device__ __forceinline__ void done(const Unit&) const {}
};

#ifndef PG8_MASK
#define PG8_MASK 0xffffffffu
#endif
template <int ID, class Epi, class Sched>
__device__ __forceinline__ void run_gemm(LAS unsigned char* lds, const Gemm g, const Sched& S, const Epi& E) {
    if constexpr ((PG8_MASK >> ID) & 1u) gemm_phase<Epi, Sched, true, true>(lds, g, S, E); else gemm_v0(g, S, E);
}

__device__ __forceinline__ v4u pack8(const f32x4 a, const f32x4 b) { v4u w; w.x = pk2(a[0], a[1]); w.y = pk2(a[2], a[3]); w.z = pk2(b[0], b[1]); w.w = pk2(b[2], b[3]); return w; }

struct EpiIn0 {
    static constexpr bool PERM = true, AFTER_DRAIN = false;
    unsigned char* big; const float *qg, *kg, *lbv; const f32x2 *ropeR, *ropeC;
    __device__ __forceinline__ void operator()(const f32x4 (&acc)[2][2][4][2], const Unit& u, int wr, int wc, int fr, int fq) const {
        const int pn = u.pn, type = pn >> 1, j9 = u.pm % 9; const bool lat = j9 > 0;
        if (type < 2) {
            const float* gain = type ? kg : qg; bf16* dst = (bf16*)(big + (type ? B_KD : B_QD));
            const int h = 2 * (pn & 1) + (wc >> 1), c = wc & 1;
            f32x4 g[2][2];
#pragma unroll
            for (int bj = 0; bj < 2; ++bj)
#pragma unroll
                for (int n = 0; n < 2; ++n) g[bj][n] = *(const f32x4*)(gain + 32 * bj + 16 * n + 4 * fq);
#pragma unroll
            for (int ai = 0; ai < 2; ++ai)
#pragma unroll
                for (int m = 0; m < 4; ++m) {
                    const int rr = opaque(ai * 128 + wr * 64 + m * 16 + fr); const size_t R = (size_t)u.pm * 256 + rr;
                    float s = 0.f;
#pragma unroll
                    for (int bj = 0; bj < 2; ++bj)
#pragma unroll
                        for (int n = 0; n < 2; ++n) { const f32x4 x = acc[ai][bj][m][n]; s += (x[0] * x[0] + x[1] * x[1]) + (x[2] * x[2] + x[3] * x[3]); }
                    s += __shfl_xor(s, 16); s += __shfl_xor(s, 32);
                    const float rstd = 1.0f / sqrtf(s * (1.0f / 64.0f) + EPS);
                    f32x4 y[2][2];
#pragma unroll
                    for (int bj = 0; bj < 2; ++bj)
#pragma unroll
                        for (int n = 0; n < 2; ++n) y[bj][n] = acc[ai][bj][m][n] * rstd * g[bj][n];
                    if (lat) { const int t = (j9 - 1) * 256 + rr, grow = t >> 6, gcol = t & 63;
#pragma unroll
                        for (int bj = 0; bj < 2; ++bj) { const f32x2* tab = bj ? (ropeC + gcol * 16 + 4 * fq) : (ropeR + grow * 16 + 4 * fq);
                            const f32x4 t0 = *(const f32x4*)tab, t1 = *(const f32x4*)(tab + 2);
                            const float cs[4] = {t0[0], t0[2], t1[0], t1[2]}, sn[4] = {t0[1], t0[3], t1[1], t1[3]};
#pragma unroll
                            for (int e = 0; e < 4; ++e) { const float x1 = y[bj][0][e], x2 = y[bj][1][e]; y[bj][0][e] = x1 * cs[e] - x2 * sn[e]; y[bj][1][e] = x1 * sn[e] + x2 * cs[e]; } } }
#pragma unroll
                    for (int bj = 0; bj < 2; ++bj) *(v4u*)(dst + R * 512 + h * 128 + c * 64 + 32 * bj + 8 * fq) = pack8(y[bj][0], y[bj][1]);
                    asm volatile("" ::: "memory");
                }
        } else {
            const int colt = (pn & 1) * 256;
            size_t boffs; if (type == 2) boffs = B_VD; else if (type == 3) boffs = B_HQ; else if (type == 4) boffs = B_LF0; else if (type == 5) boffs = B_LF1; else if (type == 6) boffs = B_HV; else boffs = B_HG;
            bf16* dst = (bf16*)(big + boffs);
#pragma unroll
            for (int bj = 0; bj < 2; ++bj) { const int col = colt + bj * 128 + wc * 32 + 8 * fq;
                f32x4 lb0 = {0.f, 0.f, 0.f, 0.f}, lb1 = lb0;
                if (type == 4 || type == 5) { const float* lp = lbv + (type - 4) * 512 + col; lb0 = *(const f32x4*)lp; lb1 = *(const f32x4*)(lp + 4); }
#pragma unroll
                for (int ai = 0; ai < 2; ++ai)
#pragma unroll
                    for (int m = 0; m < 4; ++m) { const size_t R = (size_t)u.pm * 256 + opaque(ai * 128 + wr * 64 + m * 16 + fr);
                        f32x4 a = acc[ai][bj][m][0], b = acc[ai][bj][m][1]; v4u w;
                        if (type == 3 || type == 7) {
#pragma unroll
                            for (int e = 0; e < 4; ++e) { a[e] = siluf_(a[e]); b[e] = siluf_(b[e]); }
                            w = pack8(a, b);
                        } else if (type == 4 || type == 5) {
#pragma unroll
                            for (int e = 0; e < 4; ++e) { a[e] = __logf(lb0[e] + (1.0f - lb0[e]) * sigmoidf_(a[e])); b[e] = __logf(lb1[e] + (1.0f - lb1[e]) * sigmoidf_(b[e])); }
                            w.x = pkh2(a[0], a[1]); w.y = pkh2(a[2], a[3]); w.z = pkh2(b[0], b[1]); w.w = pkh2(b[2], b[3]);
                        } else w = pack8(a, b);
                        *(v4u*)(dst + R * 512 + col) = w; asm volatile("" ::: "memory"); } }
        }
    }
};

struct EpiOut {
    static constexpr bool PERM = false, AFTER_DRAIN = false;
    const Frame* F; int layer; bool from_input;
    __device__ __forceinline__ void operator()(const f32x4 (&acc)[2][2][4][2], const Unit& u, int wr, int wc, int fr, int fq) const {
        const int b = u.pm / 9, j9 = u.pm % 9, r = j9 ? b : 8;
        const float* gm = F->modv_() + (size_t)(layer * 9 + r) * 6144 + 2048;
#pragma unroll
        for (int ai = 0; ai < 2; ++ai)
#pragma unroll
            for (int m = 0; m < 4; ++m) { const int s = j9 * 256 + opaque(ai * 128 + wr * 64 + m * 16 + fr);
                float* xo = xrow_ptr(*F, b, s); const float* xb = from_input ? xin_ptr(*F, b, s) : xo;
#pragma unroll
                for (int bj = 0; bj < 2; ++bj)
#pragma unroll
                    for (int n = 0; n < 2; ++n) { const int col = u.pn * 256 + bj * 128 + wc * 32 + 16 * n + 4 * fq;
                        *(f32x4*)(xo + col) = *(const f32x4*)(xb + col) + *(const f32x4*)(gm + col) * acc[ai][bj][m][n]; } asm volatile("" ::: "memory"); }
    }
};

struct EpiGU {
    static constexpr bool PERM = true, AFTER_DRAIN = false;
    bf16* Hout;
    __device__ __forceinline__ void operator()(const f32x4 (&acc)[2][2][4][2], const Unit& u, int wr, int wc, int fr, int fq) const {
        const int pnl = u.pn & 3;
#pragma unroll
        for (int ai = 0; ai < 2; ++ai)
#pragma unroll
            for (int m = 0; m < 4; ++m) { const size_t row = (size_t)u.pm * 256 + opaque(ai * 128 + wr * 64 + m * 16 + fr);
                f32x4 h[2];
#pragma unroll
                for (int n = 0; n < 2; ++n)
#pragma unroll
                    for (int e = 0; e < 4; ++e) h[n][e] = siluf_(acc[ai][0][m][n][e]) * acc[ai][1][m][n][e];
                *(v4u*)(Hout + row * 512 + pnl * 128 + wc * 32 + 8 * fq) = pack8(h[0], h[1]); }
    }
};

struct EpiDownS {
    static constexpr bool PERM = false, AFTER_DRAIN = false;
    const Frame* F; int layer;
    __device__ __forceinline__ void operator()(const f32x4 (&acc)[2][2][4][2], const Unit& u, int wr, int wc, int fr, int fq) const {
        const int b = u.pm / 9, j9 = u.pm % 9, r = j9 ? b : 8;
        const float* gf = F->modv_() + (size_t)(layer * 9 + r) * 6144 + 5120;
#pragma unroll
        for (int ai = 0; ai < 2; ++ai)
#pragma unroll
            for (int m = 0; m < 4; ++m) { const int s = j9 * 256 + opaque(ai * 128 + wr * 64 + m * 16 + fr); float* xo = xrow_ptr(*F, b, s);
#pragma unroll
                for (int bj = 0; bj < 2; ++bj)
#pragma unroll
                    for (int n = 0; n < 2; ++n) { const int col = u.pn * 256 + bj * 128 + wc * 32 + 16 * n + 4 * fq;
                        *(f32x4*)(xo + col) = *(const f32x4*)(xo + col) + *(const f32x4*)(gf + col) * acc[ai][bj][m][n]; } asm volatile("" ::: "memory"); }
    }
};

struct EpiDownR {
    static constexpr bool PERM = true, AFTER_DRAIN = false;
    bf16* Ye;
    __device__ __forceinline__ void operator()(const f32x4 (&acc)[2][2][4][2], const Unit& u, int wr, int wc, int fr, int fq) const {
        const int pnl = u.pn & 3;
#pragma unroll
        for (int ai = 0; ai < 2; ++ai)
#pragma unroll
            for (int m = 0; m < 4; ++m) { const size_t row = (size_t)u.pm * 256 + opaque(ai * 128 + wr * 64 + m * 16 + fr);
#pragma unroll
                for (int bj = 0; bj < 2; ++bj) *(v4u*)(Ye + row * 1024 + pnl * 256 + bj * 128 + wc * 32 + 8 * fq) = pack8(acc[ai][bj][m][0], acc[ai][bj][m][1]); }
    }
};

struct EpiIn1 {
    static constexpr bool PERM = true, AFTER_DRAIN = false;
    unsigned char* big; float* ssq; const float* krg; const f32x2 *ropeR, *ropeC;
    __device__ __forceinline__ void operator()(const f32x4 (&acc)[2][2][4][2], const Unit& u, int wr, int wc, int fr, int fq) const {
        const int pn = u.pn, j9 = u.pm % 9; const bool lat = j9 > 0;
        bf16* Ckv = (bf16*)(big + B_CKV); bf16* Cq = (bf16*)(big + B_CQ); bf16* Kr = (bf16*)(big + B_KR);
        if (pn == 2 && wc == 3) {
#pragma unroll
            for (int ai = 0; ai < 2; ++ai)
#pragma unroll
                for (int m = 0; m < 4; ++m) {
                    const int rr = opaque(ai * 128 + wr * 64 + m * 16 + fr); const size_t R = (size_t)u.pm * 256 + rr;
                    float s = 0.f;
#pragma unroll
                    for (int bj = 0; bj < 2; ++bj)
#pragma unroll
                        for (int n = 0; n < 2; ++n) { const f32x4 x = acc[ai][bj][m][n]; s += (x[0] * x[0] + x[1] * x[1]) + (x[2] * x[2] + x[3] * x[3]); }
                    s += __shfl_xor(s, 16); s += __shfl_xor(s, 32);
                    const float rstd = 1.0f / sqrtf(s * (1.0f / 64.0f) + EPS);
                    f32x4 y[2][2];
#pragma unroll
                    for (int bj = 0; bj < 2; ++bj)
#pragma unroll
                        for (int n = 0; n < 2; ++n) y[bj][n] = acc[ai][bj][m][n] * rstd * *(const f32x4*)(krg + 32 * bj + 16 * n + 4 * fq);
                    if (lat) { const int t = (j9 - 1) * 256 + rr, grow = t >> 6, gcol = t & 63;
#pragma unroll
                        for (int bj = 0; bj < 2; ++bj) { const f32x2* tab = bj ? (ropeC + gcol * 16 + 4 * fq) : (ropeR + grow * 16 + 4 * fq);
                            const f32x4 t0 = *(const f32x4*)tab, t1 = *(const f32x4*)(tab + 2);
                            const float cs[4] = {t0[0], t0[2], t1[0], t1[2]}, sn[4] = {t0[1], t0[3], t1[1], t1[3]};
#pragma unroll
                            for (int e = 0; e < 4; ++e) { const float x1 = y[bj][0][e], x2 = y[bj][1][e]; y[bj][0][e] = x1 * cs[e] - x2 * sn[e]; y[bj][1][e] = x1 * sn[e] + x2 * cs[e]; } } }
#pragma unroll
                    for (int bj = 0; bj < 2; ++bj) *(v4u*)(Kr + R * 64 + 32 * bj + 8 * fq) = pack8(y[bj][0], y[bj][1]);
                    asm volatile("" ::: "memory");
                }
            return;
        }
#pragma unroll
        for (int ai = 0; ai < 2; ++ai)
#pragma unroll
            for (int m = 0; m < 4; ++m) {
                const size_t R = (size_t)u.pm * 256 + opaque(ai * 128 + wr * 64 + m * 16 + fr);
                float s = 0.f;
#pragma unroll
                for (int bj = 0; bj < 2; ++bj) { const f32x4 a = acc[ai][bj][m][0], b = acc[ai][bj][m][1];
                    s += (a[0] * a[0] + a[1] * a[1]) + (a[2] * a[2] + a[3] * a[3]) + (b[0] * b[0] + b[1] * b[1]) + (b[2] * b[2] + b[3] * b[3]);
                    const v4u w = pack8(a, b);
                    if (pn == 0) *(v4u*)(Ckv + R * 256 + bj * 128 + wc * 32 + 8 * fq) = w;
                    else if (pn == 1) *(v4u*)(Cq + R * 384 + bj * 128 + wc * 32 + 8 * fq) = w;
                    else { if (bj == 0) *(v4u*)(Cq + R * 384 + 256 + wc * 32 + 8 * fq) = w; else if (wc == 0) *(v4u*)(Cq + R * 384 + 352 + 8 * fq) = w; } }
                s += __shfl_xor(s, 16); s += __shfl_xor(s, 32);
                if (fq == 0) ssq[R * 12 + pn * 4 + wc] = s;
                asm volatile("" ::: "memory");
            }
    }
};

struct EpiUq {
    static constexpr bool PERM = true, AFTER_DRAIN = false;
    bf16* Q1; const float* ssq; const float *qng, *qrg; const f32x2 *ropeR, *ropeC; LAS float* xl;
    __device__ __forceinline__ float rq_of(size_t R) const { const float* sp = ssq + R * 12; const f32x4 s1 = *(const f32x4*)(sp + 4), s2 = *(const f32x4*)(sp + 8);
        return 1.0f / sqrtf(((s1[0] + s1[1]) + (s1[2] + s1[3]) + (s2[0] + s2[1]) + s2[2]) * (1.0f / 384.0f) + EPS); }
    __device__ __forceinline__ void operator()(const f32x4 (&acc)[2][2][4][2], const Unit& u, int wr, int wc, int fr, int fq) const {
        const int pn = u.pn, j9 = u.pm % 9;
        if (pn < 4) {
#pragma unroll
            for (int ai = 0; ai < 2; ++ai)
#pragma unroll
                for (int m = 0; m < 4; ++m)
#pragma unroll
                    for (int bj = 0; bj < 2; ++bj) { float s = 0.f;
#pragma unroll
                        for (int n = 0; n < 2; ++n) { const f32x4 x = acc[ai][bj][m][n]; s += (x[0] * x[0] + x[1] * x[1]) + (x[2] * x[2] + x[3] * x[3]); }
                        s += __shfl_xor(s, 16); s += __shfl_xor(s, 32);
                        if (fq == 0) xl[(ai * 128 + wr * 64 + m * 16 + fr) * 8 + bj * 4 + wc] = s; }
            EPI_BAR();
#pragma unroll
            for (int ai = 0; ai < 2; ++ai)
#pragma unroll
                for (int m = 0; m < 4; ++m) { const int rr = opaque(ai * 128 + wr * 64 + m * 16 + fr); const size_t R = (size_t)u.pm * 256 + rr; const float rq = rq_of(R);
                    f32x4 g[2];
#pragma unroll
                    for (int n = 0; n < 2; ++n) g[n] = *(const f32x4*)(qng + wc * 32 + 8 * fq + 4 * n);
#pragma unroll
                    for (int bj = 0; bj < 2; ++bj) { const f32x4 p = *(const LAS f32x4*)(xl + rr * 8 + bj * 4);
                        const float rstd = rq / sqrtf(((p[0] + p[1]) + (p[2] + p[3])) * (rq * rq) * (1.0f / 128.0f) + EPS);
                        const int h = 2 * pn + bj;
                        *(v4u*)(Q1 + R * 1536 + h * 192 + wc * 32 + 8 * fq) = pack8(acc[ai][bj][m][0] * rstd * g[0], acc[ai][bj][m][1] * rstd * g[1]); } asm volatile("" ::: "memory"); }
            EPI_BAR();
        } else {
            const int h = 4 * (pn - 4) + wc;
#pragma unroll
            for (int ai = 0; ai < 2; ++ai)
#pragma unroll
                for (int m = 0; m < 4; ++m) {
                    const int rr = opaque(ai * 128 + wr * 64 + m * 16 + fr); const size_t R = (size_t)u.pm * 256 + rr; const float rq = rq_of(R);
                    float s = 0.f; f32x4 y[2][2];
#pragma unroll
                    for (int bj = 0; bj < 2; ++bj)
#pragma unroll
                        for (int n = 0; n < 2; ++n) { const f32x4 x = acc[ai][bj][m][n] * rq; y[bj][n] = x; s += (x[0] * x[0] + x[1] * x[1]) + (x[2] * x[2] + x[3] * x[3]); }
                    s += __shfl_xor(s, 16); s += __shfl_xor(s, 32);
                    const float rstd = 1.0f / sqrtf(s * (1.0f / 64.0f) + EPS);
#pragma unroll
                    for (int bj = 0; bj < 2; ++bj)
#pragma unroll
                        for (int n = 0; n < 2; ++n) y[bj][n] = y[bj][n] * rstd * *(const f32x4*)(qrg + 32 * bj + 16 * n + 4 * fq);
                    { const int t = (j9 - 1) * 256 + rr, grow = t >> 6, gcol = t & 63;
#pragma unroll
                        for (int bj = 0; bj < 2; ++bj) { const f32x2* tab = bj ? (ropeC + gcol * 16 + 4 * fq) : (ropeR + grow * 16 + 4 * fq);
                            const f32x4 t0 = *(const f32x4*)tab, t1 = *(const f32x4*)(tab + 2);
                            const float cs[4] = {t0[0], t0[2], t1[0], t1[2]}, sn[4] = {t0[1], t0[3], t1[1], t1[3]};
#pragma unroll
                            for (int e = 0; e < 4; ++e) { const float x1 = y[bj][0][e], x2 = y[bj][1][e]; y[bj][0][e] = x1 * cs[e] - x2 * sn[e]; y[bj][1][e] = x1 * sn[e] + x2 * cs[e]; } } }
#pragma unroll
                    for (int bj = 0; bj < 2; ++bj) *(v4u*)(Q1 + R * 1536 + h * 192 + 128 + 32 * bj + 8 * fq) = pack8(y[bj][0], y[bj][1]);
                    asm volatile("" ::: "memory");
                }
        }
    }
};

struct EpiUkv {
    static constexpr bool PERM = true, AFTER_DRAIN = false;
    bf16 *Kn, *V1; const float* ssq; const float* kng; LAS float* xl;
    __device__ __forceinline__ void operator()(const f32x4 (&acc)[2][2][4][2], const Unit& u, int wr, int wc, int fr, int fq) const {
        const int h = u.pn;
#pragma unroll
        for (int ai = 0; ai < 2; ++ai)
#pragma unroll
            for (int m = 0; m < 4; ++m) { float s = 0.f;
#pragma unroll
                for (int n = 0; n < 2; ++n) { const f32x4 x = acc[ai][0][m][n]; s += (x[0] * x[0] + x[1] * x[1]) + (x[2] * x[2] + x[3] * x[3]); }
                s += __shfl_xor(s, 16); s += __shfl_xor(s, 32);
                if (fq == 0) xl[(ai * 128 + wr * 64 + m * 16 + fr) * 4 + wc] = s; }
        EPI_BAR();
#pragma unroll
        for (int ai = 0; ai < 2; ++ai)
#pragma unroll
            for (int m = 0; m < 4; ++m) { const int rr = opaque(ai * 128 + wr * 64 + m * 16 + fr); const size_t R = (size_t)u.pm * 256 + rr;
                f32x4 g[2];
#pragma unroll
                for (int n = 0; n < 2; ++n) g[n] = *(const f32x4*)(kng + wc * 32 + 8 * fq + 4 * n);
                const f32x4 s0 = *(const f32x4*)(ssq + R * 12);
                const float rk = 1.0f / sqrtf(((s0[0] + s0[1]) + (s0[2] + s0[3])) * (1.0f / 256.0f) + EPS);
                const f32x4 p = *(const LAS f32x4*)(xl + rr * 4);
                const float rstd = rk / sqrtf(((p[0] + p[1]) + (p[2] + p[3])) * (rk * rk) * (1.0f / 128.0f) + EPS);
                *(v4u*)(Kn + R * 1024 + h * 128 + wc * 32 + 8 * fq) = pack8(acc[ai][0][m][0] * rstd * g[0], acc[ai][0][m][1] * rstd * g[1]);
                *(v4u*)(V1 + R * 1024 + h * 128 + wc * 32 + 8 * fq) = pack8(acc[ai][1][m][0] * rk, acc[ai][1][m][1] * rk); asm volatile("" ::: "memory"); }
        EPI_BAR();
    }
};

__device__ __forceinline__ bf16x8 pack_p(const f32x16& p, int s) { v4u w; w.x = pk2(p[8 * s + 0], p[8 * s + 1]); w.y = pk2(p[8 * s + 2], p[8 * s + 3]); w.z = pk2(p[8 * s + 4], p[8 * s + 5]); w.w = pk2(p[8 * s + 6], p[8 * s + 7]); return __builtin_bit_cast(bf16x8, w); }
__device__ __forceinline__ bf16x8 load_vfrag(const bf16* vp, int ld, int s) {
    bf16x8 r;
#pragma unroll
    for (int j = 0; j < 8; ++j) r[j] = (short)vp[(size_t)(16 * s + 8 * (j >> 2) + (j & 3)) * ld];
    return r;
}

__device__ __forceinline__ void diff_attn_unit_v0(Frame& F, int a) {
    const int lane = F.lane, r32 = lane & 31, hh = lane >> 5, wid = F.wave;
    int b, h, q0, nkeys;
    if (a < 256) { b = a >> 5; h = (a >> 3) & 3; q0 = b * RPB + CTXL + (a & 7) * 256; nkeys = RPB; } else { const int a2 = a - 256; b = a2 >> 2; h = a2 & 3; q0 = b * RPB; nkeys = CTXL; }
    const int kbase = b * RPB;
    const bf16* Qd = (const bf16*)(F.big_() + B_QD); const bf16* Kd = (const bf16*)(F.big_() + B_KD); const bf16* Vd = (const bf16*)(F.big_() + B_VD);
    const float lam = F.lamv_()[0];
    const float sc2 = 0.125f * LOG2E;
    const bf16* qp = Qd + (size_t)(q0 + wid * 32 + r32) * 512 + h * 128 + hh * 8;
    f32x16 O[2][4];
#pragma unroll
    for (int c = 0; c < 2; ++c)
#pragma unroll
        for (int d = 0; d < 4; ++d)
#pragma unroll
            for (int r = 0; r < 16; ++r) O[c][d][r] = 0.f;
    float l0 = 0.f, l1 = 0.f;
    for (int kt = 0; kt < nkeys; kt += 32) {
        bf16x8 pf[2][2];
        const bf16* kp = Kd + (size_t)(kbase + kt + r32) * 512 + h * 128 + hh * 8;
#pragma unroll
        for (int c = 0; c < 2; ++c) {
            f32x16 S;
#pragma unroll
            for (int r = 0; r < 16; ++r) S[r] = 0.f;
#pragma unroll
            for (int ks = 0; ks < 4; ++ks) { const bf16x8 kf = *(const bf16x8*)(kp + c * 64 + ks * 16); const bf16x8 qv = *(const bf16x8*)(qp + c * 64 + ks * 16); S = __builtin_amdgcn_mfma_f32_32x32x16_bf16(kf, qv, S, 0, 0, 0); }
            float ls = 0.f;
#pragma unroll
            for (int r = 0; r < 16; ++r) { S[r] = __builtin_amdgcn_exp2f(S[r] * sc2); ls += S[r]; }
            if (c == 0) l0 += ls; else l1 += ls;
            pf[c][0] = pack_p(S, 0); pf[c][1] = pack_p(S, 1);
        }
        const bf16* vp = Vd + (size_t)(kbase + kt + 4 * hh) * 512 + h * 128 + r32;
#pragma unroll
        for (int d = 0; d < 4; ++d)
#pragma unroll
            for (int s = 0; s < 2; ++s) { const bf16x8 vf = load_vfrag(vp + d * 32, 512, s);
                O[0][d] = __builtin_amdgcn_mfma_f32_32x32x16_bf16(pf[0][s], vf, O[0][d], 0, 0, 0);
                O[1][d] = __builtin_amdgcn_mfma_f32_32x32x16_bf16(pf[1][s], vf, O[1][d], 0, 0, 0); asm volatile("" ::: "memory"); }
    }
    l0 += __shfl_xor(l0, 32); l1 += __shfl_xor(l1, 32);
    const float* sg = F.ar->in[I_DSUBLN];
    float gsub[4];
#pragma unroll
    for (int d = 0; d < 4; ++d) gsub[d] = sg[d * 32 + r32] * 0.8f;
#pragma unroll
    for (int r = 0; r < 16; ++r) {
        const int qi = crow(r, hh);
        const float i0 = 1.0f / __shfl(l0, qi), i1 = lam / __shfl(l1, qi);
        float o[4]; float s = 0.f;
#pragma unroll
        for (int d = 0; d < 4; ++d) { o[d] = O[0][d][r] * i0 - O[1][d][r] * i1; s += o[d] * o[d]; }
        s += __shfl_xor(s, 1); s += __shfl_xor(s, 2); s += __shfl_xor(s, 4); s += __shfl_xor(s, 8); s += __shfl_xor(s, 16);
        const float rstd = 1.0f / sqrtf(s * (1.0f / 128.0f) + EPS);
        bf16* op = F.H_() + (size_t)(q0 + wid * 32 + qi) * D + h * 128 + r32;
#pragma unroll
        for (int d = 0; d < 4; ++d) op[d * 32] = (bf16)f2bf(o[d] * rstd * gsub[d]);
    }
}

__device__ __forceinline__ void mla_attn_unit_v0(Frame& F, int a) {
    const int lane = F.lane, r32 = lane & 31, hh = lane >> 5, wid = F.wave;
    const int b = a >> 6, h = (a >> 3) & 7, q0 = b * RPB + CTXL + (a & 7) * 256, kbase = b * RPB;
    const bf16* Q1 = (const bf16*)(F.big_() + B_Q1); const bf16* Kn = (const bf16*)(F.big_() + B_KN); const bf16* Kr = (const bf16*)(F.big_() + B_KR); const bf16* V1 = (const bf16*)(F.big_() + B_V1);
    const float sc2 = 0.07216878364870323f * LOG2E;
    bf16x8 qf[12];
    { const bf16* qp = Q1 + (size_t)(q0 + wid * 32 + r32) * 1536 + h * 192 + hh * 8;
#pragma unroll
        for (int ks = 0; ks < 12; ++ks) qf[ks] = *(const bf16x8*)(qp + ks * 16); }
    f32x16 O[4];
#pragma unroll
    for (int d = 0; d < 4; ++d)
#pragma unroll
        for (int r = 0; r < 16; ++r) O[d][r] = 0.f;
    float l0 = 0.f;
    for (int kt = 0; kt < RPB; kt += 32) {
        const bf16* knp = Kn + (size_t)(kbase + kt + r32) * 1024 + h * 128 + hh * 8;
        const bf16* krp = Kr + (size_t)(kbase + kt + r32) * 64 + hh * 8;
        f32x16 S;
#pragma unroll
        for (int r = 0; r < 16; ++r) S[r] = 0.f;
#pragma unroll
        for (int ks = 0; ks < 8; ++ks) { const bf16x8 kf = *(const bf16x8*)(knp + ks * 16); S = __builtin_amdgcn_mfma_f32_32x32x16_bf16(kf, qf[ks], S, 0, 0, 0); }
#pragma unroll
        for (int ks = 0; ks < 4; ++ks) { const bf16x8 kf = *(const bf16x8*)(krp + ks * 16); S = __builtin_amdgcn_mfma_f32_32x32x16_bf16(kf, qf[8 + ks], S, 0, 0, 0); }
        float ls = 0.f;
#pragma unroll
        for (int r = 0; r < 16; ++r) { S[r] = __builtin_amdgcn_exp2f(S[r] * sc2); ls += S[r]; }
        l0 += ls;
        const bf16x8 p0 = pack_p(S, 0), p1 = pack_p(S, 1);
        const bf16* vp = V1 + (size_t)(kbase + kt + 4 * hh) * 1024 + h * 128 + r32;
#pragma unroll
        for (int d = 0; d < 4; ++d) { const bf16x8 v0 = load_vfrag(vp + d * 32, 1024, 0), v1 = load_vfrag(vp + d * 32, 1024, 1);
            O[d] = __builtin_amdgcn_mfma_f32_32x32x16_bf16(p0, v0, O[d], 0, 0, 0);
            O[d] = __builtin_amdgcn_mfma_f32_32x32x16_bf16(p1, v1, O[d], 0, 0, 0); }
    }
    l0 += __shfl_xor(l0, 32);
#pragma unroll
    for (int r = 0; r < 16; ++r) { const int qi = crow(r, hh); const float i0 = 1.0f / __shfl(l0, qi);
        bf16* op = F.H_() + (size_t)(q0 + wid * 32 + qi) * D + h * 128 + r32;
#pragma unroll
        for (int d = 0; d < 4; ++d) op[d * 32] = (bf16)f2bf(O[d][r] * i0); }
}

__device__ __forceinline__ void hgrn_unit_v0(Frame& F, int a) {
    const int dvq = a & 3, dir = (a >> 2) & 1, h = (a >> 3) & 3, b = a >> 5;
    const bf16* Hq = (const bf16*)(F.big_() + B_HQ); const f16* Lf = (const f16*)(F.big_() + (dir ? B_LF1 : B_LF0)); const bf16* Hv = (const bf16*)(F.big_() + B_HV);
    bf16* Ho = (bf16*)(F.big_() + (dir ? B_HO1 : B_HO0));
    LAS float* lq = (LAS float*)F.lds;
    LAS float* lf = lq + 2048;
    LAS float* lk = lf + 2048;
    LAS float* lv = lk + 2048;
    LAS float* part = lv + 512;
    const int tid = F.tid, v = tid & 31, kg = tid >> 5;
    float S[8];
#pragma unroll
    for (int j = 0; j < 8; ++j) S[j] = 0.f;
    for (int ch = 0; ch < RPB / 16; ++ch) {
        for (int e = tid; e < 2048; e += NTHREADS) { const int tok = e >> 7, k = e & 127, n = ch * 16 + tok;
            const int s = dir ? (n < CTXL ? CTXL - 1 - n : RPB + CTXL - 1 - n) : n; const size_t R = (size_t)b * RPB + s;
            lq[e] = bf2f(Hq[R * 512 + h * 128 + k]) * 0.08838834764831845f;
            const float f = fexp((float)Lf[R * 512 + h * 128 + k]); lf[e] = f; lk[e] = 1.0f - f; }
        { const int tok = tid >> 5, n = ch * 16 + tok; const int s = dir ? (n < CTXL ? CTXL - 1 - n : RPB + CTXL - 1 - n) : n; const size_t R = (size_t)b * RPB + s;
            lv[tid] = bf2f(Hv[R * 512 + h * 128 + dvq * 32 + v]); }
        __syncthreads();
#pragma unroll 4
        for (int tok = 0; tok < 16; ++tok) {
            const f32x4 q0 = *(const LAS f32x4*)(lq + tok * 128 + kg * 8), q1 = *(const LAS f32x4*)(lq + tok * 128 + kg * 8 + 4);
            const f32x4 f0 = *(const LAS f32x4*)(lf + tok * 128 + kg * 8), f1 = *(const LAS f32x4*)(lf + tok * 128 + kg * 8 + 4);
            const f32x4 k0 = *(const LAS f32x4*)(lk + tok * 128 + kg * 8), k1 = *(const LAS f32x4*)(lk + tok * 128 + kg * 8 + 4);
            const float vv = lv[tok * 32 + v];
            float po = 0.f;
#pragma unroll
            for (int j = 0; j < 4; ++j) { S[j] = f0[j] * S[j] + k0[j] * vv; po += S[j] * q0[j]; S[4 + j] = f1[j] * S[4 + j] + k1[j] * vv; po += S[4 + j] * q1[j]; }
            part[(tok * 16 + kg) * 32 + v] = po;
        }
        __syncthreads();
        { const int tok = tid >> 5, n = ch * 16 + tok; const int s = dir ? (n < CTXL ? CTXL - 1 - n : RPB + CTXL - 1 - n) : n; const size_t R = (size_t)b * RPB + s;
            float o = 0.f;
#pragma unroll
            for (int g = 0; g < 16; ++g) o += part[(tok * 16 + g) * 32 + v];
            Ho[R * 512 + h * 128 + dvq * 32 + v] = (bf16)f2bf(o); }
        __syncthreads();
    }
}

constexpr int NPHASES = 20;
__global__ void __launch_bounds__(NTHREADS, 2) mk_fwd(Args args) {
    extern __shared__ __attribute__((aligned(16))) unsigned char lds[];
    Frame F;
    F.lds = (LAS unsigned char*)lds;
    F.tid = threadIdx.x; F.lane = F.tid & 63; F.wave = __builtin_amdgcn_readfirstlane(F.tid >> 6); F.G = gridDim.x; F.bid = blockIdx.x;
    F.ar = &args; F.out = args.out; F.ws = args.ws;

    volatile LAS unsigned* MISC = (volatile LAS unsigned*)(F.lds + LDS_MISC);
    for (int u = F.tid; u < 256; u += NTHREADS) MISC[u] = 0u;
    __syncthreads();
    XcdBarrier bar; bar.bar = (unsigned*)(F.ctl_() + CW_BAR); bar.x = 0; bar.st = nullptr;
    if (MK_N_LAUNCHES == 1) bar = xcd_barrier_post((unsigned*)(F.ctl_() + CW_BAR), MISC + 8);
    LAS float* xl = (LAS float*)(F.lds + LDS_XCH);

    const int lo = args.ph_lo, hi = args.ph_hi;
#ifdef DBG_ONLY
#define IN(k) ((k) == DBG_ONLY && lo <= (k) && (k) < hi)
#else
#define IN(k) (lo <= (k) && (k) < hi)
#endif
#define SEAM(k) do { if (IN(k) && IN((k) + 1)) xcd_barrier(bar); } while (0)

    if (IN(0)) { p0_prologue(F); } SEAM(0);
    if (IN(1)) { p_norm0(F); } SEAM(1);
    if (IN(2)) { Gemm g{F.H_(), F.Win0_(), 1024}; SchedGrid S{NT_ALL, 16, F.G, F.bid, false};
        EpiIn0 E{F.big_(), F.ar->in[I_DQG], F.ar->in[I_DKG], F.lbv_(), F.ropeR_(), F.ropeC_()}; run_gemm<0>(F.lds, g, S, E); } SEAM(2);
    if (IN(3)) { for (int a = F.bid; a < 256; a += F.G) hgrn_unit_v0(F, a);
        for (int a = F.bid; a < 288; a += F.G) diff_attn_unit_v0(F, a); } SEAM(3);
    if (IN(4)) { p_hgrn_post(F); } SEAM(4);
    if (IN(5)) { Gemm g{F.H_(), F.Wout0_(), 1024}; SchedGrid S{NT_ALL, 4, F.G, F.bid, false}; EpiOut E{&F, 0, true}; run_gemm<1>(F.lds, g, S, E); } SEAM(5);
    if (IN(6)) { p_norm_route(F, 0, false); } SEAM(6);
    if (IN(7)) { p_permute(F, 0, false);
        Gemm g{F.H_(), F.Wgu_() + (size_t)(0 * 17 + 16) * 1024 * 1024, 1024}; SchedGrid S{NT_ALL, 4, F.G, F.bid, false}; EpiGU E{(bf16*)(F.big_() + B_HS)}; run_gemm<2>(F.lds, g, S, E); } SEAM(7);
    if (IN(8)) { { SchedRouted S; load_expoff(F, 0, S.eo); S.G = F.G; S.c = F.bid; Gemm g{(const bf16*)(F.big_() + B_AP), F.Wgu_() + (size_t)(0 * 17) * 1024 * 1024, 1024}; EpiGU E{(bf16*)(F.big_() + B_HE)}; run_gemm<3>(F.lds, g, S, E); }
        { Gemm g{(const bf16*)(F.big_() + B_HS), F.Wd_() + (size_t)(0 * 17 + 16) * 1024 * 512, 512}; SchedGrid S{NT_ALL, 4, F.G, F.bid, false}; EpiDownS E{&F, 0}; run_gemm<4>(F.lds, g, S, E); } } SEAM(8);
    if (IN(9)) { SchedRouted S; load_expoff(F, 0, S.eo); S.G = F.G; S.c = F.bid; Gemm g{(const bf16*)(F.big_() + B_HE), F.Wd_() + (size_t)(0 * 17) * 1024 * 512, 512}; EpiDownR E{(bf16*)(F.big_() + B_YE)}; run_gemm<5>(F.lds, g, S, E); } SEAM(9);
    if (IN(10)) { p_combine(F, 0, false, true); } SEAM(10);
    if (IN(11)) { Gemm g{F.H_(), F.Win1_(), 1024}; SchedGrid S{NT_ALL, 3, F.G, F.bid, false}; EpiIn1 E{F.big_(), F.ssq_(), F.ar->in[I_KRG], F.ropeR_(), F.ropeC_()}; run_gemm<6>(F.lds, g, S, E); } SEAM(11);
    if (IN(12)) { { Gemm g{(const bf16*)(F.big_() + B_CQ), F.Wuq_(), 384}; SchedGrid S{NT_LAT, 6, F.G, F.bid, true};
            EpiUq E{(bf16*)(F.big_() + B_Q1), F.ssq_(), F.ar->in[I_QNG], F.ar->in[I_QRG], F.ropeR_(), F.ropeC_(), xl}; run_gemm<7>(F.lds, g, S, E); }
        { Gemm g{(const bf16*)(F.big_() + B_CKV), F.Wukv_(), 256}; SchedGrid S{NT_ALL, 8, F.G, F.bid, false};
            EpiUkv E{(bf16*)(F.big_() + B_KN), (bf16*)(F.big_() + B_V1), F.ssq_(), F.ar->in[I_KNG], xl}; run_gemm<8>(F.lds, g, S, E); } } SEAM(12);
    if (IN(13)) { for (int a = F.bid; a < 512; a += F.G) mla_attn_unit_v0(F, a); } SEAM(13);
    if (IN(14)) { Gemm g{F.H_(), F.Wout1_(), 1024}; SchedGrid S{NT_LAT, 4, F.G, F.bid, true}; EpiOut E{&F, 1, false}; run_gemm<9>(F.lds, g, S, E); } SEAM(14);
    if (IN(15)) { p_norm_route(F, 1, true); } SEAM(15);
    if (IN(16)) { p_permute(F, 1, true);
        Gemm g{F.H_(), F.Wgu_() + (size_t)(1 * 17 + 16) * 1024 * 1024, 1024}; SchedGrid S{NT_LAT, 4, F.G, F.bid, true}; EpiGU E{(bf16*)(F.big_() + B_HS)}; run_gemm<10>(F.lds, g, S, E); } SEAM(16);
    if (IN(17)) { { SchedRouted S; load_expoff(F, 1, S.eo); S.G = F.G; S.c = F.bid; Gemm g{(const bf16*)(F.big_() + B_AP), F.Wgu_() + (size_t)(1 * 17) * 1024 * 1024, 1024}; EpiGU E{(bf16*)(F.big_() + B_HE)}; run_gemm<11>(F.lds, g, S, E); }
        { Gemm g{(const bf16*)(F.big_() + B_HS), F.Wd_() + (size_t)(1 * 17 + 16) * 1024 * 512, 512}; SchedGrid S{NT_LAT, 4, F.G, F.bid, true}; EpiDownS E{&F, 1}; run_gemm<12>(F.lds, g, S, E); } } SEAM(17);
    if (IN(18)) { SchedRouted S; load_expoff(F, 1, S.eo); S.G = F.G; S.c = F.bid; Gemm g{(const bf16*)(F.big_() + B_HE), F.Wd_() + (size_t)(1 * 17) * 1024 * 512, 512}; EpiDownR E{(bf16*)(F.big_() + B_YE)}; run_gemm<13>(F.lds, g, S, E); } SEAM(18);
    if (IN(19)) { p_combine(F, 1, true, false); }
#undef IN
#undef SEAM
}

extern "C" void kernel_launch(void* const* d_in, const int* in_sizes, int n_in, void* d_out, int out_size, void* d_ws, size_t ws_size, hipStream_t stream) {
    static int grid = 0;
    if (grid == 0) {
        if (n_in != 34 || in_sizes[0] != NB * SEQ * D || out_size != NB * SEQ * D || ws_size < WS_END) {
            fprintf(stderr, "kernel_launch: unexpected problem: n_in %d in0 %d out %d ws %zu (need %zu); nothing launched\n", n_in, n_in > 0 ? in_sizes[0] : -1, out_size, ws_size, (size_t)WS_END); grid = -1; return; }
        int dev = 0, cus = 0;
        if (hipGetDevice(&dev) != hipSuccess || hipDeviceGetAttribute(&cus, hipDeviceAttributeMultiprocessorCount, dev) != hipSuccess) { grid = -1; return; }
        if (hipFuncSetAttribute((const void*)mk_fwd, hipFuncAttributeMaxDynamicSharedMemorySize, LDS_BYTES) != hipSuccess) { fprintf(stderr, "kernel_launch: hipFuncSetAttribute failed\n"); grid = -1; return; }
        int per_cu = 0;
        if (hipOccupancyMaxActiveBlocksPerMultiprocessor(&per_cu, (const void*)mk_fwd, NTHREADS, LDS_BYTES) != hipSuccess || per_cu < 1) fprintf(stderr, "kernel_launch: note: occupancy query reports %d\n", per_cu);
        (void)hipGetLastError();
        grid = cus;
    }
    if (grid < 0) return;
    if (hipMemsetAsync((char*)d_ws + WS_CTL, 0, CTL_ZERO_BYTES, stream) != hipSuccess) { fprintf(stderr, "kernel_launch: memset failed\n"); return; }
    Args a{};
    for (int i = 0; i < 34; ++i) a.in[i] = (const float*)d_in[i];
    a.out = (float*)d_out; a.ws = (unsigned char*)d_ws;
    if (MK_N_LAUNCHES == 1) { a.ph_lo = 0; a.ph_hi = NPHASES; hipLaunchKernelGGL(mk_fwd, dim3(grid), dim3(NTHREADS), LDS_BYTES, stream, a); }
    else for (int p = 0; p < NPHASES; ++p) { a.ph_lo = p; a.ph_hi = p + 1; hipLaunchKernelGGL(mk_fwd, dim3(grid), dim3(NTHREADS), LDS_BYTES, stream, a); }
    const hipError_t le = hipPeekAtLastError();
    if (le != hipSuccess) fprintf(stderr, "kernel_launch: launch failed: %s\n", hipGetErrorName(le));
}
```

```cpp
#include <hip/hip_runtime.h>
#include <cstdio>
#include <cstdint>

#ifndef MK_N_LAUNCHES
#define MK_N_LAUNCHES 1
#endif

#define GAS __attribute__((address_space(1)))
#define LAS __attribute__((address_space(3)))
typedef unsigned short bf16;
typedef _Float16 f16;
typedef short bf16x8 __attribute__((ext_vector_type(8)));
typedef float f32x4 __attribute__((ext_vector_type(4)));
typedef float f32x2 __attribute__((ext_vector_type(2)));
typedef float f32x16 __attribute__((ext_vector_type(16)));
typedef unsigned v4u __attribute__((ext_vector_type(4)));
typedef unsigned v2u __attribute__((ext_vector_type(2)));
typedef GAS unsigned gu32;
#define RLX_AGENT __ATOMIC_RELAXED, __HIP_MEMORY_SCOPE_AGENT
#define LDS_WAIT() asm volatile("s_waitcnt lgkmcnt(0)" ::: "memory")
#define VM_WAIT() asm volatile("s_waitcnt vmcnt(0)" ::: "memory")
#define EPI_BAR() do { asm volatile("s_waitcnt lgkmcnt(0)" ::: "memory"); __builtin_amdgcn_s_barrier(); asm volatile("" ::: "memory"); } while (0)

constexpr int NB = 8, SEQ = 2048, CTXL = 256, RPB = 2304  , NR = NB * RPB  , D = 1024;
constexpr int NT_ALL = NR / 256  , NT_LAT = 64;
constexpr int NEXP = 16, FF = 512;
constexpr int MP_MAX = 41216;
constexpr float EPS = 1e-6f;
constexpr float LOG2E = 1.4426950408889634f;
constexpr int NWAVES = 8, NTHREADS = 512;

constexpr size_t MiB = 1u << 20;
constexpr size_t WS_CTL = 0, CTL_ZERO_BYTES = 1 * MiB;
constexpr int CW_TMO = 0, CW_CODE = 1, CW_BAR = 4096, CW_CNT = 8192;
constexpr size_t WS_SMALL = 1 * MiB;
constexpr size_t SM_MODV = 0;
constexpr size_t SM_ROPER = 448 * 1024;
constexpr size_t SM_ROPEC = 452 * 1024;
constexpr size_t SM_LBV = 460 * 1024;
constexpr size_t SM_LAM = 464 * 1024;
constexpr size_t SM_ROUTE_E = 512 * 1024;
constexpr size_t SM_ROUTE_W = 584 * 1024;
constexpr size_t SM_ROUTE_S = 728 * 1024;
constexpr size_t SM_POS = 872 * 1024;
constexpr size_t SM_ROWIDX = 1016 * 1024;
constexpr size_t SM_SSQ = 1280 * 1024;
static_assert(SM_ROUTE_E + (size_t)NR * 4 <= SM_ROUTE_W && SM_ROUTE_W + (size_t)NR * 8 <= SM_ROUTE_S && SM_ROUTE_S + (size_t)NR * 8 <= SM_POS && SM_POS + (size_t)NR * 8 <= SM_ROWIDX &&
              SM_ROWIDX + (size_t)MP_MAX * 4 <= SM_SSQ && SM_SSQ + (size_t)NR * 48 <= 3 * MiB, "small map");
constexpr size_t WS_WIN0 = 4 * MiB, WS_WOUT0 = 12 * MiB, WS_WIN1 = 14 * MiB, WS_WUQ = 16 * MiB, WS_WUKV = 18 * MiB, WS_WOUT1 = 19 * MiB;
constexpr size_t WS_WGU = 22 * MiB;
constexpr size_t WS_WD = 90 * MiB;
constexpr size_t WS_XC = 124 * MiB;
constexpr size_t WS_H = 132 * MiB;
constexpr size_t WS_BIG = 168 * MiB;
constexpr size_t WS_END = 348 * MiB;
constexpr size_t SZ18 = 18 * MiB;
constexpr size_t B_QD = 0, B_KD = SZ18, B_VD = 2 * SZ18, B_HQ = 3 * SZ18, B_LF0 = 4 * SZ18, B_LF1 = 5 * SZ18, B_HV = 6 * SZ18, B_HG = 7 * SZ18, B_HO0 = 8 * SZ18, B_HO1 = 9 * SZ18;
constexpr size_t B_HS = 0, B_HE = 18 * MiB, B_YE = 60 * MiB, B_AP = 60 * MiB;
static_assert(B_HE + (size_t)MP_MAX * 512 * 2 <= B_YE && B_YE + (size_t)MP_MAX * 1024 * 2 <= 180 * MiB, "moe map");
constexpr size_t B_CKV = 0, B_CQ = 9 * MiB, B_KR = 23 * MiB, B_Q1 = 26 * MiB, B_KN = 80 * MiB, B_V1 = 116 * MiB;

constexpr int LDS_BYTES = 155648;
constexpr int LDS_MISC = 131072;
constexpr int LDS_XCH = 132096;

__device__ __forceinline__ unsigned f2bf(float f) { unsigned u = __builtin_bit_cast(unsigned, f); return (u + 0x7fffu + ((u >> 16) & 1u)) >> 16; }
__device__ __forceinline__ unsigned pk2(float lo, float hi) { return f2bf(lo) | (f2bf(hi) << 16); }
__device__ __forceinline__ float bf2f(bf16 h) { return __builtin_bit_cast(float, (unsigned)h << 16); }
__device__ __forceinline__ float bflo(unsigned w) { return __builtin_bit_cast(float, w << 16); }
__device__ __forceinline__ float bfhi(unsigned w) { return __builtin_bit_cast(float, w & 0xffff0000u); }
__device__ __forceinline__ unsigned pkh2(float lo, float hi) { f16 a = (f16)lo, b = (f16)hi; return (unsigned)__builtin_bit_cast(unsigned short, a) | ((unsigned)__builtin_bit_cast(unsigned short, b) << 16); }
__device__ __forceinline__ float fexp(float x) { return __builtin_amdgcn_exp2f(x * LOG2E); }
__device__ __forceinline__ float sigmoidf_(float x) { return 1.0f / (1.0f + fexp(-x)); }
__device__ __forceinline__ float siluf_(float x) { return x / (1.0f + fexp(-x)); }
__device__ __forceinline__ float wave_sum(float v) {
#pragma unroll
    for (int o = 1; o < 64; o <<= 1) v += __shfl_xor(v, o);
    return v;
}
__host__ __device__ __forceinline__ int perm32(int rho) { const int n = rho >> 4, i = rho & 15; return 8 * (i >> 2) + 4 * n + (i & 3); }
__host__ __device__ __forceinline__ int ddmap(int j) { return 16 * ((j >> 2) & 1) + 4 * (j >> 3) + (j & 3); }
__device__ __forceinline__ int opaque(int x) { asm volatile("" : "+v"(x)); return x; }
__device__ __forceinline__ int crow(int r, int hi) { return (r & 3) + 8 * (r >> 2) + 4 * hi; }

#define XB_TMO      128
#define XB_XCNT(j)  (256  + 64 * (j))
#define XB_XSUB(j)  (1280 + 64 * (j))
#define XB_XGEN(j)  (2304 + 64 * (j))
#define XB_TOP      3328
#define XB_TOPGEN   3392
#define XCD_BAR_WORDS 3456
#define XB_SPIN_CAP (1u << 18)
__device__ __forceinline__ unsigned xb_ld(unsigned* p)              { return __hip_atomic_load(p, __ATOMIC_RELAXED, __HIP_MEMORY_SCOPE_AGENT); }
__device__ __forceinline__ unsigned xb_add(unsigned* p, unsigned v) { return __hip_atomic_fetch_add(p, v, __ATOMIC_RELAXED, __HIP_MEMORY_SCOPE_AGENT); }
__device__ __forceinline__ unsigned xb_xcc_id() { return (unsigned)__builtin_amdgcn_s_getreg((3 << 11) | 20) & 0xFu; }
#define XB_SPIN(cond, bar) do { unsigned _sp = 0; while (cond) { __builtin_amdgcn_s_sleep(1); \
    if ((++_sp & 255u) == 0u) { if (xb_ld(&(bar)[XB_TMO])) break; if (_sp > XB_SPIN_CAP) { atomicAdd(&(bar)[XB_TMO], 1u); break; } } } } while (0)
struct XcdBarrier { unsigned* bar; unsigned x; volatile LAS unsigned* st; };
__device__ __forceinline__ XcdBarrier xcd_barrier_post(unsigned* bar, volatile LAS unsigned* st) {
    XcdBarrier b; b.bar = bar; b.x = xb_xcc_id(); b.st = st;
    if (threadIdx.x == 0) (void)xb_add(&bar[XB_XCNT(b.x)], 1u);
    return b;
}
__device__ __forceinline__ void xcd_barrier_complete(unsigned* bar, unsigned x, unsigned& nloc, unsigned& nx) {
    const unsigned G = gridDim.x * gridDim.y * gridDim.z;
    unsigned sum, cnt, mine, sp = 0u;
    for (;;) {
        sum = 0u; cnt = 0u; mine = 0u;
#pragma unroll
        for (unsigned j = 0; j < 16; ++j) { const unsigned c = xb_ld(&bar[XB_XCNT(j)]); sum += c; cnt += (c > 0u) ? 1u : 0u; mine = (j == x) ? c : mine; }
        if (sum == G) break;
        __builtin_amdgcn_s_sleep(1);
        if ((++sp & 255u) == 0u) { if (xb_ld(&bar[XB_TMO])) break; if (sp > XB_SPIN_CAP) { atomicAdd(&bar[XB_TMO], 1u); break; } }
    }
    nloc = mine > 0u ? mine : 1u; nx = cnt > 0u ? cnt : 1u;
}
__device__ __forceinline__ void xcd_barrier(const XcdBarrier& b) {
    asm volatile("s_waitcnt vmcnt(0)" ::: "memory");
    __syncthreads();
    if (threadIdx.x == 0) {
        unsigned* bar = b.bar;
        __builtin_amdgcn_s_waitcnt(0);
        unsigned nloc = b.st[0], nx = b.st[1];
        if (nloc == 0u) { xcd_barrier_complete(bar, b.x, nloc, nx); b.st[0] = nloc; b.st[1] = nx; }
        const unsigned old = xb_add(&bar[XB_XSUB(b.x)], 1u);
        const unsigned gen = old / nloc;
        if (old + 1u == (gen + 1u) * nloc) {
            __builtin_amdgcn_fence(__ATOMIC_RELEASE, "agent");
            asm volatile("s_waitcnt vmcnt(0)" ::: "memory");
            const unsigned og = xb_add(&bar[XB_TOP], 1u);
            const unsigned tg = og / nx;
            if (og + 1u == (tg + 1u) * nx) xb_add(&bar[XB_TOPGEN], 1u);
            else XB_SPIN(xb_ld(&bar[XB_TOPGEN]) == tg, bar);
            __builtin_amdgcn_fence(__ATOMIC_ACQUIRE, "agent");
            xb_add(&bar[XB_XGEN(b.x)], 1u);
            asm volatile("s_waitcnt vmcnt(0)" ::: "memory");
        } else {
            XB_SPIN(xb_ld(&bar[XB_XGEN(b.x)]) == gen, bar);
            __builtin_amdgcn_fence(__ATOMIC_ACQUIRE, "agent");
            asm volatile("s_waitcnt vmcnt(0)" ::: "memory");
        }
    }
    __syncthreads();
}

struct Args { const float* in[34]; float* out; unsigned char* ws; int ph_lo, ph_hi; };

struct Frame {
    LAS unsigned char* lds;
    int tid, lane, wave, G, bid;
    const Args* ar;
    float* out; unsigned char* ws;
    __device__ __forceinline__ gu32* ctl_() const { return (gu32*)(ws + WS_CTL); }
    __device__ __forceinline__ float* modv_() const { return (float*)(ws + WS_SMALL + SM_MODV); }
    __device__ __forceinline__ f32x2* ropeR_() const { return (f32x2*)(ws + WS_SMALL + SM_ROPER); }
    __device__ __forceinline__ f32x2* ropeC_() const { return (f32x2*)(ws + WS_SMALL + SM_ROPEC); }
    __device__ __forceinline__ float* lbv_() const { return (float*)(ws + WS_SMALL + SM_LBV); }
    __device__ __forceinline__ float* lamv_() const { return (float*)(ws + WS_SMALL + SM_LAM); }
    __device__ __forceinline__ int* route_e_() const { return (int*)(ws + WS_SMALL + SM_ROUTE_E); }
    __device__ __forceinline__ float* route_w_() const { return (float*)(ws + WS_SMALL + SM_ROUTE_W); }
    __device__ __forceinline__ int* route_s_() const { return (int*)(ws + WS_SMALL + SM_ROUTE_S); }
    __device__ __forceinline__ int* pos_() const { return (int*)(ws + WS_SMALL + SM_POS); }
    __device__ __forceinline__ float* ssq_() const { return (float*)(ws + WS_SMALL + SM_SSQ); }
    __device__ __forceinline__ bf16* Win0_() const { return (bf16*)(ws + WS_WIN0); }
    __device__ __forceinline__ bf16* Wout0_() const { return (bf16*)(ws + WS_WOUT0); }
    __device__ __forceinline__ bf16* Win1_() const { return (bf16*)(ws + WS_WIN1); }
    __device__ __forceinline__ bf16* Wuq_() const { return (bf16*)(ws + WS_WUQ); }
    __device__ __forceinline__ bf16* Wukv_() const { return (bf16*)(ws + WS_WUKV); }
    __device__ __forceinline__ bf16* Wout1_() const { return (bf16*)(ws + WS_WOUT1); }
    __device__ __forceinline__ bf16* Wgu_() const { return (bf16*)(ws + WS_WGU); }
    __device__ __forceinline__ bf16* Wd_() const { return (bf16*)(ws + WS_WD); }
    __device__ __forceinline__ float* xc_() const { return (float*)(ws + WS_XC); }
    __device__ __forceinline__ bf16* H_() const { return (bf16*)(ws + WS_H); }
    __device__ __forceinline__ unsigned char* big_() const { return ws + WS_BIG; }
};
enum { I_X = 0, I_C, I_CTX, I_CCTX, I_MODW, I_MODB, I_NMIX, I_NFFN, I_EWIN, I_EWOUT, I_DQG, I_DKG, I_DLAM, I_DSUBLN, I_LBL, I_HOG, I_OWIN, I_QAG, I_KVAG, I_WUQ, I_WUKV,
       I_QNG, I_QRG, I_KNG, I_KRG, I_OWOUT, I_RW, I_RB, I_EG, I_EU, I_ED, I_SG, I_SU, I_SD };

__device__ __forceinline__ float* xrow_ptr(const Frame& F, int b, int s) { return s < CTXL ? F.xc_() + (size_t)(b * CTXL + s) * D : F.out + (size_t)(b * SEQ + s - CTXL) * D; }
__device__ __forceinline__ const float* xin_ptr(const Frame& F, int b, int s) { return s < CTXL ? F.ar->in[I_CTX] + (size_t)(b * CTXL + s) * D : F.ar->in[I_X] + (size_t)(b * SEQ + s - CTXL) * D; }

__device__ __forceinline__ void p0_transpose_item(const float* W, int ldn, int srccol0, bool perm, const float* kscale, bf16* WT  , int K, int k0, LAS float* scr, int lane) {
    if (srccol0 >= 0) {
#pragma unroll 8
        for (int i = 0; i < 32; ++i) { const int kk = 2 * i + (lane >> 5); float v = W[(size_t)(k0 + kk) * ldn + srccol0 + (lane & 31)]; if (kscale) v *= kscale[k0 + kk]; scr[kk * 33 + (lane & 31)] = v; }
    } else {
#pragma unroll 8
        for (int i = 0; i < 32; ++i) { const int kk = 2 * i + (lane >> 5); scr[kk * 33 + (lane & 31)] = 0.f; }
    }
    LDS_WAIT(); asm volatile("" ::: "memory");
    const int c = lane & 7;
#pragma unroll
    for (int j = 0; j < 4; ++j) { const int n = (lane >> 3) + 8 * j; const int sn = perm ? ddmap(n) : n; const LAS float* s = scr + (8 * c) * 33 + sn;
        v4u o; o.x = pk2(s[0 * 33], s[1 * 33]); o.y = pk2(s[2 * 33], s[3 * 33]); o.z = pk2(s[4 * 33], s[5 * 33]); o.w = pk2(s[6 * 33], s[7 * 33]);
        *(GAS v4u*)(WT + (size_t)n * K + k0 + 8 * c) = o; }
    LDS_WAIT(); asm volatile("" ::: "memory");
}

__device__ __forceinline__ void p0_convert_item(Frame& F, int it, LAS float* scr) {
    const int lane = F.lane;
    if (it < 2048) {
        const int kb = it >> 7, tb = it & 127, pn = tb >> 3, blk = tb & 7, bj = blk >> 2, wc = blk & 3;
        int sb; bool perm = false;
        if (pn < 4) { sb = pn * 8 + 2 * wc + bj; perm = true; } else sb = tb;
        p0_transpose_item(F.ar->in[I_EWIN], 4096, sb * 32, perm, nullptr, F.Win0_() + (size_t)tb * 32 * 1024, 1024, kb * 64, scr, lane); return; }
    it -= 2048;
    if (it < 512) { const int kb = it >> 5, tb = it & 31; p0_transpose_item(F.ar->in[I_EWOUT], 1024, tb * 32, false, nullptr, F.Wout0_() + (size_t)tb * 32 * 1024, 1024, kb * 64, scr, lane); return; }
    it -= 512;
    if (it < 384) {
        const int kb = it / 24, tb = it % 24; int sc; bool perm = false;
        if (tb < 8) sc = 384 + tb * 32;
        else if (tb < 16) sc = (tb - 8) * 32;
        else { const int blk = tb - 16, bj = blk >> 2, wc = blk & 3;
            if (bj == 0) { if (wc < 3) sc = 256 + wc * 32; else { sc = 640; perm = true; } }
            else { if (wc == 0) sc = 352; else if (wc == 3) { sc = 672; perm = true; } else sc = -1; } }
        p0_transpose_item(F.ar->in[I_OWIN], 704, sc, perm, nullptr, F.Win1_() + (size_t)tb * 32 * 1024, 1024, kb * 64, scr, lane); return; }
    it -= 384;
    if (it < 288) {
        const int kb = it / 48, tb = it % 48, t = tb >> 3, blk = tb & 7, bj = blk >> 2, wc = blk & 3; int sc; bool perm = false;
        if (t < 4) { const int h = 2 * t + bj; sc = h * 192 + 32 * wc; }
        else { const int h = 4 * (t - 4) + wc; sc = h * 192 + 128 + 32 * bj; perm = true; }
        p0_transpose_item(F.ar->in[I_WUQ], 1536, sc, perm, F.ar->in[I_QAG], F.Wuq_() + (size_t)tb * 32 * 384, 384, kb * 64, scr, lane); return; }
    it -= 288;
    if (it < 256) { const int kb = it >> 6, tb = it & 63; p0_transpose_item(F.ar->in[I_WUKV], 2048, tb * 32, false, F.ar->in[I_KVAG], F.Wukv_() + (size_t)tb * 32 * 256, 256, kb * 64, scr, lane); return; }
    it -= 256;
    if (it < 512) { const int kb = it >> 5, tb = it & 31; p0_transpose_item(F.ar->in[I_OWOUT], 1024, tb * 32, false, nullptr, F.Wout1_() + (size_t)tb * 32 * 1024, 1024, kb * 64, scr, lane); return; }
    it -= 512;
    {
        const int le = it / 768, r2 = it % 768, l = le / 17, e = le % 17;
        if (r2 < 512) { const int kb = r2 >> 5, tb = r2 & 31, pnl = tb >> 3, blk = tb & 7, bj = blk >> 2, wcb = blk & 3;
            const float* src = (e < 16) ? (bj ? F.ar->in[I_EU] : F.ar->in[I_EG]) + (size_t)(l * 16 + e) * 1024 * 512 : (bj ? F.ar->in[I_SU] : F.ar->in[I_SG]) + (size_t)l * 1024 * 512;
            p0_transpose_item(src, 512, (pnl * 4 + wcb) * 32, false, nullptr, F.Wgu_() + ((size_t)(l * 17 + e) * 1024 + tb * 32) * 1024, 1024, kb * 64, scr, lane); }
        else { const int r3 = r2 - 512, kb = r3 >> 5, tb = r3 & 31;
            const float* src = (e < 16) ? F.ar->in[I_ED] + (size_t)(l * 16 + e) * 512 * 1024 : F.ar->in[I_SD] + (size_t)l * 512 * 1024;
            p0_transpose_item(src, 1024, tb * 32, false, nullptr, F.Wd_() + ((size_t)(l * 17 + e) * 1024 + tb * 32) * 512, 512, kb * 64, scr, lane); }
    }
}
constexpr int P0_NITEMS = 2048 + 512 + 384 + 288 + 256 + 512 + 2 * 17 * 768;

__device__ __forceinline__ void p0_prologue(Frame& F) {
    LAS float* ldsf = (LAS float*)F.lds;
    for (int it = F.bid; it < 192; it += F.G) {
        const int l = it / 96, n0 = (it % 96) * 64;
        LAS float* sc = ldsf;
        LAS float* red = ldsf + 9 * 1024;
        for (int e = F.tid; e < 9 * 1024; e += NTHREADS) { const int r = e >> 10, k = e & 1023; const float v = (r < 8) ? F.ar->in[I_C][r * 1024 + k] : F.ar->in[I_CCTX][k]; sc[e] = siluf_(v); }
        __syncthreads();
        float a[9];
#pragma unroll
        for (int r = 0; r < 9; ++r) a[r] = 0.f;
        const float* w = F.ar->in[I_MODW] + (size_t)l * 1024 * 6144 + n0 + F.lane;
        const int kbeg = F.wave * 128;
#pragma unroll 4
        for (int k = kbeg; k < kbeg + 128; ++k) { const float wv = w[(size_t)k * 6144];
#pragma unroll
            for (int r = 0; r < 9; ++r) a[r] += sc[r * 1024 + k] * wv; }
#pragma unroll
        for (int r = 0; r < 9; ++r) red[(F.wave * 9 + r) * 64 + F.lane] = a[r];
        __syncthreads();
        for (int e = F.tid; e < 9 * 64; e += NTHREADS) { const int r = e >> 6, c = e & 63; float s = 0.f;
#pragma unroll
            for (int w8 = 0; w8 < 8; ++w8) s += red[(w8 * 9 + r) * 64 + c];
            F.modv_()[(size_t)(l * 9 + r) * 6144 + n0 + c] = s + F.ar->in[I_MODB][l * 6144 + n0 + c]; }
        __syncthreads();
    }
    if (F.bid == F.G - 1) {
        for (int e = F.tid; e < 96 * 16; e += NTHREADS) { const int p = e >> 4, i = e & 15;
            const float inv = __builtin_amdgcn_exp2f(-(float)(2 * i) * (1.0f / 32.0f) * 13.287712379549449f);
            const float pos = (p < 32) ? (float)p : (float)(p - 32); const float ang = pos * inv;
            const f32x2 cs = {__cosf(ang), __sinf(ang)};
            if (p < 32) F.ropeR_()[p * 16 + i] = cs; else F.ropeC_()[(p - 32) * 16 + i] = cs; }
        for (int e = F.tid; e < 1024; e += NTHREADS) { const float l0 = F.ar->in[I_LBL][e], l1 = F.ar->in[I_LBL][1024 + e]; F.lbv_()[e] = 1.0f / (1.0f + fexp(l1 - l0)); }
        if (F.wave == 0) { const float* lv = F.ar->in[I_DLAM]; float s1 = wave_sum(lv[F.lane] * lv[64 + F.lane]), s2 = wave_sum(lv[128 + F.lane] * lv[192 + F.lane]);
            if (F.lane == 0) { F.lamv_()[0] = fexp(s1) - fexp(s2) + 0.2f; } }
    }
    __syncthreads();
    LAS float* scr = (LAS float*)(F.lds + F.wave * 8704);
    const int gw = F.bid * NWAVES + F.wave, NGW = F.G * NWAVES;
    for (int it = gw; it < P0_NITEMS; it += NGW) p0_convert_item(F, it, scr);
}

__device__ __forceinline__ void modnorm_store(const f32x4 (&v)[4], const float* gain, const float* sh, const float* sc, bf16* orow, int lane) {
    float s = 0.f;
#pragma unroll
    for (int j = 0; j < 4; ++j) s += (v[j].x * v[j].x + v[j].y * v[j].y) + (v[j].z * v[j].z + v[j].w * v[j].w);
    const float rstd = 1.0f / sqrtf(wave_sum(s) * (1.0f / D) + EPS);
#pragma unroll
    for (int j = 0; j < 4; ++j) { const int c = 4 * (lane + 64 * j);
        const f32x4 g = *(const f32x4*)(gain + c), a = *(const f32x4*)(sc + c), b = *(const f32x4*)(sh + c);
        const f32x4 y = (v[j] * rstd) * g * (1.0f + a) + b;
        v2u o; o.x = pk2(y.x, y.y); o.y = pk2(y.z, y.w); *(v2u*)(orow + c) = o; }
}

__device__ __forceinline__ void p_norm0(Frame& F) {
    const int gw = F.bid * NWAVES + F.wave, NGW = F.G * NWAVES;
    for (int R = gw; R < NR; R += NGW) {
        const int b = R / RPB, s = R - b * RPB, r = s < CTXL ? 8 : b;
        const f32x4* src = (const f32x4*)xin_ptr(F, b, s) + F.lane;
        f32x4 v[4];
#pragma unroll
        for (int j = 0; j < 4; ++j) v[j] = src[64 * j];
        const float* mv = F.modv_() + (size_t)(0 * 9 + r) * 6144;
        modnorm_store(v, F.ar->in[I_NMIX], mv + 0, mv + 1024, F.H_() + (size_t)R * D, F.lane);
    }
}

__device__ __forceinline__ void p_hgrn_post(Frame& F) {
    const int gw = F.bid * NWAVES + F.wave, NGW = F.G * NWAVES;
    const bf16* Ho0 = (const bf16*)(F.big_() + B_HO0); const bf16* Ho1 = (const bf16*)(F.big_() + B_HO1); const bf16* Hg = (const bf16*)(F.big_() + B_HG);
    for (int R = gw; R < NR; R += NGW) {
        const int c = F.lane * 8;
        const v4u a = *(const v4u*)(Ho0 + (size_t)R * 512 + c), bq = *(const v4u*)(Ho1 + (size_t)R * 512 + c), g = *(const v4u*)(Hg + (size_t)R * 512 + c);
        float o[8];
        o[0] = bflo(a.x) + bflo(bq.x); o[1] = bfhi(a.x) + bfhi(bq.x); o[2] = bflo(a.y) + bflo(bq.y); o[3] = bfhi(a.y) + bfhi(bq.y);
        o[4] = bflo(a.z) + bflo(bq.z); o[5] = bfhi(a.z) + bfhi(bq.z); o[6] = bflo(a.w) + bflo(bq.w); o[7] = bfhi(a.w) + bfhi(bq.w);
        float s = 0.f;
#pragma unroll
        for (int i = 0; i < 8; ++i) s += o[i] * o[i];
        s += __shfl_xor(s, 1); s += __shfl_xor(s, 2); s += __shfl_xor(s, 4); s += __shfl_xor(s, 8);
        const float rstd = 1.0f / sqrtf(s * (1.0f / 128.0f) + EPS);
        const float* og = F.ar->in[I_HOG] + (c & 127);
        const float gg[8] = {bflo(g.x), bfhi(g.x), bflo(g.y), bfhi(g.y), bflo(g.z), bfhi(g.z), bflo(g.w), bfhi(g.w)};
        float y[8];
#pragma unroll
        for (int i = 0; i < 8; ++i) y[i] = o[i] * rstd * og[i] * gg[i];
        v4u w; w.x = pk2(y[0], y[1]); w.y = pk2(y[2], y[3]); w.z = pk2(y[4], y[5]); w.w = pk2(y[6], y[7]);
        *(v4u*)(F.H_() + (size_t)R * D + 512 + c) = w;
    }
}

__device__ __forceinline__ void p_norm_route(Frame& F, int layer, bool lat_only) {
    const int gw = F.bid * NWAVES + F.wave, NGW = F.G * NWAVES;
    const float* rw = F.ar->in[I_RW];
    unsigned* cnt = (unsigned*)(F.ctl_() + CW_CNT + 64 * layer);
    for (int R = gw; R < NR; R += NGW) {
        const int b = R / RPB, s = R - b * RPB, r = s < CTXL ? 8 : b;
        if (lat_only && s < CTXL) continue;
        const f32x4* src = (const f32x4*)xrow_ptr(F, b, s) + F.lane;
        f32x4 v[4];
#pragma unroll
        for (int j = 0; j < 4; ++j) v[j] = src[64 * j];
        const float* mv = F.modv_() + (size_t)(layer * 9 + r) * 6144;
        const float* gain = F.ar->in[I_NFFN] + layer * 1024; const float* sh = mv + 3072; const float* sc = mv + 4096;
        float ss = 0.f;
#pragma unroll
        for (int j = 0; j < 4; ++j) ss += (v[j].x * v[j].x + v[j].y * v[j].y) + (v[j].z * v[j].z + v[j].w * v[j].w);
        const float rstd = 1.0f / sqrtf(wave_sum(ss) * (1.0f / D) + EPS);
        float lg[16];
#pragma unroll
        for (int e = 0; e < 16; ++e) lg[e] = 0.f;
#pragma unroll
        for (int j = 0; j < 4; ++j) { const int c = 4 * (F.lane + 64 * j);
            const f32x4 g = *(const f32x4*)(gain + c), a = *(const f32x4*)(sc + c), bb = *(const f32x4*)(sh + c);
            const f32x4 y = (v[j] * rstd) * g * (1.0f + a) + bb;
            v2u o; o.x = pk2(y.x, y.y); o.y = pk2(y.z, y.w); *(v2u*)(F.H_() + (size_t)R * D + c) = o;
#pragma unroll
            for (int q = 0; q < 4; ++q) { const float yv = y[q]; const f32x4* wr = (const f32x4*)(rw + (size_t)(c + q) * 16);
                const f32x4 w0 = wr[0], w1 = wr[1], w2 = wr[2], w3 = wr[3];
                lg[0] += yv * w0.x; lg[1] += yv * w0.y; lg[2] += yv * w0.z; lg[3] += yv * w0.w;
                lg[4] += yv * w1.x; lg[5] += yv * w1.y; lg[6] += yv * w1.z; lg[7] += yv * w1.w;
                lg[8] += yv * w2.x; lg[9] += yv * w2.y; lg[10] += yv * w2.z; lg[11] += yv * w2.w;
                lg[12] += yv * w3.x; lg[13] += yv * w3.y; lg[14] += yv * w3.z; lg[15] += yv * w3.w; } }
#pragma unroll
        for (int e = 0; e < 16; ++e) lg[e] = wave_sum(lg[e]);
        float scv[16], bi[16];
#pragma unroll
        for (int e = 0; e < 16; ++e) { scv[e] = sigmoidf_(lg[e]); bi[e] = scv[e] + F.ar->in[I_RB][e]; }
        float bestgs = -3.0e38f; int e1 = 0, e2 = 1; float w1 = 0.f, w2 = 0.f;
#pragma unroll
        for (int g = 0; g < 4; ++g) {
            const float x0 = bi[4 * g], x1 = bi[4 * g + 1], x2 = bi[4 * g + 2], x3 = bi[4 * g + 3];
            const float gs = fmaxf(fmaxf(fmaxf(x0 + x1, x0 + x2), fmaxf(x0 + x3, x1 + x2)), fmaxf(x1 + x3, x2 + x3));
            int i1 = 0; float m1 = x0;
            if (x1 > m1) { m1 = x1; i1 = 1; } if (x2 > m1) { m1 = x2; i1 = 2; } if (x3 > m1) { m1 = x3; i1 = 3; }
            int i2 = -1; float m2 = -3.0e38f;
            if (i1 != 0 && x0 > m2) { m2 = x0; i2 = 0; } if (i1 != 1 && x1 > m2) { m2 = x1; i2 = 1; } if (i1 != 2 && x2 > m2) { m2 = x2; i2 = 2; } if (i1 != 3 && x3 > m2) { m2 = x3; i2 = 3; }
            const float s0 = scv[4 * g], s1 = scv[4 * g + 1], s2 = scv[4 * g + 2], s3 = scv[4 * g + 3];
            const float wa = i1 == 0 ? s0 : i1 == 1 ? s1 : i1 == 2 ? s2 : s3;
            const float wb = i2 == 0 ? s0 : i2 == 1 ? s1 : i2 == 2 ? s2 : s3;
            if (gs > bestgs) { bestgs = gs; e1 = 4 * g + i1; e2 = 4 * g + i2; w1 = wa; w2 = wb; }
        }
        const float wn = 1.0f / (w1 + w2); w1 *= wn; w2 *= wn;
        if (F.lane == 0) {
            const unsigned s1 = __hip_atomic_fetch_add(cnt + e1, 1u, RLX_AGENT), s2 = __hip_atomic_fetch_add(cnt + e2, 1u, RLX_AGENT);
            F.route_e_()[R] = e1 | (e2 << 8); F.route_w_()[2 * R] = w1; F.route_w_()[2 * R + 1] = w2; F.route_s_()[2 * R] = (int)s1; F.route_s_()[2 * R + 1] = (int)s2;
        }
    }
}

struct ExpOff { int off[17]; };
__device__ __forceinline__ void load_expoff(Frame& F, int layer, ExpOff& eo) {
    const unsigned* cnt = (const unsigned*)(F.ctl_() + CW_CNT + 64 * layer); int a = 0;
#pragma unroll
    for (int e = 0; e < 16; ++e) { eo.off[e] = a; const int c = __builtin_amdgcn_readfirstlane((int)__hip_atomic_load(cnt + e, RLX_AGENT)); a += (c + 255) & ~255; }
    eo.off[16] = a;
}
__device__ __forceinline__ int expoff_sel(const ExpOff& eo, int e) { int r = 0;
#pragma unroll
    for (int i = 0; i < 16; ++i) r = (e == i) ? eo.off[i] : r;
    return r; }

__device__ __forceinline__ void p_permute(Frame& F, int layer, bool lat_only) {
    ExpOff eo; load_expoff(F, layer, eo);
    const int gw = F.bid * NWAVES + F.wave, NGW = F.G * NWAVES;
    bf16* AP = (bf16*)(F.big_() + B_AP);
    for (int R = gw; R < NR; R += NGW) {
        const int s = R % RPB; if (lat_only && s < CTXL) continue;
        const int ee = F.route_e_()[R], e1 = ee & 255, e2 = ee >> 8;
        const int p1 = expoff_sel(eo, e1) + F.route_s_()[2 * R], p2 = expoff_sel(eo, e2) + F.route_s_()[2 * R + 1];
        if (F.lane == 0) { F.pos_()[2 * R] = p1; F.pos_()[2 * R + 1] = p2; }
        const v4u* src = (const v4u*)(F.H_() + (size_t)R * D) + F.lane;
        const v4u a0 = src[0], a1 = src[64];
        v4u* d1 = (v4u*)(AP + (size_t)p1 * D) + F.lane; v4u* d2 = (v4u*)(AP + (size_t)p2 * D) + F.lane;
        d1[0] = a0; d1[64] = a1; d2[0] = a0; d2[64] = a1;
    }
}

__device__ __forceinline__ void p_combine(Frame& F, int layer, bool lat_only, bool do_norm) {
    const int gw = F.bid * NWAVES + F.wave, NGW = F.G * NWAVES;
    const bf16* Ye = (const bf16*)(F.big_() + B_YE);
    for (int R = gw; R < NR; R += NGW) {
        const int b = R / RPB, s = R - b * RPB, r = s < CTXL ? 8 : b;
        if (lat_only && s < CTXL) continue;
        float* xr = xrow_ptr(F, b, s);
        const float* gf = F.modv_() + (size_t)(layer * 9 + r) * 6144 + 5120;
        const int p1 = F.pos_()[2 * R], p2 = F.pos_()[2 * R + 1]; const float w1 = F.route_w_()[2 * R], w2 = F.route_w_()[2 * R + 1];
        f32x4 v[4];
#pragma unroll
        for (int j = 0; j < 4; ++j) { const int c = 4 * (F.lane + 64 * j);
            const f32x4 x = *(const f32x4*)(xr + c), g = *(const f32x4*)(gf + c);
            const v2u a = *(const v2u*)(Ye + (size_t)p1 * D + c), bq = *(const v2u*)(Ye + (size_t)p2 * D + c);
            f32x4 m; m.x = w1 * bflo(a.x) + w2 * bflo(bq.x); m.y = w1 * bfhi(a.x) + w2 * bfhi(bq.x); m.z = w1 * bflo(a.y) + w2 * bflo(bq.y); m.w = w1 * bfhi(a.y) + w2 * bfhi(bq.y);
            v[j] = x + g * m; *(f32x4*)(xr + c) = v[j]; }
        if (do_norm) { const float* mv = F.modv_() + (size_t)((layer + 1) * 9 + r) * 6144;
            modnorm_store(v, F.ar->in[I_NMIX] + (layer + 1) * 1024, mv + 0, mv + 1024, F.H_() + (size_t)R * D, F.lane); }
    }
}

struct Unit { int pm, pn; };
struct Gemm { const bf16* A; const bf16* Bt; int K; };
template <class Epi, class Sched>
__device__ __forceinline__ void gemm_v0(const Gemm g, const Sched& S, const Epi& E) {
    const int tid = opaque((int)threadIdx.x), wid = __builtin_amdgcn_readfirstlane(tid >> 6), lane = tid & 63, wr = wid >> 2, wc = wid & 3, fr = lane & 15, fq = lane >> 4;
    const int K = g.K;
    Unit u;
    for (int i = 0; S.next(i, u); ++i) {
        f32x4 acc[2][2][4][2];
#pragma unroll
        for (int a = 0; a < 2; ++a)
#pragma unroll
            for (int b = 0; b < 2; ++b)
#pragma unroll
                for (int m = 0; m < 4; ++m)
#pragma unroll
                    for (int n = 0; n < 2; ++n) acc[a][b][m][n] = (f32x4){0.f, 0.f, 0.f, 0.f};
        unsigned aoff[2][4], boff[2][2];
#pragma unroll
        for (int ai = 0; ai < 2; ++ai)
#pragma unroll
            for (int m = 0; m < 4; ++m) { const int rr = u.pm * 256 + ai * 128 + wr * 64 + m * 16 + fr; const int arow = rr; aoff[ai][m] = (unsigned)arow * (unsigned)K * 2u + fq * 16u; }
#pragma unroll
        for (int bj = 0; bj < 2; ++bj)
#pragma unroll
            for (int n = 0; n < 2; ++n) { const int rho = 16 * n + fr; const int brow = u.pn * 256 + bj * 128 + wc * 32 + (Epi::PERM ? perm32(rho) : rho); boff[bj][n] = (unsigned)brow * (unsigned)K * 2u + fq * 16u; }
        const char* Ab = (const char*)g.A; const char* Bb = (const char*)g.Bt;
        for (int kt = 0; kt < K; kt += 32) {
            bf16x8 b[2][2];
#pragma unroll
            for (int bj = 0; bj < 2; ++bj)
#pragma unroll
                for (int n = 0; n < 2; ++n) b[bj][n] = *(const bf16x8*)(Bb + boff[bj][n] + kt * 2);
#pragma unroll
            for (int ai = 0; ai < 2; ++ai) {
                bf16x8 a[4];
#pragma unroll
                for (int m = 0; m < 4; ++m) a[m] = *(const bf16x8*)(Ab + aoff[ai][m] + kt * 2);
#pragma unroll
                for (int bj = 0; bj < 2; ++bj)
#pragma unroll
                    for (int m = 0; m < 4; ++m)
#pragma unroll
                        for (int n = 0; n < 2; ++n) acc[ai][bj][m][n] = __builtin_amdgcn_mfma_f32_16x16x32_bf16(b[bj][n], a[m], acc[ai][bj][m][n], 0, 0, 0);
                asm volatile("" ::: "memory");
            }
        }
        E(acc, u, wr, wc, fr, fq);
    }
}


constexpr int BM = 256, BK = 64, HALF = 128, HTB = HALF * BK * 2, STAGE_BYTES = 8 * HTB, NXCD = 8, WGM = 8;
__host__ __device__ __forceinline__ int lds_byte(int r, int c) { const int st = (r >> 4) * 2 + (c >> 5), rr = r & 15, cc = c & 31, ob = rr * 64 + cc * 2; return st * 1024 + (ob ^ (((ob >> 9) & 1) << 5)); }
__host__ __device__ __forceinline__ void stage_rc(int b, int& R, int& C) { const int st = b / 1024, sb = b % 1024, swz = sb ^ (((sb >> 9) & 1) << 5); R = (st >> 1) * 16 + swz / 64; C = (st & 1) * 32 + (swz % 64) / 2; }
template <class Epi, class Sched, bool ALIGN_EPI = false, bool SP2 = false>
__device__ __forceinline__ void gemm_phase(LAS unsigned char* lds, const Gemm g, const Sched& S, const Epi& E) {
    const int tid = opaque((int)threadIdx.x), wid = __builtin_amdgcn_readfirstlane(tid >> 6), lane = tid & 63, wr = wid >> 2, wc = wid & 3, fr = lane & 15, fq = lane >> 4;
    const int K = g.K, nt = K / BK;
    unsigned voffA[2], voffB[2];
#pragma unroll
    for (int i = 0; i < 2; ++i) { int R, C; stage_rc(tid * 16 + i * 8192, R, C); const int Rb = Epi::PERM ? ((R & ~31) + perm32(R & 31)) : R;
        voffA[i] = (unsigned)(R * K + C) * 2u; voffB[i] = (unsigned)(Rb * K + C) * 2u; }
    const size_t kstep = (size_t)(BK * 2);
    const size_t hstep = (size_t)HALF * K * 2;
    const size_t tstep = 2 * hstep;
    const unsigned ldsw = (unsigned)wid * 1024u;
    const int aoff = lds_byte(wr * 64 + fr, fq * 8), boff = lds_byte(wc * 32 + fr, fq * 8);
#define PG8_SA(b, h) (((b) * 2 + (h)) * HTB)
#define PG8_SB(b, h) ((4 + (b) * 2 + (h)) * HTB)
#define PG8_STAGE(bufoff, gbase, voff) do { _Pragma("unroll") for (int _i = 0; _i < 2; ++_i) \
        __builtin_amdgcn_global_load_lds((const unsigned*)((const char*)(gbase) + (voff)[_i]), (LAS unsigned*)(lds + (bufoff) + ldsw + _i * 8192), 16, 0, 0); } while (0)
#define PG8_LDA(dst, b, h) do { _Pragma("unroll") for (int m = 0; m < 4; ++m) _Pragma("unroll") for (int k = 0; k < 2; ++k) dst[m][k] = *(const LAS bf16x8*)(lds + PG8_SA(b, h) + aoff + m * 2048 + k * 1024); } while (0)
#define PG8_LDB(dst, b, h) do { _Pragma("unroll") for (int n = 0; n < 2; ++n) _Pragma("unroll") for (int k = 0; k < 2; ++k) dst[n][k] = *(const LAS bf16x8*)(lds + PG8_SB(b, h) + boff + n * 2048 + k * 1024); } while (0)
#define PG8_MMA(ai, bj, At, Bt) do { __builtin_amdgcn_s_setprio(1); _Pragma("unroll") for (int m = 0; m < 4; ++m) _Pragma("unroll") for (int n = 0; n < 2; ++n) _Pragma("unroll") for (int k = 0; k < 2; ++k) \
        acc[ai][bj][m][n] = __builtin_amdgcn_mfma_f32_16x16x32_bf16(Bt[n][k], At[m][k], acc[ai][bj][m][n], 0, 0, 0); __builtin_amdgcn_s_setprio(0); } while (0)
#define PG8_WAIT_V(n) asm volatile("s_waitcnt vmcnt(" #n ")" ::: "memory")
#define PG8_WAIT_L(n) asm volatile("s_waitcnt lgkmcnt(" #n ")" ::: "memory")
#define PG8_BAR __builtin_amdgcn_s_barrier()
#define PG8_SCHED __builtin_amdgcn_sched_barrier(0)
    Unit cur, nxt; int ui = 0;
    if (!S.next(0, cur)) return;
    f32x4 acc[2][2][4][2];
#pragma unroll
    for (int a = 0; a < 2; ++a)
#pragma unroll
        for (int b = 0; b < 2; ++b)
#pragma unroll
            for (int m = 0; m < 4; ++m)
#pragma unroll
                for (int n = 0; n < 2; ++n) acc[a][b][m][n] = (f32x4){0.f, 0.f, 0.f, 0.f};
    bf16x8 At[4][2], B0[2][2], B1[2][2];
    const char* cA = (const char*)g.A + (size_t)cur.pm * tstep; const char* cB = (const char*)g.Bt + (size_t)cur.pn * tstep;
    S.a_ready(cur);
    if constexpr (SP2) {
        PG8_STAGE(PG8_SB(0, 0), cB, voffB); PG8_STAGE(PG8_SB(0, 1), cB + hstep, voffB); PG8_STAGE(PG8_SA(0, 0), cA, voffA); PG8_STAGE(PG8_SA(0, 1), cA + hstep, voffA);
        if (wr == 1) PG8_BAR;
        PG8_WAIT_V(2); PG8_BAR;
        PG8_STAGE(PG8_SB(1, 0), cB + kstep, voffB); PG8_STAGE(PG8_SA(1, 0), cA + kstep, voffA); PG8_STAGE(PG8_SB(1, 1), cB + hstep + kstep, voffB);
        PG8_WAIT_V(6); PG8_BAR;
    } else {
        PG8_STAGE(PG8_SB(0, 0), cB, voffB); PG8_STAGE(PG8_SA(0, 0), cA, voffA); PG8_STAGE(PG8_SB(0, 1), cB + hstep, voffB); PG8_STAGE(PG8_SA(0, 1), cA + hstep, voffA);
        if (wr == 1) PG8_BAR;
        PG8_WAIT_V(4); PG8_BAR;
        PG8_STAGE(PG8_SB(1, 0), cB + kstep, voffB); PG8_STAGE(PG8_SA(1, 0), cA + kstep, voffA); PG8_STAGE(PG8_SB(1, 1), cB + hstep + kstep, voffB);
        PG8_WAIT_V(6); PG8_BAR;
    }
    for (;;) {
        const bool has_next = S.next(ui + 1, nxt);
        const char* nA = has_next ? (const char*)g.A + (size_t)nxt.pm * tstep : cA; const char* nB = has_next ? (const char*)g.Bt + (size_t)nxt.pn * tstep : cB;
#pragma unroll 1
        for (int t = 0; t < nt; t += 2) {
            const bool last = (t == nt - 2);
            const char* a1 = cA + (size_t)(t + 1) * kstep;
            const char* a2 = last ? nA : cA + (size_t)(t + 2) * kstep; const char* b2 = last ? nB : cB + (size_t)(t + 2) * kstep;
            const char* a3 = a2 + kstep; const char* b3 = b2 + kstep;
            if (last && has_next) S.a_ready(nxt);
            if constexpr (SP2) {
            PG8_LDB(B0, 0, 0); PG8_LDB(B1, 0, 1); PG8_SCHED; PG8_LDA(At, 0, 0); PG8_STAGE(PG8_SA(1, 1), a1 + hstep, voffA);
            PG8_WAIT_V(8); PG8_WAIT_L(0); PG8_BAR; PG8_MMA(0, 0, At, B0); PG8_MMA(0, 1, At, B1); PG8_BAR; PG8_SCHED;
            PG8_LDA(At, 0, 1); PG8_STAGE(PG8_SB(0, 0), b2, voffB); PG8_STAGE(PG8_SB(0, 1), b2 + hstep, voffB); PG8_STAGE(PG8_SA(0, 0), a2, voffA);
            PG8_WAIT_V(8); PG8_WAIT_L(0); PG8_BAR; PG8_MMA(1, 0, At, B0); PG8_MMA(1, 1, At, B1); PG8_BAR; PG8_SCHED;
            PG8_LDB(B0, 1, 0); PG8_LDB(B1, 1, 1); PG8_SCHED; PG8_LDA(At, 1, 0); PG8_STAGE(PG8_SA(0, 1), a2 + hstep, voffA);
            PG8_WAIT_V(8); PG8_WAIT_L(0); PG8_BAR; PG8_MMA(0, 0, At, B0); PG8_MMA(0, 1, At, B1); PG8_BAR; PG8_SCHED;
            PG8_LDA(At, 1, 1); PG8_STAGE(PG8_SB(1, 0), b3, voffB); PG8_STAGE(PG8_SB(1, 1), b3 + hstep, voffB); PG8_STAGE(PG8_SA(1, 0), a3, voffA);
            PG8_WAIT_V(8); PG8_WAIT_L(0); PG8_BAR; PG8_MMA(1, 0, At, B0); PG8_MMA(1, 1, At, B1); PG8_BAR; PG8_SCHED;
            } else {
            PG8_LDB(B0, 0, 0); PG8_SCHED; PG8_LDA(At, 0, 0); PG8_STAGE(PG8_SA(1, 1), a1 + hstep, voffA);
            PG8_WAIT_L(8); PG8_BAR; PG8_WAIT_L(0); PG8_MMA(0, 0, At, B0); PG8_BAR; PG8_SCHED;
            PG8_LDB(B1, 0, 1); PG8_STAGE(PG8_SB(0, 0), b2, voffB);
            PG8_BAR; PG8_WAIT_L(0); PG8_MMA(0, 1, At, B1); PG8_BAR;
            PG8_LDA(At, 0, 1); PG8_STAGE(PG8_SA(0, 0), a2, voffA);
            PG8_BAR; PG8_WAIT_L(0); PG8_MMA(1, 0, At, B0); PG8_BAR; PG8_SCHED;
            PG8_STAGE(PG8_SB(0, 1), b2 + hstep, voffB);
            PG8_WAIT_V(6); PG8_BAR; PG8_MMA(1, 1, At, B1); PG8_BAR;
            PG8_LDB(B0, 1, 0); PG8_SCHED; PG8_LDA(At, 1, 0); PG8_STAGE(PG8_SA(0, 1), a2 + hstep, voffA);
            PG8_WAIT_L(8); PG8_BAR; PG8_WAIT_L(0); PG8_MMA(0, 0, At, B0); PG8_BAR; PG8_SCHED;
            PG8_LDB(B1, 1, 1); PG8_STAGE(PG8_SB(1, 0), b3, voffB);
            PG8_BAR; PG8_WAIT_L(0); PG8_MMA(0, 1, At, B1); PG8_BAR;
            PG8_LDA(At, 1, 1); PG8_STAGE(PG8_SA(1, 0), a3, voffA);
            PG8_BAR; PG8_WAIT_L(0); PG8_MMA(1, 0, At, B0); PG8_BAR; PG8_SCHED;
            PG8_STAGE(PG8_SB(1, 1), b3 + hstep, voffB);
            PG8_WAIT_V(6); PG8_BAR; PG8_MMA(1, 1, At, B1); PG8_BAR;
            }
        }
        if constexpr (ALIGN_EPI) { if (wr == 0) PG8_BAR; }
        if constexpr (!Epi::AFTER_DRAIN) { E(acc, cur, wr, wc, fr, fq); S.done(cur); }
        if (!has_next) break;
#pragma unroll
        for (int a = 0; a < 2; ++a)
#pragma unroll
            for (int b = 0; b < 2; ++b)
#pragma unroll
                for (int m = 0; m < 4; ++m)
#pragma unroll
                    for (int n = 0; n < 2; ++n) acc[a][b][m][n] = (f32x4){0.f, 0.f, 0.f, 0.f};
        cur = nxt; cA = nA; cB = nB; ++ui;
        if constexpr (ALIGN_EPI) { if (wr == 1) PG8_BAR; }
    }
    PG8_WAIT_V(0);
    if constexpr (!ALIGN_EPI) { if (wr == 0) PG8_BAR; }
    PG8_BAR;
    if constexpr (Epi::AFTER_DRAIN) { E.fused(acc, cur, wr, wc, fr, fq, lds, wid, lane); S.done(cur); }
#undef PG8_SA
#undef PG8_SB
#undef PG8_STAGE
#undef PG8_LDA
#undef PG8_LDB
#undef PG8_MMA
#undef PG8_WAIT_V
#undef PG8_WAIT_L
#undef PG8_BAR
#undef PG8_SCHED
}


__device__ __forceinline__ int xcd_remap(int L, int nwg) { const int q = nwg / NXCD, r = nwg % NXCD, xcd = L % NXCD, off = L / NXCD; return (xcd < r ? xcd * (q + 1) : r * (q + 1) + (xcd - r) * q) + off; }
struct SchedGrid {
    int nm, nn, G, c; bool lat;
    __device__ __forceinline__ bool next(int i, Unit& u) const { const int nwg = nm * nn; const int L = i * G + c; if (L >= nwg) return false;
        const int wgid = xcd_remap(L, nwg); const int nig = WGM * nn, gid = wgid / nig, fm = gid * WGM, gsz = (nm - fm) < WGM ? (nm - fm) : WGM;
        int pm = fm + ((wgid % nig) % gsz); u.pn = (wgid % nig) / gsz; if (lat) pm = (pm >> 3) * 9 + 1 + (pm & 7); u.pm = pm; return true; }
    __device__ __forceinline__ void a_ready(const Unit&) const {}
    __device__ __forceinline__ void done(const Unit&) const {}
};
struct SchedRouted {
    ExpOff eo; int G, c;
    __device__ __forceinline__ bool next(int i, Unit& u) const { const int nt = eo.off[16] >> 8, nwg = nt * 4; const int L = i * G + c; if (L >= nwg) return false;
        const int wgid = xcd_remap(L, nwg); const int pm = wgid >> 2, pnl = wgid & 3; int e = 0;
#pragma unroll
        for (int k = 1; k < 16; ++k) e += (pm * 256 >= eo.off[k]) ? 1 : 0;
        u.pm = pm; u.pn = e * 4 + pnl; return true; }
    __device__ __forceinline__ void a_ready(const Unit&) const {}
    __device__ __forceinline__ void done(const Unit&) const {}
};

#ifndef ATTN_V1
#define ATTN_V1 3
#endif
#ifndef PG8_MASK
#define PG8_MASK 0xffffffffu
#endif
template <int ID, class Epi, class Sched>
__device__ __forceinline__ void run_gemm(LAS unsigned char* lds, const Gemm g, const Sched& S, const Epi& E) {
    if constexpr ((PG8_MASK >> ID) & 1u) gemm_phase<Epi, Sched, true, true>(lds, g, S, E); else gemm_v0(g, S, E);
}

__device__ __forceinline__ v4u pack8(const f32x4 a, const f32x4 b) { v4u w; w.x = pk2(a[0], a[1]); w.y = pk2(a[2], a[3]); w.z = pk2(b[0], b[1]); w.w = pk2(b[2], b[3]); return w; }

struct EpiIn0 {
    static constexpr bool PERM = true, AFTER_DRAIN = false;
    unsigned char* big; const float *qg, *kg, *lbv; const f32x2 *ropeR, *ropeC;
    __device__ __forceinline__ void operator()(const f32x4 (&acc)[2][2][4][2], const Unit& u, int wr, int wc, int fr, int fq) const {
        const int pn = u.pn, type = pn >> 1, j9 = u.pm % 9; const bool lat = j9 > 0;
        if (type < 2) {
            const float* gain = type ? kg : qg; bf16* dst = (bf16*)(big + (type ? B_KD : B_QD));
            const int h = 2 * (pn & 1) + (wc >> 1), c = wc & 1;
            f32x4 g[2][2];
#pragma unroll
            for (int bj = 0; bj < 2; ++bj)
#pragma unroll
                for (int n = 0; n < 2; ++n) g[bj][n] = *(const f32x4*)(gain + 32 * bj + 16 * n + 4 * fq);
#pragma unroll
            for (int ai = 0; ai < 2; ++ai)
#pragma unroll
                for (int m = 0; m < 4; ++m) {
                    const int rr = opaque(ai * 128 + wr * 64 + m * 16 + fr); const size_t R = (size_t)u.pm * 256 + rr;
                    float s = 0.f;
#pragma unroll
                    for (int bj = 0; bj < 2; ++bj)
#pragma unroll
                        for (int n = 0; n < 2; ++n) { const f32x4 x = acc[ai][bj][m][n]; s += (x[0] * x[0] + x[1] * x[1]) + (x[2] * x[2] + x[3] * x[3]); }
                    s += __shfl_xor(s, 16); s += __shfl_xor(s, 32);
                    const float rstd = 1.0f / sqrtf(s * (1.0f / 64.0f) + EPS);
                    f32x4 y[2][2];
#pragma unroll
                    for (int bj = 0; bj < 2; ++bj)
#pragma unroll
                        for (int n = 0; n < 2; ++n) y[bj][n] = acc[ai][bj][m][n] * (type == 0 ? rstd * (0.125f * LOG2E) : rstd) * g[bj][n];
                    if (lat) { const int t = (j9 - 1) * 256 + rr, grow = t >> 6, gcol = t & 63;
#pragma unroll
                        for (int bj = 0; bj < 2; ++bj) { const f32x2* tab = bj ? (ropeC + gcol * 16 + 4 * fq) : (ropeR + grow * 16 + 4 * fq);
                            const f32x4 t0 = *(const f32x4*)tab, t1 = *(const f32x4*)(tab + 2);
                            const float cs[4] = {t0[0], t0[2], t1[0], t1[2]}, sn[4] = {t0[1], t0[3], t1[1], t1[3]};
#pragma unroll
                            for (int e = 0; e < 4; ++e) { const float x1 = y[bj][0][e], x2 = y[bj][1][e]; y[bj][0][e] = x1 * cs[e] - x2 * sn[e]; y[bj][1][e] = x1 * sn[e] + x2 * cs[e]; } } }
#pragma unroll
                    for (int bj = 0; bj < 2; ++bj) *(v4u*)(dst + R * 512 + h * 128 + c * 64 + 32 * bj + 8 * fq) = pack8(y[bj][0], y[bj][1]);
                    asm volatile("" ::: "memory");
                }
        } else {
            const int colt = (pn & 1) * 256;
            size_t boffs; if (type == 2) boffs = B_VD; else if (type == 3) boffs = B_HQ; else if (type == 4) boffs = B_LF0; else if (type == 5) boffs = B_LF1; else if (type == 6) boffs = B_HV; else boffs = B_HG;
            bf16* dst = (bf16*)(big + boffs);
#pragma unroll
            for (int bj = 0; bj < 2; ++bj) { const int col = colt + bj * 128 + wc * 32 + 8 * fq;
                f32x4 lb0 = {0.f, 0.f, 0.f, 0.f}, lb1 = lb0;
                if (type == 4 || type == 5) { const float* lp = lbv + (type - 4) * 512 + col; lb0 = *(const f32x4*)lp; lb1 = *(const f32x4*)(lp + 4); }
#pragma unroll
                for (int ai = 0; ai < 2; ++ai)
#pragma unroll
                    for (int m = 0; m < 4; ++m) { const size_t R = (size_t)u.pm * 256 + opaque(ai * 128 + wr * 64 + m * 16 + fr);
                        f32x4 a = acc[ai][bj][m][0], b = acc[ai][bj][m][1]; v4u w;
                        if (type == 3 || type == 7) {
#pragma unroll
                            for (int e = 0; e < 4; ++e) { a[e] = siluf_(a[e]); b[e] = siluf_(b[e]); }
                            w = pack8(a, b);
                        } else if (type == 4 || type == 5) {
#pragma unroll
                            for (int e = 0; e < 4; ++e) { a[e] = __logf(lb0[e] + (1.0f - lb0[e]) * sigmoidf_(a[e])); b[e] = __logf(lb1[e] + (1.0f - lb1[e]) * sigmoidf_(b[e])); }
                            w.x = pkh2(a[0], a[1]); w.y = pkh2(a[2], a[3]); w.z = pkh2(b[0], b[1]); w.w = pkh2(b[2], b[3]);
                        } else w = pack8(a, b);
                        *(v4u*)(dst + R * 512 + col) = w; asm volatile("" ::: "memory"); } }
        }
    }
};

struct EpiOut {
    static constexpr bool PERM = false, AFTER_DRAIN = false;
    const Frame* F; int layer; bool from_input;
    __device__ __forceinline__ void operator()(const f32x4 (&acc)[2][2][4][2], const Unit& u, int wr, int wc, int fr, int fq) const {
        const int b = u.pm / 9, j9 = u.pm % 9, r = j9 ? b : 8;
        const float* gm = F->modv_() + (size_t)(layer * 9 + r) * 6144 + 2048;
#pragma unroll
        for (int ai = 0; ai < 2; ++ai)
#pragma unroll
            for (int m = 0; m < 4; ++m) { const int s = j9 * 256 + opaque(ai * 128 + wr * 64 + m * 16 + fr);
                float* xo = xrow_ptr(*F, b, s); const float* xb = from_input ? xin_ptr(*F, b, s) : xo;
#pragma unroll
                for (int bj = 0; bj < 2; ++bj)
#pragma unroll
                    for (int n = 0; n < 2; ++n) { const int col = u.pn * 256 + bj * 128 + wc * 32 + 16 * n + 4 * fq;
                        *(f32x4*)(xo + col) = *(const f32x4*)(xb + col) + *(const f32x4*)(gm + col) * acc[ai][bj][m][n]; } asm volatile("" ::: "memory"); }
    }
};

struct EpiGU {
    static constexpr bool PERM = true, AFTER_DRAIN = false;
    bf16* Hout;
    __device__ __forceinline__ void operator()(const f32x4 (&acc)[2][2][4][2], const Unit& u, int wr, int wc, int fr, int fq) const {
        const int pnl = u.pn & 3;
#pragma unroll
        for (int ai = 0; ai < 2; ++ai)
#pragma unroll
            for (int m = 0; m < 4; ++m) { const size_t row = (size_t)u.pm * 256 + opaque(ai * 128 + wr * 64 + m * 16 + fr);
                f32x4 h[2];
#pragma unroll
                for (int n = 0; n < 2; ++n)
#pragma unroll
                    for (int e = 0; e < 4; ++e) h[n][e] = siluf_(acc[ai][0][m][n][e]) * acc[ai][1][m][n][e];
                *(v4u*)(Hout + row * 512 + pnl * 128 + wc * 32 + 8 * fq) = pack8(h[0], h[1]); }
    }
};

struct EpiDownS {
    static constexpr bool PERM = false, AFTER_DRAIN = false;
    const Frame* F; int layer;
    __device__ __forceinline__ void operator()(const f32x4 (&acc)[2][2][4][2], const Unit& u, int wr, int wc, int fr, int fq) const {
        const int b = u.pm / 9, j9 = u.pm % 9, r = j9 ? b : 8;
        const float* gf = F->modv_() + (size_t)(layer * 9 + r) * 6144 + 5120;
#pragma unroll
        for (int ai = 0; ai < 2; ++ai)
#pragma unroll
            for (int m = 0; m < 4; ++m) { const int s = j9 * 256 + opaque(ai * 128 + wr * 64 + m * 16 + fr); float* xo = xrow_ptr(*F, b, s);
#pragma unroll
                for (int bj = 0; bj < 2; ++bj)
#pragma unroll
                    for (int n = 0; n < 2; ++n) { const int col = u.pn * 256 + bj * 128 + wc * 32 + 16 * n + 4 * fq;
                        *(f32x4*)(xo + col) = *(const f32x4*)(xo + col) + *(const f32x4*)(gf + col) * acc[ai][bj][m][n]; } asm volatile("" ::: "memory"); }
    }
};

struct EpiDownR {
    static constexpr bool PERM = true, AFTER_DRAIN = false;
    bf16* Ye;
    __device__ __forceinline__ void operator()(const f32x4 (&acc)[2][2][4][2], const Unit& u, int wr, int wc, int fr, int fq) const {
        const int pnl = u.pn & 3;
#pragma unroll
        for (int ai = 0; ai < 2; ++ai)
#pragma unroll
            for (int m = 0; m < 4; ++m) { const size_t row = (size_t)u.pm * 256 + opaque(ai * 128 + wr * 64 + m * 16 + fr);
#pragma unroll
                for (int bj = 0; bj < 2; ++bj) *(v4u*)(Ye + row * 1024 + pnl * 256 + bj * 128 + wc * 32 + 8 * fq) = pack8(acc[ai][bj][m][0], acc[ai][bj][m][1]); }
    }
};

struct EpiIn1 {
    static constexpr bool PERM = true, AFTER_DRAIN = false;
    unsigned char* big; float* ssq; const float* krg; const f32x2 *ropeR, *ropeC;
    __device__ __forceinline__ void operator()(const f32x4 (&acc)[2][2][4][2], const Unit& u, int wr, int wc, int fr, int fq) const {
        const int pn = u.pn, j9 = u.pm % 9; const bool lat = j9 > 0;
        bf16* Ckv = (bf16*)(big + B_CKV); bf16* Cq = (bf16*)(big + B_CQ); bf16* Kr = (bf16*)(big + B_KR);
        if (pn == 2 && wc == 3) {
#pragma unroll
            for (int ai = 0; ai < 2; ++ai)
#pragma unroll
                for (int m = 0; m < 4; ++m) {
                    const int rr = opaque(ai * 128 + wr * 64 + m * 16 + fr); const size_t R = (size_t)u.pm * 256 + rr;
                    float s = 0.f;
#pragma unroll
                    for (int bj = 0; bj < 2; ++bj)
#pragma unroll
                        for (int n = 0; n < 2; ++n) { const f32x4 x = acc[ai][bj][m][n]; s += (x[0] * x[0] + x[1] * x[1]) + (x[2] * x[2] + x[3] * x[3]); }
                    s += __shfl_xor(s, 16); s += __shfl_xor(s, 32);
                    const float rstd = 1.0f / sqrtf(s * (1.0f / 64.0f) + EPS);
                    f32x4 y[2][2];
#pragma unroll
                    for (int bj = 0; bj < 2; ++bj)
#pragma unroll
                        for (int n = 0; n < 2; ++n) y[bj][n] = acc[ai][bj][m][n] * rstd * *(const f32x4*)(krg + 32 * bj + 16 * n + 4 * fq);
                    if (lat) { const int t = (j9 - 1) * 256 + rr, grow = t >> 6, gcol = t & 63;
#pragma unroll
                        for (int bj = 0; bj < 2; ++bj) { const f32x2* tab = bj ? (ropeC + gcol * 16 + 4 * fq) : (ropeR + grow * 16 + 4 * fq);
                            const f32x4 t0 = *(const f32x4*)tab, t1 = *(const f32x4*)(tab + 2);
                            const float cs[4] = {t0[0], t0[2], t1[0], t1[2]}, sn[4] = {t0[1], t0[3], t1[1], t1[3]};
#pragma unroll
                            for (int e = 0; e < 4; ++e) { const float x1 = y[bj][0][e], x2 = y[bj][1][e]; y[bj][0][e] = x1 * cs[e] - x2 * sn[e]; y[bj][1][e] = x1 * sn[e] + x2 * cs[e]; } } }
#pragma unroll
                    for (int bj = 0; bj < 2; ++bj) *(v4u*)(Kr + R * 64 + 32 * bj + 8 * fq) = pack8(y[bj][0], y[bj][1]);
                    asm volatile("" ::: "memory");
                }
            return;
        }
#pragma unroll
        for (int ai = 0; ai < 2; ++ai)
#pragma unroll
            for (int m = 0; m < 4; ++m) {
                const size_t R = (size_t)u.pm * 256 + opaque(ai * 128 + wr * 64 + m * 16 + fr);
                float s = 0.f;
#pragma unroll
                for (int bj = 0; bj < 2; ++bj) { const f32x4 a = acc[ai][bj][m][0], b = acc[ai][bj][m][1];
                    s += (a[0] * a[0] + a[1] * a[1]) + (a[2] * a[2] + a[3] * a[3]) + (b[0] * b[0] + b[1] * b[1]) + (b[2] * b[2] + b[3] * b[3]);
                    const v4u w = pack8(a, b);
                    if (pn == 0) *(v4u*)(Ckv + R * 256 + bj * 128 + wc * 32 + 8 * fq) = w;
                    else if (pn == 1) *(v4u*)(Cq + R * 384 + bj * 128 + wc * 32 + 8 * fq) = w;
                    else { if (bj == 0) *(v4u*)(Cq + R * 384 + 256 + wc * 32 + 8 * fq) = w; else if (wc == 0) *(v4u*)(Cq + R * 384 + 352 + 8 * fq) = w; } }
                s += __shfl_xor(s, 16); s += __shfl_xor(s, 32);
                if (fq == 0) ssq[R * 12 + pn * 4 + wc] = s;
                asm volatile("" ::: "memory");
            }
    }
};

struct EpiUq {
    static constexpr bool PERM = true, AFTER_DRAIN = false;
    bf16* Q1; const float* ssq; const float *qng, *qrg; const f32x2 *ropeR, *ropeC; LAS float* xl;
    __device__ __forceinline__ float rq_of(size_t R) const { const float* sp = ssq + R * 12; const f32x4 s1 = *(const f32x4*)(sp + 4), s2 = *(const f32x4*)(sp + 8);
        return 1.0f / sqrtf(((s1[0] + s1[1]) + (s1[2] + s1[3]) + (s2[0] + s2[1]) + s2[2]) * (1.0f / 384.0f) + EPS); }
    __device__ __forceinline__ void operator()(const f32x4 (&acc)[2][2][4][2], const Unit& u, int wr, int wc, int fr, int fq) const {
        const int pn = u.pn, j9 = u.pm % 9;
        if (pn < 4) {
#pragma unroll
            for (int ai = 0; ai < 2; ++ai)
#pragma unroll
                for (int m = 0; m < 4; ++m)
#pragma unroll
                    for (int bj = 0; bj < 2; ++bj) { float s = 0.f;
#pragma unroll
                        for (int n = 0; n < 2; ++n) { const f32x4 x = acc[ai][bj][m][n]; s += (x[0] * x[0] + x[1] * x[1]) + (x[2] * x[2] + x[3] * x[3]); }
                        s += __shfl_xor(s, 16); s += __shfl_xor(s, 32);
                        if (fq == 0) xl[(ai * 128 + wr * 64 + m * 16 + fr) * 8 + bj * 4 + wc] = s; }
            EPI_BAR();
#pragma unroll
            for (int ai = 0; ai < 2; ++ai)
#pragma unroll
                for (int m = 0; m < 4; ++m) { const int rr = opaque(ai * 128 + wr * 64 + m * 16 + fr); const size_t R = (size_t)u.pm * 256 + rr; const float rq = rq_of(R);
                    f32x4 g[2];
#pragma unroll
                    for (int n = 0; n < 2; ++n) g[n] = *(const f32x4*)(qng + wc * 32 + 8 * fq + 4 * n);
#pragma unroll
                    for (int bj = 0; bj < 2; ++bj) { const f32x4 p = *(const LAS f32x4*)(xl + rr * 8 + bj * 4);
                        const float rstd = (0.07216878364870323f * LOG2E) * rq / sqrtf(((p[0] + p[1]) + (p[2] + p[3])) * (rq * rq) * (1.0f / 128.0f) + EPS);
                        const int h = 2 * pn + bj;
                        *(v4u*)(Q1 + R * 1536 + h * 192 + wc * 32 + 8 * fq) = pack8(acc[ai][bj][m][0] * rstd * g[0], acc[ai][bj][m][1] * rstd * g[1]); } asm volatile("" ::: "memory"); }
            EPI_BAR();
        } else {
            const int h = 4 * (pn - 4) + wc;
#pragma unroll
            for (int ai = 0; ai < 2; ++ai)
#pragma unroll
                for (int m = 0; m < 4; ++m) {
                    const int rr = opaque(ai * 128 + wr * 64 + m * 16 + fr); const size_t R = (size_t)u.pm * 256 + rr; const float rq = rq_of(R);
                    float s = 0.f; f32x4 y[2][2];
#pragma unroll
                    for (int bj = 0; bj < 2; ++bj)
#pragma unroll
                        for (int n = 0; n < 2; ++n) { const f32x4 x = acc[ai][bj][m][n] * rq; y[bj][n] = x; s += (x[0] * x[0] + x[1] * x[1]) + (x[2] * x[2] + x[3] * x[3]); }
                    s += __shfl_xor(s, 16); s += __shfl_xor(s, 32);
                    const float rstd = (0.07216878364870323f * LOG2E) / sqrtf(s * (1.0f / 64.0f) + EPS);
#pragma unroll
                    for (int bj = 0; bj < 2; ++bj)
#pragma unroll
                        for (int n = 0; n < 2; ++n) y[bj][n] = y[bj][n] * rstd * *(const f32x4*)(qrg + 32 * bj + 16 * n + 4 * fq);
                    { const int t = (j9 - 1) * 256 + rr, grow = t >> 6, gcol = t & 63;
#pragma unroll
                        for (int bj = 0; bj < 2; ++bj) { const f32x2* tab = bj ? (ropeC + gcol * 16 + 4 * fq) : (ropeR + grow * 16 + 4 * fq);
                            const f32x4 t0 = *(const f32x4*)tab, t1 = *(const f32x4*)(tab + 2);
                            const float cs[4] = {t0[0], t0[2], t1[0], t1[2]}, sn[4] = {t0[1], t0[3], t1[1], t1[3]};
#pragma unroll
                            for (int e = 0; e < 4; ++e) { const float x1 = y[bj][0][e], x2 = y[bj][1][e]; y[bj][0][e] = x1 * cs[e] - x2 * sn[e]; y[bj][1][e] = x1 * sn[e] + x2 * cs[e]; } } }
#pragma unroll
                    for (int bj = 0; bj < 2; ++bj) *(v4u*)(Q1 + R * 1536 + h * 192 + 128 + 32 * bj + 8 * fq) = pack8(y[bj][0], y[bj][1]);
                    asm volatile("" ::: "memory");
                }
        }
    }
};

struct EpiUkv {
    static constexpr bool PERM = true, AFTER_DRAIN = false;
    bf16 *Kn, *V1; const float* ssq; const float* kng; LAS float* xl;
    __device__ __forceinline__ void operator()(const f32x4 (&acc)[2][2][4][2], const Unit& u, int wr, int wc, int fr, int fq) const {
        const int h = u.pn;
#pragma unroll
        for (int ai = 0; ai < 2; ++ai)
#pragma unroll
            for (int m = 0; m < 4; ++m) { float s = 0.f;
#pragma unroll
                for (int n = 0; n < 2; ++n) { const f32x4 x = acc[ai][0][m][n]; s += (x[0] * x[0] + x[1] * x[1]) + (x[2] * x[2] + x[3] * x[3]); }
                s += __shfl_xor(s, 16); s += __shfl_xor(s, 32);
                if (fq == 0) xl[(ai * 128 + wr * 64 + m * 16 + fr) * 4 + wc] = s; }
        EPI_BAR();
#pragma unroll
        for (int ai = 0; ai < 2; ++ai)
#pragma unroll
            for (int m = 0; m < 4; ++m) { const int rr = opaque(ai * 128 + wr * 64 + m * 16 + fr); const size_t R = (size_t)u.pm * 256 + rr;
                f32x4 g[2];
#pragma unroll
                for (int n = 0; n < 2; ++n) g[n] = *(const f32x4*)(kng + wc * 32 + 8 * fq + 4 * n);
                const f32x4 s0 = *(const f32x4*)(ssq + R * 12);
                const float rk = 1.0f / sqrtf(((s0[0] + s0[1]) + (s0[2] + s0[3])) * (1.0f / 256.0f) + EPS);
                const f32x4 p = *(const LAS f32x4*)(xl + rr * 4);
                const float rstd = rk / sqrtf(((p[0] + p[1]) + (p[2] + p[3])) * (rk * rk) * (1.0f / 128.0f) + EPS);
                *(v4u*)(Kn + R * 1024 + h * 128 + wc * 32 + 8 * fq) = pack8(acc[ai][0][m][0] * rstd * g[0], acc[ai][0][m][1] * rstd * g[1]);
                *(v4u*)(V1 + R * 1024 + h * 128 + wc * 32 + 8 * fq) = pack8(acc[ai][1][m][0] * rk, acc[ai][1][m][1] * rk); asm volatile("" ::: "memory"); }
        EPI_BAR();
    }
};

__device__ __forceinline__ bf16x8 pack_p(const f32x16& p, int s) { v4u w; w.x = pk2(p[8 * s + 0], p[8 * s + 1]); w.y = pk2(p[8 * s + 2], p[8 * s + 3]); w.z = pk2(p[8 * s + 4], p[8 * s + 5]); w.w = pk2(p[8 * s + 6], p[8 * s + 7]); return __builtin_bit_cast(bf16x8, w); }
__device__ __forceinline__ bf16x8 load_vfrag(const bf16* vp, int ld, int s) {
    bf16x8 r;
#pragma unroll
    for (int j = 0; j < 8; ++j) r[j] = (short)vp[(size_t)(16 * s + 8 * (j >> 2) + (j & 3)) * ld];
    return r;
}

__device__ __forceinline__ void diff_attn_unit_v0(Frame& F, int a) {
    const int lane = F.lane, r32 = lane & 31, hh = lane >> 5, wid = F.wave;
    int b, h, q0, nkeys;
    if (a < 256) { b = a >> 5; h = (a >> 3) & 3; q0 = b * RPB + CTXL + (a & 7) * 256; nkeys = RPB; } else { const int a2 = a - 256; b = a2 >> 2; h = a2 & 3; q0 = b * RPB; nkeys = CTXL; }
    const int kbase = b * RPB;
    const bf16* Qd = (const bf16*)(F.big_() + B_QD); const bf16* Kd = (const bf16*)(F.big_() + B_KD); const bf16* Vd = (const bf16*)(F.big_() + B_VD);
    const float lam = F.lamv_()[0];
    const bf16* qp = Qd + (size_t)(q0 + wid * 32 + r32) * 512 + h * 128 + hh * 8;
    f32x16 O[2][4];
#pragma unroll
    for (int c = 0; c < 2; ++c)
#pragma unroll
        for (int d = 0; d < 4; ++d)
#pragma unroll
            for (int r = 0; r < 16; ++r) O[c][d][r] = 0.f;
    float l0 = 0.f, l1 = 0.f;
    for (int kt = 0; kt < nkeys; kt += 32) {
        bf16x8 pf[2][2];
        const bf16* kp = Kd + (size_t)(kbase + kt + r32) * 512 + h * 128 + hh * 8;
#pragma unroll
        for (int c = 0; c < 2; ++c) {
            f32x16 S;
#pragma unroll
            for (int r = 0; r < 16; ++r) S[r] = 0.f;
#pragma unroll
            for (int ks = 0; ks < 4; ++ks) { const bf16x8 kf = *(const bf16x8*)(kp + c * 64 + ks * 16); const bf16x8 qv = *(const bf16x8*)(qp + c * 64 + ks * 16); S = __builtin_amdgcn_mfma_f32_32x32x16_bf16(kf, qv, S, 0, 0, 0); }
            float ls = 0.f;
#pragma unroll
            for (int r = 0; r < 16; ++r) { S[r] = __builtin_amdgcn_exp2f(S[r]); ls += S[r]; }
            if (c == 0) l0 += ls; else l1 += ls;
            pf[c][0] = pack_p(S, 0); pf[c][1] = pack_p(S, 1);
        }
        const bf16* vp = Vd + (size_t)(kbase + kt + 4 * hh) * 512 + h * 128 + r32;
#pragma unroll
        for (int d = 0; d < 4; ++d)
#pragma unroll
            for (int s = 0; s < 2; ++s) { const bf16x8 vf = load_vfrag(vp + d * 32, 512, s);
                O[0][d] = __builtin_amdgcn_mfma_f32_32x32x16_bf16(pf[0][s], vf, O[0][d], 0, 0, 0);
                O[1][d] = __builtin_amdgcn_mfma_f32_32x32x16_bf16(pf[1][s], vf, O[1][d], 0, 0, 0); asm volatile("" ::: "memory"); }
    }
    l0 += __shfl_xor(l0, 32); l1 += __shfl_xor(l1, 32);
    const float* sg = F.ar->in[I_DSUBLN];
    float gsub[4];
#pragma unroll
    for (int d = 0; d < 4; ++d) gsub[d] = sg[d * 32 + r32] * 0.8f;
#pragma unroll
    for (int r = 0; r < 16; ++r) {
        const int qi = crow(r, hh);
        const float i0 = 1.0f / __shfl(l0, qi), i1 = lam / __shfl(l1, qi);
        float o[4]; float s = 0.f;
#pragma unroll
        for (int d = 0; d < 4; ++d) { o[d] = O[0][d][r] * i0 - O[1][d][r] * i1; s += o[d] * o[d]; }
        s += __shfl_xor(s, 1); s += __shfl_xor(s, 2); s += __shfl_xor(s, 4); s += __shfl_xor(s, 8); s += __shfl_xor(s, 16);
        const float rstd = 1.0f / sqrtf(s * (1.0f / 128.0f) + EPS);
        bf16* op = F.H_() + (size_t)(q0 + wid * 32 + qi) * D + h * 128 + r32;
#pragma unroll
        for (int d = 0; d < 4; ++d) op[d * 32] = (bf16)f2bf(o[d] * rstd * gsub[d]);
    }
}

__device__ __forceinline__ void mla_attn_unit_v0(Frame& F, int a) {
    const int lane = F.lane, r32 = lane & 31, hh = lane >> 5, wid = F.wave;
    const int b = a >> 6, h = (a >> 3) & 7, q0 = b * RPB + CTXL + (a & 7) * 256, kbase = b * RPB;
    const bf16* Q1 = (const bf16*)(F.big_() + B_Q1); const bf16* Kn = (const bf16*)(F.big_() + B_KN); const bf16* Kr = (const bf16*)(F.big_() + B_KR); const bf16* V1 = (const bf16*)(F.big_() + B_V1);
    bf16x8 qf[12];
    { const bf16* qp = Q1 + (size_t)(q0 + wid * 32 + r32) * 1536 + h * 192 + hh * 8;
#pragma unroll
        for (int ks = 0; ks < 12; ++ks) qf[ks] = *(const bf16x8*)(qp + ks * 16); }
    f32x16 O[4];
#pragma unroll
    for (int d = 0; d < 4; ++d)
#pragma unroll
        for (int r = 0; r < 16; ++r) O[d][r] = 0.f;
    float l0 = 0.f;
    for (int kt = 0; kt < RPB; kt += 32) {
        const bf16* knp = Kn + (size_t)(kbase + kt + r32) * 1024 + h * 128 + hh * 8;
        const bf16* krp = Kr + (size_t)(kbase + kt + r32) * 64 + hh * 8;
        f32x16 S;
#pragma unroll
        for (int r = 0; r < 16; ++r) S[r] = 0.f;
#pragma unroll
        for (int ks = 0; ks < 8; ++ks) { const bf16x8 kf = *(const bf16x8*)(knp + ks * 16); S = __builtin_amdgcn_mfma_f32_32x32x16_bf16(kf, qf[ks], S, 0, 0, 0); }
#pragma unroll
        for (int ks = 0; ks < 4; ++ks) { const bf16x8 kf = *(const bf16x8*)(krp + ks * 16); S = __builtin_amdgcn_mfma_f32_32x32x16_bf16(kf, qf[8 + ks], S, 0, 0, 0); }
        float ls = 0.f;
#pragma unroll
        for (int r = 0; r < 16; ++r) { S[r] = __builtin_amdgcn_exp2f(S[r]); ls += S[r]; }
        l0 += ls;
        const bf16x8 p0 = pack_p(S, 0), p1 = pack_p(S, 1);
        const bf16* vp = V1 + (size_t)(kbase + kt + 4 * hh) * 1024 + h * 128 + r32;
#pragma unroll
        for (int d = 0; d < 4; ++d) { const bf16x8 v0 = load_vfrag(vp + d * 32, 1024, 0), v1 = load_vfrag(vp + d * 32, 1024, 1);
            O[d] = __builtin_amdgcn_mfma_f32_32x32x16_bf16(p0, v0, O[d], 0, 0, 0);
            O[d] = __builtin_amdgcn_mfma_f32_32x32x16_bf16(p1, v1, O[d], 0, 0, 0); }
    }
    l0 += __shfl_xor(l0, 32);
#pragma unroll
    for (int r = 0; r < 16; ++r) { const int qi = crow(r, hh); const float i0 = 1.0f / __shfl(l0, qi);
        bf16* op = F.H_() + (size_t)(q0 + wid * 32 + qi) * D + h * 128 + r32;
#pragma unroll
        for (int d = 0; d < 4; ++d) op[d * 32] = (bf16)f2bf(O[d][r] * i0); }
}

typedef short s16x4 __attribute__((ext_vector_type(4)));
#define KSWZ64(row, colB) ((row) * 128 + ((colB) ^ (((row) & 7) << 4)))
__device__ __forceinline__ unsigned cvtpk(float lo, float hi) { unsigned r; asm volatile("v_cvt_pk_bf16_f32 %0, %1, %2" : "=v"(r) : "v"(lo), "v"(hi)); return r; }
__device__ __forceinline__ int v_st(int k, int c) { const int kk = (k & ~0xC) | ((k & 4) << 1) | ((k & 8) >> 1); return ((kk >> 3) * 4 + (c >> 5)) * 512 + ((kk & 7) * 32 + (c & 31)) * 2; }
__device__ __forceinline__ int v_rd_base(int lane) { return ((lane & 3) << 3) | (((lane >> 2) & 3) << 6) | (((lane >> 4) & 1) << 5) | (((lane >> 5) & 1) << 8); }
constexpr int v_rd_off(int d0, int ks, int half) { return d0 * 512 + ks * 4096 + half * 2048; }
template <int OFF> __device__ __forceinline__ s16x4 tr_read(int vb) { s16x4 r; asm volatile("ds_read_b64_tr_b16 %0, %1 offset:%2" : "=&v"(r) : "v"(vb), "i"(OFF) : "memory"); return r; }
template <int D0> __device__ __forceinline__ void pv_one(f32x16& od, int vb, bf16x8 pa0, bf16x8 pa1, bf16x8 pa2, bf16x8 pa3) {
    const s16x4 l0 = tr_read<v_rd_off(D0, 0, 0)>(vb), h0 = tr_read<v_rd_off(D0, 0, 1)>(vb), l1 = tr_read<v_rd_off(D0, 1, 0)>(vb), h1 = tr_read<v_rd_off(D0, 1, 1)>(vb);
    const s16x4 l2 = tr_read<v_rd_off(D0, 2, 0)>(vb), h2 = tr_read<v_rd_off(D0, 2, 1)>(vb), l3 = tr_read<v_rd_off(D0, 3, 0)>(vb), h3 = tr_read<v_rd_off(D0, 3, 1)>(vb);
    asm volatile("s_waitcnt lgkmcnt(0)" ::: "memory"); __builtin_amdgcn_sched_barrier(0);
#define PKV(L, H) (bf16x8){L[0], L[1], L[2], L[3], H[0], H[1], H[2], H[3]}
    od = __builtin_amdgcn_mfma_f32_32x32x16_bf16(pa0, PKV(l0, h0), od, 0, 0, 0);
    od = __builtin_amdgcn_mfma_f32_32x32x16_bf16(pa1, PKV(l1, h1), od, 0, 0, 0);
    od = __builtin_amdgcn_mfma_f32_32x32x16_bf16(pa2, PKV(l2, h2), od, 0, 0, 0);
    od = __builtin_amdgcn_mfma_f32_32x32x16_bf16(pa3, PKV(l3, h3), od, 0, 0, 0);
#undef PKV
}
#define PK4(P, BASE, OUT) do { unsigned a0 = cvtpk(P[BASE + 0], P[BASE + 1]), a1 = cvtpk(P[BASE + 2], P[BASE + 3]);   \
    unsigned b0 = cvtpk(P[BASE + 4], P[BASE + 5]), b1 = cvtpk(P[BASE + 6], P[BASE + 7]);                              \
    auto r0 = __builtin_amdgcn_permlane32_swap(a0, b0, false, false); auto r1 = __builtin_amdgcn_permlane32_swap(a1, b1, false, false); \
    v4u w = {r0[0], r1[0], r0[1], r1[1]}; OUT = __builtin_bit_cast(bf16x8, w); } while (0)

template <int NSUB>
__device__ __forceinline__ void attn_pass(f32x16 (&o)[4], float& l_acc, const bf16x8 (&qf)[NSUB * 4], const bf16* k0, const bf16* k1, const bf16* k2, int ld0, int ld1, int ld2,
                                          const bf16* vsrc, int vld, int nkeys, LAS unsigned char* lds) {
    constexpr int BUF = NSUB * 8192 + 16384;
    const int tid = opaque((int)threadIdx.x), lane = tid & 63, r32 = lane & 31, hh = lane >> 5;
    const int krow = tid >> 3, kch = tid & 7, sr = tid >> 4, sc = (tid & 15) * 8;
    const int kdst = KSWZ64(krow, kch * 16), vst0 = NSUB * 8192 + v_st(sr, sc), vst1 = NSUB * 8192 + v_st(32 + sr, sc);
    const int vb0 = (int)(unsigned)(uintptr_t)lds + NSUB * 8192 + v_rd_base(lane);
    const int ka0 = r32 * 128, ka1 = (32 + r32) * 128;
    bf16x8 sk0, sk1, sk2, sv0, sv1;
#define ALOAD(key0) do { sk0 = *(const bf16x8*)(k0 + (size_t)((key0) + krow) * ld0 + kch * 8); \
        if (NSUB > 1) sk1 = *(const bf16x8*)(k1 + (size_t)((key0) + krow) * ld1 + kch * 8); if (NSUB > 2) sk2 = *(const bf16x8*)(k2 + (size_t)((key0) + krow) * ld2 + kch * 8); \
        sv0 = *(const bf16x8*)(vsrc + (size_t)((key0) + sr) * vld + sc); sv1 = *(const bf16x8*)(vsrc + (size_t)((key0) + 32 + sr) * vld + sc); } while (0)
#define AWRITE(b) do { LAS unsigned char* bb = lds + (b) * BUF; *(LAS bf16x8*)(bb + kdst) = sk0; if (NSUB > 1) *(LAS bf16x8*)(bb + 8192 + kdst) = sk1; if (NSUB > 2) *(LAS bf16x8*)(bb + 16384 + kdst) = sk2; \
        *(LAS bf16x8*)(bb + vst0) = sv0; *(LAS bf16x8*)(bb + vst1) = sv1; } while (0)
    const int NT = nkeys >> 6;
    ALOAD(0); AWRITE(0); __syncthreads();
    for (int t = 0; t < NT; ++t) {
        const int b = t & 1;
        if (t + 1 < NT) ALOAD((t + 1) * 64);
        const LAS unsigned char* kb = lds + b * BUF;
        f32x16 p0, p1;
#pragma unroll
        for (int r = 0; r < 16; ++r) { p0[r] = 0.f; p1[r] = 0.f; }
#pragma unroll
        for (int s = 0; s < NSUB; ++s)
#pragma unroll
            for (int ks = 0; ks < 4; ++ks) { const int cb = (ks * 16 + hh * 8) * 2, x = (r32 & 7) << 4;
                const bf16x8 b0 = *(const LAS bf16x8*)(kb + s * 8192 + ka0 + (cb ^ x)), b1 = *(const LAS bf16x8*)(kb + s * 8192 + ka1 + (cb ^ x));
                p0 = __builtin_amdgcn_mfma_f32_32x32x16_bf16(b0, qf[s * 4 + ks], p0, 0, 0, 0);
                p1 = __builtin_amdgcn_mfma_f32_32x32x16_bf16(b1, qf[s * 4 + ks], p1, 0, 0, 0); }
        float ps = 0.f;
#pragma unroll
        for (int r = 0; r < 16; ++r) { p0[r] = __builtin_amdgcn_exp2f(p0[r]); p1[r] = __builtin_amdgcn_exp2f(p1[r]); ps += p0[r] + p1[r]; }
        l_acc += ps;
        bf16x8 pa0, pa1, pa2, pa3;
        PK4(p0, 0, pa0); PK4(p0, 8, pa1); PK4(p1, 0, pa2); PK4(p1, 8, pa3);
        const int vb = vb0 + b * BUF;
        pv_one<0>(o[0], vb, pa0, pa1, pa2, pa3); pv_one<1>(o[1], vb, pa0, pa1, pa2, pa3); pv_one<2>(o[2], vb, pa0, pa1, pa2, pa3); pv_one<3>(o[3], vb, pa0, pa1, pa2, pa3);
        if (t + 1 < NT) AWRITE(b ^ 1);
        __syncthreads();
    }
#undef ALOAD
#undef AWRITE
}

__device__ __forceinline__ void diff_attn_unit_v1(Frame& F, int a) {
    const int lane = F.lane, r32 = lane & 31, hh = lane >> 5, wid = F.wave;
    int b, h, q0, nkeys;
    if (a < 256) { b = a >> 5; h = (a >> 3) & 3; q0 = b * RPB + CTXL + (a & 7) * 256; nkeys = RPB; } else { const int a2 = a - 256; b = a2 >> 2; h = a2 & 3; q0 = b * RPB; nkeys = CTXL; }
    const bf16* Qd = (const bf16*)(F.big_() + B_QD); const bf16* Kd = (const bf16*)(F.big_() + B_KD); const bf16* Vd = (const bf16*)(F.big_() + B_VD);
    const bf16* kbase = Kd + (size_t)b * RPB * 512 + h * 128; const bf16* vbase = Vd + (size_t)b * RPB * 512 + h * 128;
    const bf16* qp = Qd + (size_t)(q0 + wid * 32 + r32) * 512 + h * 128 + hh * 8;
    const float lam = F.lamv_()[0];
    f32x16 osum[4];
#pragma unroll
    for (int d = 0; d < 4; ++d)
#pragma unroll
        for (int r = 0; r < 16; ++r) osum[d][r] = 0.f;
#pragma unroll 1
    for (int c = 0; c < 2; ++c) {
        bf16x8 qf[4];
#pragma unroll
        for (int ks = 0; ks < 4; ++ks) qf[ks] = *(const bf16x8*)(qp + c * 64 + ks * 16);
        f32x16 o[4];
#pragma unroll
        for (int d = 0; d < 4; ++d)
#pragma unroll
            for (int r = 0; r < 16; ++r) o[d][r] = 0.f;
        float l = 0.f;
        attn_pass<1>(o, l, qf, kbase + c * 64, kbase, kbase, 512, 512, 512, vbase, 512, nkeys, F.lds);
        l += __shfl_xor(l, 32);
        const float coef = c ? -lam : 1.0f;
#pragma unroll
        for (int r = 0; r < 16; ++r) { const float i0 = coef / __shfl(l, crow(r, hh));
#pragma unroll
            for (int d = 0; d < 4; ++d) osum[d][r] += o[d][r] * i0; }
    }
    const float* sg = F.ar->in[I_DSUBLN];
    float gsub[4];
#pragma unroll
    for (int d = 0; d < 4; ++d) gsub[d] = sg[d * 32 + r32] * 0.8f;
#pragma unroll
    for (int r = 0; r < 16; ++r) {
        const int qi = crow(r, hh);
        float s = 0.f;
#pragma unroll
        for (int d = 0; d < 4; ++d) s += osum[d][r] * osum[d][r];
        s += __shfl_xor(s, 1); s += __shfl_xor(s, 2); s += __shfl_xor(s, 4); s += __shfl_xor(s, 8); s += __shfl_xor(s, 16);
        const float rstd = 1.0f / sqrtf(s * (1.0f / 128.0f) + EPS);
        bf16* op = F.H_() + (size_t)(q0 + wid * 32 + qi) * D + h * 128 + r32;
#pragma unroll
        for (int d = 0; d < 4; ++d) op[d * 32] = (bf16)f2bf(osum[d][r] * rstd * gsub[d]);
    }
}

__device__ __forceinline__ void mla_attn_unit_v1(Frame& F, int a) {
    const int lane = F.lane, r32 = lane & 31, hh = lane >> 5, wid = F.wave;
    const int b = a >> 6, h = (a >> 3) & 7, q0 = b * RPB + CTXL + (a & 7) * 256;
    const bf16* Q1 = (const bf16*)(F.big_() + B_Q1); const bf16* Kn = (const bf16*)(F.big_() + B_KN); const bf16* Kr = (const bf16*)(F.big_() + B_KR); const bf16* V1 = (const bf16*)(F.big_() + B_V1);
    const bf16* knb = Kn + (size_t)b * RPB * 1024 + h * 128; const bf16* krb = Kr + (size_t)b * RPB * 64; const bf16* vb = V1 + (size_t)b * RPB * 1024 + h * 128;
    bf16x8 qf[12];
    { const bf16* qp = Q1 + (size_t)(q0 + wid * 32 + r32) * 1536 + h * 192 + hh * 8;
#pragma unroll
        for (int ks = 0; ks < 12; ++ks) qf[ks] = *(const bf16x8*)(qp + ks * 16); }
    f32x16 o[4];
#pragma unroll
    for (int d = 0; d < 4; ++d)
#pragma unroll
        for (int r = 0; r < 16; ++r) o[d][r] = 0.f;
    float l0 = 0.f;
    attn_pass<3>(o, l0, qf, knb, knb + 64, krb, 1024, 1024, 64, vb, 1024, RPB, F.lds);
    l0 += __shfl_xor(l0, 32);
#pragma unroll
    for (int r = 0; r < 16; ++r) { const int qi = crow(r, hh); const float i0 = 1.0f / __shfl(l0, qi);
        bf16* op = F.H_() + (size_t)(q0 + wid * 32 + qi) * D + h * 128 + r32;
#pragma unroll
        for (int d = 0; d < 4; ++d) op[d * 32] = (bf16)f2bf(o[d][r] * i0); }
}

__device__ __forceinline__ void hgrn_unit_v0(Frame& F, int a) {
    const int dvq = a & 3, dir = (a >> 2) & 1, h = (a >> 3) & 3, b = a >> 5;
    const bf16* Hq = (const bf16*)(F.big_() + B_HQ); const f16* Lf = (const f16*)(F.big_() + (dir ? B_LF1 : B_LF0)); const bf16* Hv = (const bf16*)(F.big_() + B_HV);
    bf16* Ho = (bf16*)(F.big_() + (dir ? B_HO1 : B_HO0));
    LAS float* lq = (LAS float*)F.lds;
    LAS float* lf = lq + 2048;
    LAS float* lk = lf + 2048;
    LAS float* lv = lk + 2048;
    LAS float* part = lv + 512;
    const int tid = F.tid, v = tid & 31, kg = tid >> 5;
    float S[8];
#pragma unroll
    for (int j = 0; j < 8; ++j) S[j] = 0.f;
    for (int ch = 0; ch < RPB / 16; ++ch) {
        for (int e = tid; e < 2048; e += NTHREADS) { const int tok = e >> 7, k = e & 127, n = ch * 16 + tok;
            const int s = dir ? (n < CTXL ? CTXL - 1 - n : RPB + CTXL - 1 - n) : n; const size_t R = (size_t)b * RPB + s;
            lq[e] = bf2f(Hq[R * 512 + h * 128 + k]) * 0.08838834764831845f;
            const float f = fexp((float)Lf[R * 512 + h * 128 + k]); lf[e] = f; lk[e] = 1.0f - f; }
        { const int tok = tid >> 5, n = ch * 16 + tok; const int s = dir ? (n < CTXL ? CTXL - 1 - n : RPB + CTXL - 1 - n) : n; const size_t R = (size_t)b * RPB + s;
            lv[tid] = bf2f(Hv[R * 512 + h * 128 + dvq * 32 + v]); }
        __syncthreads();
#pragma unroll 4
        for (int tok = 0; tok < 16; ++tok) {
            const f32x4 q0 = *(const LAS f32x4*)(lq + tok * 128 + kg * 8), q1 = *(const LAS f32x4*)(lq + tok * 128 + kg * 8 + 4);
            const f32x4 f0 = *(const LAS f32x4*)(lf + tok * 128 + kg * 8), f1 = *(const LAS f32x4*)(lf + tok * 128 + kg * 8 + 4);
            const f32x4 k0 = *(const LAS f32x4*)(lk + tok * 128 + kg * 8), k1 = *(const LAS f32x4*)(lk + tok * 128 + kg * 8 + 4);
            const float vv = lv[tok * 32 + v];
            float po = 0.f;
#pragma unroll
            for (int j = 0; j < 4; ++j) { S[j] = f0[j] * S[j] + k0[j] * vv; po += S[j] * q0[j]; S[4 + j] = f1[j] * S[4 + j] + k1[j] * vv; po += S[4 + j] * q1[j]; }
            part[(tok * 16 + kg) * 32 + v] = po;
        }
        __syncthreads();
        { const int tok = tid >> 5, n = ch * 16 + tok; const int s = dir ? (n < CTXL ? CTXL - 1 - n : RPB + CTXL - 1 - n) : n; const size_t R = (size_t)b * RPB + s;
            float o = 0.f;
#pragma unroll
            for (int g = 0; g < 16; ++g) o += part[(tok * 16 + g) * 32 + v];
            Ho[R * 512 + h * 128 + dvq * 32 + v] = (bf16)f2bf(o); }
        __syncthreads();
    }
}

constexpr int NPHASES = 20;
__global__ void __launch_bounds__(NTHREADS, 2) mk_fwd(Args args) {
    extern __shared__ __attribute__((aligned(16))) unsigned char lds[];
    Frame F;
    F.lds = (LAS unsigned char*)lds;
    F.tid = threadIdx.x; F.lane = F.tid & 63; F.wave = __builtin_amdgcn_readfirstlane(F.tid >> 6); F.G = gridDim.x; F.bid = blockIdx.x;
    F.ar = &args; F.out = args.out; F.ws = args.ws;

    volatile LAS unsigned* MISC = (volatile LAS unsigned*)(F.lds + LDS_MISC);
    for (int u = F.tid; u < 256; u += NTHREADS) MISC[u] = 0u;
    __syncthreads();
    XcdBarrier bar; bar.bar = (unsigned*)(F.ctl_() + CW_BAR); bar.x = 0; bar.st = nullptr;
    if (MK_N_LAUNCHES == 1) bar = xcd_barrier_post((unsigned*)(F.ctl_() + CW_BAR), MISC + 8);
    LAS float* xl = (LAS float*)(F.lds + LDS_XCH);

    const int lo = args.ph_lo, hi = args.ph_hi;
#ifdef DBG_ONLY
#define IN(k) ((k) == DBG_ONLY && lo <= (k) && (k) < hi)
#else
#define IN(k) (lo <= (k) && (k) < hi)
#endif
#define SEAM(k) do { if (IN(k) && IN((k) + 1)) xcd_barrier(bar); } while (0)

    if (IN(0)) { p0_prologue(F); } SEAM(0);
    if (IN(1)) { p_norm0(F); } SEAM(1);
    if (IN(2)) { Gemm g{F.H_(), F.Win0_(), 1024}; SchedGrid S{NT_ALL, 16, F.G, F.bid, false};
        EpiIn0 E{F.big_(), F.ar->in[I_DQG], F.ar->in[I_DKG], F.lbv_(), F.ropeR_(), F.ropeC_()}; run_gemm<0>(F.lds, g, S, E); } SEAM(2);
    if (IN(3)) { for (int a = F.bid; a < 256; a += F.G) hgrn_unit_v0(F, a);
        for (int a = F.bid; a < 288; a += F.G) { if (ATTN_V1 & 1) diff_attn_unit_v1(F, a); else diff_attn_unit_v0(F, a); } } SEAM(3);
    if (IN(4)) { p_hgrn_post(F); } SEAM(4);
    if (IN(5)) { Gemm g{F.H_(), F.Wout0_(), 1024}; SchedGrid S{NT_ALL, 4, F.G, F.bid, false}; EpiOut E{&F, 0, true}; run_gemm<1>(F.lds, g, S, E); } SEAM(5);
    if (IN(6)) { p_norm_route(F, 0, false); } SEAM(6);
    if (IN(7)) { p_permute(F, 0, false);
        Gemm g{F.H_(), F.Wgu_() + (size_t)(0 * 17 + 16) * 1024 * 1024, 1024}; SchedGrid S{NT_ALL, 4, F.G, F.bid, false}; EpiGU E{(bf16*)(F.big_() + B_HS)}; run_gemm<2>(F.lds, g, S, E); } SEAM(7);
    if (IN(8)) { { SchedRouted S; load_expoff(F, 0, S.eo); S.G = F.G; S.c = F.bid; Gemm g{(const bf16*)(F.big_() + B_AP), F.Wgu_() + (size_t)(0 * 17) * 1024 * 1024, 1024}; EpiGU E{(bf16*)(F.big_() + B_HE)}; run_gemm<3>(F.lds, g, S, E); }
        { Gemm g{(const bf16*)(F.big_() + B_HS), F.Wd_() + (size_t)(0 * 17 + 16) * 1024 * 512, 512}; SchedGrid S{NT_ALL, 4, F.G, F.bid, false}; EpiDownS E{&F, 0}; run_gemm<4>(F.lds, g, S, E); } } SEAM(8);
    if (IN(9)) { SchedRouted S; load_expoff(F, 0, S.eo); S.G = F.G; S.c = F.bid; Gemm g{(const bf16*)(F.big_() + B_HE), F.Wd_() + (size_t)(0 * 17) * 1024 * 512, 512}; EpiDownR E{(bf16*)(F.big_() + B_YE)}; run_gemm<5>(F.lds, g, S, E); } SEAM(9);
    if (IN(10)) { p_combine(F, 0, false, true); } SEAM(10);
    if (IN(11)) { Gemm g{F.H_(), F.Win1_(), 1024}; SchedGrid S{NT_ALL, 3, F.G, F.bid, false}; EpiIn1 E{F.big_(), F.ssq_(), F.ar->in[I_KRG], F.ropeR_(), F.ropeC_()}; run_gemm<6>(F.lds, g, S, E); } SEAM(11);
    if (IN(12)) { { Gemm g{(const bf16*)(F.big_() + B_CQ), F.Wuq_(), 384}; SchedGrid S{NT_LAT, 6, F.G, F.bid, true};
            EpiUq E{(bf16*)(F.big_() + B_Q1), F.ssq_(), F.ar->in[I_QNG], F.ar->in[I_QRG], F.ropeR_(), F.ropeC_(), xl}; run_gemm<7>(F.lds, g, S, E); }
        { Gemm g{(const bf16*)(F.big_() + B_CKV), F.Wukv_(), 256}; SchedGrid S{NT_ALL, 8, F.G, F.bid, false};
            EpiUkv E{(bf16*)(F.big_() + B_KN), (bf16*)(F.big_() + B_V1), F.ssq_(), F.ar->in[I_KNG], xl}; run_gemm<8>(F.lds, g, S, E); } } SEAM(12);
    if (IN(13)) { for (int a = F.bid; a < 512; a += F.G) { if (ATTN_V1 & 2) mla_attn_unit_v1(F, a); else mla_attn_unit_v0(F, a); } } SEAM(13);
    if (IN(14)) { Gemm g{F.H_(), F.Wout1_(), 1024}; SchedGrid S{NT_LAT, 4, F.G, F.bid, true}; EpiOut E{&F, 1, false}; run_gemm<9>(F.lds, g, S, E); } SEAM(14);
    if (IN(15)) { p_norm_route(F, 1, true); } SEAM(15);
    if (IN(16)) { p_permute(F, 1, true);
        Gemm g{F.H_(), F.Wgu_() + (size_t)(1 * 17 + 16) * 1024 * 1024, 1024}; SchedGrid S{NT_LAT, 4, F.G, F.bid, true}; EpiGU E{(bf16*)(F.big_() + B_HS)}; run_gemm<10>(F.lds, g, S, E); } SEAM(16);
    if (IN(17)) { { SchedRouted S; load_expoff(F, 1, S.eo); S.G = F.G; S.c = F.bid; Gemm g{(const bf16*)(F.big_() + B_AP), F.Wgu_() + (size_t)(1 * 17) * 1024 * 1024, 1024}; EpiGU E{(bf16*)(F.big_() + B_HE)}; run_gemm<11>(F.lds, g, S, E); }
        { Gemm g{(const bf16*)(F.big_() + B_HS), F.Wd_() + (size_t)(1 * 17 + 16) * 1024 * 512, 512}; SchedGrid S{NT_LAT, 4, F.G, F.bid, true}; EpiDownS E{&F, 1}; run_gemm<12>(F.lds, g, S, E); } } SEAM(17);
    if (IN(18)) { SchedRouted S; load_expoff(F, 1, S.eo); S.G = F.G; S.c = F.bid; Gemm g{(const bf16*)(F.big_() + B_HE), F.Wd_() + (size_t)(1 * 17) * 1024 * 512, 512}; EpiDownR E{(bf16*)(F.big_() + B_YE)}; run_gemm<13>(F.lds, g, S, E); } SEAM(18);
    if (IN(19)) { p_combine(F, 1, true, false); }
#undef IN
#undef SEAM
}

extern "C" void kernel_launch(void* const* d_in, const int* in_sizes, int n_in, void* d_out, int out_size, void* d_ws, size_t ws_size, hipStream_t stream) {
    static int grid = 0;
    if (grid == 0) {
        if (n_in != 34 || in_sizes[0] != NB * SEQ * D || out_size != NB * SEQ * D || ws_size < WS_END) {
            fprintf(stderr, "kernel_launch: unexpected problem: n_in %d in0 %d out %d ws %zu (need %zu); nothing launched\n", n_in, n_in > 0 ? in_sizes[0] : -1, out_size, ws_size, (size_t)WS_END); grid = -1; return; }
        int dev = 0, cus = 0;
        if (hipGetDevice(&dev) != hipSuccess || hipDeviceGetAttribute(&cus, hipDeviceAttributeMultiprocessorCount, dev) != hipSuccess) { grid = -1; return; }
        if (hipFuncSetAttribute((const void*)mk_fwd, hipFuncAttributeMaxDynamicSharedMemorySize, LDS_BYTES) != hipSuccess) { fprintf(stderr, "kernel_launch: hipFuncSetAttribute failed\n"); grid = -1; return; }
        int per_cu = 0;
        if (hipOccupancyMaxActiveBlocksPerMultiprocessor(&per_cu, (const void*)mk_fwd, NTHREADS, LDS_BYTES) != hipSuccess || per_cu < 1) fprintf(stderr, "kernel_launch: note: occupancy query reports %d\n", per_cu);
        (void)hipGetLastError();
        grid = cus;
    }
    if (grid < 0) return;
    if (hipMemsetAsync((char*)d_ws + WS_CTL, 0, CTL_ZERO_BYTES, stream) != hipSuccess) { fprintf(stderr, "kernel_launch: memset failed\n"); return; }
    Args a{};
    for (int i = 0; i < 34; ++i) a.in[i] = (const float*)d_in[i];
    a.out = (float*)d_out; a.ws = (unsigned char*)d_ws;
    if (MK_N_LAUNCHES == 1) { a.ph_lo = 0; a.ph_hi = NPHASES; hipLaunchKernelGGL(mk_fwd, dim3(grid), dim3(NTHREADS), LDS_BYTES, stream, a); }
    else for (int p = 0; p < NPHASES; ++p) { a.ph_lo = p; a.ph_hi = p + 1; hipLaunchKernelGGL(mk_fwd, dim3(grid), dim3(NTHREADS), LDS_BYTES, stream, a); }
    const hipError_t le = hipPeekAtLastError();
    if (le != hipSuccess) fprintf(stderr, "kernel_launch: launch failed: %s\n", hipGetErrorName(le));
}
```

```cpp
#include <hip/hip_runtime.h>
#include <cstdio>
#include <cstdint>

#ifndef MK_N_LAUNCHES
#define MK_N_LAUNCHES 1
#endif

#define GAS __attribute__((address_space(1)))
#define LAS __attribute__((address_space(3)))
typedef unsigned short bf16;
typedef _Float16 f16;
typedef short bf16x8 __attribute__((ext_vector_type(8)));
typedef float f32x4 __attribute__((ext_vector_type(4)));
typedef float f32x2 __attribute__((ext_vector_type(2)));
typedef float f32x16 __attribute__((ext_vector_type(16)));
typedef unsigned v4u __attribute__((ext_vector_type(4)));
typedef unsigned v2u __attribute__((ext_vector_type(2)));
typedef GAS unsigned gu32;
#define RLX_AGENT __ATOMIC_RELAXED, __HIP_MEMORY_SCOPE_AGENT
#define LDS_WAIT() asm volatile("s_waitcnt lgkmcnt(0)" ::: "memory")
#define VM_WAIT() asm volatile("s_waitcnt vmcnt(0)" ::: "memory")
#define EPI_BAR() do { asm volatile("s_waitcnt lgkmcnt(0)" ::: "memory"); __builtin_amdgcn_s_barrier(); asm volatile("" ::: "memory"); } while (0)

constexpr int NB = 8, SEQ = 2048, CTXL = 256, RPB = 2304  , NR = NB * RPB  , D = 1024;
constexpr int NT_ALL = NR / 256  , NT_LAT = 64;
constexpr int NEXP = 16, FF = 512;
constexpr int MP_MAX = 41216;
constexpr float EPS = 1e-6f;
constexpr float LOG2E = 1.4426950408889634f;
constexpr int NWAVES = 8, NTHREADS = 512;

constexpr size_t MiB = 1u << 20;
constexpr size_t WS_CTL = 0, CTL_ZERO_BYTES = 1 * MiB;
constexpr int CW_TMO = 0, CW_CODE = 1, CW_BAR = 4096, CW_CNT = 8192;
constexpr size_t WS_SMALL = 1 * MiB;
constexpr size_t SM_MODV = 0;
constexpr size_t SM_ROPER = 448 * 1024;
constexpr size_t SM_ROPEC = 452 * 1024;
constexpr size_t SM_LBV = 460 * 1024;
constexpr size_t SM_LAM = 464 * 1024;
constexpr size_t SM_ROUTE_E = 512 * 1024;
constexpr size_t SM_ROUTE_W = 584 * 1024;
constexpr size_t SM_ROUTE_S = 728 * 1024;
constexpr size_t SM_POS = 872 * 1024;
constexpr size_t SM_ROWIDX = 1016 * 1024;
constexpr size_t SM_SSQ = 1280 * 1024;
static_assert(SM_ROUTE_E + (size_t)NR * 4 <= SM_ROUTE_W && SM_ROUTE_W + (size_t)NR * 8 <= SM_ROUTE_S && SM_ROUTE_S + (size_t)NR * 8 <= SM_POS && SM_POS + (size_t)NR * 8 <= SM_ROWIDX &&
              SM_ROWIDX + (size_t)MP_MAX * 4 <= SM_SSQ && SM_SSQ + (size_t)NR * 48 <= 3 * MiB, "small map");
constexpr size_t WS_WIN0 = 4 * MiB, WS_WOUT0 = 12 * MiB, WS_WIN1 = 14 * MiB, WS_WUQ = 16 * MiB, WS_WUKV = 18 * MiB, WS_WOUT1 = 19 * MiB;
constexpr size_t WS_WGU = 22 * MiB;
constexpr size_t WS_WD = 90 * MiB;
constexpr size_t WS_XC = 124 * MiB;
constexpr size_t WS_H = 132 * MiB;
constexpr size_t WS_BIG = 168 * MiB;
constexpr size_t WS_END = 348 * MiB;
constexpr size_t SZ18 = 18 * MiB;
constexpr size_t B_QD = 0, B_KD = SZ18, B_VD = 2 * SZ18, B_HQ = 3 * SZ18, B_LF0 = 4 * SZ18, B_LF1 = 5 * SZ18, B_HV = 6 * SZ18, B_HG = 7 * SZ18, B_HO0 = 8 * SZ18, B_HO1 = 9 * SZ18;
constexpr size_t B_HS = 0, B_HE = 18 * MiB, B_YE = 60 * MiB, B_AP = 60 * MiB;
static_assert(B_HE + (size_t)MP_MAX * 512 * 2 <= B_YE && B_YE + (size_t)MP_MAX * 1024 * 2 <= 180 * MiB, "moe map");
constexpr size_t B_CKV = 0, B_CQ = 9 * MiB, B_KR = 23 * MiB, B_Q1 = 26 * MiB, B_KN = 80 * MiB, B_V1 = 116 * MiB;

constexpr int LDS_BYTES = 155648;
constexpr int LDS_MISC = 131072;
constexpr int LDS_XCH = 132096;

__device__ __forceinline__ unsigned f2bf(float f) { unsigned u = __builtin_bit_cast(unsigned, f); return (u + 0x7fffu + ((u >> 16) & 1u)) >> 16; }
__device__ __forceinline__ unsigned pk2(float lo, float hi) { return f2bf(lo) | (f2bf(hi) << 16); }
__device__ __forceinline__ float bf2f(bf16 h) { return __builtin_bit_cast(float, (unsigned)h << 16); }
__device__ __forceinline__ float bflo(unsigned w) { return __builtin_bit_cast(float, w << 16); }
__device__ __forceinline__ float bfhi(unsigned w) { return __builtin_bit_cast(float, w & 0xffff0000u); }
__device__ __forceinline__ unsigned pkh2(float lo, float hi) { f16 a = (f16)lo, b = (f16)hi; return (unsigned)__builtin_bit_cast(unsigned short, a) | ((unsigned)__builtin_bit_cast(unsigned short, b) << 16); }
__device__ __forceinline__ float fexp(float x) { return __builtin_amdgcn_exp2f(x * LOG2E); }
__device__ __forceinline__ float sigmoidf_(float x) { return 1.0f / (1.0f + fexp(-x)); }
__device__ __forceinline__ float siluf_(float x) { return x / (1.0f + fexp(-x)); }
__device__ __forceinline__ float wave_sum(float v) {
#pragma unroll
    for (int o = 1; o < 64; o <<= 1) v += __shfl_xor(v, o);
    return v;
}
__host__ __device__ __forceinline__ int perm32(int rho) { const int n = rho >> 4, i = rho & 15; return 8 * (i >> 2) + 4 * n + (i & 3); }
__host__ __device__ __forceinline__ int ddmap(int j) { return 16 * ((j >> 2) & 1) + 4 * (j >> 3) + (j & 3); }
__device__ __forceinline__ int opaque(int x) { asm volatile("" : "+v"(x)); return x; }
__device__ __forceinline__ int crow(int r, int hi) { return (r & 3) + 8 * (r >> 2) + 4 * hi; }

#define XB_TMO      128
#define XB_XCNT(j)  (256  + 64 * (j))
#define XB_XSUB(j)  (1280 + 64 * (j))
#define XB_XGEN(j)  (2304 + 64 * (j))
#define XB_TOP      3328
#define XB_TOPGEN   3392
#define XCD_BAR_WORDS 3456
#define XB_SPIN_CAP (1u << 18)
__device__ __forceinline__ unsigned xb_ld(unsigned* p)              { return __hip_atomic_load(p, __ATOMIC_RELAXED, __HIP_MEMORY_SCOPE_AGENT); }
__device__ __forceinline__ unsigned xb_add(unsigned* p, unsigned v) { return __hip_atomic_fetch_add(p, v, __ATOMIC_RELAXED, __HIP_MEMORY_SCOPE_AGENT); }
__device__ __forceinline__ unsigned xb_xcc_id() { return (unsigned)__builtin_amdgcn_s_getreg((3 << 11) | 20) & 0xFu; }
#define XB_SPIN(cond, bar) do { unsigned _sp = 0; while (cond) { __builtin_amdgcn_s_sleep(1); \
    if ((++_sp & 255u) == 0u) { if (xb_ld(&(bar)[XB_TMO])) break; if (_sp > XB_SPIN_CAP) { atomicAdd(&(bar)[XB_TMO], 1u); break; } } } } while (0)
struct XcdBarrier { unsigned* bar; unsigned x; volatile LAS unsigned* st; };
__device__ __forceinline__ XcdBarrier xcd_barrier_post(unsigned* bar, volatile LAS unsigned* st) {
    XcdBarrier b; b.bar = bar; b.x = xb_xcc_id(); b.st = st;
    if (threadIdx.x == 0) (void)xb_add(&bar[XB_XCNT(b.x)], 1u);
    return b;
}
__device__ __forceinline__ void xcd_barrier_complete(unsigned* bar, unsigned x, unsigned& nloc, unsigned& nx) {
    const unsigned G = gridDim.x * gridDim.y * gridDim.z;
    unsigned sum, cnt, mine, sp = 0u;
    for (;;) {
        sum = 0u; cnt = 0u; mine = 0u;
#pragma unroll
        for (unsigned j = 0; j < 16; ++j) { const unsigned c = xb_ld(&bar[XB_XCNT(j)]); sum += c; cnt += (c > 0u) ? 1u : 0u; mine = (j == x) ? c : mine; }
        if (sum == G) break;
        __builtin_amdgcn_s_sleep(1);
        if ((++sp & 255u) == 0u) { if (xb_ld(&bar[XB_TMO])) break; if (sp > XB_SPIN_CAP) { atomicAdd(&bar[XB_TMO], 1u); break; } }
    }
    nloc = mine > 0u ? mine : 1u; nx = cnt > 0u ? cnt : 1u;
}
__device__ __forceinline__ void xcd_barrier(const XcdBarrier& b) {
    asm volatile("s_waitcnt vmcnt(0)" ::: "memory");
    __syncthreads();
    if (threadIdx.x == 0) {
        unsigned* bar = b.bar;
        __builtin_amdgcn_s_waitcnt(0);
        unsigned nloc = b.st[0], nx = b.st[1];
        if (nloc == 0u) { xcd_barrier_complete(bar, b.x, nloc, nx); b.st[0] = nloc; b.st[1] = nx; }
        const unsigned old = xb_add(&bar[XB_XSUB(b.x)], 1u);
        const unsigned gen = old / nloc;
        if (old + 1u == (gen + 1u) * nloc) {
            __builtin_amdgcn_fence(__ATOMIC_RELEASE, "agent");
            asm volatile("s_waitcnt vmcnt(0)" ::: "memory");
            const unsigned og = xb_add(&bar[XB_TOP], 1u);
            const unsigned tg = og / nx;
            if (og + 1u == (tg + 1u) * nx) xb_add(&bar[XB_TOPGEN], 1u);
            else XB_SPIN(xb_ld(&bar[XB_TOPGEN]) == tg, bar);
            __builtin_amdgcn_fence(__ATOMIC_ACQUIRE, "agent");
            xb_add(&bar[XB_XGEN(b.x)], 1u);
            asm volatile("s_waitcnt vmcnt(0)" ::: "memory");
        } else {
            XB_SPIN(xb_ld(&bar[XB_XGEN(b.x)]) == gen, bar);
            __builtin_amdgcn_fence(__ATOMIC_ACQUIRE, "agent");
            asm volatile("s_waitcnt vmcnt(0)" ::: "memory");
        }
    }
    __syncthreads();
}

struct Args { const float* in[34]; float* out; unsigned char* ws; int ph_lo, ph_hi; };

struct Frame {
    LAS unsigned char* lds;
    int tid, lane, wave, G, bid;
    const Args* ar;
    float* out; unsigned char* ws;
    __device__ __forceinline__ gu32* ctl_() const { return (gu32*)(ws + WS_CTL); }
    __device__ __forceinline__ float* modv_() const { return (float*)(ws + WS_SMALL + SM_MODV); }
    __device__ __forceinline__ f32x2* ropeR_() const { return (f32x2*)(ws + WS_SMALL + SM_ROPER); }
    __device__ __forceinline__ f32x2* ropeC_() const { return (f32x2*)(ws + WS_SMALL + SM_ROPEC); }
    __device__ __forceinline__ float* lbv_() const { return (float*)(ws + WS_SMALL + SM_LBV); }
    __device__ __forceinline__ float* lamv_() const { return (float*)(ws + WS_SMALL + SM_LAM); }
    __device__ __forceinline__ int* route_e_() const { return (int*)(ws + WS_SMALL + SM_ROUTE_E); }
    __device__ __forceinline__ float* route_w_() const { return (float*)(ws + WS_SMALL + SM_ROUTE_W); }
    __device__ __forceinline__ int* route_s_() const { return (int*)(ws + WS_SMALL + SM_ROUTE_S); }
    __device__ __forceinline__ int* pos_() const { return (int*)(ws + WS_SMALL + SM_POS); }
    __device__ __forceinline__ float* ssq_() const { return (float*)(ws + WS_SMALL + SM_SSQ); }
    __device__ __forceinline__ bf16* Win0_() const { return (bf16*)(ws + WS_WIN0); }
    __device__ __forceinline__ bf16* Wout0_() const { return (bf16*)(ws + WS_WOUT0); }
    __device__ __forceinline__ bf16* Win1_() const { return (bf16*)(ws + WS_WIN1); }
    __device__ __forceinline__ bf16* Wuq_() const { return (bf16*)(ws + WS_WUQ); }
    __device__ __forceinline__ bf16* Wukv_() const { return (bf16*)(ws + WS_WUKV); }
    __device__ __forceinline__ bf16* Wout1_() const { return (bf16*)(ws + WS_WOUT1); }
    __device__ __forceinline__ bf16* Wgu_() const { return (bf16*)(ws + WS_WGU); }
    __device__ __forceinline__ bf16* Wd_() const { return (bf16*)(ws + WS_WD); }
    __device__ __forceinline__ float* xc_() const { return (float*)(ws + WS_XC); }
    __device__ __forceinline__ bf16* H_() const { return (bf16*)(ws + WS_H); }
    __device__ __forceinline__ unsigned char* big_() const { return ws + WS_BIG; }
};
enum { I_X = 0, I_C, I_CTX, I_CCTX, I_MODW, I_MODB, I_NMIX, I_NFFN, I_EWIN, I_EWOUT, I_DQG, I_DKG, I_DLAM, I_DSUBLN, I_LBL, I_HOG, I_OWIN, I_QAG, I_KVAG, I_WUQ, I_WUKV,
       I_QNG, I_QRG, I_KNG, I_KRG, I_OWOUT, I_RW, I_RB, I_EG, I_EU, I_ED, I_SG, I_SU, I_SD };

__device__ __forceinline__ float* xrow_ptr(const Frame& F, int b, int s) { return s < CTXL ? F.xc_() + (size_t)(b * CTXL + s) * D : F.out + (size_t)(b * SEQ + s - CTXL) * D; }
__device__ __forceinline__ const float* xin_ptr(const Frame& F, int b, int s) { return s < CTXL ? F.ar->in[I_CTX] + (size_t)(b * CTXL + s) * D : F.ar->in[I_X] + (size_t)(b * SEQ + s - CTXL) * D; }

__device__ __forceinline__ void p0_transpose_item(const float* W, int ldn, int srccol0, bool perm, const float* kscale, bf16* WT  , int K, int k0, LAS float* scr, int lane) {
    if (srccol0 >= 0) {
#pragma unroll 8
        for (int i = 0; i < 32; ++i) { const int kk = 2 * i + (lane >> 5); float v = W[(size_t)(k0 + kk) * ldn + srccol0 + (lane & 31)]; if (kscale) v *= kscale[k0 + kk]; scr[kk * 33 + (lane & 31)] = v; }
    } else {
#pragma unroll 8
        for (int i = 0; i < 32; ++i) { const int kk = 2 * i + (lane >> 5); scr[kk * 33 + (lane & 31)] = 0.f; }
    }
    LDS_WAIT(); asm volatile("" ::: "memory");
    const int c = lane & 7;
#pragma unroll
    for (int j = 0; j < 4; ++j) { const int n = (lane >> 3) + 8 * j; const int sn = perm ? ddmap(n) : n; const LAS float* s = scr + (8 * c) * 33 + sn;
        v4u o; o.x = pk2(s[0 * 33], s[1 * 33]); o.y = pk2(s[2 * 33], s[3 * 33]); o.z = pk2(s[4 * 33], s[5 * 33]); o.w = pk2(s[6 * 33], s[7 * 33]);
        *(GAS v4u*)(WT + (size_t)n * K + k0 + 8 * c) = o; }
    LDS_WAIT(); asm volatile("" ::: "memory");
}

__device__ __forceinline__ void p0_convert_item(Frame& F, int it, LAS float* scr) {
    const int lane = F.lane;
    if (it < 2048) {
        const int kb = it >> 7, tb = it & 127, pn = tb >> 3, blk = tb & 7, bj = blk >> 2, wc = blk & 3;
        int sb; bool perm = false;
        if (pn < 4) { sb = pn * 8 + 2 * wc + bj; perm = true; } else sb = tb;
        p0_transpose_item(F.ar->in[I_EWIN], 4096, sb * 32, perm, nullptr, F.Win0_() + (size_t)tb * 32 * 1024, 1024, kb * 64, scr, lane); return; }
    it -= 2048;
    if (it < 512) { const int kb = it >> 5, tb = it & 31; p0_transpose_item(F.ar->in[I_EWOUT], 1024, tb * 32, false, nullptr, F.Wout0_() + (size_t)tb * 32 * 1024, 1024, kb * 64, scr, lane); return; }
    it -= 512;
    if (it < 384) {
        const int kb = it / 24, tb = it % 24; int sc; bool perm = false;
        if (tb < 8) sc = 384 + tb * 32;
        else if (tb < 16) sc = (tb - 8) * 32;
        else { const int blk = tb - 16, bj = blk >> 2, wc = blk & 3;
            if (bj == 0) { if (wc < 3) sc = 256 + wc * 32; else { sc = 640; perm = true; } }
            else { if (wc == 0) sc = 352; else if (wc == 3) { sc = 672; perm = true; } else sc = -1; } }
        p0_transpose_item(F.ar->in[I_OWIN], 704, sc, perm, nullptr, F.Win1_() + (size_t)tb * 32 * 1024, 1024, kb * 64, scr, lane); return; }
    it -= 384;
    if (it < 288) {
        const int kb = it / 48, tb = it % 48, t = tb >> 3, blk = tb & 7, bj = blk >> 2, wc = blk & 3; int sc; bool perm = false;
        if (t < 4) { const int h = 2 * t + bj; sc = h * 192 + 32 * wc; }
        else { const int h = 4 * (t - 4) + wc; sc = h * 192 + 128 + 32 * bj; perm = true; }
        p0_transpose_item(F.ar->in[I_WUQ], 1536, sc, perm, F.ar->in[I_QAG], F.Wuq_() + (size_t)tb * 32 * 384, 384, kb * 64, scr, lane); return; }
    it -= 288;
    if (it < 256) { const int kb = it >> 6, tb = it & 63; p0_transpose_item(F.ar->in[I_WUKV], 2048, tb * 32, false, F.ar->in[I_KVAG], F.Wukv_() + (size_t)tb * 32 * 256, 256, kb * 64, scr, lane); return; }
    it -= 256;
    if (it < 512) { const int kb = it >> 5, tb = it & 31; p0_transpose_item(F.ar->in[I_OWOUT], 1024, tb * 32, false, nullptr, F.Wout1_() + (size_t)tb * 32 * 1024, 1024, kb * 64, scr, lane); return; }
    it -= 512;
    {
        const int le = it / 768, r2 = it % 768, l = le / 17, e = le % 17;
        if (r2 < 512) { const int kb = r2 >> 5, tb = r2 & 31, pnl = tb >> 3, blk = tb & 7, bj = blk >> 2, wcb = blk & 3;
            const float* src = (e < 16) ? (bj ? F.ar->in[I_EU] : F.ar->in[I_EG]) + (size_t)(l * 16 + e) * 1024 * 512 : (bj ? F.ar->in[I_SU] : F.ar->in[I_SG]) + (size_t)l * 1024 * 512;
            p0_transpose_item(src, 512, (pnl * 4 + wcb) * 32, false, nullptr, F.Wgu_() + ((size_t)(l * 17 + e) * 1024 + tb * 32) * 1024, 1024, kb * 64, scr, lane); }
        else { const int r3 = r2 - 512, kb = r3 >> 5, tb = r3 & 31;
            const float* src = (e < 16) ? F.ar->in[I_ED] + (size_t)(l * 16 + e) * 512 * 1024 : F.ar->in[I_SD] + (size_t)l * 512 * 1024;
            p0_transpose_item(src, 1024, tb * 32, false, nullptr, F.Wd_() + ((size_t)(l * 17 + e) * 1024 + tb * 32) * 512, 512, kb * 64, scr, lane); }
    }
}
constexpr int P0_NITEMS = 2048 + 512 + 384 + 288 + 256 + 512 + 2 * 17 * 768;

__device__ __forceinline__ void p0_prologue(Frame& F) {
    LAS float* ldsf = (LAS float*)F.lds;
    __syncthreads();
    for (int it = F.bid; it < 192; it += F.G) {
        const int l = it / 96, n0 = (it % 96) * 64;
        LAS float* sc = ldsf;
        LAS float* red = ldsf + 9 * 1024;
        for (int e = F.tid; e < 9 * 1024; e += NTHREADS) { const int r = e >> 10, k = e & 1023; const float v = (r < 8) ? F.ar->in[I_C][r * 1024 + k] : F.ar->in[I_CCTX][k]; sc[e] = siluf_(v); }
        __syncthreads();
        float a[9];
#pragma unroll
        for (int r = 0; r < 9; ++r) a[r] = 0.f;
        const float* w = F.ar->in[I_MODW] + (size_t)l * 1024 * 6144 + n0 + F.lane;
        const int kbeg = F.wave * 128;
#pragma unroll 4
        for (int k = kbeg; k < kbeg + 128; ++k) { const float wv = w[(size_t)k * 6144];
#pragma unroll
            for (int r = 0; r < 9; ++r) a[r] += sc[r * 1024 + k] * wv; }
#pragma unroll
        for (int r = 0; r < 9; ++r) red[(F.wave * 9 + r) * 64 + F.lane] = a[r];
        __syncthreads();
        for (int e = F.tid; e < 9 * 64; e += NTHREADS) { const int r = e >> 6, c = e & 63; float s = 0.f;
#pragma unroll
            for (int w8 = 0; w8 < 8; ++w8) s += red[(w8 * 9 + r) * 64 + c];
            F.modv_()[(size_t)(l * 9 + r) * 6144 + n0 + c] = s + F.ar->in[I_MODB][l * 6144 + n0 + c]; }
        __syncthreads();
    }
    if (F.bid == F.G - 1) {
        for (int e = F.tid; e < 96 * 16; e += NTHREADS) { const int p = e >> 4, i = e & 15;
            const float inv = __builtin_amdgcn_exp2f(-(float)(2 * i) * (1.0f / 32.0f) * 13.287712379549449f);
            const float pos = (p < 32) ? (float)p : (float)(p - 32); const float ang = pos * inv;
            const f32x2 cs = {__cosf(ang), __sinf(ang)};
            if (p < 32) F.ropeR_()[p * 16 + i] = cs; else F.ropeC_()[(p - 32) * 16 + i] = cs; }
        for (int e = F.tid; e < 1024; e += NTHREADS) { const float l0 = F.ar->in[I_LBL][e], l1 = F.ar->in[I_LBL][1024 + e]; F.lbv_()[e] = 1.0f / (1.0f + fexp(l1 - l0)); }
        if (F.wave == 0) { const float* lv = F.ar->in[I_DLAM]; float s1 = wave_sum(lv[F.lane] * lv[64 + F.lane]), s2 = wave_sum(lv[128 + F.lane] * lv[192 + F.lane]);
            if (F.lane == 0) { F.lamv_()[0] = fexp(s1) - fexp(s2) + 0.2f; } }
    }
    __syncthreads();
    LAS float* scr = (LAS float*)(F.lds + F.wave * 8704);
    const int gw = F.bid * NWAVES + F.wave, NGW = F.G * NWAVES;
    for (int it = gw; it < P0_NITEMS; it += NGW) p0_convert_item(F, it, scr);
}

__device__ __forceinline__ void modnorm_store(const f32x4 (&v)[4], const float* gain, const float* sh, const float* sc, bf16* orow, int lane) {
    float s = 0.f;
#pragma unroll
    for (int j = 0; j < 4; ++j) s += (v[j].x * v[j].x + v[j].y * v[j].y) + (v[j].z * v[j].z + v[j].w * v[j].w);
    const float rstd = 1.0f / sqrtf(wave_sum(s) * (1.0f / D) + EPS);
#pragma unroll
    for (int j = 0; j < 4; ++j) { const int c = 4 * (lane + 64 * j);
        const f32x4 g = *(const f32x4*)(gain + c), a = *(const f32x4*)(sc + c), b = *(const f32x4*)(sh + c);
        const f32x4 y = (v[j] * rstd) * g * (1.0f + a) + b;
        v2u o; o.x = pk2(y.x, y.y); o.y = pk2(y.z, y.w); *(v2u*)(orow + c) = o; }
}

__device__ __forceinline__ void p_norm0(Frame& F) {
    const int gw = F.bid * NWAVES + F.wave, NGW = F.G * NWAVES;
    for (int R = gw; R < NR; R += NGW) {
        const int b = R / RPB, s = R - b * RPB, r = s < CTXL ? 8 : b;
        const f32x4* src = (const f32x4*)xin_ptr(F, b, s) + F.lane;
        f32x4 v[4];
#pragma unroll
        for (int j = 0; j < 4; ++j) v[j] = src[64 * j];
        const float* mv = F.modv_() + (size_t)(0 * 9 + r) * 6144;
        modnorm_store(v, F.ar->in[I_NMIX], mv + 0, mv + 1024, F.H_() + (size_t)R * D, F.lane);
    }
}

__device__ __forceinline__ void p_hgrn_post(Frame& F) {
    const int gw = F.bid * NWAVES + F.wave, NGW = F.G * NWAVES;
    const bf16* Ho0 = (const bf16*)(F.big_() + B_HO0); const bf16* Ho1 = (const bf16*)(F.big_() + B_HO1); const bf16* Hg = (const bf16*)(F.big_() + B_HG);
    for (int R = gw; R < NR; R += NGW) {
        const int c = F.lane * 8;
        const v4u a = *(const v4u*)(Ho0 + (size_t)R * 512 + c), bq = *(const v4u*)(Ho1 + (size_t)R * 512 + c), g = *(const v4u*)(Hg + (size_t)R * 512 + c);
        float o[8];
        o[0] = bflo(a.x) + bflo(bq.x); o[1] = bfhi(a.x) + bfhi(bq.x); o[2] = bflo(a.y) + bflo(bq.y); o[3] = bfhi(a.y) + bfhi(bq.y);
        o[4] = bflo(a.z) + bflo(bq.z); o[5] = bfhi(a.z) + bfhi(bq.z); o[6] = bflo(a.w) + bflo(bq.w); o[7] = bfhi(a.w) + bfhi(bq.w);
        float s = 0.f;
#pragma unroll
        for (int i = 0; i < 8; ++i) s += o[i] * o[i];
        s += __shfl_xor(s, 1); s += __shfl_xor(s, 2); s += __shfl_xor(s, 4); s += __shfl_xor(s, 8);
        const float rstd = 1.0f / sqrtf(s * (1.0f / 128.0f) + EPS);
        const float* og = F.ar->in[I_HOG] + (c & 127);
        const float gg[8] = {bflo(g.x), bfhi(g.x), bflo(g.y), bfhi(g.y), bflo(g.z), bfhi(g.z), bflo(g.w), bfhi(g.w)};
        float y[8];
#pragma unroll
        for (int i = 0; i < 8; ++i) y[i] = o[i] * rstd * og[i] * gg[i];
        v4u w; w.x = pk2(y[0], y[1]); w.y = pk2(y[2], y[3]); w.z = pk2(y[4], y[5]); w.w = pk2(y[6], y[7]);
        *(v4u*)(F.H_() + (size_t)R * D + 512 + c) = w;
    }
}

__device__ __forceinline__ void p_norm_route(Frame& F, int layer, bool lat_only) {
    const int gw = F.bid * NWAVES + F.wave, NGW = F.G * NWAVES;
    const float* rw = F.ar->in[I_RW];
    unsigned* cnt = (unsigned*)(F.ctl_() + CW_CNT + 64 * layer);
    for (int R = gw; R < NR; R += NGW) {
        const int b = R / RPB, s = R - b * RPB, r = s < CTXL ? 8 : b;
        if (lat_only && s < CTXL) continue;
        const f32x4* src = (const f32x4*)xrow_ptr(F, b, s) + F.lane;
        f32x4 v[4];
#pragma unroll
        for (int j = 0; j < 4; ++j) v[j] = src[64 * j];
        const float* mv = F.modv_() + (size_t)(layer * 9 + r) * 6144;
        const float* gain = F.ar->in[I_NFFN] + layer * 1024; const float* sh = mv + 3072; const float* sc = mv + 4096;
        float ss = 0.f;
#pragma unroll
        for (int j = 0; j < 4; ++j) ss += (v[j].x * v[j].x + v[j].y * v[j].y) + (v[j].z * v[j].z + v[j].w * v[j].w);
        const float rstd = 1.0f / sqrtf(wave_sum(ss) * (1.0f / D) + EPS);
        float lg[16];
#pragma unroll
        for (int e = 0; e < 16; ++e) lg[e] = 0.f;
#pragma unroll
        for (int j = 0; j < 4; ++j) { const int c = 4 * (F.lane + 64 * j);
            const f32x4 g = *(const f32x4*)(gain + c), a = *(const f32x4*)(sc + c), bb = *(const f32x4*)(sh + c);
            const f32x4 y = (v[j] * rstd) * g * (1.0f + a) + bb;
            v2u o; o.x = pk2(y.x, y.y); o.y = pk2(y.z, y.w); *(v2u*)(F.H_() + (size_t)R * D + c) = o;
#pragma unroll
            for (int q = 0; q < 4; ++q) { const float yv = y[q]; const f32x4* wr = (const f32x4*)(rw + (size_t)(c + q) * 16);
                const f32x4 w0 = wr[0], w1 = wr[1], w2 = wr[2], w3 = wr[3];
                lg[0] += yv * w0.x; lg[1] += yv * w0.y; lg[2] += yv * w0.z; lg[3] += yv * w0.w;
                lg[4] += yv * w1.x; lg[5] += yv * w1.y; lg[6] += yv * w1.z; lg[7] += yv * w1.w;
                lg[8] += yv * w2.x; lg[9] += yv * w2.y; lg[10] += yv * w2.z; lg[11] += yv * w2.w;
                lg[12] += yv * w3.x; lg[13] += yv * w3.y; lg[14] += yv * w3.z; lg[15] += yv * w3.w; } }
#pragma unroll
        for (int e = 0; e < 16; ++e) lg[e] = wave_sum(lg[e]);
        float scv[16], bi[16];
#pragma unroll
        for (int e = 0; e < 16; ++e) { scv[e] = sigmoidf_(lg[e]); bi[e] = scv[e] + F.ar->in[I_RB][e]; }
        float bestgs = -3.0e38f; int e1 = 0, e2 = 1; float w1 = 0.f, w2 = 0.f;
#pragma unroll
        for (int g = 0; g < 4; ++g) {
            const float x0 = bi[4 * g], x1 = bi[4 * g + 1], x2 = bi[4 * g + 2], x3 = bi[4 * g + 3];
            const float gs = fmaxf(fmaxf(fmaxf(x0 + x1, x0 + x2), fmaxf(x0 + x3, x1 + x2)), fmaxf(x1 + x3, x2 + x3));
            int i1 = 0; float m1 = x0;
            if (x1 > m1) { m1 = x1; i1 = 1; } if (x2 > m1) { m1 = x2; i1 = 2; } if (x3 > m1) { m1 = x3; i1 = 3; }
            int i2 = -1; float m2 = -3.0e38f;
            if (i1 != 0 && x0 > m2) { m2 = x0; i2 = 0; } if (i1 != 1 && x1 > m2) { m2 = x1; i2 = 1; } if (i1 != 2 && x2 > m2) { m2 = x2; i2 = 2; } if (i1 != 3 && x3 > m2) { m2 = x3; i2 = 3; }
            const float s0 = scv[4 * g], s1 = scv[4 * g + 1], s2 = scv[4 * g + 2], s3 = scv[4 * g + 3];
            const float wa = i1 == 0 ? s0 : i1 == 1 ? s1 : i1 == 2 ? s2 : s3;
            const float wb = i2 == 0 ? s0 : i2 == 1 ? s1 : i2 == 2 ? s2 : s3;
            if (gs > bestgs) { bestgs = gs; e1 = 4 * g + i1; e2 = 4 * g + i2; w1 = wa; w2 = wb; }
        }
        const float wn = 1.0f / (w1 + w2); w1 *= wn; w2 *= wn;
        if (F.lane == 0) {
            const unsigned s1 = __hip_atomic_fetch_add(cnt + e1, 1u, RLX_AGENT), s2 = __hip_atomic_fetch_add(cnt + e2, 1u, RLX_AGENT);
            F.route_e_()[R] = e1 | (e2 << 8); F.route_w_()[2 * R] = w1; F.route_w_()[2 * R + 1] = w2; F.route_s_()[2 * R] = (int)s1; F.route_s_()[2 * R + 1] = (int)s2;
        }
    }
}

struct ExpOff { int off[17]; };
__device__ __forceinline__ void load_expoff(Frame& F, int layer, ExpOff& eo) {
    const unsigned* cnt = (const unsigned*)(F.ctl_() + CW_CNT + 64 * layer); int a = 0;
#pragma unroll
    for (int e = 0; e < 16; ++e) { eo.off[e] = a; const int c = __builtin_amdgcn_readfirstlane((int)__hip_atomic_load(cnt + e, RLX_AGENT)); a += (c + 255) & ~255; }
    eo.off[16] = a;
}
__device__ __forceinline__ int expoff_sel(const ExpOff& eo, int e) { int r = 0;
#pragma unroll
    for (int i = 0; i < 16; ++i) r = (e == i) ? eo.off[i] : r;
    return r; }

__device__ __forceinline__ void p_permute(Frame& F, int layer, bool lat_only) {
    ExpOff eo; load_expoff(F, layer, eo);
    const int gw = F.bid * NWAVES + F.wave, NGW = F.G * NWAVES;
    bf16* AP = (bf16*)(F.big_() + B_AP);
    for (int R = gw; R < NR; R += NGW) {
        const int s = R % RPB; if (lat_only && s < CTXL) continue;
        const int ee = F.route_e_()[R], e1 = ee & 255, e2 = ee >> 8;
        const int p1 = expoff_sel(eo, e1) + F.route_s_()[2 * R], p2 = expoff_sel(eo, e2) + F.route_s_()[2 * R + 1];
        if (F.lane == 0) { F.pos_()[2 * R] = p1; F.pos_()[2 * R + 1] = p2; }
        const v4u* src = (const v4u*)(F.H_() + (size_t)R * D) + F.lane;
        const v4u a0 = src[0], a1 = src[64];
        v4u* d1 = (v4u*)(AP + (size_t)p1 * D) + F.lane; v4u* d2 = (v4u*)(AP + (size_t)p2 * D) + F.lane;
        d1[0] = a0; d1[64] = a1; d2[0] = a0; d2[64] = a1;
    }
}

__device__ __forceinline__ void p_combine(Frame& F, int layer, bool lat_only, bool do_norm) {
    const int gw = F.bid * NWAVES + F.wave, NGW = F.G * NWAVES;
    const bf16* Ye = (const bf16*)(F.big_() + B_YE);
    for (int R = gw; R < NR; R += NGW) {
        const int b = R / RPB, s = R - b * RPB, r = s < CTXL ? 8 : b;
        if (lat_only && s < CTXL) continue;
        float* xr = xrow_ptr(F, b, s);
        const float* gf = F.modv_() + (size_t)(layer * 9 + r) * 6144 + 5120;
        const int p1 = F.pos_()[2 * R], p2 = F.pos_()[2 * R + 1]; const float w1 = F.route_w_()[2 * R], w2 = F.route_w_()[2 * R + 1];
        f32x4 v[4];
#pragma unroll
        for (int j = 0; j < 4; ++j) { const int c = 4 * (F.lane + 64 * j);
            const f32x4 x = *(const f32x4*)(xr + c), g = *(const f32x4*)(gf + c);
            const v2u a = *(const v2u*)(Ye + (size_t)p1 * D + c), bq = *(const v2u*)(Ye + (size_t)p2 * D + c);
            f32x4 m; m.x = w1 * bflo(a.x) + w2 * bflo(bq.x); m.y = w1 * bfhi(a.x) + w2 * bfhi(bq.x); m.z = w1 * bflo(a.y) + w2 * bflo(bq.y); m.w = w1 * bfhi(a.y) + w2 * bfhi(bq.y);
            v[j] = x + g * m; *(f32x4*)(xr + c) = v[j]; }
        if (do_norm) { const float* mv = F.modv_() + (size_t)((layer + 1) * 9 + r) * 6144;
            modnorm_store(v, F.ar->in[I_NMIX] + (layer + 1) * 1024, mv + 0, mv + 1024, F.H_() + (size_t)R * D, F.lane); }
    }
}

struct Unit { int pm, pn; };
struct Gemm { const bf16* A; const bf16* Bt; int K; };
template <class Epi, class Sched>
__device__ __forceinline__ void gemm_v0(const Gemm g, const Sched& S, const Epi& E) {
    const int tid = opaque((int)threadIdx.x), wid = __builtin_amdgcn_readfirstlane(tid >> 6), lane = tid & 63, wr = wid >> 2, wc = wid & 3, fr = lane & 15, fq = lane >> 4;
    const int K = g.K;
    Unit u;
    for (int i = 0; S.next(i, u); ++i) {
        f32x4 acc[2][2][4][2];
#pragma unroll
        for (int a = 0; a < 2; ++a)
#pragma unroll
            for (int b = 0; b < 2; ++b)
#pragma unroll
                for (int m = 0; m < 4; ++m)
#pragma unroll
                    for (int n = 0; n < 2; ++n) acc[a][b][m][n] = (f32x4){0.f, 0.f, 0.f, 0.f};
        unsigned aoff[2][4], boff[2][2];
#pragma unroll
        for (int ai = 0; ai < 2; ++ai)
#pragma unroll
            for (int m = 0; m < 4; ++m) { const int rr = u.pm * 256 + ai * 128 + wr * 64 + m * 16 + fr; const int arow = rr; aoff[ai][m] = (unsigned)arow * (unsigned)K * 2u + fq * 16u; }
#pragma unroll
        for (int bj = 0; bj < 2; ++bj)
#pragma unroll
            for (int n = 0; n < 2; ++n) { const int rho = 16 * n + fr; const int brow = u.pn * 256 + bj * 128 + wc * 32 + (Epi::PERM ? perm32(rho) : rho); boff[bj][n] = (unsigned)brow * (unsigned)K * 2u + fq * 16u; }
        const char* Ab = (const char*)g.A; const char* Bb = (const char*)g.Bt;
        for (int kt = 0; kt < K; kt += 32) {
            bf16x8 b[2][2];
#pragma unroll
            for (int bj = 0; bj < 2; ++bj)
#pragma unroll
                for (int n = 0; n < 2; ++n) b[bj][n] = *(const bf16x8*)(Bb + boff[bj][n] + kt * 2);
#pragma unroll
            for (int ai = 0; ai < 2; ++ai) {
                bf16x8 a[4];
#pragma unroll
                for (int m = 0; m < 4; ++m) a[m] = *(const bf16x8*)(Ab + aoff[ai][m] + kt * 2);
#pragma unroll
                for (int bj = 0; bj < 2; ++bj)
#pragma unroll
                    for (int m = 0; m < 4; ++m)
#pragma unroll
                        for (int n = 0; n < 2; ++n) acc[ai][bj][m][n] = __builtin_amdgcn_mfma_f32_16x16x32_bf16(b[bj][n], a[m], acc[ai][bj][m][n], 0, 0, 0);
                asm volatile("" ::: "memory");
            }
        }
        E(acc, u, wr, wc, fr, fq);
    }
}


constexpr int BM = 256, BK = 64, HALF = 128, HTB = HALF * BK * 2, STAGE_BYTES = 8 * HTB, NXCD = 8, WGM = 8;
__host__ __device__ __forceinline__ int lds_byte(int r, int c) { const int st = (r >> 4) * 2 + (c >> 5), rr = r & 15, cc = c & 31, ob = rr * 64 + cc * 2; return st * 1024 + (ob ^ (((ob >> 9) & 1) << 5)); }
__host__ __device__ __forceinline__ void stage_rc(int b, int& R, int& C) { const int st = b / 1024, sb = b % 1024, swz = sb ^ (((sb >> 9) & 1) << 5); R = (st >> 1) * 16 + swz / 64; C = (st & 1) * 32 + (swz % 64) / 2; }
template <class Epi, class Sched, bool ALIGN_EPI = false, bool SP2 = false>
__device__ __forceinline__ void gemm_phase(LAS unsigned char* lds, const Gemm g, const Sched& S, const Epi& E) {
    const int tid = opaque((int)threadIdx.x), wid = __builtin_amdgcn_readfirstlane(tid >> 6), lane = tid & 63, wr = wid >> 2, wc = wid & 3, fr = lane & 15, fq = lane >> 4;
    const int K = g.K, nt = K / BK;
    unsigned voffA[2], voffB[2];
#pragma unroll
    for (int i = 0; i < 2; ++i) { int R, C; stage_rc(tid * 16 + i * 8192, R, C); const int Rb = Epi::PERM ? ((R & ~31) + perm32(R & 31)) : R;
        voffA[i] = (unsigned)(R * K + C) * 2u; voffB[i] = (unsigned)(Rb * K + C) * 2u; }
    const size_t kstep = (size_t)(BK * 2);
    const size_t hstep = (size_t)HALF * K * 2;
    const size_t tstep = 2 * hstep;
    const unsigned ldsw = (unsigned)wid * 1024u;
    const int aoff = lds_byte(wr * 64 + fr, fq * 8), boff = lds_byte(wc * 32 + fr, fq * 8);
#define PG8_SA(b, h) (((b) * 2 + (h)) * HTB)
#define PG8_SB(b, h) ((4 + (b) * 2 + (h)) * HTB)
#define PG8_STAGE(bufoff, gbase, voff) do { _Pragma("unroll") for (int _i = 0; _i < 2; ++_i) \
        __builtin_amdgcn_global_load_lds((const unsigned*)((const char*)(gbase) + (voff)[_i]), (LAS unsigned*)(lds + (bufoff) + ldsw + _i * 8192), 16, 0, 0); } while (0)
#define PG8_LDA(dst, b, h) do { _Pragma("unroll") for (int m = 0; m < 4; ++m) _Pragma("unroll") for (int k = 0; k < 2; ++k) dst[m][k] = *(const LAS bf16x8*)(lds + PG8_SA(b, h) + aoff + m * 2048 + k * 1024); } while (0)
#define PG8_LDB(dst, b, h) do { _Pragma("unroll") for (int n = 0; n < 2; ++n) _Pragma("unroll") for (int k = 0; k < 2; ++k) dst[n][k] = *(const LAS bf16x8*)(lds + PG8_SB(b, h) + boff + n * 2048 + k * 1024); } while (0)
#define PG8_MMA(ai, bj, At, Bt) do { __builtin_amdgcn_s_setprio(1); _Pragma("unroll") for (int m = 0; m < 4; ++m) _Pragma("unroll") for (int n = 0; n < 2; ++n) _Pragma("unroll") for (int k = 0; k < 2; ++k) \
        acc[ai][bj][m][n] = __builtin_amdgcn_mfma_f32_16x16x32_bf16(Bt[n][k], At[m][k], acc[ai][bj][m][n], 0, 0, 0); __builtin_amdgcn_s_setprio(0); } while (0)
#define PG8_WAIT_V(n) asm volatile("s_waitcnt vmcnt(" #n ")" ::: "memory")
#define PG8_WAIT_L(n) asm volatile("s_waitcnt lgkmcnt(" #n ")" ::: "memory")
#define PG8_BAR __builtin_amdgcn_s_barrier()
#define PG8_SCHED __builtin_amdgcn_sched_barrier(0)
    Unit cur, nxt; int ui = 0;
    if (!S.next(0, cur)) return;
    f32x4 acc[2][2][4][2];
#pragma unroll
    for (int a = 0; a < 2; ++a)
#pragma unroll
        for (int b = 0; b < 2; ++b)
#pragma unroll
            for (int m = 0; m < 4; ++m)
#pragma unroll
                for (int n = 0; n < 2; ++n) acc[a][b][m][n] = (f32x4){0.f, 0.f, 0.f, 0.f};
    bf16x8 At[4][2], B0[2][2], B1[2][2];
    const char* cA = (const char*)g.A + (size_t)cur.pm * tstep; const char* cB = (const char*)g.Bt + (size_t)cur.pn * tstep;
    S.a_ready(cur);
    if constexpr (SP2) {
        PG8_STAGE(PG8_SB(0, 0), cB, voffB); PG8_STAGE(PG8_SB(0, 1), cB + hstep, voffB); PG8_STAGE(PG8_SA(0, 0), cA, voffA); PG8_STAGE(PG8_SA(0, 1), cA + hstep, voffA);
        if (wr == 1) PG8_BAR;
        PG8_WAIT_V(2); PG8_BAR;
        PG8_STAGE(PG8_SB(1, 0), cB + kstep, voffB); PG8_STAGE(PG8_SA(1, 0), cA + kstep, voffA); PG8_STAGE(PG8_SB(1, 1), cB + hstep + kstep, voffB);
        PG8_WAIT_V(6); PG8_BAR;
    } else {
        PG8_STAGE(PG8_SB(0, 0), cB, voffB); PG8_STAGE(PG8_SA(0, 0), cA, voffA); PG8_STAGE(PG8_SB(0, 1), cB + hstep, voffB); PG8_STAGE(PG8_SA(0, 1), cA + hstep, voffA);
        if (wr == 1) PG8_BAR;
        PG8_WAIT_V(4); PG8_BAR;
        PG8_STAGE(PG8_SB(1, 0), cB + kstep, voffB); PG8_STAGE(PG8_SA(1, 0), cA + kstep, voffA); PG8_STAGE(PG8_SB(1, 1), cB + hstep + kstep, voffB);
        PG8_WAIT_V(6); PG8_BAR;
    }
    for (;;) {
        const bool has_next = S.next(ui + 1, nxt);
        const char* nA = has_next ? (const char*)g.A + (size_t)nxt.pm * tstep : cA; const char* nB = has_next ? (const char*)g.Bt + (size_t)nxt.pn * tstep : cB;
#pragma unroll 1
        for (int t = 0; t < nt; t += 2) {
            const bool last = (t == nt - 2);
            const char* a1 = cA + (size_t)(t + 1) * kstep;
            const char* a2 = last ? nA : cA + (size_t)(t + 2) * kstep; const char* b2 = last ? nB : cB + (size_t)(t + 2) * kstep;
            const char* a3 = a2 + kstep; const char* b3 = b2 + kstep;
            if (last && has_next) S.a_ready(nxt);
            if constexpr (SP2) {
            PG8_LDB(B0, 0, 0); PG8_LDB(B1, 0, 1); PG8_SCHED; PG8_LDA(At, 0, 0); PG8_STAGE(PG8_SA(1, 1), a1 + hstep, voffA);
            PG8_WAIT_V(8); PG8_WAIT_L(0); PG8_BAR; PG8_MMA(0, 0, At, B0); PG8_MMA(0, 1, At, B1); PG8_BAR; PG8_SCHED;
            PG8_LDA(At, 0, 1); PG8_STAGE(PG8_SB(0, 0), b2, voffB); PG8_STAGE(PG8_SB(0, 1), b2 + hstep, voffB); PG8_STAGE(PG8_SA(0, 0), a2, voffA);
            PG8_WAIT_V(8); PG8_WAIT_L(0); PG8_BAR; PG8_MMA(1, 0, At, B0); PG8_MMA(1, 1, At, B1); PG8_BAR; PG8_SCHED;
            PG8_LDB(B0, 1, 0); PG8_LDB(B1, 1, 1); PG8_SCHED; PG8_LDA(At, 1, 0); PG8_STAGE(PG8_SA(0, 1), a2 + hstep, voffA);
            PG8_WAIT_V(8); PG8_WAIT_L(0); PG8_BAR; PG8_MMA(0, 0, At, B0); PG8_MMA(0, 1, At, B1); PG8_BAR; PG8_SCHED;
            PG8_LDA(At, 1, 1); PG8_STAGE(PG8_SB(1, 0), b3, voffB); PG8_STAGE(PG8_SB(1, 1), b3 + hstep, voffB); PG8_STAGE(PG8_SA(1, 0), a3, voffA);
            PG8_WAIT_V(8); PG8_WAIT_L(0); PG8_BAR; PG8_MMA(1, 0, At, B0); PG8_MMA(1, 1, At, B1); PG8_BAR; PG8_SCHED;
            } else {
            PG8_LDB(B0, 0, 0); PG8_SCHED; PG8_LDA(At, 0, 0); PG8_STAGE(PG8_SA(1, 1), a1 + hstep, voffA);
            PG8_WAIT_L(8); PG8_BAR; PG8_WAIT_L(0); PG8_MMA(0, 0, At, B0); PG8_BAR; PG8_SCHED;
            PG8_LDB(B1, 0, 1); PG8_STAGE(PG8_SB(0, 0), b2, voffB);
            PG8_BAR; PG8_WAIT_L(0); PG8_MMA(0, 1, At, B1); PG8_BAR;
            PG8_LDA(At, 0, 1); PG8_STAGE(PG8_SA(0, 0), a2, voffA);
            PG8_BAR; PG8_WAIT_L(0); PG8_MMA(1, 0, At, B0); PG8_BAR; PG8_SCHED;
            PG8_STAGE(PG8_SB(0, 1), b2 + hstep, voffB);
            PG8_WAIT_V(6); PG8_BAR; PG8_MMA(1, 1, At, B1); PG8_BAR;
            PG8_LDB(B0, 1, 0); PG8_SCHED; PG8_LDA(At, 1, 0); PG8_STAGE(PG8_SA(0, 1), a2 + hstep, voffA);
            PG8_WAIT_L(8); PG8_BAR; PG8_WAIT_L(0); PG8_MMA(0, 0, At, B0); PG8_BAR; PG8_SCHED;
            PG8_LDB(B1, 1, 1); PG8_STAGE(PG8_SB(1, 0), b3, voffB);
            PG8_BAR; PG8_WAIT_L(0); PG8_MMA(0, 1, At, B1); PG8_BAR;
            PG8_LDA(At, 1, 1); PG8_STAGE(PG8_SA(1, 0), a3, voffA);
            PG8_BAR; PG8_WAIT_L(0); PG8_MMA(1, 0, At, B0); PG8_BAR; PG8_SCHED;
            PG8_STAGE(PG8_SB(1, 1), b3 + hstep, voffB);
            PG8_WAIT_V(6); PG8_BAR; PG8_MMA(1, 1, At, B1); PG8_BAR;
            }
        }
        if constexpr (ALIGN_EPI) { if (wr == 0) PG8_BAR; }
        if constexpr (!Epi::AFTER_DRAIN) { E(acc, cur, wr, wc, fr, fq); S.done(cur); }
        if (!has_next) break;
#pragma unroll
        for (int a = 0; a < 2; ++a)
#pragma unroll
            for (int b = 0; b < 2; ++b)
#pragma unroll
                for (int m = 0; m < 4; ++m)
#pragma unroll
                    for (int n = 0; n < 2; ++n) acc[a][b][m][n] = (f32x4){0.f, 0.f, 0.f, 0.f};
        cur = nxt; cA = nA; cB = nB; ++ui;
        if constexpr (ALIGN_EPI) { if (wr == 1) PG8_BAR; }
    }
    PG8_WAIT_V(0);
    if constexpr (!ALIGN_EPI) { if (wr == 0) PG8_BAR; }
    PG8_BAR;
    if constexpr (Epi::AFTER_DRAIN) { E.fused(acc, cur, wr, wc, fr, fq, lds, wid, lane); S.done(cur); }
#undef PG8_SA
#undef PG8_SB
#undef PG8_STAGE
#undef PG8_LDA
#undef PG8_LDB
#undef PG8_MMA
#undef PG8_WAIT_V
#undef PG8_WAIT_L
#undef PG8_BAR
#undef PG8_SCHED
}


__device__ __forceinline__ int xcd_remap(int L, int nwg) { const int q = nwg / NXCD, r = nwg % NXCD, xcd = L % NXCD, off = L / NXCD; return (xcd < r ? xcd * (q + 1) : r * (q + 1) + (xcd - r) * q) + off; }
struct SchedGrid {
    int nm, nn, G, c; bool lat;
    __device__ __forceinline__ bool next(int i, Unit& u) const { const int nwg = nm * nn; const int L = i * G + c; if (L >= nwg) return false;
        const int wgid = xcd_remap(L, nwg); const int nig = WGM * nn, gid = wgid / nig, fm = gid * WGM, gsz = (nm - fm) < WGM ? (nm - fm) : WGM;
        int pm = fm + ((wgid % nig) % gsz); u.pn = (wgid % nig) / gsz; if (lat) pm = (pm >> 3) * 9 + 1 + (pm & 7); u.pm = pm; return true; }
    __device__ __forceinline__ void a_ready(const Unit&) const {}
    __device__ __forceinline__ void done(const Unit&) const {}
};
struct SchedRouted {
    ExpOff eo; int G, c;
    __device__ __forceinline__ bool next(int i, Unit& u) const { const int nt = eo.off[16] >> 8, nwg = nt * 4; const int L = i * G + c; if (L >= nwg) return false;
        const int wgid = xcd_remap(L, nwg); const int pm = wgid >> 2, pnl = wgid & 3; int e = 0;
#pragma unroll
        for (int k = 1; k < 16; ++k) e += (pm * 256 >= eo.off[k]) ? 1 : 0;
        u.pm = pm; u.pn = e * 4 + pnl; return true; }
    __device__ __forceinline__ void a_ready(const Unit&) const {}
    __device__ __forceinline__ void done(const Unit&) const {}
};

#ifndef PROBE_REP
#define PROBE_REP -1
#endif
#define REP(k) for (int rep_ = 0; rep_ < ((PROBE_REP == (k)) ? 2 : 1); ++rep_)
#ifndef ATTN_V1
#define ATTN_V1 3
#endif
#ifndef HGRN_V1
#define HGRN_V1 1
#endif
#ifndef PG8_MASK
#define PG8_MASK 0xffffffffu
#endif
template <int ID, class Epi, class Sched>
__device__ __forceinline__ void run_gemm(LAS unsigned char* lds, const Gemm g, const Sched& S, const Epi& E) {
    if constexpr ((PG8_MASK >> ID) & 1u) gemm_phase<Epi, Sched, true, true>(lds, g, S, E); else gemm_v0(g, S, E);
}

__device__ __forceinline__ v4u pack8(const f32x4 a, const f32x4 b) { v4u w; w.x = pk2(a[0], a[1]); w.y = pk2(a[2], a[3]); w.z = pk2(b[0], b[1]); w.w = pk2(b[2], b[3]); return w; }

struct EpiIn0 {
    static constexpr bool PERM = true, AFTER_DRAIN = false;
    unsigned char* big; const float *qg, *kg, *lbv; const f32x2 *ropeR, *ropeC;
    __device__ __forceinline__ void operator()(const f32x4 (&acc)[2][2][4][2], const Unit& u, int wr, int wc, int fr, int fq) const {
        const int pn = u.pn, type = pn >> 1, j9 = u.pm % 9; const bool lat = j9 > 0;
        if (type < 2) {
            const float* gain = type ? kg : qg; bf16* dst = (bf16*)(big + (type ? B_KD : B_QD));
            const int h = 2 * (pn & 1) + (wc >> 1), c = wc & 1;
            f32x4 g[2][2];
#pragma unroll
            for (int bj = 0; bj < 2; ++bj)
#pragma unroll
                for (int n = 0; n < 2; ++n) g[bj][n] = *(const f32x4*)(gain + 32 * bj + 16 * n + 4 * fq);
#pragma unroll
            for (int ai = 0; ai < 2; ++ai)
#pragma unroll
                for (int m = 0; m < 4; ++m) {
                    const int rr = opaque(ai * 128 + wr * 64 + m * 16 + fr); const size_t R = (size_t)u.pm * 256 + rr;
                    float s = 0.f;
#pragma unroll
                    for (int bj = 0; bj < 2; ++bj)
#pragma unroll
                        for (int n = 0; n < 2; ++n) { const f32x4 x = acc[ai][bj][m][n]; s += (x[0] * x[0] + x[1] * x[1]) + (x[2] * x[2] + x[3] * x[3]); }
                    s += __shfl_xor(s, 16); s += __shfl_xor(s, 32);
                    const float rstd = 1.0f / sqrtf(s * (1.0f / 64.0f) + EPS);
                    f32x4 y[2][2];
#pragma unroll
                    for (int bj = 0; bj < 2; ++bj)
#pragma unroll
                        for (int n = 0; n < 2; ++n) y[bj][n] = acc[ai][bj][m][n] * (type == 0 ? rstd * (0.125f * LOG2E) : rstd) * g[bj][n];
                    if (lat) { const int t = (j9 - 1) * 256 + rr, grow = t >> 6, gcol = t & 63;
#pragma unroll
                        for (int bj = 0; bj < 2; ++bj) { const f32x2* tab = bj ? (ropeC + gcol * 16 + 4 * fq) : (ropeR + grow * 16 + 4 * fq);
                            const f32x4 t0 = *(const f32x4*)tab, t1 = *(const f32x4*)(tab + 2);
                            const float cs[4] = {t0[0], t0[2], t1[0], t1[2]}, sn[4] = {t0[1], t0[3], t1[1], t1[3]};
#pragma unroll
                            for (int e = 0; e < 4; ++e) { const float x1 = y[bj][0][e], x2 = y[bj][1][e]; y[bj][0][e] = x1 * cs[e] - x2 * sn[e]; y[bj][1][e] = x1 * sn[e] + x2 * cs[e]; } } }
#pragma unroll
                    for (int bj = 0; bj < 2; ++bj) *(v4u*)(dst + R * 512 + h * 128 + c * 64 + 32 * bj + 8 * fq) = pack8(y[bj][0], y[bj][1]);
                    asm volatile("" ::: "memory");
                }
        } else {
            const int colt = (pn & 1) * 256;
            size_t boffs; if (type == 2) boffs = B_VD; else if (type == 3) boffs = B_HQ; else if (type == 4) boffs = B_LF0; else if (type == 5) boffs = B_LF1; else if (type == 6) boffs = B_HV; else boffs = B_HG;
            bf16* dst = (bf16*)(big + boffs);
#pragma unroll
            for (int bj = 0; bj < 2; ++bj) { const int col = colt + bj * 128 + wc * 32 + 8 * fq;
                f32x4 lb0 = {0.f, 0.f, 0.f, 0.f}, lb1 = lb0;
                if (type == 4 || type == 5) { const float* lp = lbv + (type - 4) * 512 + col; lb0 = *(const f32x4*)lp; lb1 = *(const f32x4*)(lp + 4); }
#pragma unroll
                for (int ai = 0; ai < 2; ++ai)
#pragma unroll
                    for (int m = 0; m < 4; ++m) { const size_t R = (size_t)u.pm * 256 + opaque(ai * 128 + wr * 64 + m * 16 + fr);
                        f32x4 a = acc[ai][bj][m][0], b = acc[ai][bj][m][1]; v4u w;
                        if (type == 3 || type == 7) {
#pragma unroll
                            for (int e = 0; e < 4; ++e) { a[e] = siluf_(a[e]); b[e] = siluf_(b[e]); }
                            if (type == 3) { a = a * 0.08838834764831845f; b = b * 0.08838834764831845f; }
                            w = pack8(a, b);
                        } else if (type == 4 || type == 5) {
#pragma unroll
                            for (int e = 0; e < 4; ++e) { a[e] = __logf(lb0[e] + (1.0f - lb0[e]) * sigmoidf_(a[e])); b[e] = __logf(lb1[e] + (1.0f - lb1[e]) * sigmoidf_(b[e])); }
                            w.x = pkh2(a[0], a[1]); w.y = pkh2(a[2], a[3]); w.z = pkh2(b[0], b[1]); w.w = pkh2(b[2], b[3]);
                        } else w = pack8(a, b);
                        *(v4u*)(dst + R * 512 + col) = w; asm volatile("" ::: "memory"); } }
        }
    }
};

struct EpiOut {
    static constexpr bool PERM = false, AFTER_DRAIN = false;
    const Frame* F; int layer; bool from_input;
    __device__ __forceinline__ void operator()(const f32x4 (&acc)[2][2][4][2], const Unit& u, int wr, int wc, int fr, int fq) const {
        const int b = u.pm / 9, j9 = u.pm % 9, r = j9 ? b : 8;
        const float* gm = F->modv_() + (size_t)(layer * 9 + r) * 6144 + 2048;
#pragma unroll
        for (int ai = 0; ai < 2; ++ai)
#pragma unroll
            for (int m = 0; m < 4; ++m) { const int s = j9 * 256 + opaque(ai * 128 + wr * 64 + m * 16 + fr);
                float* xo = xrow_ptr(*F, b, s); const float* xb = from_input ? xin_ptr(*F, b, s) : xo;
#pragma unroll
                for (int bj = 0; bj < 2; ++bj)
#pragma unroll
                    for (int n = 0; n < 2; ++n) { const int col = u.pn * 256 + bj * 128 + wc * 32 + 16 * n + 4 * fq;
                        *(f32x4*)(xo + col) = *(const f32x4*)(xb + col) + *(const f32x4*)(gm + col) * acc[ai][bj][m][n]; } asm volatile("" ::: "memory"); }
    }
};

struct EpiGU {
    static constexpr bool PERM = true, AFTER_DRAIN = false;
    bf16* Hout;
    __device__ __forceinline__ void operator()(const f32x4 (&acc)[2][2][4][2], const Unit& u, int wr, int wc, int fr, int fq) const {
        const int pnl = u.pn & 3;
#pragma unroll
        for (int ai = 0; ai < 2; ++ai)
#pragma unroll
            for (int m = 0; m < 4; ++m) { const size_t row = (size_t)u.pm * 256 + opaque(ai * 128 + wr * 64 + m * 16 + fr);
                f32x4 h[2];
#pragma unroll
                for (int n = 0; n < 2; ++n)
#pragma unroll
                    for (int e = 0; e < 4; ++e) h[n][e] = siluf_(acc[ai][0][m][n][e]) * acc[ai][1][m][n][e];
                *(v4u*)(Hout + row * 512 + pnl * 128 + wc * 32 + 8 * fq) = pack8(h[0], h[1]); }
    }
};

struct EpiDownS {
    static constexpr bool PERM = false, AFTER_DRAIN = false;
    const Frame* F; int layer;
    __device__ __forceinline__ void operator()(const f32x4 (&acc)[2][2][4][2], const Unit& u, int wr, int wc, int fr, int fq) const {
        const int b = u.pm / 9, j9 = u.pm % 9, r = j9 ? b : 8;
        const float* gf = F->modv_() + (size_t)(layer * 9 + r) * 6144 + 5120;
#pragma unroll
        for (int ai = 0; ai < 2; ++ai)
#pragma unroll
            for (int m = 0; m < 4; ++m) { const int s = j9 * 256 + opaque(ai * 128 + wr * 64 + m * 16 + fr); float* xo = xrow_ptr(*F, b, s);
#pragma unroll
                for (int bj = 0; bj < 2; ++bj)
#pragma unroll
                    for (int n = 0; n < 2; ++n) { const int col = u.pn * 256 + bj * 128 + wc * 32 + 16 * n + 4 * fq;
                        *(f32x4*)(xo + col) = *(const f32x4*)(xo + col) + *(const f32x4*)(gf + col) * acc[ai][bj][m][n]; } asm volatile("" ::: "memory"); }
    }
};

struct EpiDownR {
    static constexpr bool PERM = true, AFTER_DRAIN = false;
    bf16* Ye;
    __device__ __forceinline__ void operator()(const f32x4 (&acc)[2][2][4][2], const Unit& u, int wr, int wc, int fr, int fq) const {
        const int pnl = u.pn & 3;
#pragma unroll
        for (int ai = 0; ai < 2; ++ai)
#pragma unroll
            for (int m = 0; m < 4; ++m) { const size_t row = (size_t)u.pm * 256 + opaque(ai * 128 + wr * 64 + m * 16 + fr);
#pragma unroll
                for (int bj = 0; bj < 2; ++bj) *(v4u*)(Ye + row * 1024 + pnl * 256 + bj * 128 + wc * 32 + 8 * fq) = pack8(acc[ai][bj][m][0], acc[ai][bj][m][1]); }
    }
};

struct EpiIn1 {
    static constexpr bool PERM = true, AFTER_DRAIN = false;
    unsigned char* big; float* ssq; const float* krg; const f32x2 *ropeR, *ropeC;
    __device__ __forceinline__ void operator()(const f32x4 (&acc)[2][2][4][2], const Unit& u, int wr, int wc, int fr, int fq) const {
        const int pn = u.pn, j9 = u.pm % 9; const bool lat = j9 > 0;
        bf16* Ckv = (bf16*)(big + B_CKV); bf16* Cq = (bf16*)(big + B_CQ); bf16* Kr = (bf16*)(big + B_KR);
        if (pn == 2 && wc == 3) {
#pragma unroll
            for (int ai = 0; ai < 2; ++ai)
#pragma unroll
                for (int m = 0; m < 4; ++m) {
                    const int rr = opaque(ai * 128 + wr * 64 + m * 16 + fr); const size_t R = (size_t)u.pm * 256 + rr;
                    float s = 0.f;
#pragma unroll
                    for (int bj = 0; bj < 2; ++bj)
#pragma unroll
                        for (int n = 0; n < 2; ++n) { const f32x4 x = acc[ai][bj][m][n]; s += (x[0] * x[0] + x[1] * x[1]) + (x[2] * x[2] + x[3] * x[3]); }
                    s += __shfl_xor(s, 16); s += __shfl_xor(s, 32);
                    const float rstd = 1.0f / sqrtf(s * (1.0f / 64.0f) + EPS);
                    f32x4 y[2][2];
#pragma unroll
                    for (int bj = 0; bj < 2; ++bj)
#pragma unroll
                        for (int n = 0; n < 2; ++n) y[bj][n] = acc[ai][bj][m][n] * rstd * *(const f32x4*)(krg + 32 * bj + 16 * n + 4 * fq);
                    if (lat) { const int t = (j9 - 1) * 256 + rr, grow = t >> 6, gcol = t & 63;
#pragma unroll
                        for (int bj = 0; bj < 2; ++bj) { const f32x2* tab = bj ? (ropeC + gcol * 16 + 4 * fq) : (ropeR + grow * 16 + 4 * fq);
                            const f32x4 t0 = *(const f32x4*)tab, t1 = *(const f32x4*)(tab + 2);
                            const float cs[4] = {t0[0], t0[2], t1[0], t1[2]}, sn[4] = {t0[1], t0[3], t1[1], t1[3]};
#pragma unroll
                            for (int e = 0; e < 4; ++e) { const float x1 = y[bj][0][e], x2 = y[bj][1][e]; y[bj][0][e] = x1 * cs[e] - x2 * sn[e]; y[bj][1][e] = x1 * sn[e] + x2 * cs[e]; } } }
#pragma unroll
                    for (int bj = 0; bj < 2; ++bj) *(v4u*)(Kr + R * 64 + 32 * bj + 8 * fq) = pack8(y[bj][0], y[bj][1]);
                    asm volatile("" ::: "memory");
                }
            return;
        }
#pragma unroll
        for (int ai = 0; ai < 2; ++ai)
#pragma unroll
            for (int m = 0; m < 4; ++m) {
                const size_t R = (size_t)u.pm * 256 + opaque(ai * 128 + wr * 64 + m * 16 + fr);
                float s = 0.f;
#pragma unroll
                for (int bj = 0; bj < 2; ++bj) { const f32x4 a = acc[ai][bj][m][0], b = acc[ai][bj][m][1];
                    s += (a[0] * a[0] + a[1] * a[1]) + (a[2] * a[2] + a[3] * a[3]) + (b[0] * b[0] + b[1] * b[1]) + (b[2] * b[2] + b[3] * b[3]);
                    const v4u w = pack8(a, b);
                    if (pn == 0) *(v4u*)(Ckv + R * 256 + bj * 128 + wc * 32 + 8 * fq) = w;
                    else if (pn == 1) *(v4u*)(Cq + R * 384 + bj * 128 + wc * 32 + 8 * fq) = w;
                    else { if (bj == 0) *(v4u*)(Cq + R * 384 + 256 + wc * 32 + 8 * fq) = w; else if (wc == 0) *(v4u*)(Cq + R * 384 + 352 + 8 * fq) = w; } }
                s += __shfl_xor(s, 16); s += __shfl_xor(s, 32);
                if (fq == 0) ssq[R * 12 + pn * 4 + wc] = s;
                asm volatile("" ::: "memory");
            }
    }
};

struct EpiUq {
    static constexpr bool PERM = true, AFTER_DRAIN = false;
    bf16* Q1; const float* ssq; const float *qng, *qrg; const f32x2 *ropeR, *ropeC; LAS float* xl;
    __device__ __forceinline__ float rq_of(size_t R) const { const float* sp = ssq + R * 12; const f32x4 s1 = *(const f32x4*)(sp + 4), s2 = *(const f32x4*)(sp + 8);
        return 1.0f / sqrtf(((s1[0] + s1[1]) + (s1[2] + s1[3]) + (s2[0] + s2[1]) + s2[2]) * (1.0f / 384.0f) + EPS); }
    __device__ __forceinline__ void operator()(const f32x4 (&acc)[2][2][4][2], const Unit& u, int wr, int wc, int fr, int fq) const {
        const int pn = u.pn, j9 = u.pm % 9;
        if (pn < 4) {
#pragma unroll
            for (int ai = 0; ai < 2; ++ai)
#pragma unroll
                for (int m = 0; m < 4; ++m)
#pragma unroll
                    for (int bj = 0; bj < 2; ++bj) { float s = 0.f;
#pragma unroll
                        for (int n = 0; n < 2; ++n) { const f32x4 x = acc[ai][bj][m][n]; s += (x[0] * x[0] + x[1] * x[1]) + (x[2] * x[2] + x[3] * x[3]); }
                        s += __shfl_xor(s, 16); s += __shfl_xor(s, 32);
                        if (fq == 0) xl[(ai * 128 + wr * 64 + m * 16 + fr) * 8 + bj * 4 + wc] = s; }
            EPI_BAR();
#pragma unroll
            for (int ai = 0; ai < 2; ++ai)
#pragma unroll
                for (int m = 0; m < 4; ++m) { const int rr = opaque(ai * 128 + wr * 64 + m * 16 + fr); const size_t R = (size_t)u.pm * 256 + rr; const float rq = rq_of(R);
                    f32x4 g[2];
#pragma unroll
                    for (int n = 0; n < 2; ++n) g[n] = *(const f32x4*)(qng + wc * 32 + 8 * fq + 4 * n);
#pragma unroll
                    for (int bj = 0; bj < 2; ++bj) { const f32x4 p = *(const LAS f32x4*)(xl + rr * 8 + bj * 4);
                        const float rstd = (0.07216878364870323f * LOG2E) * rq / sqrtf(((p[0] + p[1]) + (p[2] + p[3])) * (rq * rq) * (1.0f / 128.0f) + EPS);
                        const int h = 2 * pn + bj;
                        *(v4u*)(Q1 + R * 1536 + h * 192 + wc * 32 + 8 * fq) = pack8(acc[ai][bj][m][0] * rstd * g[0], acc[ai][bj][m][1] * rstd * g[1]); } asm volatile("" ::: "memory"); }
            EPI_BAR();
        } else {
            const int h = 4 * (pn - 4) + wc;
#pragma unroll
            for (int ai = 0; ai < 2; ++ai)
#pragma unroll
                for (int m = 0; m < 4; ++m) {
                    const int rr = opaque(ai * 128 + wr * 64 + m * 16 + fr); const size_t R = (size_t)u.pm * 256 + rr; const float rq = rq_of(R);
                    float s = 0.f; f32x4 y[2][2];
#pragma unroll
                    for (int bj = 0; bj < 2; ++bj)
#pragma unroll
                        for (int n = 0; n < 2; ++n) { const f32x4 x = acc[ai][bj][m][n] * rq; y[bj][n] = x; s += (x[0] * x[0] + x[1] * x[1]) + (x[2] * x[2] + x[3] * x[3]); }
                    s += __shfl_xor(s, 16); s += __shfl_xor(s, 32);
                    const float rstd = (0.07216878364870323f * LOG2E) / sqrtf(s * (1.0f / 64.0f) + EPS);
#pragma unroll
                    for (int bj = 0; bj < 2; ++bj)
#pragma unroll
                        for (int n = 0; n < 2; ++n) y[bj][n] = y[bj][n] * rstd * *(const f32x4*)(qrg + 32 * bj + 16 * n + 4 * fq);
                    { const int t = (j9 - 1) * 256 + rr, grow = t >> 6, gcol = t & 63;
#pragma unroll
                        for (int bj = 0; bj < 2; ++bj) { const f32x2* tab = bj ? (ropeC + gcol * 16 + 4 * fq) : (ropeR + grow * 16 + 4 * fq);
                            const f32x4 t0 = *(const f32x4*)tab, t1 = *(const f32x4*)(tab + 2);
                            const float cs[4] = {t0[0], t0[2], t1[0], t1[2]}, sn[4] = {t0[1], t0[3], t1[1], t1[3]};
#pragma unroll
                            for (int e = 0; e < 4; ++e) { const float x1 = y[bj][0][e], x2 = y[bj][1][e]; y[bj][0][e] = x1 * cs[e] - x2 * sn[e]; y[bj][1][e] = x1 * sn[e] + x2 * cs[e]; } } }
#pragma unroll
                    for (int bj = 0; bj < 2; ++bj) *(v4u*)(Q1 + R * 1536 + h * 192 + 128 + 32 * bj + 8 * fq) = pack8(y[bj][0], y[bj][1]);
                    asm volatile("" ::: "memory");
                }
        }
    }
};

struct EpiUkv {
    static constexpr bool PERM = true, AFTER_DRAIN = false;
    bf16 *Kn, *V1; const float* ssq; const float* kng; LAS float* xl;
    __device__ __forceinline__ void operator()(const f32x4 (&acc)[2][2][4][2], const Unit& u, int wr, int wc, int fr, int fq) const {
        const int h = u.pn;
#pragma unroll
        for (int ai = 0; ai < 2; ++ai)
#pragma unroll
            for (int m = 0; m < 4; ++m) { float s = 0.f;
#pragma unroll
                for (int n = 0; n < 2; ++n) { const f32x4 x = acc[ai][0][m][n]; s += (x[0] * x[0] + x[1] * x[1]) + (x[2] * x[2] + x[3] * x[3]); }
                s += __shfl_xor(s, 16); s += __shfl_xor(s, 32);
                if (fq == 0) xl[(ai * 128 + wr * 64 + m * 16 + fr) * 4 + wc] = s; }
        EPI_BAR();
#pragma unroll
        for (int ai = 0; ai < 2; ++ai)
#pragma unroll
            for (int m = 0; m < 4; ++m) { const int rr = opaque(ai * 128 + wr * 64 + m * 16 + fr); const size_t R = (size_t)u.pm * 256 + rr;
                f32x4 g[2];
#pragma unroll
                for (int n = 0; n < 2; ++n) g[n] = *(const f32x4*)(kng + wc * 32 + 8 * fq + 4 * n);
                const f32x4 s0 = *(const f32x4*)(ssq + R * 12);
                const float rk = 1.0f / sqrtf(((s0[0] + s0[1]) + (s0[2] + s0[3])) * (1.0f / 256.0f) + EPS);
                const f32x4 p = *(const LAS f32x4*)(xl + rr * 4);
                const float rstd = rk / sqrtf(((p[0] + p[1]) + (p[2] + p[3])) * (rk * rk) * (1.0f / 128.0f) + EPS);
                *(v4u*)(Kn + R * 1024 + h * 128 + wc * 32 + 8 * fq) = pack8(acc[ai][0][m][0] * rstd * g[0], acc[ai][0][m][1] * rstd * g[1]);
                *(v4u*)(V1 + R * 1024 + h * 128 + wc * 32 + 8 * fq) = pack8(acc[ai][1][m][0] * rk, acc[ai][1][m][1] * rk); asm volatile("" ::: "memory"); }
        EPI_BAR();
    }
};

__device__ __forceinline__ bf16x8 pack_p(const f32x16& p, int s) { v4u w; w.x = pk2(p[8 * s + 0], p[8 * s + 1]); w.y = pk2(p[8 * s + 2], p[8 * s + 3]); w.z = pk2(p[8 * s + 4], p[8 * s + 5]); w.w = pk2(p[8 * s + 6], p[8 * s + 7]); return __builtin_bit_cast(bf16x8, w); }
__device__ __forceinline__ bf16x8 load_vfrag(const bf16* vp, int ld, int s) {
    bf16x8 r;
#pragma unroll
    for (int j = 0; j < 8; ++j) r[j] = (short)vp[(size_t)(16 * s + 8 * (j >> 2) + (j & 3)) * ld];
    return r;
}

__device__ __forceinline__ void diff_attn_unit_v0(Frame& F, int a) {
    const int lane = F.lane, r32 = lane & 31, hh = lane >> 5, wid = F.wave;
    int b, h, q0, nkeys;
    if (a < 256) { b = a >> 5; h = (a >> 3) & 3; q0 = b * RPB + CTXL + (a & 7) * 256; nkeys = RPB; } else { const int a2 = a - 256; b = a2 >> 2; h = a2 & 3; q0 = b * RPB; nkeys = CTXL; }
    const int kbase = b * RPB;
    const bf16* Qd = (const bf16*)(F.big_() + B_QD); const bf16* Kd = (const bf16*)(F.big_() + B_KD); const bf16* Vd = (const bf16*)(F.big_() + B_VD);
    const float lam = F.lamv_()[0];
    const bf16* qp = Qd + (size_t)(q0 + wid * 32 + r32) * 512 + h * 128 + hh * 8;
    f32x16 O[2][4];
#pragma unroll
    for (int c = 0; c < 2; ++c)
#pragma unroll
        for (int d = 0; d < 4; ++d)
#pragma unroll
            for (int r = 0; r < 16; ++r) O[c][d][r] = 0.f;
    float l0 = 0.f, l1 = 0.f;
    for (int kt = 0; kt < nkeys; kt += 32) {
        bf16x8 pf[2][2];
        const bf16* kp = Kd + (size_t)(kbase + kt + r32) * 512 + h * 128 + hh * 8;
#pragma unroll
        for (int c = 0; c < 2; ++c) {
            f32x16 S;
#pragma unroll
            for (int r = 0; r < 16; ++r) S[r] = 0.f;
#pragma unroll
            for (int ks = 0; ks < 4; ++ks) { const bf16x8 kf = *(const bf16x8*)(kp + c * 64 + ks * 16); const bf16x8 qv = *(const bf16x8*)(qp + c * 64 + ks * 16); S = __builtin_amdgcn_mfma_f32_32x32x16_bf16(kf, qv, S, 0, 0, 0); }
            float ls = 0.f;
#pragma unroll
            for (int r = 0; r < 16; ++r) { S[r] = __builtin_amdgcn_exp2f(S[r]); ls += S[r]; }
            if (c == 0) l0 += ls; else l1 += ls;
            pf[c][0] = pack_p(S, 0); pf[c][1] = pack_p(S, 1);
        }
        const bf16* vp = Vd + (size_t)(kbase + kt + 4 * hh) * 512 + h * 128 + r32;
#pragma unroll
        for (int d = 0; d < 4; ++d)
#pragma unroll
            for (int s = 0; s < 2; ++s) { const bf16x8 vf = load_vfrag(vp + d * 32, 512, s);
                O[0][d] = __builtin_amdgcn_mfma_f32_32x32x16_bf16(pf[0][s], vf, O[0][d], 0, 0, 0);
                O[1][d] = __builtin_amdgcn_mfma_f32_32x32x16_bf16(pf[1][s], vf, O[1][d], 0, 0, 0); asm volatile("" ::: "memory"); }
    }
    l0 += __shfl_xor(l0, 32); l1 += __shfl_xor(l1, 32);
    const float* sg = F.ar->in[I_DSUBLN];
    float gsub[4];
#pragma unroll
    for (int d = 0; d < 4; ++d) gsub[d] = sg[d * 32 + r32] * 0.8f;
#pragma unroll
    for (int r = 0; r < 16; ++r) {
        const int qi = crow(r, hh);
        const float i0 = 1.0f / __shfl(l0, qi), i1 = lam / __shfl(l1, qi);
        float o[4]; float s = 0.f;
#pragma unroll
        for (int d = 0; d < 4; ++d) { o[d] = O[0][d][r] * i0 - O[1][d][r] * i1; s += o[d] * o[d]; }
        s += __shfl_xor(s, 1); s += __shfl_xor(s, 2); s += __shfl_xor(s, 4); s += __shfl_xor(s, 8); s += __shfl_xor(s, 16);
        const float rstd = 1.0f / sqrtf(s * (1.0f / 128.0f) + EPS);
        bf16* op = F.H_() + (size_t)(q0 + wid * 32 + qi) * D + h * 128 + r32;
#pragma unroll
        for (int d = 0; d < 4; ++d) op[d * 32] = (bf16)f2bf(o[d] * rstd * gsub[d]);
    }
}

__device__ __forceinline__ void mla_attn_unit_v0(Frame& F, int a) {
    const int lane = F.lane, r32 = lane & 31, hh = lane >> 5, wid = F.wave;
    const int b = a >> 6, h = (a >> 3) & 7, q0 = b * RPB + CTXL + (a & 7) * 256, kbase = b * RPB;
    const bf16* Q1 = (const bf16*)(F.big_() + B_Q1); const bf16* Kn = (const bf16*)(F.big_() + B_KN); const bf16* Kr = (const bf16*)(F.big_() + B_KR); const bf16* V1 = (const bf16*)(F.big_() + B_V1);
    bf16x8 qf[12];
    { const bf16* qp = Q1 + (size_t)(q0 + wid * 32 + r32) * 1536 + h * 192 + hh * 8;
#pragma unroll
        for (int ks = 0; ks < 12; ++ks) qf[ks] = *(const bf16x8*)(qp + ks * 16); }
    f32x16 O[4];
#pragma unroll
    for (int d = 0; d < 4; ++d)
#pragma unroll
        for (int r = 0; r < 16; ++r) O[d][r] = 0.f;
    float l0 = 0.f;
    for (int kt = 0; kt < RPB; kt += 32) {
        const bf16* knp = Kn + (size_t)(kbase + kt + r32) * 1024 + h * 128 + hh * 8;
        const bf16* krp = Kr + (size_t)(kbase + kt + r32) * 64 + hh * 8;
        f32x16 S;
#pragma unroll
        for (int r = 0; r < 16; ++r) S[r] = 0.f;
#pragma unroll
        for (int ks = 0; ks < 8; ++ks) { const bf16x8 kf = *(const bf16x8*)(knp + ks * 16); S = __builtin_amdgcn_mfma_f32_32x32x16_bf16(kf, qf[ks], S, 0, 0, 0); }
#pragma unroll
        for (int ks = 0; ks < 4; ++ks) { const bf16x8 kf = *(const bf16x8*)(krp + ks * 16); S = __builtin_amdgcn_mfma_f32_32x32x16_bf16(kf, qf[8 + ks], S, 0, 0, 0); }
        float ls = 0.f;
#pragma unroll
        for (int r = 0; r < 16; ++r) { S[r] = __builtin_amdgcn_exp2f(S[r]); ls += S[r]; }
        l0 += ls;
        const bf16x8 p0 = pack_p(S, 0), p1 = pack_p(S, 1);
        const bf16* vp = V1 + (size_t)(kbase + kt + 4 * hh) * 1024 + h * 128 + r32;
#pragma unroll
        for (int d = 0; d < 4; ++d) { const bf16x8 v0 = load_vfrag(vp + d * 32, 1024, 0), v1 = load_vfrag(vp + d * 32, 1024, 1);
            O[d] = __builtin_amdgcn_mfma_f32_32x32x16_bf16(p0, v0, O[d], 0, 0, 0);
            O[d] = __builtin_amdgcn_mfma_f32_32x32x16_bf16(p1, v1, O[d], 0, 0, 0); }
    }
    l0 += __shfl_xor(l0, 32);
#pragma unroll
    for (int r = 0; r < 16; ++r) { const int qi = crow(r, hh); const float i0 = 1.0f / __shfl(l0, qi);
        bf16* op = F.H_() + (size_t)(q0 + wid * 32 + qi) * D + h * 128 + r32;
#pragma unroll
        for (int d = 0; d < 4; ++d) op[d * 32] = (bf16)f2bf(O[d][r] * i0); }
}

typedef short s16x4 __attribute__((ext_vector_type(4)));
#define KSWZ64(row, colB) ((row) * 128 + ((colB) ^ (((row) & 7) << 4)))
typedef __bf16 bf16x2_t __attribute__((ext_vector_type(2)));
__device__ __forceinline__ unsigned cvtpk_b(float lo, float hi) { const f32x2 v = {lo, hi}; const bf16x2_t b = __builtin_convertvector(v, bf16x2_t); return __builtin_bit_cast(unsigned, b); }
__device__ __forceinline__ unsigned cvtpk(float lo, float hi) { unsigned r; asm volatile("v_cvt_pk_bf16_f32 %0, %1, %2" : "=v"(r) : "v"(lo), "v"(hi)); return r; }
__device__ __forceinline__ int v_st(int k, int c) { const int kk = (k & ~0xC) | ((k & 4) << 1) | ((k & 8) >> 1); return ((kk >> 3) * 4 + (c >> 5)) * 512 + ((kk & 7) * 32 + (c & 31)) * 2; }
__device__ __forceinline__ int v_rd_base(int lane) { return ((lane & 3) << 3) | (((lane >> 2) & 3) << 6) | (((lane >> 4) & 1) << 5) | (((lane >> 5) & 1) << 8); }
constexpr int v_rd_off(int d0, int ks, int half) { return d0 * 512 + ks * 4096 + half * 2048; }
template <int OFF> __device__ __forceinline__ s16x4 tr_read(int vb) { s16x4 r; asm volatile("ds_read_b64_tr_b16 %0, %1 offset:%2" : "=&v"(r) : "v"(vb), "i"(OFF) : "memory"); return r; }
template <int D0> __device__ __forceinline__ void pv_one(f32x16& od, int vb, bf16x8 pa0, bf16x8 pa1, bf16x8 pa2, bf16x8 pa3) {
    const s16x4 l0 = tr_read<v_rd_off(D0, 0, 0)>(vb), h0 = tr_read<v_rd_off(D0, 0, 1)>(vb), l1 = tr_read<v_rd_off(D0, 1, 0)>(vb), h1 = tr_read<v_rd_off(D0, 1, 1)>(vb);
    const s16x4 l2 = tr_read<v_rd_off(D0, 2, 0)>(vb), h2 = tr_read<v_rd_off(D0, 2, 1)>(vb), l3 = tr_read<v_rd_off(D0, 3, 0)>(vb), h3 = tr_read<v_rd_off(D0, 3, 1)>(vb);
    asm volatile("s_waitcnt lgkmcnt(0)" ::: "memory"); __builtin_amdgcn_sched_barrier(0);
#define PKV(L, H) (bf16x8){L[0], L[1], L[2], L[3], H[0], H[1], H[2], H[3]}
    od = __builtin_amdgcn_mfma_f32_32x32x16_bf16(pa0, PKV(l0, h0), od, 0, 0, 0);
    od = __builtin_amdgcn_mfma_f32_32x32x16_bf16(pa1, PKV(l1, h1), od, 0, 0, 0);
    od = __builtin_amdgcn_mfma_f32_32x32x16_bf16(pa2, PKV(l2, h2), od, 0, 0, 0);
    od = __builtin_amdgcn_mfma_f32_32x32x16_bf16(pa3, PKV(l3, h3), od, 0, 0, 0);
#undef PKV
}
#define PK4(P, BASE, OUT) do { unsigned a0 = cvtpk(P[BASE + 0], P[BASE + 1]), a1 = cvtpk(P[BASE + 2], P[BASE + 3]);   \
    unsigned b0 = cvtpk(P[BASE + 4], P[BASE + 5]), b1 = cvtpk(P[BASE + 6], P[BASE + 7]);                              \
    auto r0 = __builtin_amdgcn_permlane32_swap(a0, b0, false, false); auto r1 = __builtin_amdgcn_permlane32_swap(a1, b1, false, false); \
    v4u w = {r0[0], r1[0], r0[1], r1[1]}; OUT = __builtin_bit_cast(bf16x8, w); } while (0)

#define PK4B(P, BASE, OUT) do { unsigned a0 = cvtpk_b(P[BASE + 0], P[BASE + 1]), a1 = cvtpk_b(P[BASE + 2], P[BASE + 3]);   \
    unsigned b0 = cvtpk_b(P[BASE + 4], P[BASE + 5]), b1 = cvtpk_b(P[BASE + 6], P[BASE + 7]);                              \
    auto r0 = __builtin_amdgcn_permlane32_swap(a0, b0, false, false); auto r1 = __builtin_amdgcn_permlane32_swap(a1, b1, false, false); \
    v4u w = {r0[0], r1[0], r0[1], r1[1]}; OUT = __builtin_bit_cast(bf16x8, w); } while (0)

template <int NSUB>
__device__ __forceinline__ void attn_pass(f32x16 (&o)[4], float& l_acc, const bf16x8 (&qf)[NSUB * 4], const bf16* k0, const bf16* k1, const bf16* k2, int ld0, int ld1, int ld2,
                                          const bf16* vsrc, int vld, int nkeys, LAS unsigned char* lds) {
    constexpr int BUF = NSUB * 8192 + 16384;
    const int tid = opaque((int)threadIdx.x), lane = tid & 63, r32 = lane & 31, hh = lane >> 5;
    const int krow = tid >> 3, kch = tid & 7, sr = tid >> 4, sc = (tid & 15) * 8;
    const int kdst = KSWZ64(krow, kch * 16), vst0 = NSUB * 8192 + v_st(sr, sc), vst1 = NSUB * 8192 + v_st(32 + sr, sc);
    const int vb0 = (int)(unsigned)(uintptr_t)lds + NSUB * 8192 + v_rd_base(lane);
    const int ka0 = r32 * 128, ka1 = (32 + r32) * 128;
    bf16x8 sk0, sk1, sk2, sv0, sv1;
#define ALOAD(key0) do { sk0 = *(const bf16x8*)(k0 + (size_t)((key0) + krow) * ld0 + kch * 8); \
        if (NSUB > 1) sk1 = *(const bf16x8*)(k1 + (size_t)((key0) + krow) * ld1 + kch * 8); if (NSUB > 2) sk2 = *(const bf16x8*)(k2 + (size_t)((key0) + krow) * ld2 + kch * 8); \
        sv0 = *(const bf16x8*)(vsrc + (size_t)((key0) + sr) * vld + sc); sv1 = *(const bf16x8*)(vsrc + (size_t)((key0) + 32 + sr) * vld + sc); } while (0)
#define AWRITE(b) do { LAS unsigned char* bb = lds + (b) * BUF; *(LAS bf16x8*)(bb + kdst) = sk0; if (NSUB > 1) *(LAS bf16x8*)(bb + 8192 + kdst) = sk1; if (NSUB > 2) *(LAS bf16x8*)(bb + 16384 + kdst) = sk2; \
        *(LAS bf16x8*)(bb + vst0) = sv0; *(LAS bf16x8*)(bb + vst1) = sv1; } while (0)
    const int NT = nkeys >> 6;
    ALOAD(0); AWRITE(0); __syncthreads();
    for (int t = 0; t < NT; ++t) {
        const int b = t & 1;
        if (t + 1 < NT) ALOAD((t + 1) * 64);
        const LAS unsigned char* kb = lds + b * BUF;
        f32x16 p0, p1;
#pragma unroll
        for (int r = 0; r < 16; ++r) { p0[r] = 0.f; p1[r] = 0.f; }
#pragma unroll
        for (int s = 0; s < NSUB; ++s)
#pragma unroll
            for (int ks = 0; ks < 4; ++ks) { const int cb = (ks * 16 + hh * 8) * 2, x = (r32 & 7) << 4;
                const bf16x8 b0 = *(const LAS bf16x8*)(kb + s * 8192 + ka0 + (cb ^ x)), b1 = *(const LAS bf16x8*)(kb + s * 8192 + ka1 + (cb ^ x));
                p0 = __builtin_amdgcn_mfma_f32_32x32x16_bf16(b0, qf[s * 4 + ks], p0, 0, 0, 0);
                p1 = __builtin_amdgcn_mfma_f32_32x32x16_bf16(b1, qf[s * 4 + ks], p1, 0, 0, 0); }
        float ps = 0.f;
#pragma unroll
        for (int r = 0; r < 16; ++r) { p0[r] = __builtin_amdgcn_exp2f(p0[r]); p1[r] = __builtin_amdgcn_exp2f(p1[r]); ps += p0[r] + p1[r]; }
        l_acc += ps;
        bf16x8 pa0, pa1, pa2, pa3;
        PK4(p0, 0, pa0); PK4(p0, 8, pa1); PK4(p1, 0, pa2); PK4(p1, 8, pa3);
        const int vb = vb0 + b * BUF;
        pv_one<0>(o[0], vb, pa0, pa1, pa2, pa3); pv_one<1>(o[1], vb, pa0, pa1, pa2, pa3); pv_one<2>(o[2], vb, pa0, pa1, pa2, pa3); pv_one<3>(o[3], vb, pa0, pa1, pa2, pa3);
        if (t + 1 < NT) AWRITE(b ^ 1);
        __syncthreads();
    }
#undef ALOAD
#undef AWRITE
}

__device__ __forceinline__ void diff_attn_unit_v1(Frame& F, int a) {
    const int lane = F.lane, r32 = lane & 31, hh = lane >> 5, wid = F.wave;
    int b, h, q0, nkeys;
    if (a < 256) { b = a >> 5; h = (a >> 3) & 3; q0 = b * RPB + CTXL + (a & 7) * 256; nkeys = RPB; } else { const int a2 = a - 256; b = a2 >> 2; h = a2 & 3; q0 = b * RPB; nkeys = CTXL; }
    const bf16* Qd = (const bf16*)(F.big_() + B_QD); const bf16* Kd = (const bf16*)(F.big_() + B_KD); const bf16* Vd = (const bf16*)(F.big_() + B_VD);
    const bf16* kbase = Kd + (size_t)b * RPB * 512 + h * 128; const bf16* vbase = Vd + (size_t)b * RPB * 512 + h * 128;
    const bf16* qp = Qd + (size_t)(q0 + wid * 32 + r32) * 512 + h * 128 + hh * 8;
    const float lam = F.lamv_()[0];
    f32x16 osum[4];
#pragma unroll
    for (int d = 0; d < 4; ++d)
#pragma unroll
        for (int r = 0; r < 16; ++r) osum[d][r] = 0.f;
#pragma unroll 1
    for (int c = 0; c < 2; ++c) {
        bf16x8 qf[4];
#pragma unroll
        for (int ks = 0; ks < 4; ++ks) qf[ks] = *(const bf16x8*)(qp + c * 64 + ks * 16);
        f32x16 o[4];
#pragma unroll
        for (int d = 0; d < 4; ++d)
#pragma unroll
            for (int r = 0; r < 16; ++r) o[d][r] = 0.f;
        float l = 0.f;
        attn_pass<1>(o, l, qf, kbase + c * 64, kbase, kbase, 512, 512, 512, vbase, 512, nkeys, F.lds);
        l += __shfl_xor(l, 32);
        const float coef = c ? -lam : 1.0f;
#pragma unroll
        for (int r = 0; r < 16; ++r) { const float i0 = coef / __shfl(l, crow(r, hh));
#pragma unroll
            for (int d = 0; d < 4; ++d) osum[d][r] += o[d][r] * i0; }
    }
    const float* sg = F.ar->in[I_DSUBLN];
    float gsub[4];
#pragma unroll
    for (int d = 0; d < 4; ++d) gsub[d] = sg[d * 32 + r32] * 0.8f;
#pragma unroll
    for (int r = 0; r < 16; ++r) {
        const int qi = crow(r, hh);
        float s = 0.f;
#pragma unroll
        for (int d = 0; d < 4; ++d) s += osum[d][r] * osum[d][r];
        s += __shfl_xor(s, 1); s += __shfl_xor(s, 2); s += __shfl_xor(s, 4); s += __shfl_xor(s, 8); s += __shfl_xor(s, 16);
        const float rstd = 1.0f / sqrtf(s * (1.0f / 128.0f) + EPS);
        bf16* op = F.H_() + (size_t)(q0 + wid * 32 + qi) * D + h * 128 + r32;
#pragma unroll
        for (int d = 0; d < 4; ++d) op[d * 32] = (bf16)f2bf(osum[d][r] * rstd * gsub[d]);
    }
}

__device__ __forceinline__ void mla_attn_unit_v1(Frame& F, int a) {
    const int lane = F.lane, r32 = lane & 31, hh = lane >> 5, wid = F.wave;
    const int b = a >> 6, h = (a >> 3) & 7, q0 = b * RPB + CTXL + (a & 7) * 256;
    const bf16* Q1 = (const bf16*)(F.big_() + B_Q1); const bf16* Kn = (const bf16*)(F.big_() + B_KN); const bf16* Kr = (const bf16*)(F.big_() + B_KR); const bf16* V1 = (const bf16*)(F.big_() + B_V1);
    const bf16* knb = Kn + (size_t)b * RPB * 1024 + h * 128; const bf16* krb = Kr + (size_t)b * RPB * 64; const bf16* vb = V1 + (size_t)b * RPB * 1024 + h * 128;
    bf16x8 qf[12];
    { const bf16* qp = Q1 + (size_t)(q0 + wid * 32 + r32) * 1536 + h * 192 + hh * 8;
#pragma unroll
        for (int ks = 0; ks < 12; ++ks) qf[ks] = *(const bf16x8*)(qp + ks * 16); }
    f32x16 o[4];
#pragma unroll
    for (int d = 0; d < 4; ++d)
#pragma unroll
        for (int r = 0; r < 16; ++r) o[d][r] = 0.f;
    float l0 = 0.f;
    attn_pass<3>(o, l0, qf, knb, knb + 64, krb, 1024, 1024, 64, vb, 1024, RPB, F.lds);
    l0 += __shfl_xor(l0, 32);
#pragma unroll
    for (int r = 0; r < 16; ++r) { const int qi = crow(r, hh); const float i0 = 1.0f / __shfl(l0, qi);
        bf16* op = F.H_() + (size_t)(q0 + wid * 32 + qi) * D + h * 128 + r32;
#pragma unroll
        for (int d = 0; d < 4; ++d) op[d * 32] = (bf16)f2bf(o[d][r] * i0); }
}

__device__ __forceinline__ void hgrn_unit_v0(Frame& F, int a) {
    const int dvq = a & 3, dir = (a >> 2) & 1, h = (a >> 3) & 3, b = a >> 5;
    const bf16* Hq = (const bf16*)(F.big_() + B_HQ); const f16* Lf = (const f16*)(F.big_() + (dir ? B_LF1 : B_LF0)); const bf16* Hv = (const bf16*)(F.big_() + B_HV);
    bf16* Ho = (bf16*)(F.big_() + (dir ? B_HO1 : B_HO0));
    LAS float* lq = (LAS float*)F.lds;
    LAS float* lf = lq + 2048;
    LAS float* lk = lf + 2048;
    LAS float* lv = lk + 2048;
    LAS float* part = lv + 512;
    const int tid = F.tid, v = tid & 31, kg = tid >> 5;
    float S[8];
#pragma unroll
    for (int j = 0; j < 8; ++j) S[j] = 0.f;
    for (int ch = 0; ch < RPB / 16; ++ch) {
        for (int e = tid; e < 2048; e += NTHREADS) { const int tok = e >> 7, k = e & 127, n = ch * 16 + tok;
            const int s = dir ? (n < CTXL ? CTXL - 1 - n : RPB + CTXL - 1 - n) : n; const size_t R = (size_t)b * RPB + s;
            lq[e] = bf2f(Hq[R * 512 + h * 128 + k]);
            const float f = fexp((float)Lf[R * 512 + h * 128 + k]); lf[e] = f; lk[e] = 1.0f - f; }
        { const int tok = tid >> 5, n = ch * 16 + tok; const int s = dir ? (n < CTXL ? CTXL - 1 - n : RPB + CTXL - 1 - n) : n; const size_t R = (size_t)b * RPB + s;
            lv[tid] = bf2f(Hv[R * 512 + h * 128 + dvq * 32 + v]); }
        __syncthreads();
#pragma unroll 4
        for (int tok = 0; tok < 16; ++tok) {
            const f32x4 q0 = *(const LAS f32x4*)(lq + tok * 128 + kg * 8), q1 = *(const LAS f32x4*)(lq + tok * 128 + kg * 8 + 4);
            const f32x4 f0 = *(const LAS f32x4*)(lf + tok * 128 + kg * 8), f1 = *(const LAS f32x4*)(lf + tok * 128 + kg * 8 + 4);
            const f32x4 k0 = *(const LAS f32x4*)(lk + tok * 128 + kg * 8), k1 = *(const LAS f32x4*)(lk + tok * 128 + kg * 8 + 4);
            const float vv = lv[tok * 32 + v];
            float po = 0.f;
#pragma unroll
            for (int j = 0; j < 4; ++j) { S[j] = f0[j] * S[j] + k0[j] * vv; po += S[j] * q0[j]; S[4 + j] = f1[j] * S[4 + j] + k1[j] * vv; po += S[4 + j] * q1[j]; }
            part[(tok * 16 + kg) * 32 + v] = po;
        }
        __syncthreads();
        { const int tok = tid >> 5, n = ch * 16 + tok; const int s = dir ? (n < CTXL ? CTXL - 1 - n : RPB + CTXL - 1 - n) : n; const size_t R = (size_t)b * RPB + s;
            float o = 0.f;
#pragma unroll
            for (int g = 0; g < 16; ++g) o += part[(tok * 16 + g) * 32 + v];
            Ho[R * 512 + h * 128 + dvq * 32 + v] = (bf16)f2bf(o); }
        __syncthreads();
    }
}

constexpr int HL_LF = 0, HL_QR = 16384, HL_QT = 32768, HL_KT = 49152, HL_K2 = 65536, HL_VT = 81920, HL_S0 = 86016, HL_GC = 102400, HL_TOT = 102912;
__device__ __forceinline__ int tr_st(int k, int c, int NC) { const int kk = (k & ~0xC) | ((k & 4) << 1) | ((k & 8) >> 1); return ((kk >> 3) * NC + (c >> 5)) * 512 + ((kk & 7) * 32 + (c & 31)) * 2; }
constexpr int tr_off(int NC, int ks, int half) { return ((2 * ks + half) * NC) * 512; }
#define PKV2(L, H) (bf16x8){L[0], L[1], L[2], L[3], H[0], H[1], H[2], H[3]}
template <int NC, int KS> __device__ __forceinline__ bf16x8 tr_frag(int vb) { const s16x4 l = tr_read<tr_off(NC, KS, 0)>(vb), h = tr_read<tr_off(NC, KS, 1)>(vb); asm volatile("s_waitcnt lgkmcnt(0)" ::: "memory"); __builtin_amdgcn_sched_barrier(0); return PKV2(l, h); }

__device__ __forceinline__ void hgrn_unit_v1(Frame& F, int a) {
    const int dvq = a & 3, dir = (a >> 2) & 1, h = (a >> 3) & 3, b = a >> 5;
    const bf16* Hq = (const bf16*)(F.big_() + B_HQ); const f16* Lf = (const f16*)(F.big_() + (dir ? B_LF1 : B_LF0)); const bf16* Hv = (const bf16*)(F.big_() + B_HV);
    bf16* Ho = (bf16*)(F.big_() + (dir ? B_HO1 : B_HO0));
    LAS unsigned char* L = F.lds;
    const int tid = opaque((int)threadIdx.x), lane = tid & 63, r32 = lane & 31, hh = lane >> 5, wid = F.wave;
    const int ldsb = (int)(unsigned)(uintptr_t)L;
    const int colo = h * 128;
    const int ltok0 = tid >> 4, lkch = tid & 15;
    const int vtok = tid >> 2, vch = tid & 3;
    const int sk = tid & 127, tq = tid >> 7;
    v4u rl0, rl1, rq0, rq1, rv;
    rv = (v4u){0u, 0u, 0u, 0u};
#define HG_ROW(p) ((size_t)b * RPB + (dir ? ((p) < CTXL ? CTXL - 1 - (p) : RPB + CTXL - 1 - (p)) : (p)))
#define HG_LOAD(n) do { const size_t R0 = HG_ROW((n) * 64 + ltok0), R1 = HG_ROW((n) * 64 + 32 + ltok0); \
        rl0 = *(const v4u*)(Lf + R0 * 512 + colo + lkch * 8); rl1 = *(const v4u*)(Lf + R1 * 512 + colo + lkch * 8); \
        rq0 = *(const v4u*)(Hq + R0 * 512 + colo + lkch * 8); rq1 = *(const v4u*)(Hq + R1 * 512 + colo + lkch * 8); \
        if (tid < 256) rv = *(const v4u*)(Hv + HG_ROW((n) * 64 + vtok) * 512 + colo + dvq * 32 + vch * 8); } while (0)
    f32x16 S;
#pragma unroll
    for (int r = 0; r < 16; ++r) S[r] = 0.f;
    for (int e = tid; e < 512; e += NTHREADS) *(LAS v4u*)(L + HL_S0 + e * 16) = (v4u){0u, 0u, 0u, 0u};
    HG_LOAD(0);
    const int NCH = RPB / 64;
    for (int n = 0; n < NCH; ++n) {
        *(LAS v4u*)(L + HL_LF + ltok0 * 256 + lkch * 16) = rl0; *(LAS v4u*)(L + HL_LF + (ltok0 + 32) * 256 + lkch * 16) = rl1;
        *(LAS v4u*)(L + HL_QR + ltok0 * 256 + lkch * 16) = rq0; *(LAS v4u*)(L + HL_QR + (ltok0 + 32) * 256 + lkch * 16) = rq1;
        __syncthreads();
        float c[16], lf[16];
        { float run = 0.f;
#pragma unroll
            for (int j = 0; j < 16; ++j) { lf[j] = (float)*(const LAS f16*)(L + HL_LF + (16 * tq + j) * 256 + sk * 2); run += lf[j]; c[j] = run; }
            *(LAS float*)(L + HL_TOT + (tq * 128 + sk) * 4) = run; }
        __syncthreads();
        {   const float t0 = *(const LAS float*)(L + HL_TOT + (0 * 128 + sk) * 4), t1 = *(const LAS float*)(L + HL_TOT + (1 * 128 + sk) * 4);
            const float t2 = *(const LAS float*)(L + HL_TOT + (2 * 128 + sk) * 4), t3 = *(const LAS float*)(L + HL_TOT + (3 * 128 + sk) * 4);
            const float off = (tq > 0 ? t0 : 0.f) + (tq > 1 ? t1 : 0.f) + (tq > 2 ? t2 : 0.f), cumC = (t0 + t1) + (t2 + t3);
            float qp[16], kp[16], k2[16];
#pragma unroll
            for (int j = 0; j < 16; ++j) { const float cum = off + c[j]; const float eg = __builtin_amdgcn_exp2f(cum * LOG2E), f = __builtin_amdgcn_exp2f(lf[j] * LOG2E), kk = 1.0f - f;
                const float q = bf2f(*(const LAS bf16*)(L + HL_QR + (16 * tq + j) * 256 + sk * 2));
                qp[j] = q * eg; kp[j] = kk * __builtin_amdgcn_exp2f(-fmaxf(cum, -80.0f) * LOG2E); k2[j] = kk * __builtin_amdgcn_exp2f((cumC - cum) * LOG2E); }
            const int to = tr_st(sk, 16 * tq, 2);
            *(LAS v4u*)(L + HL_QT + to) = (v4u){pk2(qp[0], qp[1]), pk2(qp[2], qp[3]), pk2(qp[4], qp[5]), pk2(qp[6], qp[7])};
            *(LAS v4u*)(L + HL_QT + to + 16) = (v4u){pk2(qp[8], qp[9]), pk2(qp[10], qp[11]), pk2(qp[12], qp[13]), pk2(qp[14], qp[15])};
            *(LAS v4u*)(L + HL_KT + to) = (v4u){pk2(kp[0], kp[1]), pk2(kp[2], kp[3]), pk2(kp[4], kp[5]), pk2(kp[6], kp[7])};
            *(LAS v4u*)(L + HL_KT + to + 16) = (v4u){pk2(kp[8], kp[9]), pk2(kp[10], kp[11]), pk2(kp[12], kp[13]), pk2(kp[14], kp[15])};
            *(LAS v4u*)(L + HL_K2 + KSWZ64(sk, 32 * tq)) = (v4u){pk2(k2[0], k2[1]), pk2(k2[2], k2[3]), pk2(k2[4], k2[5]), pk2(k2[6], k2[7])};
            *(LAS v4u*)(L + HL_K2 + KSWZ64(sk, 32 * tq + 16)) = (v4u){pk2(k2[8], k2[9]), pk2(k2[10], k2[11]), pk2(k2[12], k2[13]), pk2(k2[14], k2[15])};
            if (tq == 0) *(LAS float*)(L + HL_GC + sk * 4) = __builtin_amdgcn_exp2f(cumC * LOG2E);
            if (tid < 256) *(LAS v4u*)(L + HL_VT + tr_st(vtok, vch * 8, 1)) = rv;
        }
        __syncthreads();
        if (n + 1 < NCH) HG_LOAD(n + 1);
        const int sb = (n & 1) * 8192;
        const int vbV = ldsb + HL_VT + v_rd_base(lane);
        if (wid < 4) {
#pragma unroll
            for (int g = 0; g < 4; ++g) { const f32x4 gv = *(const LAS f32x4*)(L + HL_GC + (32 * wid + 8 * g + 4 * hh) * 4);
#pragma unroll
                for (int e = 0; e < 4; ++e) S[4 * g + e] *= gv[e]; }
            { const int krow = 32 * wid + r32;
                const bf16x8 a0 = *(const LAS bf16x8*)(L + HL_K2 + KSWZ64(krow, (0 + 8 * hh) * 2)), a1 = *(const LAS bf16x8*)(L + HL_K2 + KSWZ64(krow, (16 + 8 * hh) * 2));
                const bf16x8 a2 = *(const LAS bf16x8*)(L + HL_K2 + KSWZ64(krow, (32 + 8 * hh) * 2)), a3 = *(const LAS bf16x8*)(L + HL_K2 + KSWZ64(krow, (48 + 8 * hh) * 2));
                const bf16x8 v0 = tr_frag<1, 0>(vbV), v1 = tr_frag<1, 1>(vbV), v2 = tr_frag<1, 2>(vbV), v3 = tr_frag<1, 3>(vbV);
                __builtin_amdgcn_sched_barrier(0);
                S = __builtin_amdgcn_mfma_f32_32x32x16_bf16(a0, v0, S, 0, 0, 0); S = __builtin_amdgcn_mfma_f32_32x32x16_bf16(a1, v1, S, 0, 0, 0);
                S = __builtin_amdgcn_mfma_f32_32x32x16_bf16(a2, v2, S, 0, 0, 0); S = __builtin_amdgcn_mfma_f32_32x32x16_bf16(a3, v3, S, 0, 0, 0); }
            bf16x8 f0, f1; PK4B(S, 0, f0); PK4B(S, 8, f1);
            *(LAS bf16x8*)(L + HL_S0 + (sb ^ 8192) + ((2 * wid) * 64 + lane) * 16) = f0; *(LAS bf16x8*)(L + HL_S0 + (sb ^ 8192) + ((2 * wid + 1) * 64 + lane) * 16) = f1;
        } else if (wid < 6) {
            const int ct = wid - 4;
            const int vbQ = ldsb + HL_QT + ct * 512 + v_rd_base(lane), vbK = ldsb + HL_KT + v_rd_base(lane);
            bf16x8 qf[8];
            qf[0] = tr_frag<2, 0>(vbQ); qf[1] = tr_frag<2, 1>(vbQ); qf[2] = tr_frag<2, 2>(vbQ); qf[3] = tr_frag<2, 3>(vbQ);
            qf[4] = tr_frag<2, 4>(vbQ); qf[5] = tr_frag<2, 5>(vbQ); qf[6] = tr_frag<2, 6>(vbQ); qf[7] = tr_frag<2, 7>(vbQ);
            __builtin_amdgcn_sched_barrier(0);
            f32x16 o;
#pragma unroll
            for (int r = 0; r < 16; ++r) o[r] = 0.f;
#pragma unroll
            for (int rt = 0; rt < 2; ++rt) {
                if (rt <= ct) {
                    const int vbKr = vbK + rt * 512;
                    f32x16 X;
#pragma unroll
                    for (int r = 0; r < 16; ++r) X[r] = 0.f;
                    { bf16x8 kf;
                        kf = tr_frag<2, 0>(vbKr); __builtin_amdgcn_sched_barrier(0); X = __builtin_amdgcn_mfma_f32_32x32x16_bf16(kf, qf[0], X, 0, 0, 0);
                        kf = tr_frag<2, 1>(vbKr); __builtin_amdgcn_sched_barrier(0); X = __builtin_amdgcn_mfma_f32_32x32x16_bf16(kf, qf[1], X, 0, 0, 0);
                        kf = tr_frag<2, 2>(vbKr); __builtin_amdgcn_sched_barrier(0); X = __builtin_amdgcn_mfma_f32_32x32x16_bf16(kf, qf[2], X, 0, 0, 0);
                        kf = tr_frag<2, 3>(vbKr); __builtin_amdgcn_sched_barrier(0); X = __builtin_amdgcn_mfma_f32_32x32x16_bf16(kf, qf[3], X, 0, 0, 0);
                        kf = tr_frag<2, 4>(vbKr); __builtin_amdgcn_sched_barrier(0); X = __builtin_amdgcn_mfma_f32_32x32x16_bf16(kf, qf[4], X, 0, 0, 0);
                        kf = tr_frag<2, 5>(vbKr); __builtin_amdgcn_sched_barrier(0); X = __builtin_amdgcn_mfma_f32_32x32x16_bf16(kf, qf[5], X, 0, 0, 0);
                        kf = tr_frag<2, 6>(vbKr); __builtin_amdgcn_sched_barrier(0); X = __builtin_amdgcn_mfma_f32_32x32x16_bf16(kf, qf[6], X, 0, 0, 0);
                        kf = tr_frag<2, 7>(vbKr); __builtin_amdgcn_sched_barrier(0); X = __builtin_amdgcn_mfma_f32_32x32x16_bf16(kf, qf[7], X, 0, 0, 0); }
                    if (rt == ct) {
#pragma unroll
                        for (int r = 0; r < 16; ++r) X[r] = (crow(r, hh) <= r32) ? X[r] : 0.f; }
                    bf16x8 pa0, pa1; PK4B(X, 0, pa0); PK4B(X, 8, pa1);
                    bf16x8 va, vb2;
                    if (rt == 0) { va = tr_frag<1, 0>(vbV); vb2 = tr_frag<1, 1>(vbV); } else { va = tr_frag<1, 2>(vbV); vb2 = tr_frag<1, 3>(vbV); }
                    __builtin_amdgcn_sched_barrier(0);
                    o = __builtin_amdgcn_mfma_f32_32x32x16_bf16(pa0, va, o, 0, 0, 0); o = __builtin_amdgcn_mfma_f32_32x32x16_bf16(pa1, vb2, o, 0, 0, 0);
                }
            }
#pragma unroll
            for (int ks = 0; ks < 8; ++ks) { const bf16x8 sf = *(const LAS bf16x8*)(L + HL_S0 + sb + (ks * 64 + lane) * 16); o = __builtin_amdgcn_mfma_f32_32x32x16_bf16(qf[ks], sf, o, 0, 0, 0); }
#pragma unroll
            for (int r = 0; r < 16; ++r) { const int p = n * 64 + 32 * ct + crow(r, hh); Ho[HG_ROW(p) * 512 + colo + dvq * 32 + r32] = (bf16)f2bf(o[r]); }
        }
    }
    __syncthreads();
#undef HG_ROW
#undef HG_LOAD
}

constexpr int NPHASES = 20;
__global__ void __launch_bounds__(NTHREADS, 2) mk_fwd(Args args) {
    extern __shared__ __attribute__((aligned(16))) unsigned char lds[];
    Frame F;
    F.lds = (LAS unsigned char*)lds;
    F.tid = threadIdx.x; F.lane = F.tid & 63; F.wave = __builtin_amdgcn_readfirstlane(F.tid >> 6); F.G = gridDim.x; F.bid = blockIdx.x;
    F.ar = &args; F.out = args.out; F.ws = args.ws;

    volatile LAS unsigned* MISC = (volatile LAS unsigned*)(F.lds + LDS_MISC);
    for (int u = F.tid; u < 256; u += NTHREADS) MISC[u] = 0u;
    __syncthreads();
    XcdBarrier bar; bar.bar = (unsigned*)(F.ctl_() + CW_BAR); bar.x = 0; bar.st = nullptr;
    if (MK_N_LAUNCHES == 1) bar = xcd_barrier_post((unsigned*)(F.ctl_() + CW_BAR), MISC + 8);
    LAS float* xl = (LAS float*)(F.lds + LDS_XCH);

    const int lo = args.ph_lo, hi = args.ph_hi;
#ifdef DBG_ONLY
#define IN(k) ((k) == DBG_ONLY && lo <= (k) && (k) < hi)
#else
#define IN(k) (lo <= (k) && (k) < hi)
#endif
#define SEAM(k) do { if (IN(k) && IN((k) + 1)) xcd_barrier(bar); } while (0)

    if (IN(0)) { REP(0) p0_prologue(F); } SEAM(0);
    if (IN(1)) { p_norm0(F); } SEAM(1);
    if (IN(2)) { Gemm g{F.H_(), F.Win0_(), 1024}; SchedGrid S{NT_ALL, 16, F.G, F.bid, false};
        EpiIn0 E{F.big_(), F.ar->in[I_DQG], F.ar->in[I_DKG], F.lbv_(), F.ropeR_(), F.ropeC_()}; REP(2) run_gemm<0>(F.lds, g, S, E); } SEAM(2);
    if (IN(3)) { REP(30) for (int a = F.bid; a < 256; a += F.G) { if (HGRN_V1) hgrn_unit_v1(F, a); else hgrn_unit_v0(F, a); }
        REP(31) for (int a = F.bid; a < 288; a += F.G) { if (ATTN_V1 & 1) diff_attn_unit_v1(F, a); else diff_attn_unit_v0(F, a); } } SEAM(3);
    if (IN(4)) { REP(4) p_hgrn_post(F); } SEAM(4);
    if (IN(5)) { Gemm g{F.H_(), F.Wout0_(), 1024}; SchedGrid S{NT_ALL, 4, F.G, F.bid, false}; EpiOut E{&F, 0, true}; run_gemm<1>(F.lds, g, S, E); } SEAM(5);
    if (IN(6)) { p_norm_route(F, 0, false); } SEAM(6);
    if (IN(7)) { p_permute(F, 0, false);
        Gemm g{F.H_(), F.Wgu_() + (size_t)(0 * 17 + 16) * 1024 * 1024, 1024}; SchedGrid S{NT_ALL, 4, F.G, F.bid, false}; EpiGU E{(bf16*)(F.big_() + B_HS)}; run_gemm<2>(F.lds, g, S, E); } SEAM(7);
    if (IN(8)) { { SchedRouted S; load_expoff(F, 0, S.eo); S.G = F.G; S.c = F.bid; Gemm g{(const bf16*)(F.big_() + B_AP), F.Wgu_() + (size_t)(0 * 17) * 1024 * 1024, 1024}; EpiGU E{(bf16*)(F.big_() + B_HE)}; run_gemm<3>(F.lds, g, S, E); }
        { Gemm g{(const bf16*)(F.big_() + B_HS), F.Wd_() + (size_t)(0 * 17 + 16) * 1024 * 512, 512}; SchedGrid S{NT_ALL, 4, F.G, F.bid, false}; EpiDownS E{&F, 0}; run_gemm<4>(F.lds, g, S, E); } } SEAM(8);
    if (IN(9)) { SchedRouted S; load_expoff(F, 0, S.eo); S.G = F.G; S.c = F.bid; Gemm g{(const bf16*)(F.big_() + B_HE), F.Wd_() + (size_t)(0 * 17) * 1024 * 512, 512}; EpiDownR E{(bf16*)(F.big_() + B_YE)}; run_gemm<5>(F.lds, g, S, E); } SEAM(9);
    if (IN(10)) { p_combine(F, 0, false, true); } SEAM(10);
    if (IN(11)) { Gemm g{F.H_(), F.Win1_(), 1024}; SchedGrid S{NT_ALL, 3, F.G, F.bid, false}; EpiIn1 E{F.big_(), F.ssq_(), F.ar->in[I_KRG], F.ropeR_(), F.ropeC_()}; run_gemm<6>(F.lds, g, S, E); } SEAM(11);
    if (IN(12)) { { Gemm g{(const bf16*)(F.big_() + B_CQ), F.Wuq_(), 384}; SchedGrid S{NT_LAT, 6, F.G, F.bid, true};
            EpiUq E{(bf16*)(F.big_() + B_Q1), F.ssq_(), F.ar->in[I_QNG], F.ar->in[I_QRG], F.ropeR_(), F.ropeC_(), xl}; run_gemm<7>(F.lds, g, S, E); }
        { Gemm g{(const bf16*)(F.big_() + B_CKV), F.Wukv_(), 256}; SchedGrid S{NT_ALL, 8, F.G, F.bid, false};
            EpiUkv E{(bf16*)(F.big_() + B_KN), (bf16*)(F.big_() + B_V1), F.ssq_(), F.ar->in[I_KNG], xl}; run_gemm<8>(F.lds, g, S, E); } } SEAM(12);
    if (IN(13)) { REP(13) for (int a = F.bid; a < 512; a += F.G) { if (ATTN_V1 & 2) mla_attn_unit_v1(F, a); else mla_attn_unit_v0(F, a); } } SEAM(13);
    if (IN(14)) { Gemm g{F.H_(), F.Wout1_(), 1024}; SchedGrid S{NT_LAT, 4, F.G, F.bid, true}; EpiOut E{&F, 1, false}; run_gemm<9>(F.lds, g, S, E); } SEAM(14);
    if (IN(15)) { p_norm_route(F, 1, true); } SEAM(15);
    if (IN(16)) { p_permute(F, 1, true);
        Gemm g{F.H_(), F.Wgu_() + (size_t)(1 * 17 + 16) * 1024 * 1024, 1024}; SchedGrid S{NT_LAT, 4, F.G, F.bid, true}; EpiGU E{(bf16*)(F.big_() + B_HS)}; run_gemm<10>(F.lds, g, S, E); } SEAM(16);
    if (IN(17)) { { SchedRouted S; load_expoff(F, 1, S.eo); S.G = F.G; S.c = F.bid; Gemm g{(const bf16*)(F.big_() + B_AP), F.Wgu_() + (size_t)(1 * 17) * 1024 * 1024, 1024}; EpiGU E{(bf16*)(F.big_() + B_HE)}; run_gemm<11>(F.lds, g, S, E); }
        { Gemm g{(const bf16*)(F.big_() + B_HS), F.Wd_() + (size_t)(1 * 17 + 16) * 1024 * 512, 512}; SchedGrid S{NT_LAT, 4, F.G, F.bid, true}; EpiDownS E{&F, 1}; run_gemm<12>(F.lds, g, S, E); } } SEAM(17);
    if (IN(18)) { SchedRouted S; load_expoff(F, 1, S.eo); S.G = F.G; S.c = F.bid; Gemm g{(const bf16*)(F.big_() + B_HE), F.Wd_() + (size_t)(1 * 17) * 1024 * 512, 512}; EpiDownR E{(bf16*)(F.big_() + B_YE)}; run_gemm<13>(F.lds, g, S, E); } SEAM(18);
    if (IN(19)) { p_combine(F, 1, true, false); }
#undef IN
#undef SEAM
}

extern "C" void kernel_launch(void* const* d_in, const int* in_sizes, int n_in, void* d_out, int out_size, void* d_ws, size_t ws_size, hipStream_t stream) {
    static int grid = 0;
    if (grid == 0) {
        if (n_in != 34 || in_sizes[0] != NB * SEQ * D || out_size != NB * SEQ * D || ws_size < WS_END) {
            fprintf(stderr, "kernel_launch: unexpected problem: n_in %d in0 %d out %d ws %zu (need %zu); nothing launched\n", n_in, n_in > 0 ? in_sizes[0] : -1, out_size, ws_size, (size_t)WS_END); grid = -1; return; }
        int dev = 0, cus = 0;
        if (hipGetDevice(&dev) != hipSuccess || hipDeviceGetAttribute(&cus, hipDeviceAttributeMultiprocessorCount, dev) != hipSuccess) { grid = -1; return; }
        if (hipFuncSetAttribute((const void*)mk_fwd, hipFuncAttributeMaxDynamicSharedMemorySize, LDS_BYTES) != hipSuccess) { fprintf(stderr, "kernel_launch: hipFuncSetAttribute failed\n"); grid = -1; return; }
        int per_cu = 0;
        if (hipOccupancyMaxActiveBlocksPerMultiprocessor(&per_cu, (const void*)mk_fwd, NTHREADS, LDS_BYTES) != hipSuccess || per_cu < 1) fprintf(stderr, "kernel_launch: note: occupancy query reports %d\n", per_cu);
        (void)hipGetLastError();
        grid = cus;
    }
    if (grid < 0) return;
    if (hipMemsetAsync((char*)d_ws + WS_CTL, 0, CTL_ZERO_BYTES, stream) != hipSuccess) { fprintf(stderr, "kernel_launch: memset failed\n"); return; }
    Args a{};
    for (int i = 0; i < 34; ++i) a.in[i] = (const float*)d_in[i];
    a.out = (float*)d_out; a.ws = (unsigned char*)d_ws;
    if (MK_N_LAUNCHES == 1) { a.ph_lo = 0; a.ph_hi = NPHASES; hipLaunchKernelGGL(mk_fwd, dim3(grid), dim3(NTHREADS), LDS_BYTES, stream, a); }
    else for (int p = 0; p < NPHASES; ++p) { a.ph_lo = p; a.ph_hi = p + 1; hipLaunchKernelGGL(mk_fwd, dim3(grid), dim3(NTHREADS), LDS_BYTES, stream, a); }
    const hipError_t le = hipPeekAtLastError();
    if (le != hipSuccess) fprintf(stderr, "kernel_launch: launch failed: %s\n", hipGetErrorName(le));
}
```

```cpp
#include <hip/hip_runtime.h>
#include <cstdio>
#include <cstdint>

#ifndef MK_N_LAUNCHES
#define MK_N_LAUNCHES 1
#endif

#ifndef PROBE_SEC
#define PROBE_SEC 0
#endif
#define SEC_BEGIN(id) const unsigned long long sec_t##id = (PROBE_SEC == (id)) ? (unsigned long long)clock64() : 0ull
#define SEC_END(id) do { if (PROBE_SEC == (id)) F.sec_acc += (unsigned long long)clock64() - sec_t##id; } while (0)
#define GAS __attribute__((address_space(1)))
#define LAS __attribute__((address_space(3)))
typedef unsigned short bf16;
typedef _Float16 f16;
typedef short bf16x8 __attribute__((ext_vector_type(8)));
typedef float f32x4 __attribute__((ext_vector_type(4)));
typedef float f32x2 __attribute__((ext_vector_type(2)));
typedef float f32x16 __attribute__((ext_vector_type(16)));
typedef unsigned v4u __attribute__((ext_vector_type(4)));
typedef unsigned v2u __attribute__((ext_vector_type(2)));
typedef GAS unsigned gu32;
#define RLX_AGENT __ATOMIC_RELAXED, __HIP_MEMORY_SCOPE_AGENT
#define LDS_WAIT() asm volatile("s_waitcnt lgkmcnt(0)" ::: "memory")
#define VM_WAIT() asm volatile("s_waitcnt vmcnt(0)" ::: "memory")
#define EPI_BAR() do { asm volatile("s_waitcnt lgkmcnt(0)" ::: "memory"); __builtin_amdgcn_s_barrier(); asm volatile("" ::: "memory"); } while (0)

constexpr int NB = 8, SEQ = 2048, CTXL = 256, RPB = 2304  , NR = NB * RPB  , D = 1024;
constexpr int NT_ALL = NR / 256  , NT_LAT = 64;
constexpr int NEXP = 16, FF = 512;
constexpr int MP_MAX = 41216;
constexpr float EPS = 1e-6f;
constexpr float LOG2E = 1.4426950408889634f;
constexpr int NWAVES = 8, NTHREADS = 512;

constexpr size_t MiB = 1u << 20;
constexpr size_t WS_CTL = 0, CTL_ZERO_BYTES = 1 * MiB;
constexpr int CW_TMO = 0, CW_CODE = 1, CW_BAR = 4096, CW_CNT = 8192;
constexpr size_t WS_SMALL = 1 * MiB;
constexpr size_t SM_MODV = 0;
constexpr size_t SM_ROPER = 448 * 1024;
constexpr size_t SM_ROPEC = 452 * 1024;
constexpr size_t SM_LBV = 460 * 1024;
constexpr size_t SM_LAM = 464 * 1024;
constexpr size_t SM_ROUTE_E = 512 * 1024;
constexpr size_t SM_ROUTE_W = 584 * 1024;
constexpr size_t SM_ROUTE_S = 728 * 1024;
constexpr size_t SM_POS = 872 * 1024;
constexpr size_t SM_ROWIDX = 1016 * 1024;
constexpr size_t SM_SSQ = 1280 * 1024;
static_assert(SM_ROUTE_E + (size_t)NR * 4 <= SM_ROUTE_W && SM_ROUTE_W + (size_t)NR * 8 <= SM_ROUTE_S && SM_ROUTE_S + (size_t)NR * 8 <= SM_POS && SM_POS + (size_t)NR * 8 <= SM_ROWIDX &&
              SM_ROWIDX + (size_t)MP_MAX * 4 <= SM_SSQ && SM_SSQ + (size_t)NR * 48 <= 3 * MiB, "small map");
constexpr size_t WS_WIN0 = 4 * MiB, WS_WOUT0 = 12 * MiB, WS_WIN1 = 14 * MiB, WS_WUQ = 16 * MiB, WS_WUKV = 18 * MiB, WS_WOUT1 = 19 * MiB;
constexpr size_t WS_WGU = 22 * MiB;
constexpr size_t WS_WD = 90 * MiB;
constexpr size_t WS_XC = 124 * MiB;
constexpr size_t WS_H = 132 * MiB;
constexpr size_t WS_BIG = 168 * MiB;
constexpr size_t WS_END = 348 * MiB;
constexpr size_t SZ18 = 18 * MiB;
constexpr size_t B_QD = 0, B_KD = SZ18, B_VD = 2 * SZ18, B_HQ = 3 * SZ18, B_LF0 = 4 * SZ18, B_LF1 = 5 * SZ18, B_HV = 6 * SZ18, B_HG = 7 * SZ18, B_HO0 = 8 * SZ18, B_HO1 = 9 * SZ18;
constexpr size_t B_HS = 0, B_HE = 18 * MiB, B_YE = 60 * MiB, B_AP = 60 * MiB, B_YS = 142 * MiB;
static_assert(B_HE + (size_t)MP_MAX * 512 * 2 <= B_YE && B_YE + (size_t)MP_MAX * 1024 * 2 <= B_YS && B_YS + (size_t)NR * 1024 * 2 <= 180 * MiB, "moe map");
constexpr size_t B_CKV = 0, B_CQ = 9 * MiB, B_KR = 23 * MiB, B_Q1 = 26 * MiB, B_KN = 80 * MiB, B_V1 = 116 * MiB;

constexpr int LDS_BYTES = 155648;
constexpr int LDS_MISC = 131072;
constexpr int LDS_XCH = 132096;

__device__ __forceinline__ unsigned f2bf(float f) { unsigned u = __builtin_bit_cast(unsigned, f); return (u + 0x7fffu + ((u >> 16) & 1u)) >> 16; }
__device__ __forceinline__ unsigned pk2(float lo, float hi) { return f2bf(lo) | (f2bf(hi) << 16); }
typedef __bf16 bf16x2_t __attribute__((ext_vector_type(2)));
__device__ __forceinline__ unsigned cvtpk_b(float lo, float hi) { const f32x2 v = {lo, hi}; const bf16x2_t b = __builtin_convertvector(v, bf16x2_t); return __builtin_bit_cast(unsigned, b); }
__device__ __forceinline__ float bf2f(bf16 h) { return __builtin_bit_cast(float, (unsigned)h << 16); }
__device__ __forceinline__ float bflo(unsigned w) { return __builtin_bit_cast(float, w << 16); }
__device__ __forceinline__ float bfhi(unsigned w) { return __builtin_bit_cast(float, w & 0xffff0000u); }
__device__ __forceinline__ unsigned pkh2(float lo, float hi) { f16 a = (f16)lo, b = (f16)hi; return (unsigned)__builtin_bit_cast(unsigned short, a) | ((unsigned)__builtin_bit_cast(unsigned short, b) << 16); }
__device__ __forceinline__ float fexp(float x) { return __builtin_amdgcn_exp2f(x * LOG2E); }
__device__ __forceinline__ float sigmoidf_(float x) { return __builtin_amdgcn_rcpf(1.0f + fexp(-x)); }
__device__ __forceinline__ float siluf_(float x) { return x * __builtin_amdgcn_rcpf(1.0f + fexp(-x)); }
__device__ __forceinline__ float rsq_(float x) { return __builtin_amdgcn_rsqf(x); }
__device__ __forceinline__ float wave_sum(float v) {
#pragma unroll
    for (int o = 1; o < 64; o <<= 1) v += __shfl_xor(v, o);
    return v;
}
__host__ __device__ __forceinline__ int perm32(int rho) { const int n = rho >> 4, i = rho & 15; return 8 * (i >> 2) + 4 * n + (i & 3); }
__host__ __device__ __forceinline__ int ddmap(int j) { return 16 * ((j >> 2) & 1) + 4 * (j >> 3) + (j & 3); }
__device__ __forceinline__ int opaque(int x) { asm volatile("" : "+v"(x)); return x; }
__device__ __forceinline__ int pil(int r, int c, int L) { return (r >> 1) * (2 * L) + (c >> 5) * 64 + (r & 1) * 32 + (c & 31); }
__device__ __forceinline__ size_t pil_off(size_t r, int c) { return (r >> 1) * 2048 + (size_t)((c >> 5) * 64 + (int)(r & 1) * 32 + (c & 31)); }
__device__ __forceinline__ int crow(int r, int hi) { return (r & 3) + 8 * (r >> 2) + 4 * hi; }

#define XB_TMO      128
#define XB_XCNT(j)  (256  + 64 * (j))
#define XB_XSUB(j)  (1280 + 64 * (j))
#define XB_XGEN(j)  (2304 + 64 * (j))
#define XB_TOP      3328
#define XB_TOPGEN   3392
#define XCD_BAR_WORDS 3456
#define XB_SPIN_CAP (1u << 18)
__device__ __forceinline__ unsigned xb_ld(unsigned* p)              { return __hip_atomic_load(p, __ATOMIC_RELAXED, __HIP_MEMORY_SCOPE_AGENT); }
__device__ __forceinline__ unsigned xb_add(unsigned* p, unsigned v) { return __hip_atomic_fetch_add(p, v, __ATOMIC_RELAXED, __HIP_MEMORY_SCOPE_AGENT); }
__device__ __forceinline__ unsigned xb_xcc_id() { return (unsigned)__builtin_amdgcn_s_getreg((3 << 11) | 20) & 0xFu; }
#define XB_SPIN(cond, bar) do { unsigned _sp = 0; while (cond) { __builtin_amdgcn_s_sleep(1); \
    if ((++_sp & 255u) == 0u) { if (xb_ld(&(bar)[XB_TMO])) break; if (_sp > XB_SPIN_CAP) { atomicAdd(&(bar)[XB_TMO], 1u); break; } } } } while (0)
struct XcdBarrier { unsigned* bar; unsigned x; volatile LAS unsigned* st; };
__device__ __forceinline__ XcdBarrier xcd_barrier_post(unsigned* bar, volatile LAS unsigned* st) {
    XcdBarrier b; b.bar = bar; b.x = xb_xcc_id(); b.st = st;
    if (threadIdx.x == 0) (void)xb_add(&bar[XB_XCNT(b.x)], 1u);
    return b;
}
__device__ __forceinline__ void xcd_barrier_complete(unsigned* bar, unsigned x, unsigned& nloc, unsigned& nx) {
    const unsigned G = gridDim.x * gridDim.y * gridDim.z;
    unsigned sum, cnt, mine, sp = 0u;
    for (;;) {
        sum = 0u; cnt = 0u; mine = 0u;
#pragma unroll
        for (unsigned j = 0; j < 16; ++j) { const unsigned c = xb_ld(&bar[XB_XCNT(j)]); sum += c; cnt += (c > 0u) ? 1u : 0u; mine = (j == x) ? c : mine; }
        if (sum == G) break;
        __builtin_amdgcn_s_sleep(1);
        if ((++sp & 255u) == 0u) { if (xb_ld(&bar[XB_TMO])) break; if (sp > XB_SPIN_CAP) { atomicAdd(&bar[XB_TMO], 1u); break; } }
    }
    nloc = mine > 0u ? mine : 1u; nx = cnt > 0u ? cnt : 1u;
}
__device__ __forceinline__ void xcd_barrier(const XcdBarrier& b) {
    asm volatile("s_waitcnt vmcnt(0)" ::: "memory");
    __syncthreads();
    if (threadIdx.x == 0) {
        unsigned* bar = b.bar;
        __builtin_amdgcn_s_waitcnt(0);
        unsigned nloc = b.st[0], nx = b.st[1];
        if (nloc == 0u) { xcd_barrier_complete(bar, b.x, nloc, nx); b.st[0] = nloc; b.st[1] = nx; }
        const unsigned old = xb_add(&bar[XB_XSUB(b.x)], 1u);
        const unsigned gen = old / nloc;
        if (old + 1u == (gen + 1u) * nloc) {
            __builtin_amdgcn_fence(__ATOMIC_RELEASE, "agent");
            asm volatile("s_waitcnt vmcnt(0)" ::: "memory");
            const unsigned og = xb_add(&bar[XB_TOP], 1u);
            const unsigned tg = og / nx;
            if (og + 1u == (tg + 1u) * nx) xb_add(&bar[XB_TOPGEN], 1u);
            else XB_SPIN(xb_ld(&bar[XB_TOPGEN]) == tg, bar);
            __builtin_amdgcn_fence(__ATOMIC_ACQUIRE, "agent");
            xb_add(&bar[XB_XGEN(b.x)], 1u);
            asm volatile("s_waitcnt vmcnt(0)" ::: "memory");
        } else {
            XB_SPIN(xb_ld(&bar[XB_XGEN(b.x)]) == gen, bar);
            __builtin_amdgcn_fence(__ATOMIC_ACQUIRE, "agent");
            asm volatile("s_waitcnt vmcnt(0)" ::: "memory");
        }
    }
    __syncthreads();
}

struct Args { const float* in[34]; float* out; unsigned char* ws; int ph_lo, ph_hi; };

struct Frame {
    LAS unsigned char* lds;
    int tid, lane, wave, G, bid;
    const Args* ar;
    float* out; unsigned char* ws;
    unsigned long long sec_acc;
    __device__ __forceinline__ gu32* ctl_() const { return (gu32*)(ws + WS_CTL); }
    __device__ __forceinline__ float* modv_() const { return (float*)(ws + WS_SMALL + SM_MODV); }
    __device__ __forceinline__ f32x2* ropeR_() const { return (f32x2*)(ws + WS_SMALL + SM_ROPER); }
    __device__ __forceinline__ f32x2* ropeC_() const { return (f32x2*)(ws + WS_SMALL + SM_ROPEC); }
    __device__ __forceinline__ float* lbv_() const { return (float*)(ws + WS_SMALL + SM_LBV); }
    __device__ __forceinline__ float* lamv_() const { return (float*)(ws + WS_SMALL + SM_LAM); }
    __device__ __forceinline__ int* route_e_() const { return (int*)(ws + WS_SMALL + SM_ROUTE_E); }
    __device__ __forceinline__ float* route_w_() const { return (float*)(ws + WS_SMALL + SM_ROUTE_W); }
    __device__ __forceinline__ int* route_s_() const { return (int*)(ws + WS_SMALL + SM_ROUTE_S); }
    __device__ __forceinline__ int* pos_() const { return (int*)(ws + WS_SMALL + SM_POS); }
    __device__ __forceinline__ float* ssq_() const { return (float*)(ws + WS_SMALL + SM_SSQ); }
    __device__ __forceinline__ bf16* Win0_() const { return (bf16*)(ws + WS_WIN0); }
    __device__ __forceinline__ bf16* Wout0_() const { return (bf16*)(ws + WS_WOUT0); }
    __device__ __forceinline__ bf16* Win1_() const { return (bf16*)(ws + WS_WIN1); }
    __device__ __forceinline__ bf16* Wuq_() const { return (bf16*)(ws + WS_WUQ); }
    __device__ __forceinline__ bf16* Wukv_() const { return (bf16*)(ws + WS_WUKV); }
    __device__ __forceinline__ bf16* Wout1_() const { return (bf16*)(ws + WS_WOUT1); }
    __device__ __forceinline__ bf16* Wgu_() const { return (bf16*)(ws + WS_WGU); }
    __device__ __forceinline__ bf16* Wd_() const { return (bf16*)(ws + WS_WD); }
    __device__ __forceinline__ float* xc_() const { return (float*)(ws + WS_XC); }
    __device__ __forceinline__ bf16* H_() const { return (bf16*)out; }
    __device__ __forceinline__ bf16* Xb_() const { return (bf16*)(ws + WS_H); }
    __device__ __forceinline__ unsigned char* big_() const { return ws + WS_BIG; }
};
enum { I_X = 0, I_C, I_CTX, I_CCTX, I_MODW, I_MODB, I_NMIX, I_NFFN, I_EWIN, I_EWOUT, I_DQG, I_DKG, I_DLAM, I_DSUBLN, I_LBL, I_HOG, I_OWIN, I_QAG, I_KVAG, I_WUQ, I_WUKV,
       I_QNG, I_QRG, I_KNG, I_KRG, I_OWOUT, I_RW, I_RB, I_EG, I_EU, I_ED, I_SG, I_SU, I_SD };

__device__ __forceinline__ const float* xin_ptr(const Frame& F, int b, int s) { return s < CTXL ? F.ar->in[I_CTX] + (size_t)(b * CTXL + s) * D : F.ar->in[I_X] + (size_t)(b * SEQ + s - CTXL) * D; }

struct CvtDesc { const float* W; int ldn, srccol0; bool perm; const float* kscale; bf16* WT; int K, k0; };
__device__ __forceinline__ void p0_item_load(const CvtDesc& d, float (&tv)[32], int lane) {
    if (d.srccol0 >= 0) {
#pragma unroll
        for (int i = 0; i < 32; ++i) { const int kk = 2 * i + (lane >> 5); tv[i] = d.W[(size_t)(d.k0 + kk) * d.ldn + d.srccol0 + (lane & 31)]; }
    } else {
#pragma unroll
        for (int i = 0; i < 32; ++i) tv[i] = 0.f;
    }
}
__device__ __forceinline__ void p0_item_finish(const CvtDesc& d, float (&tv)[32], LAS float* scr, int lane) {
    if (d.kscale && d.srccol0 >= 0) {
#pragma unroll
        for (int i = 0; i < 32; ++i) tv[i] *= d.kscale[d.k0 + 2 * i + (lane >> 5)]; }
#pragma unroll
    for (int i = 0; i < 32; ++i) { const int kk = 2 * i + (lane >> 5); scr[kk * 33 + (lane & 31)] = tv[i]; }
    LDS_WAIT(); asm volatile("" ::: "memory");
    const int c = lane & 7;
#pragma unroll
    for (int j = 0; j < 4; ++j) { const int n = (lane >> 3) + 8 * j; const int sn = d.perm ? ddmap(n) : n; const LAS float* sp = scr + (8 * c) * 33 + sn;
        v4u o; o.x = cvtpk_b(sp[0 * 33], sp[1 * 33]); o.y = cvtpk_b(sp[2 * 33], sp[3 * 33]); o.z = cvtpk_b(sp[4 * 33], sp[5 * 33]); o.w = cvtpk_b(sp[6 * 33], sp[7 * 33]);
        *(GAS v4u*)(d.WT + (size_t)n * d.K + d.k0 + 8 * c) = o; }
    LDS_WAIT(); asm volatile("" ::: "memory");
}

__device__ __forceinline__ CvtDesc p0_item_desc(Frame& F, int it) {
    if (it < 2048) {
        const int kb = it >> 7, tb = it & 127, pn = tb >> 3, blk = tb & 7, bj = blk >> 2, wc = blk & 3;
        int sb; bool perm = false;
        if (pn < 4) { sb = pn * 8 + 2 * wc + bj; perm = true; } else sb = tb;
        return CvtDesc{F.ar->in[I_EWIN], 4096, sb * 32, perm, nullptr, F.Win0_() + (size_t)tb * 32 * 1024, 1024, kb * 64}; }
    it -= 2048;
    if (it < 512) { const int kb = it >> 5, tb = it & 31; return CvtDesc{F.ar->in[I_EWOUT], 1024, tb * 32, false, nullptr, F.Wout0_() + (size_t)tb * 32 * 1024, 1024, kb * 64}; }
    it -= 512;
    if (it < 384) {
        const int kb = it / 24, tb = it % 24; int sc; bool perm = false;
        if (tb < 8) sc = 384 + tb * 32;
        else if (tb < 16) sc = (tb - 8) * 32;
        else { const int blk = tb - 16, bj = blk >> 2, wc = blk & 3;
            if (bj == 0) { if (wc < 3) sc = 256 + wc * 32; else { sc = 640; perm = true; } }
            else { if (wc == 0) sc = 352; else if (wc == 3) { sc = 672; perm = true; } else sc = -1; } }
        return CvtDesc{F.ar->in[I_OWIN], 704, sc, perm, nullptr, F.Win1_() + (size_t)tb * 32 * 1024, 1024, kb * 64}; }
    it -= 384;
    if (it < 288) {
        const int kb = it / 48, tb = it % 48, t = tb >> 3, blk = tb & 7, bj = blk >> 2, wc = blk & 3; int sc; bool perm = false;
        if (t < 4) { const int h = 2 * t + bj; sc = h * 192 + 32 * wc; }
        else { const int h = 4 * (t - 4) + wc; sc = h * 192 + 128 + 32 * bj; perm = true; }
        return CvtDesc{F.ar->in[I_WUQ], 1536, sc, perm, F.ar->in[I_QAG], F.Wuq_() + (size_t)tb * 32 * 384, 384, kb * 64}; }
    it -= 288;
    if (it < 256) { const int kb = it >> 6, tb = it & 63; return CvtDesc{F.ar->in[I_WUKV], 2048, tb * 32, false, F.ar->in[I_KVAG], F.Wukv_() + (size_t)tb * 32 * 256, 256, kb * 64}; }
    it -= 256;
    if (it < 512) { const int kb = it >> 5, tb = it & 31; return CvtDesc{F.ar->in[I_OWOUT], 1024, tb * 32, false, nullptr, F.Wout1_() + (size_t)tb * 32 * 1024, 1024, kb * 64}; }
    it -= 512;
    {
        const int le = it / 768, r2 = it % 768, l = le / 17, e = le % 17;
        if (r2 < 512) { const int kb = r2 >> 5, tb = r2 & 31, pnl = tb >> 3, blk = tb & 7, bj = blk >> 2, wcb = blk & 3;
            const float* src = (e < 16) ? (bj ? F.ar->in[I_EU] : F.ar->in[I_EG]) + (size_t)(l * 16 + e) * 1024 * 512 : (bj ? F.ar->in[I_SU] : F.ar->in[I_SG]) + (size_t)l * 1024 * 512;
            return CvtDesc{src, 512, (pnl * 4 + wcb) * 32, false, nullptr, F.Wgu_() + ((size_t)(l * 17 + e) * 1024 + tb * 32) * 1024, 1024, kb * 64}; }
        else { const int r3 = r2 - 512, kb = r3 >> 5, tb = r3 & 31;
            const float* src = (e < 16) ? F.ar->in[I_ED] + (size_t)(l * 16 + e) * 512 * 1024 : F.ar->in[I_SD] + (size_t)l * 512 * 1024;
            return CvtDesc{src, 1024, tb * 32, false, nullptr, F.Wd_() + ((size_t)(l * 17 + e) * 1024 + tb * 32) * 512, 512, kb * 64}; }
    }
}
constexpr int P0_NITEMS = 2048 + 512 + 384 + 288 + 256 + 512 + 2 * 17 * 768;
constexpr int P0_EARLY = 2560 + 17 * 768, P0_LATE = 1440 + 17 * 768;
static_assert(P0_EARLY + P0_LATE == P0_NITEMS, "items");

#define P0_PAIR_LOOP(start, end, stride, MAPEXPR) do { for (int jj_ = (start); jj_ < (end); jj_ += 2 * (stride)) { float ta_[32], tb_[32]; \
        int j_ = jj_; const CvtDesc da_ = p0_item_desc(F, (MAPEXPR)); p0_item_load(da_, ta_, F.lane); \
        const bool two_ = jj_ + (stride) < (end); j_ = two_ ? jj_ + (stride) : jj_; const CvtDesc db_ = p0_item_desc(F, (MAPEXPR)); if (two_) p0_item_load(db_, tb_, F.lane); \
        p0_item_finish(da_, ta_, scr, F.lane); if (two_) p0_item_finish(db_, tb_, scr, F.lane); } } while (0)
__device__ __forceinline__ void p0_prologue(Frame& F) {
    LAS float* ldsf = (LAS float*)F.lds;
    __syncthreads();
    for (int it = F.bid; it < 192; it += F.G) {
        const int l = it / 96, n0 = (it % 96) * 64;
        LAS float* sc = ldsf;
        LAS float* red = ldsf + 9 * 1024;
        for (int e = F.tid; e < 9 * 1024; e += NTHREADS) { const int r = e >> 10, k = e & 1023; const float v = (r < 8) ? F.ar->in[I_C][r * 1024 + k] : F.ar->in[I_CCTX][k]; sc[e] = siluf_(v); }
        __syncthreads();
        float a[9];
#pragma unroll
        for (int r = 0; r < 9; ++r) a[r] = 0.f;
        const float* w = F.ar->in[I_MODW] + (size_t)l * 1024 * 6144 + n0 + F.lane;
        const int kbeg = F.wave * 128;
#pragma unroll 32
        for (int k = kbeg; k < kbeg + 128; ++k) { const float wv = w[(size_t)k * 6144];
#pragma unroll
            for (int r = 0; r < 9; ++r) a[r] += sc[r * 1024 + k] * wv; }
#pragma unroll
        for (int r = 0; r < 9; ++r) red[(F.wave * 9 + r) * 64 + F.lane] = a[r];
        __syncthreads();
        for (int e = F.tid; e < 9 * 64; e += NTHREADS) { const int r = e >> 6, c = e & 63; float s = 0.f;
#pragma unroll
            for (int w8 = 0; w8 < 8; ++w8) s += red[(w8 * 9 + r) * 64 + c];
            F.modv_()[(size_t)(l * 9 + r) * 6144 + n0 + c] = s + F.ar->in[I_MODB][l * 6144 + n0 + c]; }
        __syncthreads();
    }
    if (F.bid == F.G - 1) {
        for (int e = F.tid; e < 96 * 16; e += NTHREADS) { const int p = e >> 4, i = e & 15;
            const float inv = __builtin_amdgcn_exp2f(-(float)(2 * i) * (1.0f / 32.0f) * 13.287712379549449f);
            const float pos = (p < 32) ? (float)p : (float)(p - 32); const float ang = pos * inv;
            const f32x2 cs = {__cosf(ang), __sinf(ang)};
            if (p < 32) F.ropeR_()[p * 16 + i] = cs; else F.ropeC_()[(p - 32) * 16 + i] = cs; }
        for (int e = F.tid; e < 1024; e += NTHREADS) { const float l0 = F.ar->in[I_LBL][e], l1 = F.ar->in[I_LBL][1024 + e]; F.lbv_()[e] = 1.0f / (1.0f + fexp(l1 - l0)); }
        if (F.wave == 0) { const float* lv = F.ar->in[I_DLAM]; float s1 = wave_sum(lv[F.lane] * lv[64 + F.lane]), s2 = wave_sum(lv[128 + F.lane] * lv[192 + F.lane]);
            if (F.lane == 0) { F.lamv_()[0] = fexp(s1) - fexp(s2) + 0.2f; } }
    }
    __syncthreads();

}
__device__ __forceinline__ void p0_convert_in0(Frame& F) {
    LAS float* scr = (LAS float*)(F.lds + F.wave * 8704);
    const int gw = F.bid * NWAVES + F.wave, NGW = F.G * NWAVES;
    P0_PAIR_LOOP(gw, 2048, NGW, j_);
}
__device__ __forceinline__ void p0_convert_mid(Frame& F, int first) {
    if (F.bid < first) return;
    LAS float* scr = (LAS float*)(F.lds + F.wave * 8704);
    const int gw = (F.bid - first) * NWAVES + F.wave, NGW = (F.G - first) * NWAVES;
    constexpr int NMID = 512 + 17 * 768;
#define MAPJ(j) ((j) < 512 ? 2048 + (j) : 4000 + ((j) - 512))
    P0_PAIR_LOOP(gw, NMID, NGW, MAPJ(j_));
#undef MAPJ
}
__device__ __forceinline__ void p0_convert_late(Frame& F, int part) {
    const int first = F.G > 32 ? 32 : 0, nb = F.G - first;
    if (F.bid < first) return;
    LAS float* scr = (LAS float*)(F.lds + F.wave * 8704);
    const int gw = (F.bid - first) * NWAVES + F.wave, NGW = nb * NWAVES;
    const int lo = part * (P0_LATE / 2), hi = part ? P0_LATE : (P0_LATE / 2);
#define MAPJ(j) ((j) < 1440 ? 2560 + (j) : 17056 + ((j) - 1440))
    P0_PAIR_LOOP(lo + gw, hi, NGW, MAPJ(j_));
#undef MAPJ
}

__device__ __forceinline__ void modnorm_store(const f32x4 (&v)[4], const float* gain, const float* sh, const float* sc, bf16* orow, int lane) {
    float s = 0.f;
#pragma unroll
    for (int j = 0; j < 4; ++j) s += (v[j].x * v[j].x + v[j].y * v[j].y) + (v[j].z * v[j].z + v[j].w * v[j].w);
    const float rstd = rsq_(wave_sum(s) * (1.0f / D) + EPS);
#pragma unroll
    for (int j = 0; j < 4; ++j) { const int c = 4 * (lane + 64 * j);
        const f32x4 g = *(const f32x4*)(gain + c), a = *(const f32x4*)(sc + c), b = *(const f32x4*)(sh + c);
        const f32x4 y = (v[j] * rstd) * g * (1.0f + a) + b;
        v2u o; o.x = cvtpk_b(y.x, y.y); o.y = cvtpk_b(y.z, y.w); *(v2u*)(orow + c) = o; }
}

__device__ __forceinline__ void p_norm0(Frame& F) {
    const int gw = F.bid * NWAVES + F.wave, NGW = F.G * NWAVES;
    f32x4 cur[4];
#define N0_LOAD(R_, dst) do { const int b_ = (R_) / RPB, s_ = (R_) - b_ * RPB; const f32x4* src_ = (const f32x4*)xin_ptr(F, b_, s_) + F.lane; \
        _Pragma("unroll") for (int j = 0; j < 4; ++j) dst[j] = src_[64 * j]; } while (0)
    if (gw < NR) N0_LOAD(gw, cur);
    for (int R = gw; R < NR; R += NGW) {
        const int b = R / RPB, s = R - b * RPB, r = s < CTXL ? 8 : b;
        f32x4 nxt[4];
#pragma unroll
        for (int j = 0; j < 4; ++j) nxt[j] = cur[j];
        if (R + NGW < NR) N0_LOAD(R + NGW, nxt);
        const float* mv = F.modv_() + (size_t)(0 * 9 + r) * 6144;
        modnorm_store(cur, F.ar->in[I_NMIX], mv + 0, mv + 1024, F.H_() + (size_t)R * D, F.lane);
#pragma unroll
        for (int j = 0; j < 4; ++j) cur[j] = nxt[j];
    }
#undef N0_LOAD
}

__device__ __forceinline__ void p_hgrn_post(Frame& F) {
    const int gw = F.bid * NWAVES + F.wave, NGW = F.G * NWAVES;
    const bf16* Ho0 = (const bf16*)(F.big_() + B_HO0); const bf16* Ho1 = (const bf16*)(F.big_() + B_HO1); const bf16* Hg = (const bf16*)(F.big_() + B_HG);
    const int c = F.lane * 8;
    v4u na = {0u, 0u, 0u, 0u}, nb = na, ng = na;
    if (gw < NR) { na = *(const v4u*)(Ho0 + (size_t)gw * 512 + c); nb = *(const v4u*)(Ho1 + (size_t)gw * 512 + c); ng = *(const v4u*)(Hg + pil(gw, c, 512)); }
    for (int R = gw; R < NR; R += NGW) {
        const v4u a = na, bq = nb, g = ng;
        if (R + NGW < NR) { const int Rn = R + NGW; na = *(const v4u*)(Ho0 + (size_t)Rn * 512 + c); nb = *(const v4u*)(Ho1 + (size_t)Rn * 512 + c); ng = *(const v4u*)(Hg + pil(Rn, c, 512)); }
        float o[8];
        o[0] = bflo(a.x) + bflo(bq.x); o[1] = bfhi(a.x) + bfhi(bq.x); o[2] = bflo(a.y) + bflo(bq.y); o[3] = bfhi(a.y) + bfhi(bq.y);
        o[4] = bflo(a.z) + bflo(bq.z); o[5] = bfhi(a.z) + bfhi(bq.z); o[6] = bflo(a.w) + bflo(bq.w); o[7] = bfhi(a.w) + bfhi(bq.w);
        float s = 0.f;
#pragma unroll
        for (int i = 0; i < 8; ++i) s += o[i] * o[i];
        s += __shfl_xor(s, 1); s += __shfl_xor(s, 2); s += __shfl_xor(s, 4); s += __shfl_xor(s, 8);
        const float rstd = rsq_(s * (1.0f / 128.0f) + EPS);
        const float* og = F.ar->in[I_HOG] + (c & 127);
        const float gg[8] = {bflo(g.x), bfhi(g.x), bflo(g.y), bfhi(g.y), bflo(g.z), bfhi(g.z), bflo(g.w), bfhi(g.w)};
        float y[8];
#pragma unroll
        for (int i = 0; i < 8; ++i) y[i] = o[i] * rstd * og[i] * gg[i];
        v4u w; w.x = pk2(y[0], y[1]); w.y = pk2(y[2], y[3]); w.z = pk2(y[4], y[5]); w.w = pk2(y[6], y[7]);
        *(v4u*)(F.H_() + (size_t)R * D + 512 + c) = w;
    }
}

__device__ __forceinline__ void p_norm_route(Frame& F, int layer, bool lat_only) {
    const int gw = F.bid * NWAVES + F.wave, NGW = F.G * NWAVES;
    const float* rw = F.ar->in[I_RW];
    unsigned* cnt = (unsigned*)(F.ctl_() + CW_CNT + 2048 * layer);
    LAS float* rwT = (LAS float*)F.lds;
    LAS unsigned* lcnt = (LAS unsigned*)(F.lds + 65536);
    __syncthreads();
    if (F.tid < 32) lcnt[F.tid] = 0u;
    for (int e = F.tid; e < 16384; e += NTHREADS) rwT[(e & 15) * 1024 + (e >> 4)] = rw[e];
    __syncthreads();
#define NR_NEXT(R_) do { R_ += NGW; } while (R_ < NR && lat_only && (R_ % RPB) < CTXL)
#define NR_LOAD(R_, dst) do { _Pragma("unroll") for (int j = 0; j < 4; ++j) dst[j] = *(const v2u*)(F.Xb_() + pil(R_, 4 * (F.lane + 64 * j), 1024)); } while (0)
    int R0 = gw; if (lat_only && (R0 % RPB) < CTXL) NR_NEXT(R0);
    v2u xcur[4] = {{0u, 0u}, {0u, 0u}, {0u, 0u}, {0u, 0u}};
    if (R0 < NR) NR_LOAD(R0, xcur);
    for (int R = R0; R < NR;) {
        const int b = R / RPB, s = R - b * RPB, r = s < CTXL ? 8 : b;
        int Rn = R; NR_NEXT(Rn);
        v2u xnxt[4];
#pragma unroll
        for (int j = 0; j < 4; ++j) xnxt[j] = xcur[j];
        if (Rn < NR) NR_LOAD(Rn, xnxt);
        f32x4 v[4];
#pragma unroll
        for (int j = 0; j < 4; ++j) v[j] = (f32x4){bflo(xcur[j].x), bfhi(xcur[j].x), bflo(xcur[j].y), bfhi(xcur[j].y)};
        const float* mv = F.modv_() + (size_t)(layer * 9 + r) * 6144;
        const float* gain = F.ar->in[I_NFFN] + layer * 1024; const float* sh = mv + 3072; const float* sc = mv + 4096;
        float ss = 0.f;
#pragma unroll
        for (int j = 0; j < 4; ++j) ss += (v[j].x * v[j].x + v[j].y * v[j].y) + (v[j].z * v[j].z + v[j].w * v[j].w);
        const float rstd = rsq_(wave_sum(ss) * (1.0f / D) + EPS);
        float lg[16];
#pragma unroll
        for (int e = 0; e < 16; ++e) lg[e] = 0.f;
        f32x4 y[4];
        {   f32x4 g4[4], a4[4], b4[4];
#pragma unroll
            for (int j = 0; j < 4; ++j) { const int c = 4 * (F.lane + 64 * j); g4[j] = *(const f32x4*)(gain + c); a4[j] = *(const f32x4*)(sc + c); b4[j] = *(const f32x4*)(sh + c); }
#pragma unroll
            for (int j = 0; j < 4; ++j) { const int c = 4 * (F.lane + 64 * j); y[j] = (v[j] * rstd) * g4[j] * (1.0f + a4[j]) + b4[j];
                v2u o; o.x = cvtpk_b(y[j].x, y[j].y); o.y = cvtpk_b(y[j].z, y[j].w); *(v2u*)(F.H_() + (size_t)R * D + c) = o; } }
#pragma unroll
        for (int eb = 0; eb < 16; eb += 4) {
            f32x4 w[4][4];
#pragma unroll
            for (int e = 0; e < 4; ++e)
#pragma unroll
                for (int j = 0; j < 4; ++j) w[e][j] = *(const LAS f32x4*)(rwT + (eb + e) * 1024 + 4 * (F.lane + 64 * j));
            __builtin_amdgcn_sched_barrier(0);
#pragma unroll
            for (int e = 0; e < 4; ++e)
#pragma unroll
                for (int j = 0; j < 4; ++j) lg[eb + e] += (y[j].x * w[e][j].x + y[j].y * w[e][j].y) + (y[j].z * w[e][j].z + y[j].w * w[e][j].w);
            __builtin_amdgcn_sched_barrier(0); }
        {
            const int lane = F.lane;
            float t8[8], t4[4], t2[2], t1;
#pragma unroll
            for (int i = 0; i < 8; ++i) { const float keep = (lane & 32) ? lg[8 + i] : lg[i], send = (lane & 32) ? lg[i] : lg[8 + i]; t8[i] = keep + __shfl_xor(send, 32); }
#pragma unroll
            for (int i = 0; i < 4; ++i) { const float keep = (lane & 16) ? t8[4 + i] : t8[i], send = (lane & 16) ? t8[i] : t8[4 + i]; t4[i] = keep + __shfl_xor(send, 16); }
#pragma unroll
            for (int i = 0; i < 2; ++i) { const float keep = (lane & 8) ? t4[2 + i] : t4[i], send = (lane & 8) ? t4[i] : t4[2 + i]; t2[i] = keep + __shfl_xor(send, 8); }
            { const float keep = (lane & 4) ? t2[1] : t2[0], send = (lane & 4) ? t2[0] : t2[1]; t1 = keep + __shfl_xor(send, 4); }
            t1 += __shfl_xor(t1, 2); t1 += __shfl_xor(t1, 1);
#pragma unroll
            for (int e = 0; e < 16; ++e) { const int src = ((e >> 3) & 1) * 32 + ((e >> 2) & 1) * 16 + ((e >> 1) & 1) * 8 + (e & 1) * 4; lg[e] = __builtin_bit_cast(float, __builtin_amdgcn_readlane(__builtin_bit_cast(int, t1), src)); }
        }
        float scv[16], bi[16];
#pragma unroll
        for (int e = 0; e < 16; ++e) { scv[e] = sigmoidf_(lg[e]); bi[e] = scv[e] + F.ar->in[I_RB][e]; }
        float bestgs = -3.0e38f; int e1 = 0, e2 = 1; float w1 = 0.f, w2 = 0.f;
#pragma unroll
        for (int g = 0; g < 4; ++g) {
            const float x0 = bi[4 * g], x1 = bi[4 * g + 1], x2 = bi[4 * g + 2], x3 = bi[4 * g + 3];
            const float gs = fmaxf(fmaxf(fmaxf(x0 + x1, x0 + x2), fmaxf(x0 + x3, x1 + x2)), fmaxf(x1 + x3, x2 + x3));
            int i1 = 0; float m1 = x0;
            if (x1 > m1) { m1 = x1; i1 = 1; } if (x2 > m1) { m1 = x2; i1 = 2; } if (x3 > m1) { m1 = x3; i1 = 3; }
            int i2 = -1; float m2 = -3.0e38f;
            if (i1 != 0 && x0 > m2) { m2 = x0; i2 = 0; } if (i1 != 1 && x1 > m2) { m2 = x1; i2 = 1; } if (i1 != 2 && x2 > m2) { m2 = x2; i2 = 2; } if (i1 != 3 && x3 > m2) { m2 = x3; i2 = 3; }
            const float s0 = scv[4 * g], s1 = scv[4 * g + 1], s2 = scv[4 * g + 2], s3 = scv[4 * g + 3];
            const float wa = i1 == 0 ? s0 : i1 == 1 ? s1 : i1 == 2 ? s2 : s3;
            const float wb = i2 == 0 ? s0 : i2 == 1 ? s1 : i2 == 2 ? s2 : s3;
            if (gs > bestgs) { bestgs = gs; e1 = 4 * g + i1; e2 = 4 * g + i2; w1 = wa; w2 = wb; }
        }
        const float wn = 1.0f / (w1 + w2); w1 *= wn; w2 *= wn;
        if (F.lane == 0) {
            const unsigned s1 = __hip_atomic_fetch_add(lcnt + e1, 1u, __ATOMIC_RELAXED, __HIP_MEMORY_SCOPE_WORKGROUP), s2 = __hip_atomic_fetch_add(lcnt + e2, 1u, __ATOMIC_RELAXED, __HIP_MEMORY_SCOPE_WORKGROUP);
            F.route_e_()[R] = e1 | (e2 << 8); F.route_w_()[2 * R] = w1; F.route_w_()[2 * R + 1] = w2; F.route_s_()[2 * R] = (int)s1; F.route_s_()[2 * R + 1] = (int)s2;
        }
#pragma unroll
        for (int j = 0; j < 4; ++j) xcur[j] = xnxt[j];
        R = Rn;
    }
#undef NR_LOAD
    __syncthreads();
    if (F.tid < 16) lcnt[16 + F.tid] = __hip_atomic_fetch_add(cnt + 64 * F.tid, lcnt[F.tid], RLX_AGENT);
    __syncthreads();
    for (int R = gw; R < NR; R += NGW) {
        const int s = R % RPB; if (lat_only && s < CTXL) continue;
        if (F.lane == 0) { const int ee = F.route_e_()[R]; F.route_s_()[2 * R] += (int)lcnt[16 + (ee & 255)]; F.route_s_()[2 * R + 1] += (int)lcnt[16 + (ee >> 8)]; }
    }
}

#undef NR_NEXT
struct ExpOff { int off[17]; };
__device__ __forceinline__ void load_expoff(Frame& F, int layer, ExpOff& eo) {
    const unsigned* cnt = (const unsigned*)(F.ctl_() + CW_CNT + 2048 * layer); int a = 0;
#pragma unroll
    for (int e = 0; e < 16; ++e) { eo.off[e] = a; const int c = __builtin_amdgcn_readfirstlane((int)__hip_atomic_load(cnt + 64 * e, RLX_AGENT)); a += (c + 255) & ~255; }
    eo.off[16] = a;
}
__device__ __forceinline__ int expoff_sel(const ExpOff& eo, int e) { int r = 0;
#pragma unroll
    for (int i = 0; i < 16; ++i) r = (e == i) ? eo.off[i] : r;
    return r; }

__device__ __forceinline__ void p_lists(Frame& F, int layer, bool lat_only) {
    ExpOff eo; load_expoff(F, layer, eo);
    const unsigned* cnt = (const unsigned*)(F.ctl_() + CW_CNT + 2048 * layer);
    int* rowidx = (int*)(F.ws + WS_SMALL + SM_ROWIDX);
    const int gt = F.bid * NTHREADS + F.tid, NGT = F.G * NTHREADS;
    for (int R = gt; R < NR; R += NGT) {
        const int s = R % RPB; if (lat_only && s < CTXL) continue;
        const int ee = F.route_e_()[R], e1 = ee & 255, e2 = ee >> 8;
        const int p1 = expoff_sel(eo, e1) + F.route_s_()[2 * R], p2 = expoff_sel(eo, e2) + F.route_s_()[2 * R + 1];
        rowidx[p1] = R; rowidx[p2] = R; F.pos_()[2 * R] = p1; F.pos_()[2 * R + 1] = p2;
    }
    if (F.bid < 16) { const int e = F.bid; const int c = (int)__hip_atomic_load(cnt + 64 * e, RLX_AGENT); const int o = expoff_sel(eo, e);
        for (int p = o + c + F.tid; p < o + ((c + 255) & ~255); p += NTHREADS) rowidx[p] = lat_only ? CTXL : 0; }
}

__device__ __forceinline__ void p_combine(Frame& F, int layer, bool lat_only, bool do_norm) {
    const int gw = F.bid * NWAVES + F.wave, NGW = F.G * NWAVES;
    const bf16* Ye = (const bf16*)(F.big_() + B_YE); const bf16* Ys = (const bf16*)(F.big_() + B_YS);
    for (int R = gw; R < NR; R += NGW) {
        const int b = R / RPB, s = R - b * RPB, r = s < CTXL ? 8 : b;
        if (lat_only && s < CTXL) continue;
        bf16* Xb = F.Xb_(); float* orow = F.out + (size_t)(b * SEQ + s - CTXL) * D;
        const float* gf = F.modv_() + (size_t)(layer * 9 + r) * 6144 + 5120;
        const int p1 = F.pos_()[2 * R], p2 = F.pos_()[2 * R + 1]; const float w1 = F.route_w_()[2 * R], w2 = F.route_w_()[2 * R + 1];
        f32x4 v[4];
#pragma unroll
        for (int j = 0; j < 4; ++j) { const int c = 4 * (F.lane + 64 * j);
            const v2u xw = *(const v2u*)(Xb + pil(R, c, 1024)); const f32x4 x = {bflo(xw.x), bfhi(xw.x), bflo(xw.y), bfhi(xw.y)}, g = *(const f32x4*)(gf + c);
            const v2u a = *(const v2u*)(Ye + pil_off((size_t)p1, c)), bq = *(const v2u*)(Ye + pil_off((size_t)p2, c)), ys = *(const v2u*)(Ys + pil(R, c, 1024));
            f32x4 m; m.x = bflo(ys.x) + w1 * bflo(a.x) + w2 * bflo(bq.x); m.y = bfhi(ys.x) + w1 * bfhi(a.x) + w2 * bfhi(bq.x); m.z = bflo(ys.y) + w1 * bflo(a.y) + w2 * bflo(bq.y); m.w = bfhi(ys.y) + w1 * bfhi(a.y) + w2 * bfhi(bq.y);
            v[j] = x + g * m;
            if (do_norm) { v2u o2; o2.x = cvtpk_b(v[j].x, v[j].y); o2.y = cvtpk_b(v[j].z, v[j].w); *(v2u*)(Xb + pil(R, c, 1024)) = o2; } else *(f32x4*)(orow + c) = v[j]; }
        if (do_norm) { const float* mv = F.modv_() + (size_t)((layer + 1) * 9 + r) * 6144;
            modnorm_store(v, F.ar->in[I_NMIX] + (layer + 1) * 1024, mv + 0, mv + 1024, F.H_() + (size_t)R * D, F.lane); }
    }
}

struct Unit { int pm, pn; };
struct Gemm { const bf16* A; const bf16* Bt; int K; const int* rowidx; };
constexpr int BM = 256, BK = 64, HALF = 128, HTB = HALF * BK * 2, STAGE_BYTES = 8 * HTB, NXCD = 8, WGM = 8;
__host__ __device__ __forceinline__ int lds_byte(int r, int c) { const int st = (r >> 4) * 2 + (c >> 5), rr = r & 15, cc = c & 31, ob = rr * 64 + cc * 2; return st * 1024 + (ob ^ (((ob >> 9) & 1) << 5)); }
__host__ __device__ __forceinline__ void stage_rc(int b, int& R, int& C) { const int st = b / 1024, sb = b % 1024, swz = sb ^ (((sb >> 9) & 1) << 5); R = (st >> 1) * 16 + swz / 64; C = (st & 1) * 32 + (swz % 64) / 2; }
template <class Epi, class Sched, bool ALIGN_EPI = false, bool SP2 = false, int SECID = 3, bool GATHER = false, bool APIL = false>
__device__ __forceinline__ void gemm_phase(LAS unsigned char* lds, const Gemm g, const Sched& S, const Epi& E, unsigned long long& sec_acc_) {
    const int tid = opaque((int)threadIdx.x), wid = __builtin_amdgcn_readfirstlane(tid >> 6), lane = tid & 63, wr = wid >> 2, wc = wid & 3, fr = lane & 15, fq = lane >> 4;
    const int K = g.K, nt = K / BK;
    unsigned voffA[2], voffB[2];
#pragma unroll
    for (int i = 0; i < 2; ++i) { int R, C; stage_rc(tid * 16 + i * 8192, R, C); const int Rb = Epi::PERM ? ((R & ~31) + perm32(R & 31)) : R;
        voffA[i] = APIL ? (unsigned)pil(R, C, K) * 2u : (unsigned)(R * K + C) * 2u; voffB[i] = (unsigned)(Rb * K + C) * 2u; }
    unsigned gA[2][2], gN[2][2]; int rA[2], cA2[2];
    LAS unsigned* growoff = (LAS unsigned*)(lds + LDS_XCH);
    if constexpr (GATHER) {
#pragma unroll
        for (int i = 0; i < 2; ++i) { int R, C; stage_rc(tid * 16 + i * 8192, R, C); rA[i] = R; cA2[i] = C * 2; }
        { Unit uu; for (int i = 0; i < 8 && S.next(i, uu); ++i) for (int r = tid; r < 256; r += NTHREADS) growoff[i * 256 + r] = (unsigned)g.rowidx[uu.pm * 256 + r] * (unsigned)K * 2u; }
        __syncthreads();
#pragma unroll
        for (int h = 0; h < 2; ++h)
#pragma unroll
            for (int i = 0; i < 2; ++i) { gA[h][i] = growoff[h * 128 + rA[i]] + cA2[i]; gN[h][i] = gA[h][i]; }
    }
    const size_t kstep = (size_t)(BK * 2);
    const size_t kstepA = APIL ? (size_t)(BK * 4) : kstep;
    const size_t hstep = (size_t)HALF * K * 2;
    const size_t tstep = 2 * hstep;
    const unsigned ldsw = (unsigned)wid * 1024u;
    const int aoff = lds_byte(wr * 64 + fr, fq * 8), boff = lds_byte(wc * 32 + fr, fq * 8);
#define PG8_SA(b, h) (((b) * 2 + (h)) * HTB)
#define PG8_SB(b, h) ((4 + (b) * 2 + (h)) * HTB)
#define PG8_STAGE(bufoff, gbase, voff) do { _Pragma("unroll") for (int _i = 0; _i < 2; ++_i) \
        __builtin_amdgcn_global_load_lds((const unsigned*)((const char*)(gbase) + (voff)[_i]), (LAS unsigned*)(lds + (bufoff) + ldsw + _i * 8192), 16, 0, 0); } while (0)
#define PG8_STAGE_A(bufoff, gbase, h, usenext) do { if constexpr (GATHER) { _Pragma("unroll") for (int _i = 0; _i < 2; ++_i) { const unsigned _o = (usenext) ? gN[h][_i] : gA[h][_i]; \
        __builtin_amdgcn_global_load_lds((const unsigned*)((const char*)(gbase) + _o), (LAS unsigned*)(lds + (bufoff) + ldsw + _i * 8192), 16, 0, 0); } } \
    else { PG8_STAGE(bufoff, (gbase) + (h) * hstep, voffA); } } while (0)
#define PG8_LDA(dst, b, h) do { _Pragma("unroll") for (int m = 0; m < 4; ++m) _Pragma("unroll") for (int k = 0; k < 2; ++k) dst[m][k] = *(const LAS bf16x8*)(lds + PG8_SA(b, h) + aoff + m * 2048 + k * 1024); } while (0)
#define PG8_LDB(dst, b, h) do { _Pragma("unroll") for (int n = 0; n < 2; ++n) _Pragma("unroll") for (int k = 0; k < 2; ++k) dst[n][k] = *(const LAS bf16x8*)(lds + PG8_SB(b, h) + boff + n * 2048 + k * 1024); } while (0)
#define PG8_MMA(ai, bj, At, Bt) do { __builtin_amdgcn_s_setprio(1); _Pragma("unroll") for (int m = 0; m < 4; ++m) _Pragma("unroll") for (int n = 0; n < 2; ++n) _Pragma("unroll") for (int k = 0; k < 2; ++k) \
        acc[ai][bj][m][n] = __builtin_amdgcn_mfma_f32_16x16x32_bf16(Bt[n][k], At[m][k], acc[ai][bj][m][n], 0, 0, 0); __builtin_amdgcn_s_setprio(0); } while (0)
#define PG8_WAIT_V(n) asm volatile("s_waitcnt vmcnt(" #n ")" ::: "memory")
#define PG8_WAIT_L(n) asm volatile("s_waitcnt lgkmcnt(" #n ")" ::: "memory")
#define PG8_BAR __builtin_amdgcn_s_barrier()
#define PG8_SCHED __builtin_amdgcn_sched_barrier(0)
    Unit cur, nxt; int ui = 0;
    if (!S.next(0, cur)) return;
    f32x4 acc[2][2][4][2];
#pragma unroll
    for (int a = 0; a < 2; ++a)
#pragma unroll
        for (int b = 0; b < 2; ++b)
#pragma unroll
            for (int m = 0; m < 4; ++m)
#pragma unroll
                for (int n = 0; n < 2; ++n) acc[a][b][m][n] = (f32x4){0.f, 0.f, 0.f, 0.f};
    bf16x8 At[4][2], B0[2][2], B1[2][2];
    const char* cA = (const char*)g.A + (GATHER ? (size_t)0 : (size_t)cur.pm * tstep); const char* cB = (const char*)g.Bt + (size_t)cur.pn * tstep;
    S.a_ready(cur);
    if constexpr (SP2) {
        PG8_STAGE(PG8_SB(0, 0), cB, voffB); PG8_STAGE(PG8_SB(0, 1), cB + hstep, voffB); PG8_STAGE_A(PG8_SA(0, 0), cA, 0, false); PG8_STAGE_A(PG8_SA(0, 1), cA, 1, false);
        if (wr == 1) PG8_BAR;
        PG8_WAIT_V(2); PG8_BAR;
        PG8_STAGE(PG8_SB(1, 0), cB + kstep, voffB); PG8_STAGE_A(PG8_SA(1, 0), cA + kstepA, 0, false); PG8_STAGE(PG8_SB(1, 1), cB + hstep + kstep, voffB);
        PG8_WAIT_V(6); PG8_BAR;
    } else {
        PG8_STAGE(PG8_SB(0, 0), cB, voffB); PG8_STAGE_A(PG8_SA(0, 0), cA, 0, false); PG8_STAGE(PG8_SB(0, 1), cB + hstep, voffB); PG8_STAGE_A(PG8_SA(0, 1), cA, 1, false);
        if (wr == 1) PG8_BAR;
        PG8_WAIT_V(4); PG8_BAR;
        PG8_STAGE(PG8_SB(1, 0), cB + kstep, voffB); PG8_STAGE_A(PG8_SA(1, 0), cA + kstepA, 0, false); PG8_STAGE(PG8_SB(1, 1), cB + hstep + kstep, voffB);
        PG8_WAIT_V(6); PG8_BAR;
    }
    for (;;) {
        const bool has_next = S.next(ui + 1, nxt);
        const char* nA = (has_next && !GATHER) ? (const char*)g.A + (size_t)nxt.pm * tstep : cA; const char* nB = has_next ? (const char*)g.Bt + (size_t)nxt.pn * tstep : cB;
        if constexpr (GATHER) { if (has_next) {
#pragma unroll
            for (int h = 0; h < 2; ++h)
#pragma unroll
                for (int i = 0; i < 2; ++i) gN[h][i] = growoff[(ui + 1) * 256 + h * 128 + rA[i]] + cA2[i]; } }
#pragma unroll 1
        for (int t = 0; t < nt; t += 2) {
            const bool last = (t == nt - 2);
            const char* a1 = cA + (size_t)(t + 1) * kstepA;
            const char* a2 = last ? nA : cA + (size_t)(t + 2) * kstepA; const char* b2 = last ? nB : cB + (size_t)(t + 2) * kstep;
            const char* a3 = a2 + kstepA; const char* b3 = b2 + kstep;
            if (last && has_next) S.a_ready(nxt);
            if constexpr (SP2) {
            PG8_LDB(B0, 0, 0); PG8_LDB(B1, 0, 1); PG8_SCHED; PG8_LDA(At, 0, 0); PG8_STAGE_A(PG8_SA(1, 1), a1, 1, false);
            PG8_WAIT_V(8); PG8_WAIT_L(0); PG8_BAR; PG8_MMA(0, 0, At, B0); PG8_MMA(0, 1, At, B1); PG8_BAR; PG8_SCHED;
            PG8_LDA(At, 0, 1); PG8_STAGE(PG8_SB(0, 0), b2, voffB); PG8_STAGE(PG8_SB(0, 1), b2 + hstep, voffB); PG8_STAGE_A(PG8_SA(0, 0), a2, 0, last);
            PG8_WAIT_V(8); PG8_WAIT_L(0); PG8_BAR; PG8_MMA(1, 0, At, B0); PG8_MMA(1, 1, At, B1); PG8_BAR; PG8_SCHED;
            PG8_LDB(B0, 1, 0); PG8_LDB(B1, 1, 1); PG8_SCHED; PG8_LDA(At, 1, 0); PG8_STAGE_A(PG8_SA(0, 1), a2, 1, last);
            PG8_WAIT_V(8); PG8_WAIT_L(0); PG8_BAR; PG8_MMA(0, 0, At, B0); PG8_MMA(0, 1, At, B1); PG8_BAR; PG8_SCHED;
            PG8_LDA(At, 1, 1); PG8_STAGE(PG8_SB(1, 0), b3, voffB); PG8_STAGE(PG8_SB(1, 1), b3 + hstep, voffB); PG8_STAGE_A(PG8_SA(1, 0), a3, 0, last);
            PG8_WAIT_V(8); PG8_WAIT_L(0); PG8_BAR; PG8_MMA(1, 0, At, B0); PG8_MMA(1, 1, At, B1); PG8_BAR; PG8_SCHED;
            } else {
            PG8_LDB(B0, 0, 0); PG8_SCHED; PG8_LDA(At, 0, 0); PG8_STAGE_A(PG8_SA(1, 1), a1, 1, false);
            PG8_WAIT_L(8); PG8_BAR; PG8_WAIT_L(0); PG8_MMA(0, 0, At, B0); PG8_BAR; PG8_SCHED;
            PG8_LDB(B1, 0, 1); PG8_STAGE(PG8_SB(0, 0), b2, voffB);
            PG8_BAR; PG8_WAIT_L(0); PG8_MMA(0, 1, At, B1); PG8_BAR;
            PG8_LDA(At, 0, 1); PG8_STAGE_A(PG8_SA(0, 0), a2, 0, last);
            PG8_BAR; PG8_WAIT_L(0); PG8_MMA(1, 0, At, B0); PG8_BAR; PG8_SCHED;
            PG8_STAGE(PG8_SB(0, 1), b2 + hstep, voffB);
            PG8_WAIT_V(6); PG8_BAR; PG8_MMA(1, 1, At, B1); PG8_BAR;
            PG8_LDB(B0, 1, 0); PG8_SCHED; PG8_LDA(At, 1, 0); PG8_STAGE_A(PG8_SA(0, 1), a2, 1, last);
            PG8_WAIT_L(8); PG8_BAR; PG8_WAIT_L(0); PG8_MMA(0, 0, At, B0); PG8_BAR; PG8_SCHED;
            PG8_LDB(B1, 1, 1); PG8_STAGE(PG8_SB(1, 0), b3, voffB);
            PG8_BAR; PG8_WAIT_L(0); PG8_MMA(0, 1, At, B1); PG8_BAR;
            PG8_LDA(At, 1, 1); PG8_STAGE_A(PG8_SA(1, 0), a3, 0, last);
            PG8_BAR; PG8_WAIT_L(0); PG8_MMA(1, 0, At, B0); PG8_BAR; PG8_SCHED;
            PG8_STAGE(PG8_SB(1, 1), b3 + hstep, voffB);
            PG8_WAIT_V(6); PG8_BAR; PG8_MMA(1, 1, At, B1); PG8_BAR;
            }
        }
        if constexpr (ALIGN_EPI) { if (wr == 0) PG8_BAR; }
        if constexpr (!Epi::AFTER_DRAIN) { const unsigned long long se_ = (PROBE_SEC == 3 || PROBE_SEC == SECID) ? (unsigned long long)clock64() : 0ull; E(acc, cur, wr, wc, fr, fq); S.done(cur); if (PROBE_SEC == 3 || PROBE_SEC == SECID) sec_acc_ += (unsigned long long)clock64() - se_; }
        if (!has_next) break;
#pragma unroll
        for (int a = 0; a < 2; ++a)
#pragma unroll
            for (int b = 0; b < 2; ++b)
#pragma unroll
                for (int m = 0; m < 4; ++m)
#pragma unroll
                    for (int n = 0; n < 2; ++n) acc[a][b][m][n] = (f32x4){0.f, 0.f, 0.f, 0.f};
        cur = nxt; cA = nA; cB = nB; ++ui;
        if constexpr (GATHER) {
#pragma unroll
            for (int h = 0; h < 2; ++h)
#pragma unroll
                for (int i = 0; i < 2; ++i) gA[h][i] = gN[h][i]; }
        if constexpr (ALIGN_EPI) { if (wr == 1) PG8_BAR; }
    }
    PG8_WAIT_V(0);
    if constexpr (!ALIGN_EPI) { if (wr == 0) PG8_BAR; }
    PG8_BAR;
    if constexpr (Epi::AFTER_DRAIN) { E.fused(acc, cur, wr, wc, fr, fq, lds, wid, lane); S.done(cur); }
#undef PG8_SA
#undef PG8_SB
#undef PG8_STAGE
#undef PG8_STAGE_A
#undef PG8_LDA
#undef PG8_LDB
#undef PG8_MMA
#undef PG8_WAIT_V
#undef PG8_WAIT_L
#undef PG8_BAR
#undef PG8_SCHED
}


__device__ __forceinline__ int xcd_remap(int L, int nwg) { const int q = nwg / NXCD, r = nwg % NXCD, xcd = L % NXCD, off = L / NXCD; return (xcd < r ? xcd * (q + 1) : r * (q + 1) + (xcd - r) * q) + off; }
struct SchedGrid {
    int nm, nn, G, c; bool lat;
    __device__ __forceinline__ bool next(int i, Unit& u) const { const int nwg = nm * nn; const int L = i * G + c; if (L >= nwg) return false;
        const int wgid = xcd_remap(L, nwg); const int nig = WGM * nn, gid = wgid / nig, fm = gid * WGM, gsz = (nm - fm) < WGM ? (nm - fm) : WGM;
        int pm = fm + ((wgid % nig) % gsz); u.pn = (wgid % nig) / gsz; if (lat) pm = (pm >> 3) * 9 + 1 + (pm & 7); u.pm = pm; return true; }
    __device__ __forceinline__ void a_ready(const Unit&) const {}
    __device__ __forceinline__ void done(const Unit&) const {}
};
struct SchedRouted {
    ExpOff eo; int G, c;
    __device__ __forceinline__ bool next(int i, Unit& u) const { const int nt = eo.off[16] >> 8, nwg = nt * 4; const int L = i * G + c; if (L >= nwg) return false;
        const int wgid = xcd_remap(L, nwg); const int pm = wgid >> 2, pnl = wgid & 3; int e = 0;
#pragma unroll
        for (int k = 1; k < 16; ++k) e += (pm * 256 >= eo.off[k]) ? 1 : 0;
        u.pm = pm; u.pn = e * 4 + pnl; return true; }
    __device__ __forceinline__ void a_ready(const Unit&) const {}
    __device__ __forceinline__ void done(const Unit&) const {}
};

#ifndef PROBE_REP
#define PROBE_REP -1
#endif
#define REP(k) for (int rep_ = 0; rep_ < ((PROBE_REP == (k)) ? 2 : 1); ++rep_)
#ifndef PROBE_AMP_LO
#define PROBE_AMP_LO -1
#define PROBE_AMP_HI -1
#endif
#ifndef ALIGN_MASK
#define ALIGN_MASK 0xffffffffu
#endif
template <int ID, class Epi, class Sched>
__device__ __forceinline__ void run_gemm(Frame& F, const Gemm g, const Sched& S, const Epi& E) {
    SEC_BEGIN(4);
    gemm_phase<Epi, Sched, (ID == 7 || ID == 8 || ((ALIGN_MASK >> ID) & 1u)), true, 10 + ID, (ID == 3 || ID == 11), (ID == 4 || ID == 5 || ID == 7 || ID == 8 || ID == 12 || ID == 13)>(F.lds, g, S, E, F.sec_acc);
    SEC_END(4);
}

__device__ __forceinline__ v4u pack8(const f32x4 a, const f32x4 b) { v4u w; w.x = cvtpk_b(a[0], a[1]); w.y = cvtpk_b(a[2], a[3]); w.z = cvtpk_b(b[0], b[1]); w.w = cvtpk_b(b[2], b[3]); return w; }

#ifndef EPI_NT
#define EPI_NT 1
#endif
__device__ __forceinline__ void st16(bf16* p, const v4u v) { if (EPI_NT) __builtin_nontemporal_store(v, (v4u*)p); else *(v4u*)p = v; }
__device__ __forceinline__ unsigned xchg1(unsigned v) { return (unsigned)__shfl_xor((int)v, 1); }
__device__ __forceinline__ void pair_swap(v4u& lo, v4u& hi, bool odd) {
    const unsigned s0 = odd ? lo.x : hi.x, s1 = odd ? lo.y : hi.y, s2 = odd ? lo.z : hi.z, s3 = odd ? lo.w : hi.w;
    const unsigned r0 = xchg1(s0), r1 = xchg1(s1), r2 = xchg1(s2), r3 = xchg1(s3);
    if (odd) { lo.x = r0; lo.y = r1; lo.z = r2; lo.w = r3; } else { hi.x = r0; hi.y = r1; hi.z = r2; hi.w = r3; }
}
__device__ __forceinline__ void pair_swap(f32x4& lo, f32x4& hi, bool odd) {
    v4u a = __builtin_bit_cast(v4u, lo), b = __builtin_bit_cast(v4u, hi); pair_swap(a, b, odd); lo = __builtin_bit_cast(f32x4, a); hi = __builtin_bit_cast(f32x4, b);
}
struct EpiIn0 {
    static constexpr bool PERM = true, AFTER_DRAIN = false;
    unsigned char* big; const float *qg, *kg, *lbv; const f32x2 *ropeR, *ropeC;
    __device__ __forceinline__ void operator()(const f32x4 (&acc)[2][2][4][2], const Unit& u, int wr, int wc, int fr, int fq) const {
        const int pn = u.pn, type = pn >> 1, j9 = u.pm % 9; const bool lat = j9 > 0;
        if (type < 2) {
            const float* gain = type ? kg : qg; bf16* dst = (bf16*)(big + (type ? B_KD : B_QD));
            const int h = 2 * (pn & 1) + (wc >> 1), c = wc & 1;
            f32x4 g[2][2];
#pragma unroll
            for (int bj = 0; bj < 2; ++bj)
#pragma unroll
                for (int n = 0; n < 2; ++n) g[bj][n] = *(const f32x4*)(gain + 32 * bj + 16 * n + 4 * fq);
#pragma unroll
            for (int ai = 0; ai < 2; ++ai)
#pragma unroll
                for (int m = 0; m < 4; ++m) {
                    const int rr = opaque(ai * 128 + wr * 64 + m * 16 + fr); const size_t R = (size_t)u.pm * 256 + rr;
                    float s = 0.f;
#pragma unroll
                    for (int bj = 0; bj < 2; ++bj)
#pragma unroll
                        for (int n = 0; n < 2; ++n) { const f32x4 x = acc[ai][bj][m][n]; s += (x[0] * x[0] + x[1] * x[1]) + (x[2] * x[2] + x[3] * x[3]); }
                    s += __shfl_xor(s, 16); s += __shfl_xor(s, 32);
                    const float rstd = rsq_(s * (1.0f / 64.0f) + EPS);
                    f32x4 y[2][2];
#pragma unroll
                    for (int bj = 0; bj < 2; ++bj)
#pragma unroll
                        for (int n = 0; n < 2; ++n) y[bj][n] = acc[ai][bj][m][n] * (type == 0 ? rstd * (0.125f * LOG2E) : rstd) * g[bj][n];
                    if (lat) { const int t = (j9 - 1) * 256 + rr, grow = t >> 6, gcol = t & 63;
#pragma unroll
                        for (int bj = 0; bj < 2; ++bj) { const f32x2* tab = bj ? (ropeC + gcol * 16 + 4 * fq) : (ropeR + grow * 16 + 4 * fq);
                            const f32x4 t0 = *(const f32x4*)tab, t1 = *(const f32x4*)(tab + 2);
                            const float cs[4] = {t0[0], t0[2], t1[0], t1[2]}, sn[4] = {t0[1], t0[3], t1[1], t1[3]};
#pragma unroll
                            for (int e = 0; e < 4; ++e) { const float x1 = y[bj][0][e], x2 = y[bj][1][e]; y[bj][0][e] = x1 * cs[e] - x2 * sn[e]; y[bj][1][e] = x1 * sn[e] + x2 * cs[e]; } } }
                    { v4u lo = pack8(y[0][0], y[0][1]), hi = pack8(y[1][0], y[1][1]); const bool odd = fr & 1; pair_swap(lo, hi, odd);
                        bf16* pb = dst + h * 128 + c * 64 + (odd ? 32 : 0) + 8 * fq;
                        *(v4u*)(pb + (R & ~(size_t)1) * 512) = lo; *(v4u*)(pb + (R | 1) * 512) = hi; }
                    asm volatile("" ::: "memory");
                }
        } else {
            const int colt = (pn & 1) * 256;
            size_t boffs; if (type == 2) boffs = B_VD; else if (type == 3) boffs = B_HQ; else if (type == 4) boffs = B_LF0; else if (type == 5) boffs = B_LF1; else if (type == 6) boffs = B_HV; else boffs = B_HG;
            bf16* dst = (bf16*)(big + boffs);
#pragma unroll
            for (int bj = 0; bj < 2; ++bj) { const int col = colt + bj * 128 + wc * 32 + 8 * fq;
                f32x4 lb0 = {0.f, 0.f, 0.f, 0.f}, lb1 = lb0;
                if (type == 4 || type == 5) { const float* lp = lbv + (type - 4) * 512 + col; lb0 = *(const f32x4*)lp; lb1 = *(const f32x4*)(lp + 4); }
#pragma unroll
                for (int ai = 0; ai < 2; ++ai)
#pragma unroll
                    for (int m = 0; m < 4; ++m) { const size_t R = (size_t)u.pm * 256 + opaque(ai * 128 + wr * 64 + m * 16 + fr);
                        f32x4 a = acc[ai][bj][m][0], b = acc[ai][bj][m][1]; v4u w;
                        if (type == 3 || type == 7) {
#pragma unroll
                            for (int e = 0; e < 4; ++e) { a[e] = siluf_(a[e]); b[e] = siluf_(b[e]); }
                            if (type == 3) { a = a * 0.08838834764831845f; b = b * 0.08838834764831845f; }
                            w = pack8(a, b);
                        } else if (type == 4 || type == 5) {
#pragma unroll
                            for (int e = 0; e < 4; ++e) { a[e] = __logf(lb0[e] + (1.0f - lb0[e]) * sigmoidf_(a[e])); b[e] = __logf(lb1[e] + (1.0f - lb1[e]) * sigmoidf_(b[e])); }
                            w.x = pkh2(a[0], a[1]); w.y = pkh2(a[2], a[3]); w.z = pkh2(b[0], b[1]); w.w = pkh2(b[2], b[3]);
                        } else w = pack8(a, b);
                        st16(dst + (type == 2 ? (int)R * 512 + col : pil((int)R, col, 512)), w); asm volatile("" ::: "memory"); } }
        }
    }
};

struct EpiOut {
    static constexpr bool PERM = true, AFTER_DRAIN = false;
    const Frame* F; int layer; bool from_input;
    __device__ __forceinline__ void operator()(const f32x4 (&acc)[2][2][4][2], const Unit& u, int wr, int wc, int fr, int fq) const {
        const int b = u.pm / 9, j9 = u.pm % 9, r = j9 ? b : 8;
        const float* gm = F->modv_() + (size_t)(layer * 9 + r) * 6144 + 2048;
        bf16* Xb = F->Xb_();
#pragma unroll
        for (int ai = 0; ai < 2; ++ai)
#pragma unroll
            for (int m = 0; m < 4; ++m) { const int rr = opaque(ai * 128 + wr * 64 + m * 16 + fr), R = u.pm * 256 + rr;
                const float* xi = xin_ptr(*F, b, j9 * 256 + rr);
#pragma unroll
                for (int bj = 0; bj < 2; ++bj) { const int col = u.pn * 256 + bj * 128 + wc * 32 + 8 * fq; bf16* xp = Xb + pil(R, col, 1024);
                    f32x4 b0, b1;
                    if (from_input) { b0 = *(const f32x4*)(xi + col); b1 = *(const f32x4*)(xi + col + 4); }
                    else { const v4u w = *(const v4u*)xp; b0 = (f32x4){bflo(w.x), bfhi(w.x), bflo(w.y), bfhi(w.y)}; b1 = (f32x4){bflo(w.z), bfhi(w.z), bflo(w.w), bfhi(w.w)}; }
                    st16(xp, pack8(b0 + *(const f32x4*)(gm + col) * acc[ai][bj][m][0], b1 + *(const f32x4*)(gm + col + 4) * acc[ai][bj][m][1])); }
                asm volatile("" ::: "memory"); }
    }
};

struct EpiGU {
    static constexpr bool PERM = true, AFTER_DRAIN = false;
    bf16* Hout;
    __device__ __forceinline__ void operator()(const f32x4 (&acc)[2][2][4][2], const Unit& u, int wr, int wc, int fr, int fq) const {
        const int pnl = u.pn & 3;
#pragma unroll
        for (int ai = 0; ai < 2; ++ai)
#pragma unroll
            for (int m = 0; m < 4; ++m) { const size_t row = (size_t)u.pm * 256 + opaque(ai * 128 + wr * 64 + m * 16 + fr);
                f32x4 h[2];
#pragma unroll
                for (int n = 0; n < 2; ++n)
#pragma unroll
                    for (int e = 0; e < 4; ++e) h[n][e] = siluf_(acc[ai][0][m][n][e]) * acc[ai][1][m][n][e];
                st16(Hout + pil((int)row, pnl * 128 + wc * 32 + 8 * fq, 512), pack8(h[0], h[1])); }
    }
};

struct EpiDownS {
    static constexpr bool PERM = true, AFTER_DRAIN = false;
    bf16* Ys;
    __device__ __forceinline__ void operator()(const f32x4 (&acc)[2][2][4][2], const Unit& u, int wr, int wc, int fr, int fq) const {
#pragma unroll
        for (int ai = 0; ai < 2; ++ai)
#pragma unroll
            for (int m = 0; m < 4; ++m) { const size_t row = (size_t)u.pm * 256 + opaque(ai * 128 + wr * 64 + m * 16 + fr);
#pragma unroll
                for (int bj = 0; bj < 2; ++bj) st16(Ys + pil((int)row, u.pn * 256 + bj * 128 + wc * 32 + 8 * fq, 1024), pack8(acc[ai][bj][m][0], acc[ai][bj][m][1])); }
    }
};

struct EpiDownR {
    static constexpr bool PERM = true, AFTER_DRAIN = false;
    bf16* Ye;
    __device__ __forceinline__ void operator()(const f32x4 (&acc)[2][2][4][2], const Unit& u, int wr, int wc, int fr, int fq) const {
        const int pnl = u.pn & 3;
#pragma unroll
        for (int ai = 0; ai < 2; ++ai)
#pragma unroll
            for (int m = 0; m < 4; ++m) { const size_t row = (size_t)u.pm * 256 + opaque(ai * 128 + wr * 64 + m * 16 + fr);
#pragma unroll
                for (int bj = 0; bj < 2; ++bj) st16(Ye + pil_off(row, pnl * 256 + bj * 128 + wc * 32 + 8 * fq), pack8(acc[ai][bj][m][0], acc[ai][bj][m][1])); }
    }
};

struct EpiIn1 {
    static constexpr bool PERM = true, AFTER_DRAIN = false;
    unsigned char* big; float* ssq; const float* krg; const f32x2 *ropeR, *ropeC;
    __device__ __forceinline__ void operator()(const f32x4 (&acc)[2][2][4][2], const Unit& u, int wr, int wc, int fr, int fq) const {
        const int pn = u.pn, j9 = u.pm % 9; const bool lat = j9 > 0;
        bf16* Ckv = (bf16*)(big + B_CKV); bf16* Cq = (bf16*)(big + B_CQ); bf16* Kr = (bf16*)(big + B_KR);
        if (pn == 2 && wc == 3) {
#pragma unroll
            for (int ai = 0; ai < 2; ++ai)
#pragma unroll
                for (int m = 0; m < 4; ++m) {
                    const int rr = opaque(ai * 128 + wr * 64 + m * 16 + fr); const size_t R = (size_t)u.pm * 256 + rr;
                    float s = 0.f;
#pragma unroll
                    for (int bj = 0; bj < 2; ++bj)
#pragma unroll
                        for (int n = 0; n < 2; ++n) { const f32x4 x = acc[ai][bj][m][n]; s += (x[0] * x[0] + x[1] * x[1]) + (x[2] * x[2] + x[3] * x[3]); }
                    s += __shfl_xor(s, 16); s += __shfl_xor(s, 32);
                    const float rstd = rsq_(s * (1.0f / 64.0f) + EPS);
                    f32x4 y[2][2];
#pragma unroll
                    for (int bj = 0; bj < 2; ++bj)
#pragma unroll
                        for (int n = 0; n < 2; ++n) y[bj][n] = acc[ai][bj][m][n] * rstd * *(const f32x4*)(krg + 32 * bj + 16 * n + 4 * fq);
                    if (lat) { const int t = (j9 - 1) * 256 + rr, grow = t >> 6, gcol = t & 63;
#pragma unroll
                        for (int bj = 0; bj < 2; ++bj) { const f32x2* tab = bj ? (ropeC + gcol * 16 + 4 * fq) : (ropeR + grow * 16 + 4 * fq);
                            const f32x4 t0 = *(const f32x4*)tab, t1 = *(const f32x4*)(tab + 2);
                            const float cs[4] = {t0[0], t0[2], t1[0], t1[2]}, sn[4] = {t0[1], t0[3], t1[1], t1[3]};
#pragma unroll
                            for (int e = 0; e < 4; ++e) { const float x1 = y[bj][0][e], x2 = y[bj][1][e]; y[bj][0][e] = x1 * cs[e] - x2 * sn[e]; y[bj][1][e] = x1 * sn[e] + x2 * cs[e]; } } }
                    { v4u lo = pack8(y[0][0], y[0][1]), hi = pack8(y[1][0], y[1][1]); const bool odd = fr & 1; pair_swap(lo, hi, odd);
                        bf16* pb = Kr + (odd ? 32 : 0) + 8 * fq;
                        *(v4u*)(pb + (R & ~(size_t)1) * 64) = lo; *(v4u*)(pb + (R | 1) * 64) = hi; }
                    asm volatile("" ::: "memory");
                }
            return;
        }
#pragma unroll
        for (int ai = 0; ai < 2; ++ai)
#pragma unroll
            for (int m = 0; m < 4; ++m) {
                const size_t R = (size_t)u.pm * 256 + opaque(ai * 128 + wr * 64 + m * 16 + fr);
                float s = 0.f;
#pragma unroll
                for (int bj = 0; bj < 2; ++bj) { const f32x4 a = acc[ai][bj][m][0], b = acc[ai][bj][m][1];
                    s += (a[0] * a[0] + a[1] * a[1]) + (a[2] * a[2] + a[3] * a[3]) + (b[0] * b[0] + b[1] * b[1]) + (b[2] * b[2] + b[3] * b[3]);
                    const v4u w = pack8(a, b);
                    if (pn == 0) st16(Ckv + pil((int)R, bj * 128 + wc * 32 + 8 * fq, 256), w);
                    else if (pn == 1) st16(Cq + pil((int)R, bj * 128 + wc * 32 + 8 * fq, 384), w);
                    else { if (bj == 0) st16(Cq + pil((int)R, 256 + wc * 32 + 8 * fq, 384), w); else if (wc == 0) st16(Cq + pil((int)R, 352 + 8 * fq, 384), w); } }
                s += __shfl_xor(s, 16); s += __shfl_xor(s, 32);
                if (fq == 0) ssq[R * 12 + pn * 4 + wc] = s;
                asm volatile("" ::: "memory");
            }
    }
};

struct EpiUq {
    static constexpr bool PERM = true, AFTER_DRAIN = false;
    bf16* Q1; const float* ssq; const float *qng, *qrg; const f32x2 *ropeR, *ropeC; LAS float* xl;
    __device__ __forceinline__ float rq_of(size_t R) const { const float* sp = ssq + R * 12; const f32x4 s1 = *(const f32x4*)(sp + 4), s2 = *(const f32x4*)(sp + 8);
        return rsq_(((s1[0] + s1[1]) + (s1[2] + s1[3]) + (s2[0] + s2[1]) + s2[2]) * (1.0f / 384.0f) + EPS); }
    __device__ __forceinline__ void operator()(const f32x4 (&acc)[2][2][4][2], const Unit& u, int wr, int wc, int fr, int fq) const {
        const int pn = u.pn, j9 = u.pm % 9;
        if (pn < 4) {
#pragma unroll
            for (int ai = 0; ai < 2; ++ai)
#pragma unroll
                for (int m = 0; m < 4; ++m)
#pragma unroll
                    for (int bj = 0; bj < 2; ++bj) { float s = 0.f;
#pragma unroll
                        for (int n = 0; n < 2; ++n) { const f32x4 x = acc[ai][bj][m][n]; s += (x[0] * x[0] + x[1] * x[1]) + (x[2] * x[2] + x[3] * x[3]); }
                        s += __shfl_xor(s, 16); s += __shfl_xor(s, 32);
                        if (fq == 0) xl[(ai * 128 + wr * 64 + m * 16 + fr) * 8 + bj * 4 + wc] = s; }
            EPI_BAR();
#pragma unroll
            for (int ai = 0; ai < 2; ++ai)
#pragma unroll
                for (int m = 0; m < 4; ++m) { const int rr = opaque(ai * 128 + wr * 64 + m * 16 + fr); const size_t R = (size_t)u.pm * 256 + rr; const float rq = rq_of(R);
                    f32x4 g[2];
#pragma unroll
                    for (int n = 0; n < 2; ++n) g[n] = *(const f32x4*)(qng + wc * 32 + 8 * fq + 4 * n);
#pragma unroll
                    for (int bj = 0; bj < 2; ++bj) { const f32x4 p = *(const LAS f32x4*)(xl + rr * 8 + bj * 4);
                        const float rstd = (0.07216878364870323f * LOG2E) * rq * rsq_(((p[0] + p[1]) + (p[2] + p[3])) * (rq * rq) * (1.0f / 128.0f) + EPS);
                        const int h = 2 * pn + bj;
                        st16(Q1 + pil((int)R, h * 192 + wc * 32 + 8 * fq, 1536), pack8(acc[ai][bj][m][0] * rstd * g[0], acc[ai][bj][m][1] * rstd * g[1])); } asm volatile("" ::: "memory"); }
            EPI_BAR();
        } else {
            const int h = 4 * (pn - 4) + wc;
#pragma unroll
            for (int ai = 0; ai < 2; ++ai)
#pragma unroll
                for (int m = 0; m < 4; ++m) {
                    const int rr = opaque(ai * 128 + wr * 64 + m * 16 + fr); const size_t R = (size_t)u.pm * 256 + rr; const float rq = rq_of(R);
                    float s = 0.f; f32x4 y[2][2];
#pragma unroll
                    for (int bj = 0; bj < 2; ++bj)
#pragma unroll
                        for (int n = 0; n < 2; ++n) { const f32x4 x = acc[ai][bj][m][n] * rq; y[bj][n] = x; s += (x[0] * x[0] + x[1] * x[1]) + (x[2] * x[2] + x[3] * x[3]); }
                    s += __shfl_xor(s, 16); s += __shfl_xor(s, 32);
                    const float rstd = (0.07216878364870323f * LOG2E) * rsq_(s * (1.0f / 64.0f) + EPS);
#pragma unroll
                    for (int bj = 0; bj < 2; ++bj)
#pragma unroll
                        for (int n = 0; n < 2; ++n) y[bj][n] = y[bj][n] * rstd * *(const f32x4*)(qrg + 32 * bj + 16 * n + 4 * fq);
                    { const int t = (j9 - 1) * 256 + rr, grow = t >> 6, gcol = t & 63;
#pragma unroll
                        for (int bj = 0; bj < 2; ++bj) { const f32x2* tab = bj ? (ropeC + gcol * 16 + 4 * fq) : (ropeR + grow * 16 + 4 * fq);
                            const f32x4 t0 = *(const f32x4*)tab, t1 = *(const f32x4*)(tab + 2);
                            const float cs[4] = {t0[0], t0[2], t1[0], t1[2]}, sn[4] = {t0[1], t0[3], t1[1], t1[3]};
#pragma unroll
                            for (int e = 0; e < 4; ++e) { const float x1 = y[bj][0][e], x2 = y[bj][1][e]; y[bj][0][e] = x1 * cs[e] - x2 * sn[e]; y[bj][1][e] = x1 * sn[e] + x2 * cs[e]; } } }
#pragma unroll
                    for (int bj = 0; bj < 2; ++bj) st16(Q1 + pil((int)R, h * 192 + 128 + 32 * bj + 8 * fq, 1536), pack8(y[bj][0], y[bj][1]));
                    asm volatile("" ::: "memory");
                }
        }
    }
};

struct EpiUkv {
    static constexpr bool PERM = true, AFTER_DRAIN = false;
    bf16 *Kn, *V1; const float* ssq; const float* kng; LAS float* xl;
    __device__ __forceinline__ void operator()(const f32x4 (&acc)[2][2][4][2], const Unit& u, int wr, int wc, int fr, int fq) const {
        const int h = u.pn;
#pragma unroll
        for (int ai = 0; ai < 2; ++ai)
#pragma unroll
            for (int m = 0; m < 4; ++m) { float s = 0.f;
#pragma unroll
                for (int n = 0; n < 2; ++n) { const f32x4 x = acc[ai][0][m][n]; s += (x[0] * x[0] + x[1] * x[1]) + (x[2] * x[2] + x[3] * x[3]); }
                s += __shfl_xor(s, 16); s += __shfl_xor(s, 32);
                if (fq == 0) xl[(ai * 128 + wr * 64 + m * 16 + fr) * 4 + wc] = s; }
        EPI_BAR();
#pragma unroll
        for (int ai = 0; ai < 2; ++ai)
#pragma unroll
            for (int m = 0; m < 4; ++m) { const int rr = opaque(ai * 128 + wr * 64 + m * 16 + fr); const size_t R = (size_t)u.pm * 256 + rr;
                f32x4 g[2];
#pragma unroll
                for (int n = 0; n < 2; ++n) g[n] = *(const f32x4*)(kng + wc * 32 + 8 * fq + 4 * n);
                const f32x4 s0 = *(const f32x4*)(ssq + R * 12);
                const float rk = rsq_(((s0[0] + s0[1]) + (s0[2] + s0[3])) * (1.0f / 256.0f) + EPS);
                const f32x4 p = *(const LAS f32x4*)(xl + rr * 4);
                const float rstd = rk * rsq_(((p[0] + p[1]) + (p[2] + p[3])) * (rk * rk) * (1.0f / 128.0f) + EPS);
                st16(Kn + pil((int)R, h * 128 + wc * 32 + 8 * fq, 1024), pack8(acc[ai][0][m][0] * rstd * g[0], acc[ai][0][m][1] * rstd * g[1]));
                st16(V1 + pil((int)R, h * 128 + wc * 32 + 8 * fq, 1024), pack8(acc[ai][1][m][0] * rk, acc[ai][1][m][1] * rk)); asm volatile("" ::: "memory"); }
        EPI_BAR();
    }
};

typedef short s16x4 __attribute__((ext_vector_type(4)));
#define KSWZ64(row, colB) ((row) * 128 + ((colB) ^ (((row) & 7) << 4)))
__device__ __forceinline__ unsigned cvtpk(float lo, float hi) { unsigned r; asm volatile("v_cvt_pk_bf16_f32 %0, %1, %2" : "=v"(r) : "v"(lo), "v"(hi)); return r; }
__device__ __forceinline__ int v_st(int k, int c) { const int kk = (k & ~0xC) | ((k & 4) << 1) | ((k & 8) >> 1); return ((kk >> 3) * 4 + (c >> 5)) * 512 + ((kk & 7) * 32 + (c & 31)) * 2; }
__device__ __forceinline__ int v_rd_base(int lane) { return ((lane & 3) << 3) | (((lane >> 2) & 3) << 6) | (((lane >> 4) & 1) << 5) | (((lane >> 5) & 1) << 8); }
constexpr int v_rd_off(int d0, int ks, int half) { return d0 * 512 + ks * 4096 + half * 2048; }
template <int OFF> __device__ __forceinline__ s16x4 tr_read(int vb) { s16x4 r; asm volatile("ds_read_b64_tr_b16 %0, %1 offset:%2" : "=&v"(r) : "v"(vb), "i"(OFF) : "memory"); return r; }
template <int D0> __device__ __forceinline__ void pv_one(f32x16& od, int vb, bf16x8 pa0, bf16x8 pa1, bf16x8 pa2, bf16x8 pa3) {
    const s16x4 l0 = tr_read<v_rd_off(D0, 0, 0)>(vb), h0 = tr_read<v_rd_off(D0, 0, 1)>(vb), l1 = tr_read<v_rd_off(D0, 1, 0)>(vb), h1 = tr_read<v_rd_off(D0, 1, 1)>(vb);
    const s16x4 l2 = tr_read<v_rd_off(D0, 2, 0)>(vb), h2 = tr_read<v_rd_off(D0, 2, 1)>(vb), l3 = tr_read<v_rd_off(D0, 3, 0)>(vb), h3 = tr_read<v_rd_off(D0, 3, 1)>(vb);
    asm volatile("s_waitcnt lgkmcnt(0)" ::: "memory"); __builtin_amdgcn_sched_barrier(0);
#define PKV(L, H) (bf16x8){L[0], L[1], L[2], L[3], H[0], H[1], H[2], H[3]}
    od = __builtin_amdgcn_mfma_f32_32x32x16_bf16(pa0, PKV(l0, h0), od, 0, 0, 0);
    od = __builtin_amdgcn_mfma_f32_32x32x16_bf16(pa1, PKV(l1, h1), od, 0, 0, 0);
    od = __builtin_amdgcn_mfma_f32_32x32x16_bf16(pa2, PKV(l2, h2), od, 0, 0, 0);
    od = __builtin_amdgcn_mfma_f32_32x32x16_bf16(pa3, PKV(l3, h3), od, 0, 0, 0);
#undef PKV
}
#define TRR8(D0, L0_, H0_, L1_, H1_, L2_, H2_, L3_, H3_) do { L0_ = tr_read<v_rd_off(D0, 0, 0)>(vb); H0_ = tr_read<v_rd_off(D0, 0, 1)>(vb); L1_ = tr_read<v_rd_off(D0, 1, 0)>(vb); H1_ = tr_read<v_rd_off(D0, 1, 1)>(vb); \
        L2_ = tr_read<v_rd_off(D0, 2, 0)>(vb); H2_ = tr_read<v_rd_off(D0, 2, 1)>(vb); L3_ = tr_read<v_rd_off(D0, 3, 0)>(vb); H3_ = tr_read<v_rd_off(D0, 3, 1)>(vb); } while (0)
#define PKVV(L, H) (bf16x8){L[0], L[1], L[2], L[3], H[0], H[1], H[2], H[3]}
#define MMA4(OD, L0_, H0_, L1_, H1_, L2_, H2_, L3_, H3_) do { OD = __builtin_amdgcn_mfma_f32_32x32x16_bf16(pa0, PKVV(L0_, H0_), OD, 0, 0, 0); OD = __builtin_amdgcn_mfma_f32_32x32x16_bf16(pa1, PKVV(L1_, H1_), OD, 0, 0, 0); \
        OD = __builtin_amdgcn_mfma_f32_32x32x16_bf16(pa2, PKVV(L2_, H2_), OD, 0, 0, 0); OD = __builtin_amdgcn_mfma_f32_32x32x16_bf16(pa3, PKVV(L3_, H3_), OD, 0, 0, 0); } while (0)
__device__ __forceinline__ void pv_all(f32x16 (&o)[4], int vb, bf16x8 pa0, bf16x8 pa1, bf16x8 pa2, bf16x8 pa3) {
    s16x4 a0, b0, a1, b1, a2, b2, a3, b3, c0, d0, c1, d1, c2, d2, c3, d3;
    TRR8(0, a0, b0, a1, b1, a2, b2, a3, b3); TRR8(1, c0, d0, c1, d1, c2, d2, c3, d3);
    asm volatile("s_waitcnt lgkmcnt(0)" ::: "memory"); __builtin_amdgcn_sched_barrier(0);
    MMA4(o[0], a0, b0, a1, b1, a2, b2, a3, b3);
    __builtin_amdgcn_sched_barrier(0);
    s16x4 e0, f0, e1, f1, e2, f2, e3, f3;
    TRR8(2, e0, f0, e1, f1, e2, f2, e3, f3);
    __builtin_amdgcn_sched_barrier(0);
    MMA4(o[1], c0, d0, c1, d1, c2, d2, c3, d3);
    __builtin_amdgcn_sched_barrier(0);
    TRR8(3, a0, b0, a1, b1, a2, b2, a3, b3);
    asm volatile("s_waitcnt lgkmcnt(0)" ::: "memory"); __builtin_amdgcn_sched_barrier(0);
    MMA4(o[2], e0, f0, e1, f1, e2, f2, e3, f3);
    MMA4(o[3], a0, b0, a1, b1, a2, b2, a3, b3);
}
__device__ __forceinline__ void pv_all2(f32x16 (&o)[4], int vb, bf16x8 pa0, bf16x8 pa1, bf16x8 pa2, bf16x8 pa3) {
    s16x4 a0, b0, a1, b1, a2, b2, a3, b3, c0, d0, c1, d1, c2, d2, c3, d3;
    TRR8(0, a0, b0, a1, b1, a2, b2, a3, b3);
    asm volatile("s_waitcnt lgkmcnt(0)" ::: "memory"); __builtin_amdgcn_sched_barrier(0);
    TRR8(1, c0, d0, c1, d1, c2, d2, c3, d3);
    __builtin_amdgcn_sched_barrier(0);
    MMA4(o[0], a0, b0, a1, b1, a2, b2, a3, b3);
    __builtin_amdgcn_sched_barrier(0);
    asm volatile("s_waitcnt lgkmcnt(0)" ::: "memory"); __builtin_amdgcn_sched_barrier(0);
    TRR8(2, a0, b0, a1, b1, a2, b2, a3, b3);
    __builtin_amdgcn_sched_barrier(0);
    MMA4(o[1], c0, d0, c1, d1, c2, d2, c3, d3);
    __builtin_amdgcn_sched_barrier(0);
    asm volatile("s_waitcnt lgkmcnt(0)" ::: "memory"); __builtin_amdgcn_sched_barrier(0);
    TRR8(3, c0, d0, c1, d1, c2, d2, c3, d3);
    __builtin_amdgcn_sched_barrier(0);
    MMA4(o[2], a0, b0, a1, b1, a2, b2, a3, b3);
    __builtin_amdgcn_sched_barrier(0);
    asm volatile("s_waitcnt lgkmcnt(0)" ::: "memory"); __builtin_amdgcn_sched_barrier(0);
    MMA4(o[3], c0, d0, c1, d1, c2, d2, c3, d3);
}
#define PK4(P, BASE, OUT) do { unsigned a0 = cvtpk(P[BASE + 0], P[BASE + 1]), a1 = cvtpk(P[BASE + 2], P[BASE + 3]);   \
    unsigned b0 = cvtpk(P[BASE + 4], P[BASE + 5]), b1 = cvtpk(P[BASE + 6], P[BASE + 7]);                              \
    auto r0 = __builtin_amdgcn_permlane32_swap(a0, b0, false, false); auto r1 = __builtin_amdgcn_permlane32_swap(a1, b1, false, false); \
    v4u w = {r0[0], r1[0], r0[1], r1[1]}; OUT = __builtin_bit_cast(bf16x8, w); } while (0)

#define PK4B(P, BASE, OUT) do { unsigned a0 = cvtpk_b(P[BASE + 0], P[BASE + 1]), a1 = cvtpk_b(P[BASE + 2], P[BASE + 3]);   \
    unsigned b0 = cvtpk_b(P[BASE + 4], P[BASE + 5]), b1 = cvtpk_b(P[BASE + 6], P[BASE + 7]);                              \
    auto r0 = __builtin_amdgcn_permlane32_swap(a0, b0, false, false); auto r1 = __builtin_amdgcn_permlane32_swap(a1, b1, false, false); \
    v4u w = {r0[0], r1[0], r0[1], r1[1]}; OUT = __builtin_bit_cast(bf16x8, w); } while (0)

template <int NSUB, bool PILKV = false>
__device__ __forceinline__ void attn_pass(f32x16 (&o)[4], float& l_acc, const bf16x8 (&qf)[NSUB * 4], const bf16* k0, const bf16* k1, const bf16* k2, int ld0, int ld1, int ld2,
                                          const bf16* vsrc, int vld, int nkeys, LAS unsigned char* lds) {
    constexpr int BUF = NSUB * 8192 + 16384;
    const int tid = opaque((int)threadIdx.x), lane = tid & 63, r32 = lane & 31, hh = lane >> 5;
    const int krow = tid >> 3, kch = tid & 7, sr = tid >> 4, sc = (tid & 15) * 8;
    const int kdst = KSWZ64(krow, kch * 16), vst0 = NSUB * 8192 + v_st(sr, sc), vst1 = NSUB * 8192 + v_st(32 + sr, sc);
    const int vb0 = (int)(unsigned)(uintptr_t)lds + NSUB * 8192 + v_rd_base(lane);
    const int ka0 = r32 * 128, ka1 = (32 + r32) * 128;
    bf16x8 sk0, sk1, sk2, sv0, sv1;
#define ALOAD(key0) do { sk0 = PILKV ? *(const bf16x8*)(k0 + (size_t)(key0) * ld0) : *(const bf16x8*)(k0 + (size_t)((key0) + krow) * ld0 + kch * 8); \
        if (NSUB > 1) sk1 = PILKV ? *(const bf16x8*)(k1 + (size_t)(key0) * ld1) : *(const bf16x8*)(k1 + (size_t)((key0) + krow) * ld1 + kch * 8); \
        if (NSUB > 2) sk2 = *(const bf16x8*)(k2 + (size_t)((key0) + krow) * ld2 + kch * 8); \
        sv0 = PILKV ? *(const bf16x8*)(vsrc + (size_t)(key0) * vld) : *(const bf16x8*)(vsrc + (size_t)((key0) + sr) * vld + sc); \
        sv1 = PILKV ? *(const bf16x8*)(vsrc + (size_t)((key0) + 32) * vld) : *(const bf16x8*)(vsrc + (size_t)((key0) + 32 + sr) * vld + sc); } while (0)
#define AWRITE(b) do { LAS unsigned char* bb = lds + (b) * BUF; *(LAS bf16x8*)(bb + kdst) = sk0; if (NSUB > 1) *(LAS bf16x8*)(bb + 8192 + kdst) = sk1; if (NSUB > 2) *(LAS bf16x8*)(bb + 16384 + kdst) = sk2; \
        *(LAS bf16x8*)(bb + vst0) = sv0; *(LAS bf16x8*)(bb + vst1) = sv1; } while (0)
    const int NT = nkeys >> 6;
    ALOAD(0); AWRITE(0); __syncthreads();
    for (int t = 0; t < NT; ++t) {
        const int b = t & 1;
        if (t + 1 < NT) ALOAD((t + 1) * 64);
        const LAS unsigned char* kb = lds + b * BUF;
        f32x16 p0, p1;
#pragma unroll
        for (int r = 0; r < 16; ++r) { p0[r] = 0.f; p1[r] = 0.f; }
#pragma unroll
        for (int s = 0; s < NSUB; ++s)
#pragma unroll
            for (int ks = 0; ks < 4; ++ks) { const int cb = (ks * 16 + hh * 8) * 2, x = (r32 & 7) << 4;
                const bf16x8 b0 = *(const LAS bf16x8*)(kb + s * 8192 + ka0 + (cb ^ x)), b1 = *(const LAS bf16x8*)(kb + s * 8192 + ka1 + (cb ^ x));
                p0 = __builtin_amdgcn_mfma_f32_32x32x16_bf16(b0, qf[s * 4 + ks], p0, 0, 0, 0);
                p1 = __builtin_amdgcn_mfma_f32_32x32x16_bf16(b1, qf[s * 4 + ks], p1, 0, 0, 0); }
        float ps = 0.f;
#pragma unroll
        for (int r = 0; r < 16; ++r) { p0[r] = __builtin_amdgcn_exp2f(p0[r]); p1[r] = __builtin_amdgcn_exp2f(p1[r]); ps += p0[r] + p1[r]; }
        l_acc += ps;
        bf16x8 pa0, pa1, pa2, pa3;
        PK4(p0, 0, pa0); PK4(p0, 8, pa1); PK4(p1, 0, pa2); PK4(p1, 8, pa3);
        const int vb = vb0 + b * BUF;
        pv_all(o, vb, pa0, pa1, pa2, pa3);
        if (t + 1 < NT) AWRITE(b ^ 1);
        __syncthreads();
    }
#undef ALOAD
#undef AWRITE
}

template <int D0> __device__ __forceinline__ void pv_two(f32x16& oa, f32x16& ob, int vb, bf16x8 pa0, bf16x8 pa1, bf16x8 pa2, bf16x8 pa3, bf16x8 pb0, bf16x8 pb1, bf16x8 pb2, bf16x8 pb3) {
    const s16x4 l0 = tr_read<v_rd_off(D0, 0, 0)>(vb), h0 = tr_read<v_rd_off(D0, 0, 1)>(vb), l1 = tr_read<v_rd_off(D0, 1, 0)>(vb), h1 = tr_read<v_rd_off(D0, 1, 1)>(vb);
    const s16x4 l2 = tr_read<v_rd_off(D0, 2, 0)>(vb), h2 = tr_read<v_rd_off(D0, 2, 1)>(vb), l3 = tr_read<v_rd_off(D0, 3, 0)>(vb), h3 = tr_read<v_rd_off(D0, 3, 1)>(vb);
    asm volatile("s_waitcnt lgkmcnt(0)" ::: "memory"); __builtin_amdgcn_sched_barrier(0);
#define PKV(L, H) (bf16x8){L[0], L[1], L[2], L[3], H[0], H[1], H[2], H[3]}
    const bf16x8 v0 = PKV(l0, h0), v1 = PKV(l1, h1), v2 = PKV(l2, h2), v3 = PKV(l3, h3);
    oa = __builtin_amdgcn_mfma_f32_32x32x16_bf16(pa0, v0, oa, 0, 0, 0); ob = __builtin_amdgcn_mfma_f32_32x32x16_bf16(pb0, v0, ob, 0, 0, 0);
    oa = __builtin_amdgcn_mfma_f32_32x32x16_bf16(pa1, v1, oa, 0, 0, 0); ob = __builtin_amdgcn_mfma_f32_32x32x16_bf16(pb1, v1, ob, 0, 0, 0);
    oa = __builtin_amdgcn_mfma_f32_32x32x16_bf16(pa2, v2, oa, 0, 0, 0); ob = __builtin_amdgcn_mfma_f32_32x32x16_bf16(pb2, v2, ob, 0, 0, 0);
    oa = __builtin_amdgcn_mfma_f32_32x32x16_bf16(pa3, v3, oa, 0, 0, 0); ob = __builtin_amdgcn_mfma_f32_32x32x16_bf16(pb3, v3, ob, 0, 0, 0);
#undef PKV
}
#define KSWZ256(row, colB) ((row) * 256 + ((colB) ^ (((row) & 7) << 4)))
__device__ __forceinline__ void diff_attn_unit_v2(Frame& F, int a) {
    const int tid = opaque((int)threadIdx.x), lane = tid & 63, r32 = lane & 31, hh = lane >> 5, wid = F.wave;
    int b, h, q0, nkeys;
    if (a < 256) { b = a >> 5; h = (a >> 3) & 3; q0 = b * RPB + CTXL + (a & 7) * 256; nkeys = RPB; } else { const int a2 = a - 256; b = a2 >> 2; h = a2 & 3; q0 = b * RPB; nkeys = CTXL; }
    const bf16* Qd = (const bf16*)(F.big_() + B_QD); const bf16* Kd = (const bf16*)(F.big_() + B_KD); const bf16* Vd = (const bf16*)(F.big_() + B_VD);
    const int brow = b * RPB;
    LAS unsigned char* lds = F.lds;
    constexpr int BUF = 32768;
    LAS unsigned char* Qw = lds + 65536 + wid * 8192;
#pragma unroll
    for (int it = 0; it < 8; ++it) { const int row = it * 4 + (lane >> 4), ch = lane & 15;
        *(LAS bf16x8*)(Qw + KSWZ256(row, ch * 16)) = *(const bf16x8*)(Qd + (size_t)(q0 + wid * 32 + row) * 512 + h * 128 + ch * 8); }
    const int krow = tid >> 3, kch = tid & 7, sr = tid >> 4, sc = (tid & 15) * 8;
    const int kdst = KSWZ64(krow, kch * 16), vst0 = 16384 + v_st(sr, sc), vst1 = 16384 + v_st(32 + sr, sc);
    const int vb0 = (int)(unsigned)(uintptr_t)lds + 16384 + v_rd_base(lane);
    const int xs = (r32 & 7) << 4;
    int x4[4];
#pragma unroll
    for (int ks = 0; ks < 4; ++ks) x4[ks] = ((ks * 16 + hh * 8) * 2) ^ xs;
    const int qb_ = (int)(unsigned)(uintptr_t)Qw + r32 * 256, kb_ = (int)(unsigned)(uintptr_t)lds + r32 * 128;
    bf16x8 sk0, sk1, sv0, sv1;
    const bf16* kbase = Kd + (size_t)brow * 512 + h * 128; const bf16* vsrc = Vd + (size_t)brow * 512 + h * 128;
#define DLOAD(key0) do { sk0 = *(const bf16x8*)(kbase + (size_t)((key0) + krow) * 512 + kch * 8); sk1 = *(const bf16x8*)(kbase + 64 + (size_t)((key0) + krow) * 512 + kch * 8); \
        sv0 = *(const bf16x8*)(vsrc + (size_t)((key0) + sr) * 512 + sc); sv1 = *(const bf16x8*)(vsrc + (size_t)((key0) + 32 + sr) * 512 + sc); } while (0)
#define DWRITE(bi) do { LAS unsigned char* bb = lds + (bi) * BUF; *(LAS bf16x8*)(bb + kdst) = sk0; *(LAS bf16x8*)(bb + 8192 + kdst) = sk1; *(LAS bf16x8*)(bb + vst0) = sv0; *(LAS bf16x8*)(bb + vst1) = sv1; } while (0)
    f32x16 O0[4], O1[4];
#pragma unroll
    for (int d = 0; d < 4; ++d)
#pragma unroll
        for (int r = 0; r < 16; ++r) { O0[d][r] = 0.f; O1[d][r] = 0.f; }
    float l0 = 0.f, l1 = 0.f;
    const int NT = nkeys >> 6;
    DLOAD(0); DWRITE(0); __syncthreads();
    for (int t = 0; t < NT; ++t) {
        const int bi = t & 1;
        if (t + 1 < NT) DLOAD((t + 1) * 64);
        const int kbo = opaque(kb_ + bi * BUF), qbo = opaque(qb_);
        const int vb = vb0 + bi * BUF;
        __builtin_amdgcn_sched_barrier(0);
        {   f32x16 p0, p1; bf16x8 pa0, pa1, pa2, pa3;
#pragma unroll
            for (int r = 0; r < 16; ++r) { p0[r] = 0.f; p1[r] = 0.f; }
#pragma unroll
            for (int ks = 0; ks < 4; ++ks) {
                const bf16x8 qv = *(const LAS bf16x8*)(uintptr_t)(unsigned)(qbo + x4[ks]);
                const bf16x8 k0v = *(const LAS bf16x8*)(uintptr_t)(unsigned)(kbo + x4[ks]), k1v = *(const LAS bf16x8*)(uintptr_t)(unsigned)(kbo + x4[ks] + 4096);
                p0 = __builtin_amdgcn_mfma_f32_32x32x16_bf16(k0v, qv, p0, 0, 0, 0); p1 = __builtin_amdgcn_mfma_f32_32x32x16_bf16(k1v, qv, p1, 0, 0, 0); }
            float ps = 0.f;
#pragma unroll
            for (int r = 0; r < 16; ++r) { p0[r] = __builtin_amdgcn_exp2f(p0[r]); p1[r] = __builtin_amdgcn_exp2f(p1[r]); ps += p0[r] + p1[r]; }
            l0 += ps;
            PK4(p0, 0, pa0); PK4(p0, 8, pa1); PK4(p1, 0, pa2); PK4(p1, 8, pa3);
            pv_one<0>(O0[0], vb, pa0, pa1, pa2, pa3); pv_one<1>(O0[1], vb, pa0, pa1, pa2, pa3); pv_one<2>(O0[2], vb, pa0, pa1, pa2, pa3); pv_one<3>(O0[3], vb, pa0, pa1, pa2, pa3); }
        __builtin_amdgcn_sched_barrier(0);
        {   f32x16 p0, p1; bf16x8 pa0, pa1, pa2, pa3;
#pragma unroll
            for (int r = 0; r < 16; ++r) { p0[r] = 0.f; p1[r] = 0.f; }
#pragma unroll
            for (int ks = 0; ks < 4; ++ks) {
                const bf16x8 qv = *(const LAS bf16x8*)(uintptr_t)(unsigned)(qbo + x4[ks] + 128);
                const bf16x8 k0v = *(const LAS bf16x8*)(uintptr_t)(unsigned)(kbo + x4[ks] + 8192), k1v = *(const LAS bf16x8*)(uintptr_t)(unsigned)(kbo + x4[ks] + 8192 + 4096);
                p0 = __builtin_amdgcn_mfma_f32_32x32x16_bf16(k0v, qv, p0, 0, 0, 0); p1 = __builtin_amdgcn_mfma_f32_32x32x16_bf16(k1v, qv, p1, 0, 0, 0); }
            float ps = 0.f;
#pragma unroll
            for (int r = 0; r < 16; ++r) { p0[r] = __builtin_amdgcn_exp2f(p0[r]); p1[r] = __builtin_amdgcn_exp2f(p1[r]); ps += p0[r] + p1[r]; }
            l1 += ps;
            PK4(p0, 0, pa0); PK4(p0, 8, pa1); PK4(p1, 0, pa2); PK4(p1, 8, pa3);
            pv_one<0>(O1[0], vb, pa0, pa1, pa2, pa3); pv_one<1>(O1[1], vb, pa0, pa1, pa2, pa3); pv_one<2>(O1[2], vb, pa0, pa1, pa2, pa3); pv_one<3>(O1[3], vb, pa0, pa1, pa2, pa3); }
        __builtin_amdgcn_sched_barrier(0);
        if (t + 1 < NT) DWRITE(bi ^ 1);
        __syncthreads();
    }
#undef DLOAD
#undef DWRITE
    l0 += __shfl_xor(l0, 32); l1 += __shfl_xor(l1, 32);
    const float lam = F.lamv_()[0];
    const float* sg = F.ar->in[I_DSUBLN];
    float gsub[4];
#pragma unroll
    for (int d = 0; d < 4; ++d) gsub[d] = sg[d * 32 + r32] * 0.8f;
#pragma unroll
    for (int r = 0; r < 16; ++r) {
        const int qi = crow(r, hh);
        const float i0 = __builtin_amdgcn_rcpf(__shfl(l0, qi)), i1 = lam * __builtin_amdgcn_rcpf(__shfl(l1, qi));
        float o[4]; float s = 0.f;
#pragma unroll
        for (int d = 0; d < 4; ++d) { o[d] = O0[d][r] * i0 - O1[d][r] * i1; s += o[d] * o[d]; }
        s += __shfl_xor(s, 1); s += __shfl_xor(s, 2); s += __shfl_xor(s, 4); s += __shfl_xor(s, 8); s += __shfl_xor(s, 16);
        const float rstd = rsq_(s * (1.0f / 128.0f) + EPS);
        bf16* op = F.H_() + (size_t)(q0 + wid * 32 + qi) * D + h * 128 + r32;
#pragma unroll
        for (int d = 0; d < 4; ++d) op[d * 32] = (bf16)f2bf(o[d] * rstd * gsub[d]);
    }
}

__device__ __forceinline__ void mla_attn_unit_v1(Frame& F, int a) {
    const int lane = F.lane, r32 = lane & 31, hh = lane >> 5, wid = F.wave;
    const int b = a >> 6, h = (a >> 3) & 7, q0 = b * RPB + CTXL + (a & 7) * 256;
    const bf16* Q1 = (const bf16*)(F.big_() + B_Q1); const bf16* Kn = (const bf16*)(F.big_() + B_KN); const bf16* Kr = (const bf16*)(F.big_() + B_KR); const bf16* V1 = (const bf16*)(F.big_() + B_V1);
    const int tid_ = (int)threadIdx.x, krow_ = tid_ >> 3, kch_ = tid_ & 7, sr_ = tid_ >> 4, sc_ = (tid_ & 15) * 8;
    const bf16* knb = Kn + (size_t)b * RPB * 1024 + pil(krow_, h * 128 + kch_ * 8, 1024); const bf16* krb = Kr + (size_t)b * RPB * 64; const bf16* vb = V1 + (size_t)b * RPB * 1024 + pil(sr_, h * 128 + sc_, 1024);
    bf16x8 qf[12];
    { const bf16* qp = Q1 + (size_t)(q0 + wid * 32) * 1536;
#pragma unroll
        for (int ks = 0; ks < 12; ++ks) qf[ks] = *(const bf16x8*)(qp + pil(r32, h * 192 + ks * 16 + hh * 8, 1536)); }
    f32x16 o[4];
#pragma unroll
    for (int d = 0; d < 4; ++d)
#pragma unroll
        for (int r = 0; r < 16; ++r) o[d][r] = 0.f;
    float l0 = 0.f;
    attn_pass<3, true>(o, l0, qf, knb, knb + 128, krb, 1024, 1024, 64, vb, 1024, RPB, F.lds);
    l0 += __shfl_xor(l0, 32);
#pragma unroll
    for (int r = 0; r < 16; ++r) { const int qi = crow(r, hh); const float i0 = 1.0f / __shfl(l0, qi);
        bf16* op = F.H_() + (size_t)(q0 + wid * 32 + qi) * D + h * 128 + r32;
#pragma unroll
        for (int d = 0; d < 4; ++d) op[d * 32] = (bf16)f2bf(o[d][r] * i0); }
}

constexpr int HL_LF = 0, HL_QR = 16384, HL_QT = 32768, HL_KT = 49152, HL_K2 = 65536, HL_VT = 81920, HL_S0 = 86016, HL_GC = 102400, HL_TOT = 102912, HL_PO = 104960;
__device__ __forceinline__ int tr_st(int k, int c, int NC) { const int kk = (k & ~0xC) | ((k & 4) << 1) | ((k & 8) >> 1); return ((kk >> 3) * NC + (c >> 5)) * 512 + ((kk & 7) * 32 + (c & 31)) * 2; }
constexpr int tr_off(int NC, int ks, int half) { return ((2 * ks + half) * NC) * 512; }
#define PKV2(L, H) (bf16x8){L[0], L[1], L[2], L[3], H[0], H[1], H[2], H[3]}
#define TRR(dst, vb, off) asm volatile("ds_read_b64_tr_b16 %0, %1 offset:%2" : "=&v"(dst) : "v"(vb), "i"(off) : "memory")
#define TRWAIT() do { asm volatile("s_waitcnt lgkmcnt(0)" ::: "memory"); __builtin_amdgcn_sched_barrier(0); } while (0)
template <int NC, int KS> __device__ __forceinline__ bf16x8 tr_frag(int vb) { const s16x4 l = tr_read<tr_off(NC, KS, 0)>(vb), h = tr_read<tr_off(NC, KS, 1)>(vb); asm volatile("s_waitcnt lgkmcnt(0)" ::: "memory"); __builtin_amdgcn_sched_barrier(0); return PKV2(l, h); }

__device__ __forceinline__ void hgrn_unit_v1(Frame& F, int a) {
    const int dvq = a & 3, dir = (a >> 2) & 1, h = (a >> 3) & 3, b = a >> 5;
    const bf16* Hq = (const bf16*)(F.big_() + B_HQ); const f16* Lf = (const f16*)(F.big_() + (dir ? B_LF1 : B_LF0)); const bf16* Hv = (const bf16*)(F.big_() + B_HV);
    bf16* Ho = (bf16*)(F.big_() + (dir ? B_HO1 : B_HO0));
    LAS unsigned char* L = F.lds;
    const int tid = opaque((int)threadIdx.x), lane = tid & 63, r32 = lane & 31, hh = lane >> 5, wid = F.wave;
    const int ldsb = (int)(unsigned)(uintptr_t)L;
    const int colo = h * 128;
    const int ltok0 = tid >> 4, lkch = tid & 15;
    const int vtok = tid >> 2, vch = tid & 3;
    const int sk = tid & 127, tq = tid >> 7;
    v4u rl0, rl1, rq0, rq1, rv;
    rv = (v4u){0u, 0u, 0u, 0u};
#define HG_ROW(p) ((size_t)b * RPB + (dir ? ((p) < CTXL ? CTXL - 1 - (p) : RPB + CTXL - 1 - (p)) : (p)))
#define HG_LOAD(n) do { const size_t R0 = HG_ROW((n) * 64 + ltok0), R1 = HG_ROW((n) * 64 + 32 + ltok0); \
        const int o0_ = pil((int)R0, colo + lkch * 8, 512), o1_ = pil((int)R1, colo + lkch * 8, 512); \
        rl0 = *(const v4u*)(Lf + o0_); rl1 = *(const v4u*)(Lf + o1_); rq0 = *(const v4u*)(Hq + o0_); rq1 = *(const v4u*)(Hq + o1_); \
        if (tid < 256) rv = *(const v4u*)(Hv + pil((int)HG_ROW((n) * 64 + vtok), colo + dvq * 32 + vch * 8, 512)); } while (0)
    f32x16 S, okeep;
#pragma unroll
    for (int r = 0; r < 16; ++r) { S[r] = 0.f; okeep[r] = 0.f; }
#define HG_FINISH(nn) do { if (wid == 4 || wid == 5) { const int ct_ = wid - 4; f32x16 of_ = okeep; \
        _Pragma("unroll") for (int g = 0; g < 4; ++g) { f32x4 p_ = *(const LAS f32x4*)(L + HL_PO + (1 + ct_) * 4096 + lane * 64 + g * 16); \
            if (ct_) p_ += *(const LAS f32x4*)(L + HL_PO + lane * 64 + g * 16); of_[4 * g] += p_[0]; of_[4 * g + 1] += p_[1]; of_[4 * g + 2] += p_[2]; of_[4 * g + 3] += p_[3]; } \
        _Pragma("unroll") for (int r = 0; r < 16; ++r) { const int p = (nn) * 64 + 32 * ct_ + crow(r, hh); Ho[HG_ROW(p) * 512 + colo + dvq * 32 + r32] = (bf16)f2bf(of_[r]); } } } while (0)
    for (int e = tid; e < 512; e += NTHREADS) *(LAS v4u*)(L + HL_S0 + e * 16) = (v4u){0u, 0u, 0u, 0u};
    HG_LOAD(0);
    const int NCH = RPB / 64;
    for (int n = 0; n < NCH; ++n) {
        SEC_BEGIN(1);
        *(LAS v4u*)(L + HL_LF + ltok0 * 256 + lkch * 16) = rl0; *(LAS v4u*)(L + HL_LF + (ltok0 + 32) * 256 + lkch * 16) = rl1;
        *(LAS v4u*)(L + HL_QR + ltok0 * 256 + lkch * 16) = rq0; *(LAS v4u*)(L + HL_QR + (ltok0 + 32) * 256 + lkch * 16) = rq1;
        __syncthreads();
        if (n > 0) HG_FINISH(n - 1);
        float c[16], lf[16];
        { float run = 0.f;
#pragma unroll
            for (int j = 0; j < 16; ++j) { lf[j] = (float)*(const LAS f16*)(L + HL_LF + (16 * tq + j) * 256 + sk * 2); run += lf[j]; c[j] = run; }
            *(LAS float*)(L + HL_TOT + (tq * 128 + sk) * 4) = run; }
        __syncthreads();
        {   const float t0 = *(const LAS float*)(L + HL_TOT + (0 * 128 + sk) * 4), t1 = *(const LAS float*)(L + HL_TOT + (1 * 128 + sk) * 4);
            const float t2 = *(const LAS float*)(L + HL_TOT + (2 * 128 + sk) * 4), t3 = *(const LAS float*)(L + HL_TOT + (3 * 128 + sk) * 4);
            const float off = (tq > 0 ? t0 : 0.f) + (tq > 1 ? t1 : 0.f) + (tq > 2 ? t2 : 0.f), cumC = (t0 + t1) + (t2 + t3);
            float qp[16], kp[16], k2[16];
            const float egC = __builtin_amdgcn_exp2f(cumC * LOG2E);
#pragma unroll
            for (int j = 0; j < 16; ++j) { const float cum = off + c[j]; const float eg = __builtin_amdgcn_exp2f(cum * LOG2E), f = __builtin_amdgcn_exp2f(lf[j] * LOG2E), kk = 1.0f - f;
                const float q = bf2f(*(const LAS bf16*)(L + HL_QR + (16 * tq + j) * 256 + sk * 2));
                qp[j] = q * eg; kp[j] = kk * __builtin_amdgcn_exp2f(-fmaxf(cum, -80.0f) * LOG2E); k2[j] = kp[j] * egC; }
            const int to = tr_st(sk, 16 * tq, 2);
            *(LAS v4u*)(L + HL_QT + to) = (v4u){cvtpk_b(qp[0], qp[1]), cvtpk_b(qp[2], qp[3]), cvtpk_b(qp[4], qp[5]), cvtpk_b(qp[6], qp[7])};
            *(LAS v4u*)(L + HL_QT + to + 16) = (v4u){cvtpk_b(qp[8], qp[9]), cvtpk_b(qp[10], qp[11]), cvtpk_b(qp[12], qp[13]), cvtpk_b(qp[14], qp[15])};
            *(LAS v4u*)(L + HL_KT + to) = (v4u){cvtpk_b(kp[0], kp[1]), cvtpk_b(kp[2], kp[3]), cvtpk_b(kp[4], kp[5]), cvtpk_b(kp[6], kp[7])};
            *(LAS v4u*)(L + HL_KT + to + 16) = (v4u){cvtpk_b(kp[8], kp[9]), cvtpk_b(kp[10], kp[11]), cvtpk_b(kp[12], kp[13]), cvtpk_b(kp[14], kp[15])};
            *(LAS v4u*)(L + HL_K2 + KSWZ64(sk, 32 * tq)) = (v4u){cvtpk_b(k2[0], k2[1]), cvtpk_b(k2[2], k2[3]), cvtpk_b(k2[4], k2[5]), cvtpk_b(k2[6], k2[7])};
            *(LAS v4u*)(L + HL_K2 + KSWZ64(sk, 32 * tq + 16)) = (v4u){cvtpk_b(k2[8], k2[9]), cvtpk_b(k2[10], k2[11]), cvtpk_b(k2[12], k2[13]), cvtpk_b(k2[14], k2[15])};
            if (tq == 0) *(LAS float*)(L + HL_GC + sk * 4) = egC;
            if (tid < 256) *(LAS v4u*)(L + HL_VT + tr_st(vtok, vch * 8, 1)) = rv;
        }
        __syncthreads();
        SEC_END(1);
        SEC_BEGIN(2);
        if (n + 1 < NCH) HG_LOAD(n + 1);
        const int sb = (n & 1) * 8192;
        const int vbV = ldsb + HL_VT + v_rd_base(lane);
        if (wid < 4) {
            s16x4 vl0, vh0, vl1, vh1, vl2, vh2, vl3, vh3;
            TRR(vl0, vbV, tr_off(1, 0, 0)); TRR(vh0, vbV, tr_off(1, 0, 1)); TRR(vl1, vbV, tr_off(1, 1, 0)); TRR(vh1, vbV, tr_off(1, 1, 1));
            TRR(vl2, vbV, tr_off(1, 2, 0)); TRR(vh2, vbV, tr_off(1, 2, 1)); TRR(vl3, vbV, tr_off(1, 3, 0)); TRR(vh3, vbV, tr_off(1, 3, 1));
            const int krow = 32 * wid + r32;
            const bf16x8 a0 = *(const LAS bf16x8*)(L + HL_K2 + KSWZ64(krow, (0 + 8 * hh) * 2)), a1 = *(const LAS bf16x8*)(L + HL_K2 + KSWZ64(krow, (16 + 8 * hh) * 2));
            const bf16x8 a2 = *(const LAS bf16x8*)(L + HL_K2 + KSWZ64(krow, (32 + 8 * hh) * 2)), a3 = *(const LAS bf16x8*)(L + HL_K2 + KSWZ64(krow, (48 + 8 * hh) * 2));
#pragma unroll
            for (int g = 0; g < 4; ++g) { const f32x4 gv = *(const LAS f32x4*)(L + HL_GC + (32 * wid + 8 * g + 4 * hh) * 4);
#pragma unroll
                for (int e = 0; e < 4; ++e) S[4 * g + e] *= gv[e]; }
            TRWAIT();
            S = __builtin_amdgcn_mfma_f32_32x32x16_bf16(a0, PKV2(vl0, vh0), S, 0, 0, 0); S = __builtin_amdgcn_mfma_f32_32x32x16_bf16(a1, PKV2(vl1, vh1), S, 0, 0, 0);
            S = __builtin_amdgcn_mfma_f32_32x32x16_bf16(a2, PKV2(vl2, vh2), S, 0, 0, 0); S = __builtin_amdgcn_mfma_f32_32x32x16_bf16(a3, PKV2(vl3, vh3), S, 0, 0, 0);
            bf16x8 f0, f1; PK4B(S, 0, f0); PK4B(S, 8, f1);
            *(LAS bf16x8*)(L + HL_S0 + (sb ^ 8192) + ((2 * wid) * 64 + lane) * 16) = f0; *(LAS bf16x8*)(L + HL_S0 + (sb ^ 8192) + ((2 * wid + 1) * 64 + lane) * 16) = f1;
        } else if (wid < 7) {
            const int ct = wid > 4 ? 1 : 0, rt = wid == 6 ? 1 : 0;
            const int vbQ = ldsb + HL_QT + ct * 512 + v_rd_base(lane), vbKr = ldsb + HL_KT + rt * 512 + v_rd_base(lane), vbVr = vbV + rt * 2048;
            bf16x8 qf[8];
            { s16x4 l0, h0, l1, h1, l2, h2, l3, h3, l4, h4, l5, h5, l6, h6, l7, h7;
                TRR(l0, vbQ, tr_off(2, 0, 0)); TRR(h0, vbQ, tr_off(2, 0, 1)); TRR(l1, vbQ, tr_off(2, 1, 0)); TRR(h1, vbQ, tr_off(2, 1, 1));
                TRR(l2, vbQ, tr_off(2, 2, 0)); TRR(h2, vbQ, tr_off(2, 2, 1)); TRR(l3, vbQ, tr_off(2, 3, 0)); TRR(h3, vbQ, tr_off(2, 3, 1));
                TRR(l4, vbQ, tr_off(2, 4, 0)); TRR(h4, vbQ, tr_off(2, 4, 1)); TRR(l5, vbQ, tr_off(2, 5, 0)); TRR(h5, vbQ, tr_off(2, 5, 1));
                TRR(l6, vbQ, tr_off(2, 6, 0)); TRR(h6, vbQ, tr_off(2, 6, 1)); TRR(l7, vbQ, tr_off(2, 7, 0)); TRR(h7, vbQ, tr_off(2, 7, 1));
                TRWAIT();
                qf[0] = PKV2(l0, h0); qf[1] = PKV2(l1, h1); qf[2] = PKV2(l2, h2); qf[3] = PKV2(l3, h3); qf[4] = PKV2(l4, h4); qf[5] = PKV2(l5, h5); qf[6] = PKV2(l6, h6); qf[7] = PKV2(l7, h7); }
            f32x16 X, o;
#pragma unroll
            for (int r = 0; r < 16; ++r) { X[r] = 0.f; o[r] = 0.f; }
            { s16x4 l0, h0, l1, h1, l2, h2, l3, h3, l4, h4, l5, h5, l6, h6, l7, h7, wl0, wh0, wl1, wh1;
                TRR(l0, vbKr, tr_off(2, 0, 0)); TRR(h0, vbKr, tr_off(2, 0, 1)); TRR(l1, vbKr, tr_off(2, 1, 0)); TRR(h1, vbKr, tr_off(2, 1, 1));
                TRR(l2, vbKr, tr_off(2, 2, 0)); TRR(h2, vbKr, tr_off(2, 2, 1)); TRR(l3, vbKr, tr_off(2, 3, 0)); TRR(h3, vbKr, tr_off(2, 3, 1));
                TRR(l4, vbKr, tr_off(2, 4, 0)); TRR(h4, vbKr, tr_off(2, 4, 1)); TRR(l5, vbKr, tr_off(2, 5, 0)); TRR(h5, vbKr, tr_off(2, 5, 1));
                TRR(l6, vbKr, tr_off(2, 6, 0)); TRR(h6, vbKr, tr_off(2, 6, 1)); TRR(l7, vbKr, tr_off(2, 7, 0)); TRR(h7, vbKr, tr_off(2, 7, 1));
                TRR(wl0, vbVr, tr_off(1, 0, 0)); TRR(wh0, vbVr, tr_off(1, 0, 1)); TRR(wl1, vbVr, tr_off(1, 1, 0)); TRR(wh1, vbVr, tr_off(1, 1, 1));
                TRWAIT();
                X = __builtin_amdgcn_mfma_f32_32x32x16_bf16(PKV2(l0, h0), qf[0], X, 0, 0, 0); X = __builtin_amdgcn_mfma_f32_32x32x16_bf16(PKV2(l1, h1), qf[1], X, 0, 0, 0);
                X = __builtin_amdgcn_mfma_f32_32x32x16_bf16(PKV2(l2, h2), qf[2], X, 0, 0, 0); X = __builtin_amdgcn_mfma_f32_32x32x16_bf16(PKV2(l3, h3), qf[3], X, 0, 0, 0);
                X = __builtin_amdgcn_mfma_f32_32x32x16_bf16(PKV2(l4, h4), qf[4], X, 0, 0, 0); X = __builtin_amdgcn_mfma_f32_32x32x16_bf16(PKV2(l5, h5), qf[5], X, 0, 0, 0);
                X = __builtin_amdgcn_mfma_f32_32x32x16_bf16(PKV2(l6, h6), qf[6], X, 0, 0, 0); X = __builtin_amdgcn_mfma_f32_32x32x16_bf16(PKV2(l7, h7), qf[7], X, 0, 0, 0);
                if (rt == ct) {
#pragma unroll
                    for (int r = 0; r < 16; ++r) X[r] = (crow(r, hh) <= r32) ? X[r] : 0.f; }
                bf16x8 pa0, pa1; PK4B(X, 0, pa0); PK4B(X, 8, pa1);
                o = __builtin_amdgcn_mfma_f32_32x32x16_bf16(pa0, PKV2(wl0, wh0), o, 0, 0, 0); o = __builtin_amdgcn_mfma_f32_32x32x16_bf16(pa1, PKV2(wl1, wh1), o, 0, 0, 0); }
            if (wid == 6) {
#pragma unroll
                for (int g = 0; g < 4; ++g) *(LAS f32x4*)(L + HL_PO + 0 * 4096 + lane * 64 + g * 16) = (f32x4){o[4 * g], o[4 * g + 1], o[4 * g + 2], o[4 * g + 3]};
            } else okeep = o;
        } else {
#pragma unroll
            for (int ct = 0; ct < 2; ++ct) {
                const int vbQ = ldsb + HL_QT + ct * 512 + v_rd_base(lane);
                s16x4 l0, h0, l1, h1, l2, h2, l3, h3, l4, h4, l5, h5, l6, h6, l7, h7;
                TRR(l0, vbQ, tr_off(2, 0, 0)); TRR(h0, vbQ, tr_off(2, 0, 1)); TRR(l1, vbQ, tr_off(2, 1, 0)); TRR(h1, vbQ, tr_off(2, 1, 1));
                TRR(l2, vbQ, tr_off(2, 2, 0)); TRR(h2, vbQ, tr_off(2, 2, 1)); TRR(l3, vbQ, tr_off(2, 3, 0)); TRR(h3, vbQ, tr_off(2, 3, 1));
                TRR(l4, vbQ, tr_off(2, 4, 0)); TRR(h4, vbQ, tr_off(2, 4, 1)); TRR(l5, vbQ, tr_off(2, 5, 0)); TRR(h5, vbQ, tr_off(2, 5, 1));
                TRR(l6, vbQ, tr_off(2, 6, 0)); TRR(h6, vbQ, tr_off(2, 6, 1)); TRR(l7, vbQ, tr_off(2, 7, 0)); TRR(h7, vbQ, tr_off(2, 7, 1));
                TRWAIT();
                f32x16 o;
#pragma unroll
                for (int r = 0; r < 16; ++r) o[r] = 0.f;
                o = __builtin_amdgcn_mfma_f32_32x32x16_bf16(PKV2(l0, h0), *(const LAS bf16x8*)(L + HL_S0 + sb + (0 * 64 + lane) * 16), o, 0, 0, 0);
                o = __builtin_amdgcn_mfma_f32_32x32x16_bf16(PKV2(l1, h1), *(const LAS bf16x8*)(L + HL_S0 + sb + (1 * 64 + lane) * 16), o, 0, 0, 0);
                o = __builtin_amdgcn_mfma_f32_32x32x16_bf16(PKV2(l2, h2), *(const LAS bf16x8*)(L + HL_S0 + sb + (2 * 64 + lane) * 16), o, 0, 0, 0);
                o = __builtin_amdgcn_mfma_f32_32x32x16_bf16(PKV2(l3, h3), *(const LAS bf16x8*)(L + HL_S0 + sb + (3 * 64 + lane) * 16), o, 0, 0, 0);
                o = __builtin_amdgcn_mfma_f32_32x32x16_bf16(PKV2(l4, h4), *(const LAS bf16x8*)(L + HL_S0 + sb + (4 * 64 + lane) * 16), o, 0, 0, 0);
                o = __builtin_amdgcn_mfma_f32_32x32x16_bf16(PKV2(l5, h5), *(const LAS bf16x8*)(L + HL_S0 + sb + (5 * 64 + lane) * 16), o, 0, 0, 0);
                o = __builtin_amdgcn_mfma_f32_32x32x16_bf16(PKV2(l6, h6), *(const LAS bf16x8*)(L + HL_S0 + sb + (6 * 64 + lane) * 16), o, 0, 0, 0);
                o = __builtin_amdgcn_mfma_f32_32x32x16_bf16(PKV2(l7, h7), *(const LAS bf16x8*)(L + HL_S0 + sb + (7 * 64 + lane) * 16), o, 0, 0, 0);
#pragma unroll
                for (int g = 0; g < 4; ++g) *(LAS f32x4*)(L + HL_PO + (1 + ct) * 4096 + lane * 64 + g * 16) = (f32x4){o[4 * g], o[4 * g + 1], o[4 * g + 2], o[4 * g + 3]};
            }
        }
        SEC_END(2);
    }
    __syncthreads();
    HG_FINISH(NCH - 1);
    __syncthreads();
#undef HG_FINISH
#undef HG_ROW
#undef HG_LOAD
}

constexpr int NPHASES = 20;
__global__ void __launch_bounds__(NTHREADS, 2) mk_fwd(Args args) {
    extern __shared__ __attribute__((aligned(16))) unsigned char lds[];
    Frame F;
    F.lds = (LAS unsigned char*)lds;
    F.tid = threadIdx.x; F.lane = F.tid & 63; F.wave = __builtin_amdgcn_readfirstlane(F.tid >> 6); F.G = gridDim.x; F.bid = blockIdx.x;
    F.ar = &args; F.out = args.out; F.ws = args.ws; F.sec_acc = 0ull;

    volatile LAS unsigned* MISC = (volatile LAS unsigned*)(F.lds + LDS_MISC);
    for (int u = F.tid; u < 256; u += NTHREADS) MISC[u] = 0u;
    __syncthreads();
    XcdBarrier bar; bar.bar = (unsigned*)(F.ctl_() + CW_BAR); bar.x = 0; bar.st = nullptr;
    if (MK_N_LAUNCHES == 1) bar = xcd_barrier_post((unsigned*)(F.ctl_() + CW_BAR), MISC + 8);
    LAS float* xl = (LAS float*)(F.lds + LDS_XCH);

    const int lo = args.ph_lo, hi = args.ph_hi;
#ifdef DBG_ONLY
#define IN(k) ((k) == DBG_ONLY && lo <= (k) && (k) < hi)
#else
#define IN(k) (lo <= (k) && (k) < hi)
#endif
    unsigned long long amp_t0 = 0ull, amp_t1 = 0ull;
    if (PROBE_AMP_LO == 0) amp_t0 = __builtin_amdgcn_s_memrealtime();
#define SEAM(k) do { if (IN(k) && IN((k) + 1)) xcd_barrier(bar); if ((k) + 1 == PROBE_AMP_LO) amp_t0 = __builtin_amdgcn_s_memrealtime(); if ((k) == PROBE_AMP_HI) amp_t1 = __builtin_amdgcn_s_memrealtime(); } while (0)

    if (IN(0)) { REP(0) p0_prologue(F); } SEAM(0);
    if (IN(1)) { p0_convert_in0(F); p_norm0(F); } SEAM(1);
    if (IN(2)) { Gemm g{F.H_(), F.Win0_(), 1024, nullptr}; SchedGrid S{NT_ALL, 16, F.G, F.bid, false};
        EpiIn0 E{F.big_(), F.ar->in[I_DQG], F.ar->in[I_DKG], F.lbv_(), F.ropeR_(), F.ropeC_()}; p0_convert_mid(F, (NT_ALL * 16) % F.G); __syncthreads(); REP(2) run_gemm<0>(F, g, S, E); } SEAM(2);
    if (IN(3)) { REP(30) for (int a = F.bid; a < 256; a += F.G) hgrn_unit_v1(F, (F.G == 256) ? ((a & 7) * 32 + (a >> 3)) : a);

        REP(31) for (int a = F.bid; a < 288; a += F.G) diff_attn_unit_v2(F, a); } SEAM(3);
    if (IN(4)) { REP(4) p_hgrn_post(F); } SEAM(4);
    if (IN(5)) { Gemm g{F.H_(), F.Wout0_(), 1024, nullptr}; SchedGrid S{NT_ALL, 4, F.G, F.bid, false}; EpiOut E{&F, 0, true}; run_gemm<1>(F, g, S, E); p0_convert_late(F, 0); } SEAM(5);
    if (IN(6)) { p_norm_route(F, 0, false); } SEAM(6);
    if (IN(7)) { p_lists(F, 0, false);
        Gemm g{F.H_(), F.Wgu_() + (size_t)(0 * 17 + 16) * 1024 * 1024, 1024, nullptr}; SchedGrid S{NT_ALL, 4, F.G, F.bid, false}; EpiGU E{(bf16*)(F.big_() + B_HS)}; run_gemm<2>(F, g, S, E); p0_convert_late(F, 1); } SEAM(7);
    if (IN(8)) { { SchedRouted S; load_expoff(F, 0, S.eo); S.G = F.G; S.c = F.bid; Gemm g{F.H_(), F.Wgu_() + (size_t)(0 * 17) * 1024 * 1024, 1024, (const int*)(F.ws + WS_SMALL + SM_ROWIDX)}; EpiGU E{(bf16*)(F.big_() + B_HE)}; run_gemm<3>(F, g, S, E); }
        { Gemm g{(const bf16*)(F.big_() + B_HS), F.Wd_() + (size_t)(0 * 17 + 16) * 1024 * 512, 512, nullptr}; SchedGrid S{NT_ALL, 4, F.G, (F.bid + F.G / 2) % F.G, false}; EpiDownS E{(bf16*)(F.big_() + B_YS)}; run_gemm<4>(F, g, S, E); } } SEAM(8);
    if (IN(9)) { SchedRouted S; load_expoff(F, 0, S.eo); S.G = F.G; S.c = F.bid; Gemm g{(const bf16*)(F.big_() + B_HE), F.Wd_() + (size_t)(0 * 17) * 1024 * 512, 512, nullptr}; EpiDownR E{(bf16*)(F.big_() + B_YE)}; run_gemm<5>(F, g, S, E); } SEAM(9);
    if (IN(10)) { p_combine(F, 0, false, true); } SEAM(10);
    if (IN(11)) { Gemm g{F.H_(), F.Win1_(), 1024, nullptr}; SchedGrid S{NT_ALL, 3, F.G, F.bid, false}; EpiIn1 E{F.big_(), F.ssq_(), F.ar->in[I_KRG], F.ropeR_(), F.ropeC_()}; run_gemm<6>(F, g, S, E); } SEAM(11);
    if (IN(12)) { { Gemm g{(const bf16*)(F.big_() + B_CQ), F.Wuq_(), 384, nullptr}; SchedGrid S{NT_LAT, 6, F.G, F.bid, true};
            EpiUq E{(bf16*)(F.big_() + B_Q1), F.ssq_(), F.ar->in[I_QNG], F.ar->in[I_QRG], F.ropeR_(), F.ropeC_(), xl}; run_gemm<7>(F, g, S, E); }
        { Gemm g{(const bf16*)(F.big_() + B_CKV), F.Wukv_(), 256, nullptr}; SchedGrid S{NT_ALL, 8, F.G, (F.bid + F.G / 2) % F.G, false};
            EpiUkv E{(bf16*)(F.big_() + B_KN), (bf16*)(F.big_() + B_V1), F.ssq_(), F.ar->in[I_KNG], xl}; run_gemm<8>(F, g, S, E); } } SEAM(12);
    if (IN(13)) { REP(13) for (int a = F.bid; a < 512; a += F.G) mla_attn_unit_v1(F, a); } SEAM(13);
    if (IN(14)) { Gemm g{F.H_(), F.Wout1_(), 1024, nullptr}; SchedGrid S{NT_LAT, 4, F.G, F.bid, true}; EpiOut E{&F, 1, false}; run_gemm<9>(F, g, S, E); } SEAM(14);
    if (IN(15)) { p_norm_route(F, 1, true); } SEAM(15);
    if (IN(16)) { p_lists(F, 1, true);
        Gemm g{F.H_(), F.Wgu_() + (size_t)(1 * 17 + 16) * 1024 * 1024, 1024, nullptr}; SchedGrid S{NT_LAT, 4, F.G, F.bid, true}; EpiGU E{(bf16*)(F.big_() + B_HS)}; run_gemm<10>(F, g, S, E); } SEAM(16);
    if (IN(17)) { { SchedRouted S; load_expoff(F, 1, S.eo); S.G = F.G; S.c = F.bid; Gemm g{F.H_(), F.Wgu_() + (size_t)(1 * 17) * 1024 * 1024, 1024, (const int*)(F.ws + WS_SMALL + SM_ROWIDX)}; EpiGU E{(bf16*)(F.big_() + B_HE)}; run_gemm<11>(F, g, S, E); }
        { Gemm g{(const bf16*)(F.big_() + B_HS), F.Wd_() + (size_t)(1 * 17 + 16) * 1024 * 512, 512, nullptr}; SchedGrid S{NT_LAT, 4, F.G, F.bid, true}; EpiDownS E{(bf16*)(F.big_() + B_YS)}; run_gemm<12>(F, g, S, E); } } SEAM(17);
    if (IN(18)) { SchedRouted S; load_expoff(F, 1, S.eo); S.G = F.G; S.c = F.bid; Gemm g{(const bf16*)(F.big_() + B_HE), F.Wd_() + (size_t)(1 * 17) * 1024 * 512, 512, nullptr}; EpiDownR E{(bf16*)(F.big_() + B_YE)}; run_gemm<13>(F, g, S, E); } SEAM(18);
    if (IN(19)) { p_combine(F, 1, true, false); }
    if (PROBE_SEC > 0) { const unsigned long long te = (unsigned long long)clock64(); while ((unsigned long long)clock64() - te < F.sec_acc) __builtin_amdgcn_s_sleep(8); }
    if (PROBE_AMP_LO >= 0) { __syncthreads(); if (PROBE_AMP_HI >= 19) amp_t1 = __builtin_amdgcn_s_memrealtime(); const unsigned long long te = __builtin_amdgcn_s_memrealtime(); while (__builtin_amdgcn_s_memrealtime() - te < amp_t1 - amp_t0) __builtin_amdgcn_s_sleep(8); }
#undef IN
#undef SEAM
}

extern "C" void kernel_launch(void* const* d_in, const int* in_sizes, int n_in, void* d_out, int out_size, void* d_ws, size_t ws_size, hipStream_t stream) {
    static int grid = 0;
    if (grid == 0) {
        if (n_in != 34 || in_sizes[0] != NB * SEQ * D || out_size != NB * SEQ * D || ws_size < WS_END) {
            fprintf(stderr, "kernel_launch: unexpected problem: n_in %d in0 %d out %d ws %zu (need %zu); nothing launched\n", n_in, n_in > 0 ? in_sizes[0] : -1, out_size, ws_size, (size_t)WS_END); grid = -1; return; }
        int dev = 0, cus = 0;
        if (hipGetDevice(&dev) != hipSuccess || hipDeviceGetAttribute(&cus, hipDeviceAttributeMultiprocessorCount, dev) != hipSuccess) { grid = -1; return; }
        if (hipFuncSetAttribute((const void*)mk_fwd, hipFuncAttributeMaxDynamicSharedMemorySize, LDS_BYTES) != hipSuccess) { fprintf(stderr, "kernel_launch: hipFuncSetAttribute failed\n"); grid = -1; return; }
        int per_cu = 0;
        if (hipOccupancyMaxActiveBlocksPerMultiprocessor(&per_cu, (const void*)mk_fwd, NTHREADS, LDS_BYTES) != hipSuccess || per_cu < 1) fprintf(stderr, "kernel_launch: note: occupancy query reports %d\n", per_cu);
        (void)hipGetLastError();
        grid = cus;
    }
    if (grid < 0) return;
    if (hipMemsetAsync((char*)d_ws + WS_CTL, 0, CTL_ZERO_BYTES, stream) != hipSuccess) { fprintf(stderr, "kernel_launch: memset failed\n"); return; }
    Args a{};
    for (int i = 0; i < 34; ++i) a.in[i] = (const float*)d_in[i];
    a.out = (float*)d_out; a.ws = (unsigned char*)d_ws;
    if (MK_N_LAUNCHES == 1) { a.ph_lo = 0; a.ph_hi = NPHASES; hipLaunchKernelGGL(mk_fwd, dim3(grid), dim3(NTHREADS), LDS_BYTES, stream, a); }
    else for (int p = 0; p < NPHASES; ++p) { a.ph_lo = p; a.ph_hi = p + 1; hipLaunchKernelGGL(mk_fwd, dim3(grid), dim3(NTHREADS), LDS_BYTES, stream, a); }
    const hipError_t le = hipPeekAtLastError();
    if (le != hipSuccess) fprintf(stderr, "kernel_launch: launch failed: %s\n", hipGetErrorName(le));
}
```

```cpp
#include <hip/hip_runtime.h>
#include <cstdio>
#include <cstdint>

#ifndef MK_N_LAUNCHES
#define MK_N_LAUNCHES 1
#endif

#ifndef PROBE_SEC
#define PROBE_SEC 0
#endif
#define SEC_BEGIN(id) const unsigned long long sec_t##id = (PROBE_SEC == (id)) ? (unsigned long long)clock64() : 0ull
#define SEC_END(id) do { if (PROBE_SEC == (id)) F.sec_acc += (unsigned long long)clock64() - sec_t##id; } while (0)
#define GAS __attribute__((address_space(1)))
#define LAS __attribute__((address_space(3)))
typedef unsigned short bf16;
typedef _Float16 f16;
typedef short bf16x8 __attribute__((ext_vector_type(8)));
typedef float f32x4 __attribute__((ext_vector_type(4)));
typedef float f32x2 __attribute__((ext_vector_type(2)));
typedef float f32x16 __attribute__((ext_vector_type(16)));
typedef unsigned v4u __attribute__((ext_vector_type(4)));
typedef unsigned v2u __attribute__((ext_vector_type(2)));
typedef GAS unsigned gu32;
#define RLX_AGENT __ATOMIC_RELAXED, __HIP_MEMORY_SCOPE_AGENT
#define LDS_WAIT() asm volatile("s_waitcnt lgkmcnt(0)" ::: "memory")
#define VM_WAIT() asm volatile("s_waitcnt vmcnt(0)" ::: "memory")
#define EPI_BAR() do { asm volatile("s_waitcnt lgkmcnt(0)" ::: "memory"); __builtin_amdgcn_s_barrier(); asm volatile("" ::: "memory"); } while (0)

constexpr int NB = 8, SEQ = 2048, CTXL = 256, RPB = 2304  , NR = NB * RPB  , D = 1024;
constexpr int NT_ALL = NR / 256  , NT_LAT = 64;
constexpr int NEXP = 16, FF = 512;
constexpr int MP_MAX = 41216;
constexpr float EPS = 1e-6f;
constexpr float LOG2E = 1.4426950408889634f;
constexpr int NWAVES = 8, NTHREADS = 512;

constexpr size_t MiB = 1u << 20;
constexpr size_t WS_CTL = 0, CTL_ZERO_BYTES = 64 * 1024;
constexpr int CW_TMO = 0, CW_CODE = 1, CW_BAR = 4096, CW_CNT = 8192;
constexpr size_t WS_SMALL = 1 * MiB;
constexpr size_t SM_MODV = 0;
constexpr size_t SM_ROPER = 448 * 1024;
constexpr size_t SM_ROPEC = 452 * 1024;
constexpr size_t SM_LBV = 460 * 1024;
constexpr size_t SM_LAM = 464 * 1024;
constexpr size_t SM_ROUTE_E = 512 * 1024;
constexpr size_t SM_ROUTE_W = 584 * 1024;
constexpr size_t SM_ROUTE_S = 728 * 1024;
constexpr size_t SM_POS = 872 * 1024;
constexpr size_t SM_ROWIDX = 1016 * 1024;
constexpr size_t SM_SSQ = 1280 * 1024;
static_assert(SM_ROUTE_E + (size_t)NR * 4 <= SM_ROUTE_W && SM_ROUTE_W + (size_t)NR * 8 <= SM_ROUTE_S && SM_ROUTE_S + (size_t)NR * 8 <= SM_POS && SM_POS + (size_t)NR * 8 <= SM_ROWIDX &&
              SM_ROWIDX + (size_t)MP_MAX * 4 <= SM_SSQ && SM_SSQ + (size_t)NR * 48 <= 3 * MiB, "small map");
constexpr size_t WS_WIN0 = 4 * MiB, WS_WOUT0 = 12 * MiB, WS_WIN1 = 14 * MiB, WS_WUQ = 16 * MiB, WS_WUKV = 18 * MiB, WS_WOUT1 = 19 * MiB;
constexpr size_t WS_WGU = 22 * MiB;
constexpr size_t WS_WD = 90 * MiB;
constexpr size_t WS_XC = 124 * MiB;
constexpr size_t WS_H = 132 * MiB;
constexpr size_t WS_BIG = 168 * MiB;
constexpr size_t WS_END = 348 * MiB;
constexpr size_t SZ18 = 18 * MiB;
constexpr size_t B_QD = 0, B_KD = SZ18, B_VD = 2 * SZ18, B_HQ = 3 * SZ18, B_LF0 = 4 * SZ18, B_LF1 = 5 * SZ18, B_HV = 6 * SZ18, B_HG = 7 * SZ18, B_HO0 = 8 * SZ18, B_HO1 = 9 * SZ18;
constexpr size_t B_HS = 0, B_HE = 18 * MiB, B_YE = 60 * MiB, B_AP = 60 * MiB, B_YS = 142 * MiB;
static_assert(B_HE + (size_t)MP_MAX * 512 * 2 <= B_YE && B_YE + (size_t)MP_MAX * 1024 * 2 <= B_YS && B_YS + (size_t)NR * 1024 * 2 <= 180 * MiB, "moe map");
constexpr size_t B_CKV = 0, B_CQ = 9 * MiB, B_KR = 23 * MiB, B_Q1 = 26 * MiB, B_KN = 80 * MiB, B_V1 = 116 * MiB;

constexpr int LDS_BYTES = 155648;
constexpr int LDS_MISC = 131072;
constexpr int LDS_XCH = 132096;
constexpr int LDS_RQ = LDS_XCH + 20480;

__device__ __forceinline__ unsigned f2bf(float f) { unsigned u = __builtin_bit_cast(unsigned, f); return (u + 0x7fffu + ((u >> 16) & 1u)) >> 16; }
__device__ __forceinline__ unsigned pk2(float lo, float hi) { return f2bf(lo) | (f2bf(hi) << 16); }
typedef __bf16 bf16x2_t __attribute__((ext_vector_type(2)));
__device__ __forceinline__ unsigned cvtpk_b(float lo, float hi) { const f32x2 v = {lo, hi}; const bf16x2_t b = __builtin_convertvector(v, bf16x2_t); return __builtin_bit_cast(unsigned, b); }
__device__ __forceinline__ float bf2f(bf16 h) { return __builtin_bit_cast(float, (unsigned)h << 16); }
__device__ __forceinline__ float bflo(unsigned w) { return __builtin_bit_cast(float, w << 16); }
__device__ __forceinline__ float bfhi(unsigned w) { return __builtin_bit_cast(float, w & 0xffff0000u); }
__device__ __forceinline__ unsigned pkh2(float lo, float hi) { f16 a = (f16)lo, b = (f16)hi; return (unsigned)__builtin_bit_cast(unsigned short, a) | ((unsigned)__builtin_bit_cast(unsigned short, b) << 16); }
__device__ __forceinline__ float fexp(float x) { return __builtin_amdgcn_exp2f(x * LOG2E); }
__device__ __forceinline__ float sigmoidf_(float x) { return __builtin_amdgcn_rcpf(1.0f + fexp(-x)); }
__device__ __forceinline__ float siluf_(float x) { return x * __builtin_amdgcn_rcpf(1.0f + fexp(-x)); }
__device__ __forceinline__ float rsq_(float x) { return __builtin_amdgcn_rsqf(x); }
__device__ __forceinline__ float wave_sum(float v) {
#pragma unroll
    for (int o = 1; o < 64; o <<= 1) v += __shfl_xor(v, o);
    return v;
}
__host__ __device__ __forceinline__ int perm32(int rho) { const int n = rho >> 4, i = rho & 15; return 8 * (i >> 2) + 4 * n + (i & 3); }
__host__ __device__ __forceinline__ int ddmap(int j) { return 16 * ((j >> 2) & 1) + 4 * (j >> 3) + (j & 3); }
__device__ __forceinline__ int opaque(int x) { asm volatile("" : "+v"(x)); return x; }
__device__ __forceinline__ int pil(int r, int c, int L) { return (r >> 1) * (2 * L) + (c >> 5) * 64 + (r & 1) * 32 + (c & 31); }
__device__ __forceinline__ size_t pil_off(size_t r, int c) { return (r >> 1) * 2048 + (size_t)((c >> 5) * 64 + (int)(r & 1) * 32 + (c & 31)); }
__device__ __forceinline__ int crow(int r, int hi) { return (r & 3) + 8 * (r >> 2) + 4 * hi; }

#define XB_TMO      128
#define XB_XCNT(j)  (256  + 64 * (j))
#define XB_XSUB(j)  (1280 + 64 * (j))
#define XB_XGEN(j)  (2304 + 64 * (j))
#define XB_TOP      3328
#define XB_TOPGEN   3392
#define XCD_BAR_WORDS 3456
#define XB_SPIN_CAP (1u << 18)
__device__ __forceinline__ unsigned xb_ld(unsigned* p)              { return __hip_atomic_load(p, __ATOMIC_RELAXED, __HIP_MEMORY_SCOPE_AGENT); }
__device__ __forceinline__ unsigned xb_add(unsigned* p, unsigned v) { return __hip_atomic_fetch_add(p, v, __ATOMIC_RELAXED, __HIP_MEMORY_SCOPE_AGENT); }
__device__ __forceinline__ unsigned xb_xcc_id() { return (unsigned)__builtin_amdgcn_s_getreg((3 << 11) | 20) & 0xFu; }
#define XB_SPIN(cond, bar) do { unsigned _sp = 0; while (cond) { __builtin_amdgcn_s_sleep(1); \
    if ((++_sp & 255u) == 0u) { if (xb_ld(&(bar)[XB_TMO])) break; if (_sp > XB_SPIN_CAP) { atomicAdd(&(bar)[XB_TMO], 1u); break; } } } } while (0)
struct XcdBarrier { unsigned* bar; unsigned x; volatile LAS unsigned* st; };
__device__ __forceinline__ XcdBarrier xcd_barrier_post(unsigned* bar, volatile LAS unsigned* st) {
    XcdBarrier b; b.bar = bar; b.x = xb_xcc_id(); b.st = st;
    if (threadIdx.x == 0) (void)xb_add(&bar[XB_XCNT(b.x)], 1u);
    return b;
}
__device__ __forceinline__ void xcd_barrier_complete(unsigned* bar, unsigned x, unsigned& nloc, unsigned& nx) {
    const unsigned G = gridDim.x * gridDim.y * gridDim.z;
    unsigned sum, cnt, mine, sp = 0u;
    for (;;) {
        sum = 0u; cnt = 0u; mine = 0u;
#pragma unroll
        for (unsigned j = 0; j < 16; ++j) { const unsigned c = xb_ld(&bar[XB_XCNT(j)]); sum += c; cnt += (c > 0u) ? 1u : 0u; mine = (j == x) ? c : mine; }
        if (sum == G) break;
        __builtin_amdgcn_s_sleep(1);
        if ((++sp & 255u) == 0u) { if (xb_ld(&bar[XB_TMO])) break; if (sp > XB_SPIN_CAP) { atomicAdd(&bar[XB_TMO], 1u); break; } }
    }
    nloc = mine > 0u ? mine : 1u; nx = cnt > 0u ? cnt : 1u;
}
__device__ __forceinline__ void xcd_barrier(const XcdBarrier& b) {
    asm volatile("s_waitcnt vmcnt(0)" ::: "memory");
    __syncthreads();
    if (threadIdx.x == 0) {
        unsigned* bar = b.bar;
        __builtin_amdgcn_s_waitcnt(0);
        unsigned nloc = b.st[0], nx = b.st[1];
        if (nloc == 0u) { xcd_barrier_complete(bar, b.x, nloc, nx); b.st[0] = nloc; b.st[1] = nx; }
        const unsigned old = xb_add(&bar[XB_XSUB(b.x)], 1u);
        const unsigned gen = old / nloc;
        if (old + 1u == (gen + 1u) * nloc) {
            __builtin_amdgcn_fence(__ATOMIC_RELEASE, "agent");
            asm volatile("s_waitcnt vmcnt(0)" ::: "memory");
            const unsigned og = xb_add(&bar[XB_TOP], 1u);
            const unsigned tg = og / nx;
            if (og + 1u == (tg + 1u) * nx) xb_add(&bar[XB_TOPGEN], 1u);
            else XB_SPIN(xb_ld(&bar[XB_TOPGEN]) == tg, bar);
            __builtin_amdgcn_fence(__ATOMIC_ACQUIRE, "agent");
            xb_add(&bar[XB_XGEN(b.x)], 1u);
            asm volatile("s_waitcnt vmcnt(0)" ::: "memory");
        } else {
            XB_SPIN(xb_ld(&bar[XB_XGEN(b.x)]) == gen, bar);
            __builtin_amdgcn_fence(__ATOMIC_ACQUIRE, "agent");
            asm volatile("s_waitcnt vmcnt(0)" ::: "memory");
        }
    }
    __syncthreads();
}

struct Args { const float* in[34]; float* out; unsigned char* ws; int ph_lo, ph_hi; };

struct Frame {
    LAS unsigned char* lds;
    int tid, lane, wave, G, bid;
    const Args* ar;
    float* out; unsigned char* ws;
    unsigned long long sec_acc;
    __device__ __forceinline__ gu32* ctl_() const { return (gu32*)(ws + WS_CTL); }
    __device__ __forceinline__ float* modv_() const { return (float*)(ws + WS_SMALL + SM_MODV); }
    __device__ __forceinline__ f32x2* ropeR_() const { return (f32x2*)(ws + WS_SMALL + SM_ROPER); }
    __device__ __forceinline__ f32x2* ropeC_() const { return (f32x2*)(ws + WS_SMALL + SM_ROPEC); }
    __device__ __forceinline__ float* lbv_() const { return (float*)(ws + WS_SMALL + SM_LBV); }
    __device__ __forceinline__ float* lamv_() const { return (float*)(ws + WS_SMALL + SM_LAM); }
    __device__ __forceinline__ int* route_e_() const { return (int*)(ws + WS_SMALL + SM_ROUTE_E); }
    __device__ __forceinline__ float* route_w_() const { return (float*)(ws + WS_SMALL + SM_ROUTE_W); }
    __device__ __forceinline__ int* route_s_() const { return (int*)(ws + WS_SMALL + SM_ROUTE_S); }
    __device__ __forceinline__ int* pos_() const { return (int*)(ws + WS_SMALL + SM_POS); }
    __device__ __forceinline__ float* ssq_() const { return (float*)(ws + WS_SMALL + SM_SSQ); }
    __device__ __forceinline__ bf16* Win0_() const { return (bf16*)(ws + WS_WIN0); }
    __device__ __forceinline__ bf16* Wout0_() const { return (bf16*)(ws + WS_WOUT0); }
    __device__ __forceinline__ bf16* Win1_() const { return (bf16*)(ws + WS_WIN1); }
    __device__ __forceinline__ bf16* Wuq_() const { return (bf16*)(ws + WS_WUQ); }
    __device__ __forceinline__ bf16* Wukv_() const { return (bf16*)(ws + WS_WUKV); }
    __device__ __forceinline__ bf16* Wout1_() const { return (bf16*)(ws + WS_WOUT1); }
    __device__ __forceinline__ bf16* Wgu_() const { return (bf16*)(ws + WS_WGU); }
    __device__ __forceinline__ bf16* Wd_() const { return (bf16*)(ws + WS_WD); }
    __device__ __forceinline__ float* xc_() const { return (float*)(ws + WS_XC); }
    __device__ __forceinline__ bf16* H_() const { return (bf16*)out; }
    __device__ __forceinline__ bf16* Xb_() const { return (bf16*)(ws + WS_H); }
    __device__ __forceinline__ unsigned char* big_() const { return ws + WS_BIG; }
};
enum { I_X = 0, I_C, I_CTX, I_CCTX, I_MODW, I_MODB, I_NMIX, I_NFFN, I_EWIN, I_EWOUT, I_DQG, I_DKG, I_DLAM, I_DSUBLN, I_LBL, I_HOG, I_OWIN, I_QAG, I_KVAG, I_WUQ, I_WUKV,
       I_QNG, I_QRG, I_KNG, I_KRG, I_OWOUT, I_RW, I_RB, I_EG, I_EU, I_ED, I_SG, I_SU, I_SD };

__device__ __forceinline__ const float* xin_ptr(const Frame& F, int b, int s) { return s < CTXL ? F.ar->in[I_CTX] + (size_t)(b * CTXL + s) * D : F.ar->in[I_X] + (size_t)(b * SEQ + s - CTXL) * D; }

struct CvtDesc { const float* W; int ldn, srccol0; bool perm; const float* kscale; bf16* WT; int K, k0; };
__device__ __forceinline__ void p0_item_load(const CvtDesc& d, float (&tv)[32], int lane) {
    if (d.srccol0 >= 0) {
#pragma unroll
        for (int i = 0; i < 8; ++i) { const int kk = 8 * i + (lane >> 3); const f32x4 v = __builtin_nontemporal_load((const f32x4*)(d.W + (size_t)(d.k0 + kk) * d.ldn + d.srccol0 + 4 * (lane & 7)));
            tv[4 * i] = v.x; tv[4 * i + 1] = v.y; tv[4 * i + 2] = v.z; tv[4 * i + 3] = v.w; }
    } else {
#pragma unroll
        for (int i = 0; i < 32; ++i) tv[i] = 0.f;
    }
}
__device__ __forceinline__ void p0_item_finish(const CvtDesc& d, float (&tv)[32], LAS float* scr, int lane) {
    if (d.kscale && d.srccol0 >= 0) {
#pragma unroll
        for (int i = 0; i < 8; ++i) { const float ks = d.kscale[d.k0 + 8 * i + (lane >> 3)];
#pragma unroll
            for (int e = 0; e < 4; ++e) tv[4 * i + e] *= ks; } }
#pragma unroll
    for (int i = 0; i < 8; ++i) { const int kk = 8 * i + (lane >> 3);
#pragma unroll
        for (int e = 0; e < 4; ++e) scr[kk * 33 + 4 * (lane & 7) + e] = tv[4 * i + e]; }
    LDS_WAIT(); asm volatile("" ::: "memory");
    const int c = lane & 7;
#pragma unroll
    for (int j = 0; j < 4; ++j) { const int n = (lane >> 3) + 8 * j; const int sn = d.perm ? ddmap(n) : n; const LAS float* sp = scr + (8 * c) * 33 + sn;
        v4u o; o.x = cvtpk_b(sp[0 * 33], sp[1 * 33]); o.y = cvtpk_b(sp[2 * 33], sp[3 * 33]); o.z = cvtpk_b(sp[4 * 33], sp[5 * 33]); o.w = cvtpk_b(sp[6 * 33], sp[7 * 33]);
        __builtin_nontemporal_store(o, (GAS v4u*)(d.WT + (size_t)n * d.K + d.k0 + 8 * c)); }
    LDS_WAIT(); asm volatile("" ::: "memory");
}

__device__ __forceinline__ CvtDesc p0_item_desc(Frame& F, int it) {
    if (it < 2048) {
        const int kb = it >> 7, tb = it & 127, pn = tb >> 3, blk = tb & 7, bj = blk >> 2, wc = blk & 3;
        int sb; bool perm = false;
        if (pn < 4) { sb = pn * 8 + 2 * wc + bj; perm = true; } else sb = tb;
        return CvtDesc{F.ar->in[I_EWIN], 4096, sb * 32, perm, nullptr, F.Win0_() + (size_t)tb * 32 * 1024, 1024, kb * 64}; }
    it -= 2048;
    if (it < 512) { const int kb = it >> 5, tb = it & 31; return CvtDesc{F.ar->in[I_EWOUT], 1024, tb * 32, false, nullptr, F.Wout0_() + (size_t)tb * 32 * 1024, 1024, kb * 64}; }
    it -= 512;
    if (it < 384) {
        const int kb = it / 24, tb = it % 24; int sc; bool perm = false;
        if (tb < 8) sc = 384 + tb * 32;
        else if (tb < 16) sc = (tb - 8) * 32;
        else { const int blk = tb - 16, bj = blk >> 2, wc = blk & 3;
            if (bj == 0) { if (wc < 3) sc = 256 + wc * 32; else { sc = 640; perm = true; } }
            else { if (wc == 0) sc = 352; else if (wc == 3) { sc = 672; perm = true; } else sc = -1; } }
        return CvtDesc{F.ar->in[I_OWIN], 704, sc, perm, nullptr, F.Win1_() + (size_t)tb * 32 * 1024, 1024, kb * 64}; }
    it -= 384;
    if (it < 288) {
        const int kb = it / 48, tb = it % 48, t = tb >> 3, blk = tb & 7, bj = blk >> 2, wc = blk & 3; int sc; bool perm = false;
        if (t < 4) { const int h = 2 * t + bj; sc = h * 192 + 32 * wc; }
        else { const int h = 4 * (t - 4) + wc; sc = h * 192 + 128 + 32 * bj; perm = true; }
        return CvtDesc{F.ar->in[I_WUQ], 1536, sc, perm, F.ar->in[I_QAG], F.Wuq_() + (size_t)tb * 32 * 384, 384, kb * 64}; }
    it -= 288;
    if (it < 256) { const int kb = it >> 6, tb = it & 63; return CvtDesc{F.ar->in[I_WUKV], 2048, tb * 32, false, F.ar->in[I_KVAG], F.Wukv_() + (size_t)tb * 32 * 256, 256, kb * 64}; }
    it -= 256;
    if (it < 512) { const int kb = it >> 5, tb = it & 31; return CvtDesc{F.ar->in[I_OWOUT], 1024, tb * 32, false, nullptr, F.Wout1_() + (size_t)tb * 32 * 1024, 1024, kb * 64}; }
    it -= 512;
    {
        const int le = it / 768, r2 = it % 768, l = le / 17, e = le % 17;
        if (r2 < 512) { const int kb = r2 >> 5, tb = r2 & 31, pnl = tb >> 3, blk = tb & 7, bj = blk >> 2, wcb = blk & 3;
            const float* src = (e < 16) ? (bj ? F.ar->in[I_EU] : F.ar->in[I_EG]) + (size_t)(l * 16 + e) * 1024 * 512 : (bj ? F.ar->in[I_SU] : F.ar->in[I_SG]) + (size_t)l * 1024 * 512;
            return CvtDesc{src, 512, (pnl * 4 + wcb) * 32, false, nullptr, F.Wgu_() + ((size_t)(l * 17 + e) * 1024 + tb * 32) * 1024, 1024, kb * 64}; }
        else { const int r3 = r2 - 512, kb = r3 >> 5, tb = r3 & 31;
            const float* src = (e < 16) ? F.ar->in[I_ED] + (size_t)(l * 16 + e) * 512 * 1024 : F.ar->in[I_SD] + (size_t)l * 512 * 1024;
            return CvtDesc{src, 1024, tb * 32, false, nullptr, F.Wd_() + ((size_t)(l * 17 + e) * 1024 + tb * 32) * 512, 512, kb * 64}; }
    }
}
constexpr int P0_NITEMS = 2048 + 512 + 384 + 288 + 256 + 512 + 2 * 17 * 768;
constexpr int P0_EARLY = 2560 + 17 * 768, P0_LATE = 1440 + 17 * 768;
static_assert(P0_EARLY + P0_LATE == P0_NITEMS, "items");

#define P0_PAIR_LOOP(start, end, stride, MAPEXPR) do { for (int jj_ = (start); jj_ < (end); jj_ += 2 * (stride)) { float ta_[32], tb_[32]; \
        int j_ = jj_; const CvtDesc da_ = p0_item_desc(F, (MAPEXPR)); p0_item_load(da_, ta_, F.lane); \
        const bool two_ = jj_ + (stride) < (end); j_ = two_ ? jj_ + (stride) : jj_; const CvtDesc db_ = p0_item_desc(F, (MAPEXPR)); if (two_) p0_item_load(db_, tb_, F.lane); \
        p0_item_finish(da_, ta_, scr, F.lane); if (two_) p0_item_finish(db_, tb_, scr, F.lane); } } while (0)
__device__ __forceinline__ void p0_gemv_item(Frame& F, int it) {
    LAS float* ldsf = (LAS float*)F.lds;
    __syncthreads();
    {
        const int l = it / 96, n0 = (it % 96) * 64;
        LAS float* sc = ldsf;
        LAS float* red = ldsf + 9 * 1024;
        {   float raw[18];
#pragma unroll
            for (int i = 0; i < 18; ++i) { const int k = (F.tid + i * 512) & 1023; raw[i] = (i < 16) ? F.ar->in[I_C][(i >> 1) * 1024 + k] : F.ar->in[I_CCTX][k]; }
#pragma unroll
            for (int i = 0; i < 18; ++i) sc[F.tid + i * 512] = siluf_(raw[i]); }
        __syncthreads();
        const int cq = F.lane & 15, kq = F.lane >> 4, kb = F.wave * 128 + 32 * kq;
        const float* w = F.ar->in[I_MODW] + (size_t)l * 1024 * 6144 + (size_t)kb * 6144 + n0 + 4 * cq;
        f32x4 a[9];
#pragma unroll
        for (int r = 0; r < 9; ++r) a[r] = (f32x4){0.f, 0.f, 0.f, 0.f};
        f32x4 wv[32];
#pragma unroll
        for (int i = 0; i < 32; ++i) wv[i] = __builtin_nontemporal_load((const f32x4*)(w + (size_t)i * 6144));
#pragma unroll
        for (int s4 = 0; s4 < 8; ++s4)
#pragma unroll
            for (int r = 0; r < 9; ++r) { const f32x4 sv = *(const LAS f32x4*)(sc + r * 1024 + kb + 4 * s4);
                a[r] += (sv.x * wv[4 * s4] + sv.y * wv[4 * s4 + 1]) + (sv.z * wv[4 * s4 + 2] + sv.w * wv[4 * s4 + 3]); }
#pragma unroll
        for (int r = 0; r < 9; ++r) *(LAS f32x4*)(red + ((F.wave * 4 + kq) * 9 + r) * 64 + 4 * cq) = a[r];
        __syncthreads();
        for (int e = F.tid; e < 9 * 64; e += NTHREADS) { const int r = e >> 6, c = e & 63; float s = 0.f;
#pragma unroll
            for (int g = 0; g < 32; ++g) s += red[(g * 9 + r) * 64 + c];
            F.modv_()[(size_t)(l * 9 + r) * 6144 + n0 + c] = s + F.ar->in[I_MODB][l * 6144 + n0 + c]; }
        __syncthreads();
    }
}
__device__ __forceinline__ void p0_prologue(Frame& F) {
    for (int it = F.bid; it < 96; it += F.G) p0_gemv_item(F, it);
    if (F.bid == F.G - 1) {
        for (int e = F.tid; e < 96 * 16; e += NTHREADS) { const int p = e >> 4, i = e & 15;
            const float inv = __builtin_amdgcn_exp2f(-(float)(2 * i) * (1.0f / 32.0f) * 13.287712379549449f);
            const float pos = (p < 32) ? (float)p : (float)(p - 32); const float ang = pos * inv;
            const f32x2 cs = {__cosf(ang), __sinf(ang)};
            if (p < 32) F.ropeR_()[p * 16 + i] = cs; else F.ropeC_()[(p - 32) * 16 + i] = cs; }
        for (int e = F.tid; e < 1024; e += NTHREADS) { const float l0 = F.ar->in[I_LBL][e], l1 = F.ar->in[I_LBL][1024 + e]; F.lbv_()[e] = 1.0f / (1.0f + fexp(l1 - l0)); }
        if (F.wave == 0) { const float* lv = F.ar->in[I_DLAM]; float s1 = wave_sum(lv[F.lane] * lv[64 + F.lane]), s2 = wave_sum(lv[128 + F.lane] * lv[192 + F.lane]);
            if (F.lane == 0) { F.lamv_()[0] = fexp(s1) - fexp(s2) + 0.2f; } }
    }
    __syncthreads();

}
__device__ __forceinline__ void p0_convert_in0(Frame& F) {
    LAS float* scr = (LAS float*)(F.lds + F.wave * 8704);
    const int gw = F.bid * NWAVES + F.wave, NGW = F.G * NWAVES;
    P0_PAIR_LOOP(gw, 2048, NGW, j_);
}
__device__ __forceinline__ void p0_convert_mid(Frame& F, int first) {
    if (F.bid < first) return;
    LAS float* scr = (LAS float*)(F.lds + F.wave * 8704);
    const int gw = (F.bid - first) * NWAVES + F.wave, NGW = (F.G - first) * NWAVES;
    constexpr int NMID = 512 + 17 * 512;
#define MAPJ(j) ((j) < 512 ? 2048 + (j) : 4000 + (((j) - 512) >> 9) * 768 + (((j) - 512) & 511))
    P0_PAIR_LOOP(gw, NMID, NGW, MAPJ(j_));
#undef MAPJ
}
__device__ __forceinline__ void p0_convert_late(Frame& F, int part) {
    const int first = F.G > 32 ? 32 : 0, nb = F.G - first;
    if (F.bid < first) return;
    LAS float* scr = (LAS float*)(F.lds + F.wave * 8704);
    const int gw = (F.bid - first) * NWAVES + F.wave, NGW = nb * NWAVES;
    constexpr int NL = P0_LATE / 2, ND = 17 * 256 / 2;
    const int lo = part * NL, d0 = part * ND;
#define MAPL(j) ((j) < 1440 ? 2560 + (j) : 17056 + ((j) - 1440))
#define MAPJ(j) ((j) < ND ? 4000 + ((d0 + (j)) >> 8) * 768 + 512 + ((d0 + (j)) & 255) : MAPL(lo + (j) - ND))
    P0_PAIR_LOOP(gw, ND + NL, NGW, MAPJ(j_));
#undef MAPJ
#undef MAPL
}

__device__ __forceinline__ void modnorm_store(const f32x4 (&v)[4], const float* gain, const float* sh, const float* sc, bf16* orow, int lane) {
    float s = 0.f;
#pragma unroll
    for (int j = 0; j < 4; ++j) s += (v[j].x * v[j].x + v[j].y * v[j].y) + (v[j].z * v[j].z + v[j].w * v[j].w);
    const float rstd = rsq_(wave_sum(s) * (1.0f / D) + EPS);
#pragma unroll
    for (int j = 0; j < 4; ++j) { const int c = 4 * (lane + 64 * j);
        const f32x4 g = *(const f32x4*)(gain + c), a = *(const f32x4*)(sc + c), b = *(const f32x4*)(sh + c);
        const f32x4 y = (v[j] * rstd) * g * (1.0f + a) + b;
        v2u o; o.x = cvtpk_b(y.x, y.y); o.y = cvtpk_b(y.z, y.w); *(v2u*)(orow + c) = o; }
}

__device__ __forceinline__ void p_norm0(Frame& F) {
    const int gw = F.bid * NWAVES + F.wave, NGW = F.G * NWAVES;
    f32x4 cur[4];
#define N0_LOAD(R_, dst) do { const int b_ = (R_) / RPB, s_ = (R_) - b_ * RPB; const f32x4* src_ = (const f32x4*)xin_ptr(F, b_, s_) + F.lane; \
        _Pragma("unroll") for (int j = 0; j < 4; ++j) dst[j] = __builtin_nontemporal_load(src_ + 64 * j); } while (0)
    if (gw < NR) N0_LOAD(gw, cur);
    for (int R = gw; R < NR; R += NGW) {
        const int b = R / RPB, s = R - b * RPB, r = s < CTXL ? 8 : b;
        f32x4 nxt[4];
#pragma unroll
        for (int j = 0; j < 4; ++j) nxt[j] = cur[j];
        if (R + NGW < NR) N0_LOAD(R + NGW, nxt);
        const float* mv = F.modv_() + (size_t)(0 * 9 + r) * 6144;
        modnorm_store(cur, F.ar->in[I_NMIX], mv + 0, mv + 1024, F.H_() + (size_t)R * D, F.lane);
#pragma unroll
        for (int j = 0; j < 4; ++j) cur[j] = nxt[j];
    }
#undef N0_LOAD
}

__device__ __forceinline__ void p_hgrn_post(Frame& F, int first) {
    if (F.bid < first) return;
    const int gw = (F.bid - first) * NWAVES + F.wave, NGW = (F.G - first) * NWAVES;
    const bf16* Ho0 = (const bf16*)(F.big_() + B_HO0); const bf16* Ho1 = (const bf16*)(F.big_() + B_HO1); const bf16* Hg = (const bf16*)(F.big_() + B_HG);
    const int c = F.lane * 8;
    v4u na = {0u, 0u, 0u, 0u}, nb = na, ng = na;
    if (gw < NR) { na = *(const v4u*)(Ho0 + (size_t)gw * 512 + c); nb = *(const v4u*)(Ho1 + (size_t)gw * 512 + c); ng = *(const v4u*)(Hg + pil(gw, c, 512)); }
    for (int R = gw; R < NR; R += NGW) {
        const v4u a = na, bq = nb, g = ng;
        if (R + NGW < NR) { const int Rn = R + NGW; na = *(const v4u*)(Ho0 + (size_t)Rn * 512 + c); nb = *(const v4u*)(Ho1 + (size_t)Rn * 512 + c); ng = *(const v4u*)(Hg + pil(Rn, c, 512)); }
        float o[8];
        o[0] = bflo(a.x) + bflo(bq.x); o[1] = bfhi(a.x) + bfhi(bq.x); o[2] = bflo(a.y) + bflo(bq.y); o[3] = bfhi(a.y) + bfhi(bq.y);
        o[4] = bflo(a.z) + bflo(bq.z); o[5] = bfhi(a.z) + bfhi(bq.z); o[6] = bflo(a.w) + bflo(bq.w); o[7] = bfhi(a.w) + bfhi(bq.w);
        float s = 0.f;
#pragma unroll
        for (int i = 0; i < 8; ++i) s += o[i] * o[i];
        s += __shfl_xor(s, 1); s += __shfl_xor(s, 2); s += __shfl_xor(s, 4); s += __shfl_xor(s, 8);
        const float rstd = rsq_(s * (1.0f / 128.0f) + EPS);
        const float* og = F.ar->in[I_HOG] + (c & 127);
        const float gg[8] = {bflo(g.x), bfhi(g.x), bflo(g.y), bfhi(g.y), bflo(g.z), bfhi(g.z), bflo(g.w), bfhi(g.w)};
        float y[8];
#pragma unroll
        for (int i = 0; i < 8; ++i) y[i] = o[i] * rstd * og[i] * gg[i];
        v4u w; w.x = pk2(y[0], y[1]); w.y = pk2(y[2], y[3]); w.z = pk2(y[4], y[5]); w.w = pk2(y[6], y[7]);
        *(v4u*)(F.H_() + (size_t)R * D + 512 + c) = w;
    }
}

__device__ __forceinline__ void p_norm_route(Frame& F, int layer, bool lat_only) {
    const int gw = F.bid * NWAVES + F.wave, NGW = F.G * NWAVES;
    const float* rw = F.ar->in[I_RW];
    unsigned* cnt = (unsigned*)(F.ctl_() + CW_CNT + 2048 * layer);
    constexpr int NR_RWS = 1056, NR_TAB = 67584, NR_TAB2 = LDS_XCH, NR_CNT = 124928, NR_ROW = 125184, NR_LG = LDS_XCH + 16384, NR_MAXROWS = 12;
    static_assert(NR_LG + NWAVES * NR_MAXROWS * 64 <= LDS_BYTES && (NR + 256 * NWAVES - 1) / (256 * NWAVES) <= NR_MAXROWS, "norm_route LDS records");
    LAS float* rwT = (LAS float*)F.lds;
    LAS unsigned* lcnt = (LAS unsigned*)(F.lds + NR_CNT);
    LAS int* rowl = (LAS int*)(F.lds + NR_ROW) + F.wave * 16;
    LAS float* lgl = (LAS float*)(F.lds + NR_LG) + F.wave * (NR_MAXROWS * 16);
    __syncthreads();
    if (F.tid < 32) lcnt[F.tid] = 0u;
    for (int i4 = F.tid; i4 < 4096; i4 += NTHREADS) { const f32x4 w4 = *(const f32x4*)(rw + 4 * i4); const int k = i4 >> 2, q = i4 & 3; LAS float* d = rwT + (4 * q) * NR_RWS + 8 * q + k;
        d[0] = w4.x; d[NR_RWS] = w4.y; d[2 * NR_RWS] = w4.z; d[3 * NR_RWS] = w4.w; }
    { const float* gain = F.ar->in[I_NFFN] + layer * 1024; const int nr_ = lat_only ? 8 : 9;
        for (int i4 = F.tid; i4 < nr_ * 256; i4 += NTHREADS) { const int r = i4 >> 8, c = (i4 & 255) * 4; const float* mv = F.modv_() + (size_t)(layer * 9 + r) * 6144;
            const f32x4 g = *(const f32x4*)(gain + c), a = *(const f32x4*)(mv + 4096 + c), bsh = *(const f32x4*)(mv + 3072 + c);
            LAS float* t = (LAS float*)(F.lds + (r < 7 ? NR_TAB + r * 8192 : NR_TAB2 + (r - 7) * 8192));
            *(LAS f32x4*)(t + c) = g * (1.0f + a); *(LAS f32x4*)(t + 1024 + c) = bsh; } }
    __syncthreads();
#define NR_NEXT(R_) do { R_ += NGW; } while (R_ < NR && lat_only && (R_ % RPB) < CTXL)
#define NR_LOAD(R_, dst) do { _Pragma("unroll") for (int j = 0; j < 4; ++j) dst[j] = *(const v2u*)(F.Xb_() + pil(R_, 4 * (F.lane + 64 * j), 1024)); } while (0)
#define NR_NORM(R_, xin, yo) do { const int b_ = (R_) / RPB, s_ = (R_) - b_ * RPB, r_ = s_ < CTXL ? 8 : b_; \
        const LAS float* tab_ = (const LAS float*)(F.lds + (r_ < 7 ? NR_TAB + r_ * 8192 : NR_TAB2 + (r_ - 7) * 8192)); \
        f32x4 v_[4]; _Pragma("unroll") for (int j = 0; j < 4; ++j) v_[j] = (f32x4){bflo(xin[j].x), bfhi(xin[j].x), bflo(xin[j].y), bfhi(xin[j].y)}; \
        float ss_ = 0.f; _Pragma("unroll") for (int j = 0; j < 4; ++j) ss_ += (v_[j].x * v_[j].x + v_[j].y * v_[j].y) + (v_[j].z * v_[j].z + v_[j].w * v_[j].w); \
        const float rstd_ = rsq_(wave_sum(ss_) * (1.0f / D) + EPS); \
        _Pragma("unroll") for (int j = 0; j < 4; ++j) { const int c_ = 4 * (F.lane + 64 * j); const f32x4 a4_ = *(const LAS f32x4*)(tab_ + c_), b4_ = *(const LAS f32x4*)(tab_ + 1024 + c_); \
            yo[j] = (v_[j] * rstd_) * a4_ + b4_; v2u o_; o_.x = cvtpk_b(yo[j].x, yo[j].y); o_.y = cvtpk_b(yo[j].z, yo[j].w); *(v2u*)(F.H_() + (size_t)(R_) * D + c_) = o_; } } while (0)
#define NR_PARK(lgv, R_) do { const int lane = F.lane; float t8[8], t4[4], t2[2], t1; \
        _Pragma("unroll") for (int i = 0; i < 8; ++i) { const float keep = (lane & 32) ? lgv[8 + i] : lgv[i], send = (lane & 32) ? lgv[i] : lgv[8 + i]; t8[i] = keep + __shfl_xor(send, 32); } \
        _Pragma("unroll") for (int i = 0; i < 4; ++i) { const float keep = (lane & 16) ? t8[4 + i] : t8[i], send = (lane & 16) ? t8[i] : t8[4 + i]; t4[i] = keep + __shfl_xor(send, 16); } \
        _Pragma("unroll") for (int i = 0; i < 2; ++i) { const float keep = (lane & 8) ? t4[2 + i] : t4[i], send = (lane & 8) ? t4[i] : t4[2 + i]; t2[i] = keep + __shfl_xor(send, 8); } \
        { const float keep = (lane & 4) ? t2[1] : t2[0], send = (lane & 4) ? t2[0] : t2[1]; t1 = keep + __shfl_xor(send, 4); } \
        t1 += __shfl_xor(t1, 2); t1 += __shfl_xor(t1, 1); \
        if ((lane & 3) == 0) lgl[nrec * 16 + ((lane >> 5) & 1) * 8 + ((lane >> 4) & 1) * 4 + ((lane >> 3) & 1) * 2 + ((lane >> 2) & 1)] = t1; \
        if (lane == 0) rowl[nrec] = (R_); ++nrec; } while (0)
    int Ra = gw; if (lat_only && (Ra % RPB) < CTXL) NR_NEXT(Ra);
    int Rb = Ra; if (Ra < NR) NR_NEXT(Rb);
    v2u xa[4] = {{0u, 0u}, {0u, 0u}, {0u, 0u}, {0u, 0u}}, xb[4] = {{0u, 0u}, {0u, 0u}, {0u, 0u}, {0u, 0u}};
    if (Ra < NR) { NR_LOAD(Ra, xa); if (Rb < NR) NR_LOAD(Rb, xb); }
    int nrec = 0;
    while (Ra < NR) {
        const bool hasB = Rb < NR;
        int Rna = hasB ? Rb : Ra; NR_NEXT(Rna);
        int Rnb = Rna; if (Rna < NR) NR_NEXT(Rnb);
        v2u xna[4], xnb[4];
#pragma unroll
        for (int j = 0; j < 4; ++j) { xna[j] = xa[j]; xnb[j] = xb[j]; }
        if (Rna < NR) { NR_LOAD(Rna, xna); if (Rnb < NR) NR_LOAD(Rnb, xnb); }
        f32x4 ya[4], yb[4];
        NR_NORM(Ra, xa, ya);
        if (hasB) NR_NORM(Rb, xb, yb); else {
#pragma unroll
            for (int j = 0; j < 4; ++j) yb[j] = ya[j]; }
        f32x2 yab[16];
#pragma unroll
        for (int j = 0; j < 4; ++j) { yab[4 * j] = (f32x2){ya[j].x, yb[j].x}; yab[4 * j + 1] = (f32x2){ya[j].y, yb[j].y}; yab[4 * j + 2] = (f32x2){ya[j].z, yb[j].z}; yab[4 * j + 3] = (f32x2){ya[j].w, yb[j].w}; }
        f32x2 lg2[16];
#pragma unroll
        for (int e = 0; e < 16; ++e) lg2[e] = (f32x2){0.f, 0.f};
#pragma unroll
        for (int eb = 0; eb < 16; eb += 2) {
            f32x4 w[2][4];
#pragma unroll
            for (int e = 0; e < 2; ++e)
#pragma unroll
                for (int j = 0; j < 4; ++j) w[e][j] = *(const LAS f32x4*)(rwT + (eb + e) * NR_RWS + 8 * ((eb + e) >> 2) + 4 * (F.lane + 64 * j));
            __builtin_amdgcn_sched_barrier(0);
#pragma unroll
            for (int e = 0; e < 2; ++e)
#pragma unroll
                for (int j = 0; j < 4; ++j) {
                    lg2[eb + e] = __builtin_elementwise_fma(yab[4 * j], (f32x2){w[e][j].x, w[e][j].x}, lg2[eb + e]); lg2[eb + e] = __builtin_elementwise_fma(yab[4 * j + 1], (f32x2){w[e][j].y, w[e][j].y}, lg2[eb + e]);
                    lg2[eb + e] = __builtin_elementwise_fma(yab[4 * j + 2], (f32x2){w[e][j].z, w[e][j].z}, lg2[eb + e]); lg2[eb + e] = __builtin_elementwise_fma(yab[4 * j + 3], (f32x2){w[e][j].w, w[e][j].w}, lg2[eb + e]); }
            __builtin_amdgcn_sched_barrier(0); }
        { float lga[16];
#pragma unroll
            for (int e = 0; e < 16; ++e) lga[e] = lg2[e].x;
            NR_PARK(lga, Ra); }
        if (hasB) { float lgb[16];
#pragma unroll
            for (int e = 0; e < 16; ++e) lgb[e] = lg2[e].y;
            NR_PARK(lgb, Rb); }
#pragma unroll
        for (int j = 0; j < 4; ++j) { xa[j] = xna[j]; xb[j] = xnb[j]; }
        Ra = Rna; Rb = Rnb;
    }
#undef NR_LOAD
#undef NR_NORM
#undef NR_PARK
    asm volatile("s_waitcnt lgkmcnt(0)" ::: "memory");
    const bool mine = F.lane < nrec;
    int Rm = 0; unsigned ee = 0u, sl1 = 0u, sl2 = 0u;
    if (mine) {
        Rm = rowl[F.lane];
        float lg[16];
#pragma unroll
        for (int q = 0; q < 4; ++q) { const f32x4 t = *(const LAS f32x4*)(lgl + F.lane * 16 + 4 * q); lg[4 * q] = t.x; lg[4 * q + 1] = t.y; lg[4 * q + 2] = t.z; lg[4 * q + 3] = t.w; }
        float scv[16], bi[16];
#pragma unroll
        for (int e = 0; e < 16; ++e) { scv[e] = sigmoidf_(lg[e]); bi[e] = scv[e] + F.ar->in[I_RB][e]; }
        float bestgs = -3.0e38f; int e1 = 0, e2 = 1; float w1 = 0.f, w2 = 0.f;
#pragma unroll
        for (int g = 0; g < 4; ++g) {
            const float x0 = bi[4 * g], x1 = bi[4 * g + 1], x2 = bi[4 * g + 2], x3 = bi[4 * g + 3];
            const float gs = fmaxf(fmaxf(fmaxf(x0 + x1, x0 + x2), fmaxf(x0 + x3, x1 + x2)), fmaxf(x1 + x3, x2 + x3));
            int i1 = 0; float m1 = x0;
            if (x1 > m1) { m1 = x1; i1 = 1; } if (x2 > m1) { m1 = x2; i1 = 2; } if (x3 > m1) { m1 = x3; i1 = 3; }
            int i2 = -1; float m2 = -3.0e38f;
            if (i1 != 0 && x0 > m2) { m2 = x0; i2 = 0; } if (i1 != 1 && x1 > m2) { m2 = x1; i2 = 1; } if (i1 != 2 && x2 > m2) { m2 = x2; i2 = 2; } if (i1 != 3 && x3 > m2) { m2 = x3; i2 = 3; }
            const float s0 = scv[4 * g], s1 = scv[4 * g + 1], s2 = scv[4 * g + 2], s3 = scv[4 * g + 3];
            const float wa = i1 == 0 ? s0 : i1 == 1 ? s1 : i1 == 2 ? s2 : s3;
            const float wb = i2 == 0 ? s0 : i2 == 1 ? s1 : i2 == 2 ? s2 : s3;
            if (gs > bestgs) { bestgs = gs; e1 = 4 * g + i1; e2 = 4 * g + i2; w1 = wa; w2 = wb; }
        }
        const float wn = 1.0f / (w1 + w2); w1 *= wn; w2 *= wn;
        sl1 = __hip_atomic_fetch_add(lcnt + e1, 1u, __ATOMIC_RELAXED, __HIP_MEMORY_SCOPE_WORKGROUP); sl2 = __hip_atomic_fetch_add(lcnt + e2, 1u, __ATOMIC_RELAXED, __HIP_MEMORY_SCOPE_WORKGROUP);
        ee = (unsigned)(e1 | (e2 << 8));
        F.route_e_()[Rm] = (int)ee; *(f32x2*)(F.route_w_() + 2 * (size_t)Rm) = (f32x2){w1, w2};
    }
    __syncthreads();
    if (F.tid < 16) lcnt[16 + F.tid] = __hip_atomic_fetch_add(cnt + 64 * F.tid, lcnt[F.tid], RLX_AGENT);
    __syncthreads();
    if (mine) { v2u o; o.x = sl1 + lcnt[16 + (ee & 255u)]; o.y = sl2 + lcnt[16 + (ee >> 8)]; *(v2u*)(F.route_s_() + 2 * (size_t)Rm) = o; }
}

#undef NR_NEXT
struct ExpOff { int off[17]; };
__device__ __forceinline__ void load_expoff(Frame& F, int layer, ExpOff& eo) {
    const unsigned* cnt = (const unsigned*)(F.ctl_() + CW_CNT + 2048 * layer); int a = 0;
#pragma unroll
    for (int e = 0; e < 16; ++e) { eo.off[e] = a; const int c = __builtin_amdgcn_readfirstlane((int)__hip_atomic_load(cnt + 64 * e, RLX_AGENT)); a += (c + 255) & ~255; }
    eo.off[16] = a;
}
__device__ __forceinline__ int expoff_sel(const ExpOff& eo, int e) { int r = 0;
#pragma unroll
    for (int i = 0; i < 16; ++i) r = (e == i) ? eo.off[i] : r;
    return r; }

__device__ __forceinline__ void p_lists(Frame& F, int layer, bool lat_only) {
    ExpOff eo; load_expoff(F, layer, eo);
    const unsigned* cnt = (const unsigned*)(F.ctl_() + CW_CNT + 2048 * layer);
    int* rowidx = (int*)(F.ws + WS_SMALL + SM_ROWIDX);
    const int gt = F.bid * NTHREADS + F.tid, NGT = F.G * NTHREADS;
    for (int R = gt; R < NR; R += NGT) {
        const int s = R % RPB; if (lat_only && s < CTXL) continue;
        const int ee = F.route_e_()[R], e1 = ee & 255, e2 = ee >> 8;
        const int p1 = expoff_sel(eo, e1) + F.route_s_()[2 * R], p2 = expoff_sel(eo, e2) + F.route_s_()[2 * R + 1];
        rowidx[p1] = R; rowidx[p2] = R; F.pos_()[2 * R] = p1; F.pos_()[2 * R + 1] = p2;
    }
    if (F.bid < 16) { const int e = F.bid; const int c = (int)__hip_atomic_load(cnt + 64 * e, RLX_AGENT); const int o = expoff_sel(eo, e);
        for (int p = o + c + F.tid; p < o + ((c + 255) & ~255); p += NTHREADS) rowidx[p] = lat_only ? CTXL : 0; }
}

#ifndef PC_DATA_PREFETCH
#define PC_DATA_PREFETCH 0
#endif
__device__ __forceinline__ void p_combine(Frame& F, int layer, bool lat_only, bool do_norm) {
    const int gw = F.bid * NWAVES + F.wave, NGW = F.G * NWAVES;
    const bf16* Ye = (const bf16*)(F.big_() + B_YE); const bf16* Ys = (const bf16*)(F.big_() + B_YS);
    const int TS = do_norm ? 12288 : 4096;
    __syncthreads();
    { const int nr_ = lat_only ? 8 : 9; const float* gain = F.ar->in[I_NMIX] + (layer + 1) * 1024;
        for (int i4 = F.tid; i4 < nr_ * 256; i4 += NTHREADS) { const int r = i4 >> 8, c = (i4 & 255) * 4; LAS float* t = (LAS float*)(F.lds + r * TS);
            *(LAS f32x4*)(t + c) = *(const f32x4*)(F.modv_() + (size_t)(layer * 9 + r) * 6144 + 5120 + c);
            if (do_norm) { const float* mv = F.modv_() + (size_t)((layer + 1) * 9 + r) * 6144;
                const f32x4 g = *(const f32x4*)(gain + c), bsh = *(const f32x4*)(mv + c), a = *(const f32x4*)(mv + 1024 + c);
                *(LAS f32x4*)(t + 1024 + c) = g * (1.0f + a); *(LAS f32x4*)(t + 2048 + c) = bsh; } } }
    __syncthreads();
#define PC_NEXT(R_) do { R_ += NGW; } while (R_ < NR && lat_only && (R_ % RPB) < CTXL)
#define PC_POS(R_, p1_, p2_, w1_, w2_) do { p1_ = F.pos_()[2 * (R_)]; p2_ = F.pos_()[2 * (R_) + 1]; w1_ = F.route_w_()[2 * (R_)]; w2_ = F.route_w_()[2 * (R_) + 1]; } while (0)
#define PC_DATA(R_, p1_, p2_, X_, A_, B_, S_) do { _Pragma("unroll") for (int j = 0; j < 4; ++j) { const int c = 4 * (F.lane + 64 * j); \
        X_[j] = *(const v2u*)(F.Xb_() + pil(R_, c, 1024)); A_[j] = *(const v2u*)(Ye + pil_off((size_t)(p1_), c)); B_[j] = *(const v2u*)(Ye + pil_off((size_t)(p2_), c)); S_[j] = *(const v2u*)(Ys + pil(R_, c, 1024)); } } while (0)
    int R = gw; if (lat_only && (R % RPB) < CTXL) PC_NEXT(R);
    int p1 = 0, p2 = 0, p1n = 0, p2n = 0; float w1 = 0.f, w2 = 0.f, w1n = 0.f, w2n = 0.f;
    v2u xw[4], ya[4], yb[4], ys[4];
#pragma unroll
    for (int j = 0; j < 4; ++j) { xw[j] = (v2u){0u, 0u}; ya[j] = xw[j]; yb[j] = xw[j]; ys[j] = xw[j]; }
    int Rn = R; if (R < NR) { PC_POS(R, p1, p2, w1, w2); PC_NEXT(Rn); if (Rn < NR) PC_POS(Rn, p1n, p2n, w1n, w2n);
#if PC_DATA_PREFETCH
        PC_DATA(R, p1, p2, xw, ya, yb, ys);
#endif
    }
    while (R < NR) {
        const int b = R / RPB, s = R - b * RPB, r = s < CTXL ? 8 : b;
        float* orow = F.out + (size_t)(b * SEQ + s - CTXL) * D;
        const LAS float* t = (const LAS float*)(F.lds + r * TS);
        int Rnn = Rn; int p1t = 0, p2t = 0; float w1t = 0.f, w2t = 0.f;
        if (Rn < NR) { PC_NEXT(Rnn); if (Rnn < NR) PC_POS(Rnn, p1t, p2t, w1t, w2t); }
#if PC_DATA_PREFETCH
        v2u xn[4], an[4], bn[4], sn[4];
#pragma unroll
        for (int j = 0; j < 4; ++j) { xn[j] = xw[j]; an[j] = ya[j]; bn[j] = yb[j]; sn[j] = ys[j]; }
        if (Rn < NR) PC_DATA(Rn, p1n, p2n, xn, an, bn, sn);
#else
        PC_DATA(R, p1, p2, xw, ya, yb, ys);
#endif
        f32x4 v[4];
#pragma unroll
        for (int j = 0; j < 4; ++j) { const int c = 4 * (F.lane + 64 * j);
            const f32x4 x = {bflo(xw[j].x), bfhi(xw[j].x), bflo(xw[j].y), bfhi(xw[j].y)}, g = *(const LAS f32x4*)(t + c);
            const v2u a = ya[j], bq = yb[j], y2 = ys[j];
            f32x4 m; m.x = bflo(y2.x) + w1 * bflo(a.x) + w2 * bflo(bq.x); m.y = bfhi(y2.x) + w1 * bfhi(a.x) + w2 * bfhi(bq.x); m.z = bflo(y2.y) + w1 * bflo(a.y) + w2 * bflo(bq.y); m.w = bfhi(y2.y) + w1 * bfhi(a.y) + w2 * bfhi(bq.y);
            v[j] = x + g * m;
            if (do_norm) { v2u o2; o2.x = cvtpk_b(v[j].x, v[j].y); o2.y = cvtpk_b(v[j].z, v[j].w); *(v2u*)(F.Xb_() + pil(R, c, 1024)) = o2; } else __builtin_nontemporal_store(v[j], (f32x4*)(orow + c)); }
        if (do_norm) {
            float ss = 0.f;
#pragma unroll
            for (int j = 0; j < 4; ++j) ss += (v[j].x * v[j].x + v[j].y * v[j].y) + (v[j].z * v[j].z + v[j].w * v[j].w);
            const float rstd = rsq_(wave_sum(ss) * (1.0f / D) + EPS);
            bf16* hrow = F.H_() + (size_t)R * D;
#pragma unroll
            for (int j = 0; j < 4; ++j) { const int c = 4 * (F.lane + 64 * j); const f32x4 a4 = *(const LAS f32x4*)(t + 1024 + c), b4 = *(const LAS f32x4*)(t + 2048 + c);
                const f32x4 y = (v[j] * rstd) * a4 + b4;
                v2u o; o.x = cvtpk_b(y.x, y.y); o.y = cvtpk_b(y.z, y.w); *(v2u*)(hrow + c) = o; } }
#if PC_DATA_PREFETCH
#pragma unroll
        for (int j = 0; j < 4; ++j) { xw[j] = xn[j]; ya[j] = an[j]; yb[j] = bn[j]; ys[j] = sn[j]; }
#endif
        R = Rn; Rn = Rnn; p1 = p1n; p2 = p2n; w1 = w1n; w2 = w2n; p1n = p1t; p2n = p2t; w1n = w1t; w2n = w2t;
    }
#undef PC_NEXT
#undef PC_POS
#undef PC_DATA
}

struct Unit { int pm, pn; };
struct Gemm { const bf16* A; const bf16* Bt; int K; const int* rowidx; };
constexpr int BM = 256, BK = 64, HALF = 128, HTB = HALF * BK * 2, STAGE_BYTES = 8 * HTB, NXCD = 8, WGM = 8;
__host__ __device__ __forceinline__ int lds_byte(int r, int c) { const int st = (r >> 4) * 2 + (c >> 5), rr = r & 15, cc = c & 31, ob = rr * 64 + cc * 2; return st * 1024 + (ob ^ (((ob >> 9) & 1) << 5)); }
__host__ __device__ __forceinline__ void stage_rc(int b, int& R, int& C) { const int st = b / 1024, sb = b % 1024, swz = sb ^ (((sb >> 9) & 1) << 5); R = (st >> 1) * 16 + swz / 64; C = (st & 1) * 32 + (swz % 64) / 2; }
template <class Epi, class Sched, bool ALIGN_EPI = false, bool SP2 = false, int SECID = 3, bool GATHER = false, bool APIL = false>
__device__ __forceinline__ void gemm_phase(LAS unsigned char* lds, const Gemm g, const Sched& S, const Epi& E, unsigned long long& sec_acc_) {
    const int tid = opaque((int)threadIdx.x), wid = __builtin_amdgcn_readfirstlane(tid >> 6), lane = tid & 63, wr = wid >> 2, wc = wid & 3, fr = lane & 15, fq = lane >> 4;
    const int K = g.K, nt = K / BK;
    unsigned voffA[2], voffB[2];
#pragma unroll
    for (int i = 0; i < 2; ++i) { int R, C; stage_rc(tid * 16 + i * 8192, R, C); const int Rb = Epi::PERM ? ((R & ~31) + perm32(R & 31)) : R;
        voffA[i] = APIL ? (unsigned)pil(R, C, K) * 2u : (unsigned)(R * K + C) * 2u; voffB[i] = (unsigned)(Rb * K + C) * 2u; }
    unsigned gA[2][2], gN[2][2]; int rA[2], cA2[2];
    LAS unsigned* growoff = (LAS unsigned*)(lds + LDS_XCH);
    if constexpr (GATHER) {
#pragma unroll
        for (int i = 0; i < 2; ++i) { int R, C; stage_rc(tid * 16 + i * 8192, R, C); rA[i] = R; cA2[i] = C * 2; }
        { Unit uu; for (int i = 0; i < 8 && S.next(i, uu); ++i) for (int r = tid; r < 256; r += NTHREADS) growoff[i * 256 + r] = (unsigned)g.rowidx[uu.pm * 256 + r] * (unsigned)K * 2u; }
        __syncthreads();
#pragma unroll
        for (int h = 0; h < 2; ++h)
#pragma unroll
            for (int i = 0; i < 2; ++i) { gA[h][i] = growoff[h * 128 + rA[i]] + cA2[i]; gN[h][i] = gA[h][i]; }
    }
    const size_t kstep = (size_t)(BK * 2);
    const size_t kstepA = APIL ? (size_t)(BK * 4) : kstep;
    const size_t hstep = (size_t)HALF * K * 2;
    const size_t tstep = 2 * hstep;
    const unsigned ldsw = (unsigned)wid * 1024u;
    const int aoff = lds_byte(wr * 64 + fr, fq * 8), boff = lds_byte(wc * 32 + fr, fq * 8);
#define PG8_SA(b, h) (((b) * 2 + (h)) * HTB)
#define PG8_SB(b, h) ((4 + (b) * 2 + (h)) * HTB)
#define PG8_STAGE(bufoff, gbase, voff) do { _Pragma("unroll") for (int _i = 0; _i < 2; ++_i) \
        __builtin_amdgcn_global_load_lds((const unsigned*)((const char*)(gbase) + (voff)[_i]), (LAS unsigned*)(lds + (bufoff) + ldsw + _i * 8192), 16, 0, 0); } while (0)
#define PG8_STAGE_A(bufoff, gbase, h, usenext) do { if constexpr (GATHER) { _Pragma("unroll") for (int _i = 0; _i < 2; ++_i) { const unsigned _o = (usenext) ? gN[h][_i] : gA[h][_i]; \
        __builtin_amdgcn_global_load_lds((const unsigned*)((const char*)(gbase) + _o), (LAS unsigned*)(lds + (bufoff) + ldsw + _i * 8192), 16, 0, 0); } } \
    else { PG8_STAGE(bufoff, (gbase) + (h) * hstep, voffA); } } while (0)
#define PG8_LDA(dst, b, h) do { _Pragma("unroll") for (int m = 0; m < 4; ++m) _Pragma("unroll") for (int k = 0; k < 2; ++k) dst[m][k] = *(const LAS bf16x8*)(lds + PG8_SA(b, h) + aoff + m * 2048 + k * 1024); } while (0)
#define PG8_LDB(dst, b, h) do { _Pragma("unroll") for (int n = 0; n < 2; ++n) _Pragma("unroll") for (int k = 0; k < 2; ++k) dst[n][k] = *(const LAS bf16x8*)(lds + PG8_SB(b, h) + boff + n * 2048 + k * 1024); } while (0)
#define PG8_MMA(ai, bj, At, Bt) do { __builtin_amdgcn_s_setprio(1); _Pragma("unroll") for (int m = 0; m < 4; ++m) _Pragma("unroll") for (int n = 0; n < 2; ++n) _Pragma("unroll") for (int k = 0; k < 2; ++k) \
        acc[ai][bj][m][n] = __builtin_amdgcn_mfma_f32_16x16x32_bf16(Bt[n][k], At[m][k], acc[ai][bj][m][n], 0, 0, 0); __builtin_amdgcn_s_setprio(0); } while (0)
#define PG8_WAIT_V(n) asm volatile("s_waitcnt vmcnt(" #n ")" ::: "memory")
#define PG8_WAIT_L(n) asm volatile("s_waitcnt lgkmcnt(" #n ")" ::: "memory")
#define PG8_BAR __builtin_amdgcn_s_barrier()
#define PG8_SCHED __builtin_amdgcn_sched_barrier(0)
    Unit cur, nxt; int ui = 0;
    if (!S.next(0, cur)) return;
    f32x4 acc[2][2][4][2];
#pragma unroll
    for (int a = 0; a < 2; ++a)
#pragma unroll
        for (int b = 0; b < 2; ++b)
#pragma unroll
            for (int m = 0; m < 4; ++m)
#pragma unroll
                for (int n = 0; n < 2; ++n) acc[a][b][m][n] = (f32x4){0.f, 0.f, 0.f, 0.f};
    bf16x8 At[4][2], B0[2][2], B1[2][2];
    const char* cA = (const char*)g.A + (GATHER ? (size_t)0 : (size_t)cur.pm * tstep); const char* cB = (const char*)g.Bt + (size_t)cur.pn * tstep;
    S.a_ready(cur);
    if constexpr (SP2) {
        PG8_STAGE(PG8_SB(0, 0), cB, voffB); PG8_STAGE(PG8_SB(0, 1), cB + hstep, voffB); PG8_STAGE_A(PG8_SA(0, 0), cA, 0, false); PG8_STAGE_A(PG8_SA(0, 1), cA, 1, false);
        if (wr == 1) PG8_BAR;
        PG8_WAIT_V(2); PG8_BAR;
        PG8_STAGE(PG8_SB(1, 0), cB + kstep, voffB); PG8_STAGE_A(PG8_SA(1, 0), cA + kstepA, 0, false); PG8_STAGE(PG8_SB(1, 1), cB + hstep + kstep, voffB);
        PG8_WAIT_V(6); PG8_BAR;
    } else {
        PG8_STAGE(PG8_SB(0, 0), cB, voffB); PG8_STAGE_A(PG8_SA(0, 0), cA, 0, false); PG8_STAGE(PG8_SB(0, 1), cB + hstep, voffB); PG8_STAGE_A(PG8_SA(0, 1), cA, 1, false);
        if (wr == 1) PG8_BAR;
        PG8_WAIT_V(4); PG8_BAR;
        PG8_STAGE(PG8_SB(1, 0), cB + kstep, voffB); PG8_STAGE_A(PG8_SA(1, 0), cA + kstepA, 0, false); PG8_STAGE(PG8_SB(1, 1), cB + hstep + kstep, voffB);
        PG8_WAIT_V(6); PG8_BAR;
    }
    for (;;) {
        const bool has_next = S.next(ui + 1, nxt);
        const char* nA = (has_next && !GATHER) ? (const char*)g.A + (size_t)nxt.pm * tstep : cA; const char* nB = has_next ? (const char*)g.Bt + (size_t)nxt.pn * tstep : cB;
        if constexpr (GATHER) { if (has_next) {
#pragma unroll
            for (int h = 0; h < 2; ++h)
#pragma unroll
                for (int i = 0; i < 2; ++i) gN[h][i] = growoff[(ui + 1) * 256 + h * 128 + rA[i]] + cA2[i]; } }
#pragma unroll 1
        for (int t = 0; t < nt; t += 2) {
            const bool last = (t == nt - 2);
            const char* a1 = cA + (size_t)(t + 1) * kstepA;
            const char* a2 = last ? nA : cA + (size_t)(t + 2) * kstepA; const char* b2 = last ? nB : cB + (size_t)(t + 2) * kstep;
            const char* a3 = a2 + kstepA; const char* b3 = b2 + kstep;
            if (last && has_next) S.a_ready(nxt);
            if constexpr (SP2) {
            PG8_LDB(B0, 0, 0); PG8_LDB(B1, 0, 1); PG8_SCHED; PG8_LDA(At, 0, 0); PG8_STAGE_A(PG8_SA(1, 1), a1, 1, false);
            PG8_WAIT_V(8); PG8_WAIT_L(0); PG8_BAR; PG8_MMA(0, 0, At, B0); PG8_MMA(0, 1, At, B1); PG8_BAR; PG8_SCHED;
            PG8_LDA(At, 0, 1); PG8_STAGE(PG8_SB(0, 0), b2, voffB); PG8_STAGE(PG8_SB(0, 1), b2 + hstep, voffB); PG8_STAGE_A(PG8_SA(0, 0), a2, 0, last);
            PG8_WAIT_V(8); PG8_WAIT_L(0); PG8_BAR; PG8_MMA(1, 0, At, B0); PG8_MMA(1, 1, At, B1); PG8_BAR; PG8_SCHED;
            PG8_LDB(B0, 1, 0); PG8_LDB(B1, 1, 1); PG8_SCHED; PG8_LDA(At, 1, 0); PG8_STAGE_A(PG8_SA(0, 1), a2, 1, last);
            PG8_WAIT_V(8); PG8_WAIT_L(0); PG8_BAR; PG8_MMA(0, 0, At, B0); PG8_MMA(0, 1, At, B1); PG8_BAR; PG8_SCHED;
            PG8_LDA(At, 1, 1); PG8_STAGE(PG8_SB(1, 0), b3, voffB); PG8_STAGE(PG8_SB(1, 1), b3 + hstep, voffB); PG8_STAGE_A(PG8_SA(1, 0), a3, 0, last);
            PG8_WAIT_V(8); PG8_WAIT_L(0); PG8_BAR; PG8_MMA(1, 0, At, B0); PG8_MMA(1, 1, At, B1); PG8_BAR; PG8_SCHED;
            } else {
            PG8_LDB(B0, 0, 0); PG8_SCHED; PG8_LDA(At, 0, 0); PG8_STAGE_A(PG8_SA(1, 1), a1, 1, false);
            PG8_WAIT_L(8); PG8_BAR; PG8_WAIT_L(0); PG8_MMA(0, 0, At, B0); PG8_BAR; PG8_SCHED;
            PG8_LDB(B1, 0, 1); PG8_STAGE(PG8_SB(0, 0), b2, voffB);
            PG8_BAR; PG8_WAIT_L(0); PG8_MMA(0, 1, At, B1); PG8_BAR;
            PG8_LDA(At, 0, 1); PG8_STAGE_A(PG8_SA(0, 0), a2, 0, last);
            PG8_BAR; PG8_WAIT_L(0); PG8_MMA(1, 0, At, B0); PG8_BAR; PG8_SCHED;
            PG8_STAGE(PG8_SB(0, 1), b2 + hstep, voffB);
            PG8_WAIT_V(6); PG8_BAR; PG8_MMA(1, 1, At, B1); PG8_BAR;
            PG8_LDB(B0, 1, 0); PG8_SCHED; PG8_LDA(At, 1, 0); PG8_STAGE_A(PG8_SA(0, 1), a2, 1, last);
            PG8_WAIT_L(8); PG8_BAR; PG8_WAIT_L(0); PG8_MMA(0, 0, At, B0); PG8_BAR; PG8_SCHED;
            PG8_LDB(B1, 1, 1); PG8_STAGE(PG8_SB(1, 0), b3, voffB);
            PG8_BAR; PG8_WAIT_L(0); PG8_MMA(0, 1, At, B1); PG8_BAR;
            PG8_LDA(At, 1, 1); PG8_STAGE_A(PG8_SA(1, 0), a3, 0, last);
            PG8_BAR; PG8_WAIT_L(0); PG8_MMA(1, 0, At, B0); PG8_BAR; PG8_SCHED;
            PG8_STAGE(PG8_SB(1, 1), b3 + hstep, voffB);
            PG8_WAIT_V(6); PG8_BAR; PG8_MMA(1, 1, At, B1); PG8_BAR;
            }
        }
        if constexpr (ALIGN_EPI) { if (wr == 0) PG8_BAR; }
        if constexpr (!Epi::AFTER_DRAIN) { const unsigned long long se_ = (PROBE_SEC == 3 || PROBE_SEC == SECID) ? (unsigned long long)clock64() : 0ull; E(acc, cur, wr, wc, fr, fq); S.done(cur); if (PROBE_SEC == 3 || PROBE_SEC == SECID) sec_acc_ += (unsigned long long)clock64() - se_; }
        if (!has_next) break;
#pragma unroll
        for (int a = 0; a < 2; ++a)
#pragma unroll
            for (int b = 0; b < 2; ++b)
#pragma unroll
                for (int m = 0; m < 4; ++m)
#pragma unroll
                    for (int n = 0; n < 2; ++n) acc[a][b][m][n] = (f32x4){0.f, 0.f, 0.f, 0.f};
        cur = nxt; cA = nA; cB = nB; ++ui;
        if constexpr (GATHER) {
#pragma unroll
            for (int h = 0; h < 2; ++h)
#pragma unroll
                for (int i = 0; i < 2; ++i) gA[h][i] = gN[h][i]; }
        if constexpr (ALIGN_EPI) { if (wr == 1) PG8_BAR; }
    }
    PG8_WAIT_V(0);
    if constexpr (!ALIGN_EPI) { if (wr == 0) PG8_BAR; }
    PG8_BAR;
    if constexpr (Epi::AFTER_DRAIN) { E.fused(acc, cur, wr, wc, fr, fq, lds, wid, lane); S.done(cur); }
#undef PG8_SA
#undef PG8_SB
#undef PG8_STAGE
#undef PG8_STAGE_A
#undef PG8_LDA
#undef PG8_LDB
#undef PG8_MMA
#undef PG8_WAIT_V
#undef PG8_WAIT_L
#undef PG8_BAR
#undef PG8_SCHED
}


__device__ __forceinline__ int xcd_remap(int L, int nwg) { const int q = nwg / NXCD, r = nwg % NXCD, xcd = L % NXCD, off = L / NXCD; return (xcd < r ? xcd * (q + 1) : r * (q + 1) + (xcd - r) * q) + off; }
struct SchedGrid {
    int nm, nn, G, c; bool lat;
    __device__ __forceinline__ bool next(int i, Unit& u) const { const int nwg = nm * nn; const int L = i * G + c; if (L >= nwg) return false;
        const int wgid = xcd_remap(L, nwg); const int nig = WGM * nn, gid = wgid / nig, fm = gid * WGM, gsz = (nm - fm) < WGM ? (nm - fm) : WGM;
        int pm = fm + ((wgid % nig) % gsz); u.pn = (wgid % nig) / gsz; if (lat) pm = (pm >> 3) * 9 + 1 + (pm & 7); u.pm = pm; return true; }
    __device__ __forceinline__ void a_ready(const Unit&) const {}
    __device__ __forceinline__ void done(const Unit&) const {}
};
struct SchedGridL {
    int nm, nn, G, bid, rr; bool lat; int L0, Lend, lr;
    __device__ __forceinline__ bool next(int i, Unit& u) const { const int nwg = nm * nn, nL = G - rr; int j;
        if (bid >= rr) j = (i < lr) ? i * nL + (bid - rr) : lr * nL + (i - lr) * G + bid; else j = lr * nL + i * G + bid;
        const int L = L0 + j; if (L >= Lend) return false;
        const int wgid = xcd_remap(L, nwg); const int nig = WGM * nn, gid = wgid / nig, fm = gid * WGM, gsz = (nm - fm) < WGM ? (nm - fm) : WGM;
        int pm = fm + ((wgid % nig) % gsz); u.pn = (wgid % nig) / gsz; if (lat) pm = (pm >> 3) * 9 + 1 + (pm & 7); u.pm = pm; return true; }
    __device__ __forceinline__ void a_ready(const Unit&) const {}
    __device__ __forceinline__ void done(const Unit&) const {}
};
struct SchedRouted {
    ExpOff eo; int G, c;
    __device__ __forceinline__ bool next(int i, Unit& u) const { const int nt = eo.off[16] >> 8, nwg = nt * 4; const int L = i * G + c; if (L >= nwg) return false;
        const int wgid = xcd_remap(L, nwg); const int pm = wgid >> 2, pnl = wgid & 3; int e = 0;
#pragma unroll
        for (int k = 1; k < 16; ++k) e += (pm * 256 >= eo.off[k]) ? 1 : 0;
        u.pm = pm; u.pn = e * 4 + pnl; return true; }
    __device__ __forceinline__ void a_ready(const Unit&) const {}
    __device__ __forceinline__ void done(const Unit&) const {}
};

#ifndef PROBE_REP
#define PROBE_REP -1
#endif
#define REP(k) for (int rep_ = 0; rep_ < ((PROBE_REP == (k)) ? 2 : 1); ++rep_)
#ifndef PROBE_AMP_LO
#define PROBE_AMP_LO -1
#define PROBE_AMP_HI -1
#endif
#ifndef ALIGN_MASK
#define ALIGN_MASK 0xffffffffu
#endif
template <int ID, class Epi, class Sched>
__device__ __forceinline__ void run_gemm(Frame& F, const Gemm g, const Sched& S, const Epi& E) {
    SEC_BEGIN(4);
    gemm_phase<Epi, Sched, (ID == 7 || ID == 8 || ((ALIGN_MASK >> ID) & 1u)), true, 10 + ID, (ID == 3 || ID == 11), (ID == 4 || ID == 5 || ID == 7 || ID == 8 || ID == 12 || ID == 13)>(F.lds, g, S, E, F.sec_acc);
    SEC_END(4);
}

__device__ __forceinline__ v4u pack8(const f32x4 a, const f32x4 b) { v4u w; w.x = cvtpk_b(a[0], a[1]); w.y = cvtpk_b(a[2], a[3]); w.z = cvtpk_b(b[0], b[1]); w.w = cvtpk_b(b[2], b[3]); return w; }

#ifndef EPI_NT
#define EPI_NT 1
#endif
__device__ __forceinline__ void st16(bf16* p, const v4u v) { if (EPI_NT) __builtin_nontemporal_store(v, (v4u*)p); else *(v4u*)p = v; }
__device__ __forceinline__ unsigned xchg1(unsigned v) { return (unsigned)__shfl_xor((int)v, 1); }
__device__ __forceinline__ void pair_swap(v4u& lo, v4u& hi, bool odd) {
    const unsigned s0 = odd ? lo.x : hi.x, s1 = odd ? lo.y : hi.y, s2 = odd ? lo.z : hi.z, s3 = odd ? lo.w : hi.w;
    const unsigned r0 = xchg1(s0), r1 = xchg1(s1), r2 = xchg1(s2), r3 = xchg1(s3);
    if (odd) { lo.x = r0; lo.y = r1; lo.z = r2; lo.w = r3; } else { hi.x = r0; hi.y = r1; hi.z = r2; hi.w = r3; }
}
__device__ __forceinline__ void pair_swap(f32x4& lo, f32x4& hi, bool odd) {
    v4u a = __builtin_bit_cast(v4u, lo), b = __builtin_bit_cast(v4u, hi); pair_swap(a, b, odd); lo = __builtin_bit_cast(f32x4, a); hi = __builtin_bit_cast(f32x4, b);
}
struct EpiIn0 {
    static constexpr bool PERM = true, AFTER_DRAIN = false;
    unsigned char* big; const float *qg, *kg, *lbv; const LAS f32x2 *ropeR, *ropeC;
    __device__ __forceinline__ void operator()(const f32x4 (&acc)[2][2][4][2], const Unit& u, int wr, int wc, int fr, int fq) const {
        const int pn = u.pn, type = pn >> 1, j9 = u.pm % 9; const bool lat = j9 > 0;
        if (type < 2) {
            const float* gain = type ? kg : qg; bf16* dst = (bf16*)(big + (type ? B_KD : B_QD));
            const int h = 2 * (pn & 1) + (wc >> 1), c = wc & 1;
            f32x4 g[2][2];
#pragma unroll
            for (int bj = 0; bj < 2; ++bj)
#pragma unroll
                for (int n = 0; n < 2; ++n) g[bj][n] = *(const f32x4*)(gain + 32 * bj + 16 * n + 4 * fq);
#pragma unroll
            for (int ai = 0; ai < 2; ++ai)
#pragma unroll
                for (int m = 0; m < 4; ++m) {
                    const int rr = opaque(ai * 128 + wr * 64 + m * 16 + fr); const size_t R = (size_t)u.pm * 256 + rr;
                    float s = 0.f;
#pragma unroll
                    for (int bj = 0; bj < 2; ++bj)
#pragma unroll
                        for (int n = 0; n < 2; ++n) { const f32x4 x = acc[ai][bj][m][n]; s += (x[0] * x[0] + x[1] * x[1]) + (x[2] * x[2] + x[3] * x[3]); }
                    s += __shfl_xor(s, 16); s += __shfl_xor(s, 32);
                    const float rstd = rsq_(s * (1.0f / 64.0f) + EPS);
                    f32x4 y[2][2];
#pragma unroll
                    for (int bj = 0; bj < 2; ++bj)
#pragma unroll
                        for (int n = 0; n < 2; ++n) y[bj][n] = acc[ai][bj][m][n] * (type == 0 ? rstd * (0.125f * LOG2E) : rstd) * g[bj][n];
                    if (lat) { const int t = (j9 - 1) * 256 + rr, grow = t >> 6, gcol = t & 63;
#pragma unroll
                        for (int bj = 0; bj < 2; ++bj) { const LAS f32x2* tab = bj ? (ropeC + gcol * 16 + 4 * fq) : (ropeR + grow * 16 + 4 * fq);
                            const f32x4 t0 = *(const LAS f32x4*)tab, t1 = *(const LAS f32x4*)(tab + 2);
                            const float cs[4] = {t0[0], t0[2], t1[0], t1[2]}, sn[4] = {t0[1], t0[3], t1[1], t1[3]};
#pragma unroll
                            for (int e = 0; e < 4; ++e) { const float x1 = y[bj][0][e], x2 = y[bj][1][e]; y[bj][0][e] = x1 * cs[e] - x2 * sn[e]; y[bj][1][e] = x1 * sn[e] + x2 * cs[e]; } } }
                    { v4u lo = pack8(y[0][0], y[0][1]), hi = pack8(y[1][0], y[1][1]); const bool odd = fr & 1; pair_swap(lo, hi, odd);
                        bf16* pb = dst + h * 128 + c * 64 + (odd ? 32 : 0) + 8 * fq;
                        *(v4u*)(pb + (R & ~(size_t)1) * 512) = lo; *(v4u*)(pb + (R | 1) * 512) = hi; }
                    asm volatile("" ::: "memory");
                }
        } else {
            const int colt = (pn & 1) * 256;
            size_t boffs; if (type == 2) boffs = B_VD; else if (type == 3) boffs = B_HQ; else if (type == 4) boffs = B_LF0; else if (type == 5) boffs = B_LF1; else if (type == 6) boffs = B_HV; else boffs = B_HG;
            bf16* dst = (bf16*)(big + boffs);
#pragma unroll
            for (int bj = 0; bj < 2; ++bj) { const int col = colt + bj * 128 + wc * 32 + 8 * fq;
                f32x4 lb0 = {0.f, 0.f, 0.f, 0.f}, lb1 = lb0;
                if (type == 4 || type == 5) { const float* lp = lbv + (type - 4) * 512 + col; lb0 = *(const f32x4*)lp; lb1 = *(const f32x4*)(lp + 4); }
#pragma unroll
                for (int ai = 0; ai < 2; ++ai)
#pragma unroll
                    for (int m = 0; m < 4; ++m) { const size_t R = (size_t)u.pm * 256 + opaque(ai * 128 + wr * 64 + m * 16 + fr);
                        f32x4 a = acc[ai][bj][m][0], b = acc[ai][bj][m][1]; v4u w;
                        if (type == 3 || type == 7) {
#pragma unroll
                            for (int e = 0; e < 4; ++e) { a[e] = siluf_(a[e]); b[e] = siluf_(b[e]); }
                            if (type == 3) { a = a * 0.08838834764831845f; b = b * 0.08838834764831845f; }
                            w = pack8(a, b);
                        } else if (type == 4 || type == 5) {
#pragma unroll
                            for (int e = 0; e < 4; ++e) { a[e] = lb0[e] + (1.0f - lb0[e]) * sigmoidf_(a[e]); b[e] = lb1[e] + (1.0f - lb1[e]) * sigmoidf_(b[e]);     }
                            w.x = pkh2(a[0], a[1]); w.y = pkh2(a[2], a[3]); w.z = pkh2(b[0], b[1]); w.w = pkh2(b[2], b[3]);
                        } else w = pack8(a, b);
                        st16(dst + (type == 2 ? (int)R * 512 + col : pil((int)R, col, 512)), w); asm volatile("" ::: "memory"); } }
        }
    }
};

struct EpiOut {
    static constexpr bool PERM = true, AFTER_DRAIN = false;
    const Frame* F; int layer; bool from_input;
    __device__ __forceinline__ void operator()(const f32x4 (&acc)[2][2][4][2], const Unit& u, int wr, int wc, int fr, int fq) const {
        const int b = u.pm / 9, j9 = u.pm % 9, r = j9 ? b : 8;
        const float* gm = F->modv_() + (size_t)(layer * 9 + r) * 6144 + 2048;
        bf16* Xb = F->Xb_();
        const int col0 = u.pn * 256 + wc * 32 + 8 * fq;
        f32x4 g[2][2];
#pragma unroll
        for (int bj = 0; bj < 2; ++bj) { g[bj][0] = *(const f32x4*)(gm + col0 + bj * 128); g[bj][1] = *(const f32x4*)(gm + col0 + bj * 128 + 4); }
#pragma unroll
        for (int ai = 0; ai < 2; ++ai) {
            const int rr0 = opaque(ai * 128 + wr * 64 + fr);
            if (from_input) {
                f32x4 bv[4][2][2];
#pragma unroll
                for (int m = 0; m < 4; ++m) { const float* xi = xin_ptr(*F, b, j9 * 256 + rr0 + m * 16);
#pragma unroll
                    for (int bj = 0; bj < 2; ++bj) { bv[m][bj][0] = __builtin_nontemporal_load((const f32x4*)(xi + col0 + bj * 128)); bv[m][bj][1] = __builtin_nontemporal_load((const f32x4*)(xi + col0 + bj * 128 + 4)); } }
#pragma unroll
                for (int m = 0; m < 4; ++m) { const int R = u.pm * 256 + rr0 + m * 16;
#pragma unroll
                    for (int bj = 0; bj < 2; ++bj)
                        st16(Xb + pil(R, col0 + bj * 128, 1024), pack8(bv[m][bj][0] + g[bj][0] * acc[ai][bj][m][0], bv[m][bj][1] + g[bj][1] * acc[ai][bj][m][1])); }
            } else {
                v4u bw[4][2];
#pragma unroll
                for (int m = 0; m < 4; ++m) { const int R = u.pm * 256 + rr0 + m * 16;
#pragma unroll
                    for (int bj = 0; bj < 2; ++bj) bw[m][bj] = *(const v4u*)(Xb + pil(R, col0 + bj * 128, 1024)); }
#pragma unroll
                for (int m = 0; m < 4; ++m) { const int R = u.pm * 256 + rr0 + m * 16;
#pragma unroll
                    for (int bj = 0; bj < 2; ++bj) { const v4u w = bw[m][bj];
                        const f32x4 b0 = {bflo(w.x), bfhi(w.x), bflo(w.y), bfhi(w.y)}, b1 = {bflo(w.z), bfhi(w.z), bflo(w.w), bfhi(w.w)};
                        st16(Xb + pil(R, col0 + bj * 128, 1024), pack8(b0 + g[bj][0] * acc[ai][bj][m][0], b1 + g[bj][1] * acc[ai][bj][m][1])); } }
            }
            asm volatile("" ::: "memory");
        }
    }
};

struct EpiGU {
    static constexpr bool PERM = true, AFTER_DRAIN = false;
    bf16* Hout;
    __device__ __forceinline__ void operator()(const f32x4 (&acc)[2][2][4][2], const Unit& u, int wr, int wc, int fr, int fq) const {
        const int pnl = u.pn & 3;
#pragma unroll
        for (int ai = 0; ai < 2; ++ai)
#pragma unroll
            for (int m = 0; m < 4; ++m) { const size_t row = (size_t)u.pm * 256 + opaque(ai * 128 + wr * 64 + m * 16 + fr);
                f32x4 h[2];
#pragma unroll
                for (int n = 0; n < 2; ++n)
#pragma unroll
                    for (int e = 0; e < 4; ++e) h[n][e] = siluf_(acc[ai][0][m][n][e]) * acc[ai][1][m][n][e];
                st16(Hout + pil((int)row, pnl * 128 + wc * 32 + 8 * fq, 512), pack8(h[0], h[1])); }
    }
};

struct EpiDownS {
    static constexpr bool PERM = true, AFTER_DRAIN = false;
    bf16* Ys;
    __device__ __forceinline__ void operator()(const f32x4 (&acc)[2][2][4][2], const Unit& u, int wr, int wc, int fr, int fq) const {
#pragma unroll
        for (int ai = 0; ai < 2; ++ai)
#pragma unroll
            for (int m = 0; m < 4; ++m) { const size_t row = (size_t)u.pm * 256 + opaque(ai * 128 + wr * 64 + m * 16 + fr);
#pragma unroll
                for (int bj = 0; bj < 2; ++bj) st16(Ys + pil((int)row, u.pn * 256 + bj * 128 + wc * 32 + 8 * fq, 1024), pack8(acc[ai][bj][m][0], acc[ai][bj][m][1])); }
    }
};

struct EpiDownR {
    static constexpr bool PERM = true, AFTER_DRAIN = false;
    bf16* Ye;
    __device__ __forceinline__ void operator()(const f32x4 (&acc)[2][2][4][2], const Unit& u, int wr, int wc, int fr, int fq) const {
        const int pnl = u.pn & 3;
#pragma unroll
        for (int ai = 0; ai < 2; ++ai)
#pragma unroll
            for (int m = 0; m < 4; ++m) { const size_t row = (size_t)u.pm * 256 + opaque(ai * 128 + wr * 64 + m * 16 + fr);
#pragma unroll
                for (int bj = 0; bj < 2; ++bj) st16(Ye + pil_off(row, pnl * 256 + bj * 128 + wc * 32 + 8 * fq), pack8(acc[ai][bj][m][0], acc[ai][bj][m][1])); }
    }
};

struct EpiIn1 {
    static constexpr bool PERM = true, AFTER_DRAIN = false;
    unsigned char* big; float* ssq; const float* krg; const LAS f32x2 *ropeR, *ropeC;
    __device__ __forceinline__ void operator()(const f32x4 (&acc)[2][2][4][2], const Unit& u, int wr, int wc, int fr, int fq) const {
        const int pn = u.pn, j9 = u.pm % 9; const bool lat = j9 > 0;
        bf16* Ckv = (bf16*)(big + B_CKV); bf16* Cq = (bf16*)(big + B_CQ); bf16* Kr = (bf16*)(big + B_KR);
        if (pn == 2 && wc == 3) {
#pragma unroll
            for (int ai = 0; ai < 2; ++ai)
#pragma unroll
                for (int m = 0; m < 4; ++m) {
                    const int rr = opaque(ai * 128 + wr * 64 + m * 16 + fr); const size_t R = (size_t)u.pm * 256 + rr;
                    float s = 0.f;
#pragma unroll
                    for (int bj = 0; bj < 2; ++bj)
#pragma unroll
                        for (int n = 0; n < 2; ++n) { const f32x4 x = acc[ai][bj][m][n]; s += (x[0] * x[0] + x[1] * x[1]) + (x[2] * x[2] + x[3] * x[3]); }
                    s += __shfl_xor(s, 16); s += __shfl_xor(s, 32);
                    const float rstd = rsq_(s * (1.0f / 64.0f) + EPS);
                    f32x4 y[2][2];
#pragma unroll
                    for (int bj = 0; bj < 2; ++bj)
#pragma unroll
                        for (int n = 0; n < 2; ++n) y[bj][n] = acc[ai][bj][m][n] * rstd * *(const f32x4*)(krg + 32 * bj + 16 * n + 4 * fq);
                    if (lat) { const int t = (j9 - 1) * 256 + rr, grow = t >> 6, gcol = t & 63;
#pragma unroll
                        for (int bj = 0; bj < 2; ++bj) { const LAS f32x2* tab = bj ? (ropeC + gcol * 16 + 4 * fq) : (ropeR + grow * 16 + 4 * fq);
                            const f32x4 t0 = *(const LAS f32x4*)tab, t1 = *(const LAS f32x4*)(tab + 2);
                            const float cs[4] = {t0[0], t0[2], t1[0], t1[2]}, sn[4] = {t0[1], t0[3], t1[1], t1[3]};
#pragma unroll
                            for (int e = 0; e < 4; ++e) { const float x1 = y[bj][0][e], x2 = y[bj][1][e]; y[bj][0][e] = x1 * cs[e] - x2 * sn[e]; y[bj][1][e] = x1 * sn[e] + x2 * cs[e]; } } }
                    { v4u lo = pack8(y[0][0], y[0][1]), hi = pack8(y[1][0], y[1][1]); const bool odd = fr & 1; pair_swap(lo, hi, odd);
                        bf16* pb = Kr + (odd ? 32 : 0) + 8 * fq;
                        *(v4u*)(pb + (R & ~(size_t)1) * 64) = lo; *(v4u*)(pb + (R | 1) * 64) = hi; }
                    asm volatile("" ::: "memory");
                }
            return;
        }
#pragma unroll
        for (int ai = 0; ai < 2; ++ai)
#pragma unroll
            for (int m = 0; m < 4; ++m) {
                const size_t R = (size_t)u.pm * 256 + opaque(ai * 128 + wr * 64 + m * 16 + fr);
                float s = 0.f;
#pragma unroll
                for (int bj = 0; bj < 2; ++bj) { const f32x4 a = acc[ai][bj][m][0], b = acc[ai][bj][m][1];
                    s += (a[0] * a[0] + a[1] * a[1]) + (a[2] * a[2] + a[3] * a[3]) + (b[0] * b[0] + b[1] * b[1]) + (b[2] * b[2] + b[3] * b[3]);
                    const v4u w = pack8(a, b);
                    if (pn == 0) st16(Ckv + pil((int)R, bj * 128 + wc * 32 + 8 * fq, 256), w);
                    else if (pn == 1) st16(Cq + pil((int)R, bj * 128 + wc * 32 + 8 * fq, 384), w);
                    else { if (bj == 0) st16(Cq + pil((int)R, 256 + wc * 32 + 8 * fq, 384), w); else if (wc == 0) st16(Cq + pil((int)R, 352 + 8 * fq, 384), w); } }
                s += __shfl_xor(s, 16); s += __shfl_xor(s, 32);
                if (fq == 0) ssq[R * 12 + pn * 4 + wc] = s;
                asm volatile("" ::: "memory");
            }
    }
};

struct EpiUq {
    static constexpr bool PERM = true, AFTER_DRAIN = false;
    bf16* Q1; const float* ssq; const float *qng, *qrg; const LAS f32x2 *ropeR, *ropeC; LAS float* xl;
    __device__ __forceinline__ float rq_of(size_t R) const { const float* sp = ssq + R * 12; const f32x4 s1 = *(const f32x4*)(sp + 4), s2 = *(const f32x4*)(sp + 8);
        return rsq_(((s1[0] + s1[1]) + (s1[2] + s1[3]) + (s2[0] + s2[1]) + s2[2]) * (1.0f / 384.0f) + EPS); }
    __device__ __forceinline__ void operator()(const f32x4 (&acc)[2][2][4][2], const Unit& u, int wr, int wc, int fr, int fq) const {
        const int pn = u.pn, j9 = u.pm % 9;
        LAS float* rqL = (LAS float*)((LAS unsigned char*)xl + (LDS_RQ - LDS_XCH));
        { const int t_ = (int)threadIdx.x; if (t_ < 256) rqL[t_] = rq_of((size_t)u.pm * 256 + t_); }
        if (pn >= 4) EPI_BAR();
        if (pn < 4) {
#pragma unroll
            for (int ai = 0; ai < 2; ++ai)
#pragma unroll
                for (int m = 0; m < 4; ++m)
#pragma unroll
                    for (int bj = 0; bj < 2; ++bj) { float s = 0.f;
#pragma unroll
                        for (int n = 0; n < 2; ++n) { const f32x4 x = acc[ai][bj][m][n]; s += (x[0] * x[0] + x[1] * x[1]) + (x[2] * x[2] + x[3] * x[3]); }
                        s += __shfl_xor(s, 16); s += __shfl_xor(s, 32);
                        if (fq == 0) xl[(ai * 128 + wr * 64 + m * 16 + fr) * 8 + bj * 4 + wc] = s; }
            f32x4 g[2];
#pragma unroll
            for (int n = 0; n < 2; ++n) g[n] = *(const f32x4*)(qng + wc * 32 + 8 * fq + 4 * n);
            EPI_BAR();
#pragma unroll
            for (int ai = 0; ai < 2; ++ai)
#pragma unroll
                for (int m = 0; m < 4; ++m) { const int rr = opaque(ai * 128 + wr * 64 + m * 16 + fr); const size_t R = (size_t)u.pm * 256 + rr; const float rq = rqL[rr];
#pragma unroll
                    for (int bj = 0; bj < 2; ++bj) { const f32x4 p = *(const LAS f32x4*)(xl + rr * 8 + bj * 4);
                        const float rstd = (0.07216878364870323f * LOG2E) * rq * rsq_(((p[0] + p[1]) + (p[2] + p[3])) * (rq * rq) * (1.0f / 128.0f) + EPS);
                        const int h = 2 * pn + bj;
                        st16(Q1 + pil((int)R, h * 192 + wc * 32 + 8 * fq, 1536), pack8(acc[ai][bj][m][0] * rstd * g[0], acc[ai][bj][m][1] * rstd * g[1])); } asm volatile("" ::: "memory"); }
            EPI_BAR();
        } else {
            const int h = 4 * (pn - 4) + wc;
            f32x4 qg_[2][2];
#pragma unroll
            for (int bj = 0; bj < 2; ++bj)
#pragma unroll
                for (int n = 0; n < 2; ++n) qg_[bj][n] = *(const f32x4*)(qrg + 32 * bj + 16 * n + 4 * fq);
#pragma unroll
            for (int ai = 0; ai < 2; ++ai)
#pragma unroll
                for (int m = 0; m < 4; ++m) {
                    const int rr = opaque(ai * 128 + wr * 64 + m * 16 + fr); const size_t R = (size_t)u.pm * 256 + rr; const float rq = rqL[rr];
                    float s = 0.f; f32x4 y[2][2];
#pragma unroll
                    for (int bj = 0; bj < 2; ++bj)
#pragma unroll
                        for (int n = 0; n < 2; ++n) { const f32x4 x = acc[ai][bj][m][n] * rq; y[bj][n] = x; s += (x[0] * x[0] + x[1] * x[1]) + (x[2] * x[2] + x[3] * x[3]); }
                    s += __shfl_xor(s, 16); s += __shfl_xor(s, 32);
                    const float rstd = (0.07216878364870323f * LOG2E) * rsq_(s * (1.0f / 64.0f) + EPS);
#pragma unroll
                    for (int bj = 0; bj < 2; ++bj)
#pragma unroll
                        for (int n = 0; n < 2; ++n) y[bj][n] = y[bj][n] * rstd * qg_[bj][n];
                    { const int t = (j9 - 1) * 256 + rr, grow = t >> 6, gcol = t & 63;
#pragma unroll
                        for (int bj = 0; bj < 2; ++bj) { const LAS f32x2* tab = bj ? (ropeC + gcol * 16 + 4 * fq) : (ropeR + grow * 16 + 4 * fq);
                            const f32x4 t0 = *(const LAS f32x4*)tab, t1 = *(const LAS f32x4*)(tab + 2);
                            const float cs[4] = {t0[0], t0[2], t1[0], t1[2]}, sn[4] = {t0[1], t0[3], t1[1], t1[3]};
#pragma unroll
                            for (int e = 0; e < 4; ++e) { const float x1 = y[bj][0][e], x2 = y[bj][1][e]; y[bj][0][e] = x1 * cs[e] - x2 * sn[e]; y[bj][1][e] = x1 * sn[e] + x2 * cs[e]; } } }
#pragma unroll
                    for (int bj = 0; bj < 2; ++bj) st16(Q1 + pil((int)R, h * 192 + 128 + 32 * bj + 8 * fq, 1536), pack8(y[bj][0], y[bj][1]));
                    asm volatile("" ::: "memory");
                }
        }
    }
};

struct EpiUkv {
    static constexpr bool PERM = true, AFTER_DRAIN = false;
    bf16 *Kn, *V1; const float* ssq; const float* kng; LAS float* xl;
    __device__ __forceinline__ void operator()(const f32x4 (&acc)[2][2][4][2], const Unit& u, int wr, int wc, int fr, int fq) const {
        const int h = u.pn;
        LAS float* rqL = (LAS float*)((LAS unsigned char*)xl + (LDS_RQ - LDS_XCH));
        { const int t_ = (int)threadIdx.x; if (t_ < 256) { const f32x4 s0 = *(const f32x4*)(ssq + ((size_t)u.pm * 256 + t_) * 12);
            rqL[t_] = rsq_(((s0[0] + s0[1]) + (s0[2] + s0[3])) * (1.0f / 256.0f) + EPS); } }
#pragma unroll
        for (int ai = 0; ai < 2; ++ai)
#pragma unroll
            for (int m = 0; m < 4; ++m) { float s = 0.f;
#pragma unroll
                for (int n = 0; n < 2; ++n) { const f32x4 x = acc[ai][0][m][n]; s += (x[0] * x[0] + x[1] * x[1]) + (x[2] * x[2] + x[3] * x[3]); }
                s += __shfl_xor(s, 16); s += __shfl_xor(s, 32);
                if (fq == 0) xl[(ai * 128 + wr * 64 + m * 16 + fr) * 4 + wc] = s; }
        f32x4 g[2];
#pragma unroll
        for (int n = 0; n < 2; ++n) g[n] = *(const f32x4*)(kng + wc * 32 + 8 * fq + 4 * n);
        EPI_BAR();
#pragma unroll
        for (int ai = 0; ai < 2; ++ai)
#pragma unroll
            for (int m = 0; m < 4; ++m) { const int rr = opaque(ai * 128 + wr * 64 + m * 16 + fr); const size_t R = (size_t)u.pm * 256 + rr;
                const float rk = rqL[rr];
                const f32x4 p = *(const LAS f32x4*)(xl + rr * 4);
                const float rstd = rk * rsq_(((p[0] + p[1]) + (p[2] + p[3])) * (rk * rk) * (1.0f / 128.0f) + EPS);
                st16(Kn + pil((int)R, h * 128 + wc * 32 + 8 * fq, 1024), pack8(acc[ai][0][m][0] * rstd * g[0], acc[ai][0][m][1] * rstd * g[1]));
                st16(V1 + pil((int)R, h * 128 + wc * 32 + 8 * fq, 1024), pack8(acc[ai][1][m][0] * rk, acc[ai][1][m][1] * rk)); asm volatile("" ::: "memory"); }
        EPI_BAR();
    }
};

typedef short s16x4 __attribute__((ext_vector_type(4)));
#define KSWZ64(row, colB) ((row) * 128 + ((colB) ^ (((row) & 7) << 4)))
__device__ __forceinline__ unsigned cvtpk(float lo, float hi) { unsigned r; asm volatile("v_cvt_pk_bf16_f32 %0, %1, %2" : "=v"(r) : "v"(lo), "v"(hi)); return r; }
__device__ __forceinline__ int v_st(int k, int c) { const int kk = (k & ~0xC) | ((k & 4) << 1) | ((k & 8) >> 1); return ((kk >> 3) * 4 + (c >> 5)) * 512 + ((kk & 7) * 32 + (c & 31)) * 2; }
__device__ __forceinline__ int v_rd_base(int lane) { return ((lane & 3) << 3) | (((lane >> 2) & 3) << 6) | (((lane >> 4) & 1) << 5) | (((lane >> 5) & 1) << 8); }
constexpr int v_rd_off(int d0, int ks, int half) { return d0 * 512 + ks * 4096 + half * 2048; }
template <int OFF> __device__ __forceinline__ s16x4 tr_read(int vb) { s16x4 r; asm volatile("ds_read_b64_tr_b16 %0, %1 offset:%2" : "=&v"(r) : "v"(vb), "i"(OFF) : "memory"); return r; }
template <int D0> __device__ __forceinline__ void pv_one(f32x16& od, int vb, bf16x8 pa0, bf16x8 pa1, bf16x8 pa2, bf16x8 pa3) {
    const s16x4 l0 = tr_read<v_rd_off(D0, 0, 0)>(vb), h0 = tr_read<v_rd_off(D0, 0, 1)>(vb), l1 = tr_read<v_rd_off(D0, 1, 0)>(vb), h1 = tr_read<v_rd_off(D0, 1, 1)>(vb);
    const s16x4 l2 = tr_read<v_rd_off(D0, 2, 0)>(vb), h2 = tr_read<v_rd_off(D0, 2, 1)>(vb), l3 = tr_read<v_rd_off(D0, 3, 0)>(vb), h3 = tr_read<v_rd_off(D0, 3, 1)>(vb);
    asm volatile("s_waitcnt lgkmcnt(0)" ::: "memory"); __builtin_amdgcn_sched_barrier(0);
#define PKV(L, H) (bf16x8){L[0], L[1], L[2], L[3], H[0], H[1], H[2], H[3]}
    od = __builtin_amdgcn_mfma_f32_32x32x16_bf16(pa0, PKV(l0, h0), od, 0, 0, 0);
    od = __builtin_amdgcn_mfma_f32_32x32x16_bf16(pa1, PKV(l1, h1), od, 0, 0, 0);
    od = __builtin_amdgcn_mfma_f32_32x32x16_bf16(pa2, PKV(l2, h2), od, 0, 0, 0);
    od = __builtin_amdgcn_mfma_f32_32x32x16_bf16(pa3, PKV(l3, h3), od, 0, 0, 0);
#undef PKV
}
#define TRR8(D0, L0_, H0_, L1_, H1_, L2_, H2_, L3_, H3_) do { L0_ = tr_read<v_rd_off(D0, 0, 0)>(vb); H0_ = tr_read<v_rd_off(D0, 0, 1)>(vb); L1_ = tr_read<v_rd_off(D0, 1, 0)>(vb); H1_ = tr_read<v_rd_off(D0, 1, 1)>(vb); \
        L2_ = tr_read<v_rd_off(D0, 2, 0)>(vb); H2_ = tr_read<v_rd_off(D0, 2, 1)>(vb); L3_ = tr_read<v_rd_off(D0, 3, 0)>(vb); H3_ = tr_read<v_rd_off(D0, 3, 1)>(vb); } while (0)
#define PKVV(L, H) (bf16x8){L[0], L[1], L[2], L[3], H[0], H[1], H[2], H[3]}
#define MMA4(OD, L0_, H0_, L1_, H1_, L2_, H2_, L3_, H3_) do { OD = __builtin_amdgcn_mfma_f32_32x32x16_bf16(pa0, PKVV(L0_, H0_), OD, 0, 0, 0); OD = __builtin_amdgcn_mfma_f32_32x32x16_bf16(pa1, PKVV(L1_, H1_), OD, 0, 0, 0); \
        OD = __builtin_amdgcn_mfma_f32_32x32x16_bf16(pa2, PKVV(L2_, H2_), OD, 0, 0, 0); OD = __builtin_amdgcn_mfma_f32_32x32x16_bf16(pa3, PKVV(L3_, H3_), OD, 0, 0, 0); } while (0)
__device__ __forceinline__ void pv_all(f32x16 (&o)[4], int vb, bf16x8 pa0, bf16x8 pa1, bf16x8 pa2, bf16x8 pa3) {
    s16x4 a0, b0, a1, b1, a2, b2, a3, b3, c0, d0, c1, d1, c2, d2, c3, d3;
    TRR8(0, a0, b0, a1, b1, a2, b2, a3, b3); TRR8(1, c0, d0, c1, d1, c2, d2, c3, d3);
    asm volatile("s_waitcnt lgkmcnt(0)" ::: "memory"); __builtin_amdgcn_sched_barrier(0);
    MMA4(o[0], a0, b0, a1, b1, a2, b2, a3, b3);
    __builtin_amdgcn_sched_barrier(0);
    s16x4 e0, f0, e1, f1, e2, f2, e3, f3;
    TRR8(2, e0, f0, e1, f1, e2, f2, e3, f3);
    __builtin_amdgcn_sched_barrier(0);
    MMA4(o[1], c0, d0, c1, d1, c2, d2, c3, d3);
    __builtin_amdgcn_sched_barrier(0);
    TRR8(3, a0, b0, a1, b1, a2, b2, a3, b3);
    asm volatile("s_waitcnt lgkmcnt(0)" ::: "memory"); __builtin_amdgcn_sched_barrier(0);
    MMA4(o[2], e0, f0, e1, f1, e2, f2, e3, f3);
    MMA4(o[3], a0, b0, a1, b1, a2, b2, a3, b3);
}
__device__ __forceinline__ void pv_all2(f32x16 (&o)[4], int vb, bf16x8 pa0, bf16x8 pa1, bf16x8 pa2, bf16x8 pa3) {
    s16x4 a0, b0, a1, b1, a2, b2, a3, b3, c0, d0, c1, d1, c2, d2, c3, d3;
    TRR8(0, a0, b0, a1, b1, a2, b2, a3, b3);
    asm volatile("s_waitcnt lgkmcnt(0)" ::: "memory"); __builtin_amdgcn_sched_barrier(0);
    TRR8(1, c0, d0, c1, d1, c2, d2, c3, d3);
    __builtin_amdgcn_sched_barrier(0);
    MMA4(o[0], a0, b0, a1, b1, a2, b2, a3, b3);
    __builtin_amdgcn_sched_barrier(0);
    asm volatile("s_waitcnt lgkmcnt(0)" ::: "memory"); __builtin_amdgcn_sched_barrier(0);
    TRR8(2, a0, b0, a1, b1, a2, b2, a3, b3);
    __builtin_amdgcn_sched_barrier(0);
    MMA4(o[1], c0, d0, c1, d1, c2, d2, c3, d3);
    __builtin_amdgcn_sched_barrier(0);
    asm volatile("s_waitcnt lgkmcnt(0)" ::: "memory"); __builtin_amdgcn_sched_barrier(0);
    TRR8(3, c0, d0, c1, d1, c2, d2, c3, d3);
    __builtin_amdgcn_sched_barrier(0);
    MMA4(o[2], a0, b0, a1, b1, a2, b2, a3, b3);
    __builtin_amdgcn_sched_barrier(0);
    asm volatile("s_waitcnt lgkmcnt(0)" ::: "memory"); __builtin_amdgcn_sched_barrier(0);
    MMA4(o[3], c0, d0, c1, d1, c2, d2, c3, d3);
}
#define PK4(P, BASE, OUT) do { unsigned a0 = cvtpk(P[BASE + 0], P[BASE + 1]), a1 = cvtpk(P[BASE + 2], P[BASE + 3]);   \
    unsigned b0 = cvtpk(P[BASE + 4], P[BASE + 5]), b1 = cvtpk(P[BASE + 6], P[BASE + 7]);                              \
    auto r0 = __builtin_amdgcn_permlane32_swap(a0, b0, false, false); auto r1 = __builtin_amdgcn_permlane32_swap(a1, b1, false, false); \
    v4u w = {r0[0], r1[0], r0[1], r1[1]}; OUT = __builtin_bit_cast(bf16x8, w); } while (0)

#define PK4B(P, BASE, OUT) do { unsigned a0 = cvtpk_b(P[BASE + 0], P[BASE + 1]), a1 = cvtpk_b(P[BASE + 2], P[BASE + 3]);   \
    unsigned b0 = cvtpk_b(P[BASE + 4], P[BASE + 5]), b1 = cvtpk_b(P[BASE + 6], P[BASE + 7]);                              \
    auto r0 = __builtin_amdgcn_permlane32_swap(a0, b0, false, false); auto r1 = __builtin_amdgcn_permlane32_swap(a1, b1, false, false); \
    v4u w = {r0[0], r1[0], r0[1], r1[1]}; OUT = __builtin_bit_cast(bf16x8, w); } while (0)

template <int NSUB, bool PILKV = false>
__device__ __forceinline__ void attn_pass(f32x16 (&o)[4], float& l_acc, const bf16x8 (&qf)[NSUB * 4], const bf16* k0, const bf16* k1, const bf16* k2, int ld0, int ld1, int ld2,
                                          const bf16* vsrc, int vld, int nkeys, LAS unsigned char* lds) {
    constexpr int BUF = NSUB * 8192 + 16384;
    const int tid = opaque((int)threadIdx.x), lane = tid & 63, r32 = lane & 31, hh = lane >> 5;
    const int krow = tid >> 3, kch = tid & 7, sr = tid >> 4, sc = (tid & 15) * 8;
    const int kdst = KSWZ64(krow, kch * 16), vst0 = NSUB * 8192 + v_st(sr, sc), vst1 = NSUB * 8192 + v_st(32 + sr, sc);
    const int vb0 = (int)(unsigned)(uintptr_t)lds + NSUB * 8192 + v_rd_base(lane);
    const int ka0 = r32 * 128, ka1 = (32 + r32) * 128;
    bf16x8 sk0, sk1, sk2, sv0, sv1;
#define ALOAD(key0) do { sk0 = PILKV ? *(const bf16x8*)(k0 + (size_t)(key0) * ld0) : *(const bf16x8*)(k0 + (size_t)((key0) + krow) * ld0 + kch * 8); \
        if (NSUB > 1) sk1 = PILKV ? *(const bf16x8*)(k1 + (size_t)(key0) * ld1) : *(const bf16x8*)(k1 + (size_t)((key0) + krow) * ld1 + kch * 8); \
        if (NSUB > 2) sk2 = *(const bf16x8*)(k2 + (size_t)((key0) + krow) * ld2 + kch * 8); \
        sv0 = PILKV ? *(const bf16x8*)(vsrc + (size_t)(key0) * vld) : *(const bf16x8*)(vsrc + (size_t)((key0) + sr) * vld + sc); \
        sv1 = PILKV ? *(const bf16x8*)(vsrc + (size_t)((key0) + 32) * vld) : *(const bf16x8*)(vsrc + (size_t)((key0) + 32 + sr) * vld + sc); } while (0)
#define AWRITE(b) do { LAS unsigned char* bb = lds + (b) * BUF; *(LAS bf16x8*)(bb + kdst) = sk0; if (NSUB > 1) *(LAS bf16x8*)(bb + 8192 + kdst) = sk1; if (NSUB > 2) *(LAS bf16x8*)(bb + 16384 + kdst) = sk2; \
        *(LAS bf16x8*)(bb + vst0) = sv0; *(LAS bf16x8*)(bb + vst1) = sv1; } while (0)
    const int NT = nkeys >> 6;
    ALOAD(0); AWRITE(0); __syncthreads();
    for (int t = 0; t < NT; ++t) {
        const int b = t & 1;
        if (t + 1 < NT) ALOAD((t + 1) * 64);
        const LAS unsigned char* kb = lds + b * BUF;
        f32x16 p0, p1;
#pragma unroll
        for (int r = 0; r < 16; ++r) { p0[r] = 0.f; p1[r] = 0.f; }
#pragma unroll
        for (int s = 0; s < NSUB; ++s)
#pragma unroll
            for (int ks = 0; ks < 4; ++ks) { const int cb = (ks * 16 + hh * 8) * 2, x = (r32 & 7) << 4;
                const bf16x8 b0 = *(const LAS bf16x8*)(kb + s * 8192 + ka0 + (cb ^ x)), b1 = *(const LAS bf16x8*)(kb + s * 8192 + ka1 + (cb ^ x));
                p0 = __builtin_amdgcn_mfma_f32_32x32x16_bf16(b0, qf[s * 4 + ks], p0, 0, 0, 0);
                p1 = __builtin_amdgcn_mfma_f32_32x32x16_bf16(b1, qf[s * 4 + ks], p1, 0, 0, 0); }
        float ps = 0.f;
#pragma unroll
        for (int r = 0; r < 16; ++r) { p0[r] = __builtin_amdgcn_exp2f(p0[r]); p1[r] = __builtin_amdgcn_exp2f(p1[r]); ps += p0[r] + p1[r]; }
        l_acc += ps;
        bf16x8 pa0, pa1, pa2, pa3;
        PK4(p0, 0, pa0); PK4(p0, 8, pa1); PK4(p1, 0, pa2); PK4(p1, 8, pa3);
        const int vb = vb0 + b * BUF;
        pv_all(o, vb, pa0, pa1, pa2, pa3);
        if (t + 1 < NT) AWRITE(b ^ 1);
        __syncthreads();
    }
#undef ALOAD
#undef AWRITE
}

#define TRR4(D0, KS0, L0_, H0_, L1_, H1_) do { L0_ = tr_read<v_rd_off(D0, KS0, 0)>(vb); H0_ = tr_read<v_rd_off(D0, KS0, 1)>(vb); L1_ = tr_read<v_rd_off(D0, KS0 + 1, 0)>(vb); H1_ = tr_read<v_rd_off(D0, KS0 + 1, 1)>(vb); } while (0)
template <int NSUB, bool PILKV = false>
__device__ __forceinline__ void attn_pass_v2(f32x16 (&o)[4], float& l_acc, const bf16x8 (&qf)[NSUB * 4], const bf16* k0, const bf16* k1, const bf16* k2, int ld0, int ld1, int ld2,
                                             const bf16* vsrc, int vld, int nkeys, LAS unsigned char* lds) {
    constexpr int BUF = NSUB * 8192 + 16384, NK = NSUB * 4;
    const int tid = opaque((int)threadIdx.x), lane = tid & 63, r32 = lane & 31, hh = lane >> 5;
    const int krow = tid >> 3, kch = tid & 7, sr = tid >> 4, sc = (tid & 15) * 8;
    const int kdst = KSWZ64(krow, kch * 16), vst0 = NSUB * 8192 + v_st(sr, sc), vst1 = NSUB * 8192 + v_st(32 + sr, sc);
    const int vb0 = (int)(unsigned)(uintptr_t)lds + NSUB * 8192 + v_rd_base(lane);
    const int ka0 = r32 * 128, ka1 = (32 + r32) * 128;
    bf16x8 sk0, sk1, sk2, sv0, sv1;
#define ALOAD(key0) do { sk0 = PILKV ? *(const bf16x8*)(k0 + (size_t)(key0) * ld0) : *(const bf16x8*)(k0 + (size_t)((key0) + krow) * ld0 + kch * 8); \
        if (NSUB > 1) sk1 = PILKV ? *(const bf16x8*)(k1 + (size_t)(key0) * ld1) : *(const bf16x8*)(k1 + (size_t)((key0) + krow) * ld1 + kch * 8); \
        if (NSUB > 2) sk2 = *(const bf16x8*)(k2 + (size_t)((key0) + krow) * ld2 + kch * 8); \
        sv0 = PILKV ? *(const bf16x8*)(vsrc + (size_t)(key0) * vld) : *(const bf16x8*)(vsrc + (size_t)((key0) + sr) * vld + sc); \
        sv1 = PILKV ? *(const bf16x8*)(vsrc + (size_t)((key0) + 32) * vld) : *(const bf16x8*)(vsrc + (size_t)((key0) + 32 + sr) * vld + sc); } while (0)
#define AWRITE(b) do { LAS unsigned char* bb = lds + (b) * BUF; *(LAS bf16x8*)(bb + kdst) = sk0; if (NSUB > 1) *(LAS bf16x8*)(bb + 8192 + kdst) = sk1; if (NSUB > 2) *(LAS bf16x8*)(bb + 16384 + kdst) = sk2; \
        *(LAS bf16x8*)(bb + vst0) = sv0; *(LAS bf16x8*)(bb + vst1) = sv1; } while (0)
    const int NT = nkeys >> 6;
    ALOAD(0); AWRITE(0); __syncthreads();
    for (int t = 0; t < NT; ++t) {
        const int b = t & 1;
        if (t + 1 < NT) ALOAD((t + 1) * 64);
        const LAS unsigned char* kb = lds + b * BUF;
        const int vb = vb0 + b * BUF;
        const int x = (r32 & 7) << 4;
        f32x16 p0, p1;
#pragma unroll
        for (int r = 0; r < 16; ++r) { p0[r] = 0.f; p1[r] = 0.f; }
#pragma unroll
        for (int i = 0; i < NK; ++i) { const int cb = ((i & 3) * 16 + hh * 8) * 2;
            const bf16x8 kf = *(const LAS bf16x8*)(kb + (i >> 2) * 8192 + ka0 + (cb ^ x));
            p0 = __builtin_amdgcn_mfma_f32_32x32x16_bf16(kf, qf[i], p0, 0, 0, 0); }
        __builtin_amdgcn_sched_barrier(0);
        float ps = 0.f;
#pragma unroll
        for (int i = 0; i < NK; ++i) { const int cb = ((i & 3) * 16 + hh * 8) * 2;
            const bf16x8 kf = *(const LAS bf16x8*)(kb + (i >> 2) * 8192 + ka1 + (cb ^ x));
            p1 = __builtin_amdgcn_mfma_f32_32x32x16_bf16(kf, qf[i], p1, 0, 0, 0);
            if (i >= NK - 8) { const int r = 2 * (i - (NK - 8)); p0[r] = __builtin_amdgcn_exp2f(p0[r]); p0[r + 1] = __builtin_amdgcn_exp2f(p0[r + 1]); ps += p0[r] + p0[r + 1]; } }
        bf16x8 pa0, pa1, pa2, pa3;
        PK4(p0, 0, pa0); PK4(p0, 8, pa1);
        s16x4 a0, b0, a1, b1, a2, b2, a3, b3, c0, d0, c1, d1, c2, d2, c3, d3;
        TRR4(0, 0, a0, b0, a1, b1); TRR4(1, 0, a2, b2, a3, b3); TRR4(2, 0, c0, d0, c1, d1); TRR4(3, 0, c2, d2, c3, d3);
        asm volatile("s_waitcnt lgkmcnt(0)" ::: "memory"); __builtin_amdgcn_sched_barrier(0);
#define EXP2P1(r_) do { p1[r_] = __builtin_amdgcn_exp2f(p1[r_]); p1[(r_) + 1] = __builtin_amdgcn_exp2f(p1[(r_) + 1]); ps += p1[r_] + p1[(r_) + 1]; } while (0)
        o[0] = __builtin_amdgcn_mfma_f32_32x32x16_bf16(pa0, PKVV(a0, b0), o[0], 0, 0, 0); EXP2P1(0);
        o[1] = __builtin_amdgcn_mfma_f32_32x32x16_bf16(pa0, PKVV(a2, b2), o[1], 0, 0, 0); EXP2P1(2);
        o[2] = __builtin_amdgcn_mfma_f32_32x32x16_bf16(pa0, PKVV(c0, d0), o[2], 0, 0, 0); EXP2P1(4);
        o[3] = __builtin_amdgcn_mfma_f32_32x32x16_bf16(pa0, PKVV(c2, d2), o[3], 0, 0, 0); EXP2P1(6);
        o[0] = __builtin_amdgcn_mfma_f32_32x32x16_bf16(pa1, PKVV(a1, b1), o[0], 0, 0, 0); EXP2P1(8);
        o[1] = __builtin_amdgcn_mfma_f32_32x32x16_bf16(pa1, PKVV(a3, b3), o[1], 0, 0, 0); EXP2P1(10);
        o[2] = __builtin_amdgcn_mfma_f32_32x32x16_bf16(pa1, PKVV(c1, d1), o[2], 0, 0, 0); EXP2P1(12);
        o[3] = __builtin_amdgcn_mfma_f32_32x32x16_bf16(pa1, PKVV(c3, d3), o[3], 0, 0, 0); EXP2P1(14);
#undef EXP2P1
        l_acc += ps;
        PK4(p1, 0, pa2); PK4(p1, 8, pa3);
        __builtin_amdgcn_sched_barrier(0);
        TRR4(0, 2, a0, b0, a1, b1); TRR4(1, 2, a2, b2, a3, b3); TRR4(2, 2, c0, d0, c1, d1); TRR4(3, 2, c2, d2, c3, d3);
        asm volatile("s_waitcnt lgkmcnt(0)" ::: "memory"); __builtin_amdgcn_sched_barrier(0);
        o[0] = __builtin_amdgcn_mfma_f32_32x32x16_bf16(pa2, PKVV(a0, b0), o[0], 0, 0, 0); o[1] = __builtin_amdgcn_mfma_f32_32x32x16_bf16(pa2, PKVV(a2, b2), o[1], 0, 0, 0);
        o[2] = __builtin_amdgcn_mfma_f32_32x32x16_bf16(pa2, PKVV(c0, d0), o[2], 0, 0, 0); o[3] = __builtin_amdgcn_mfma_f32_32x32x16_bf16(pa2, PKVV(c2, d2), o[3], 0, 0, 0);
        o[0] = __builtin_amdgcn_mfma_f32_32x32x16_bf16(pa3, PKVV(a1, b1), o[0], 0, 0, 0); o[1] = __builtin_amdgcn_mfma_f32_32x32x16_bf16(pa3, PKVV(a3, b3), o[1], 0, 0, 0);
        o[2] = __builtin_amdgcn_mfma_f32_32x32x16_bf16(pa3, PKVV(c1, d1), o[2], 0, 0, 0); o[3] = __builtin_amdgcn_mfma_f32_32x32x16_bf16(pa3, PKVV(c3, d3), o[3], 0, 0, 0);
        if (t + 1 < NT) AWRITE(b ^ 1);
        __syncthreads();
    }
#undef ALOAD
#undef AWRITE
}

template <int D0> __device__ __forceinline__ void pv_two(f32x16& oa, f32x16& ob, int vb, bf16x8 pa0, bf16x8 pa1, bf16x8 pa2, bf16x8 pa3, bf16x8 pb0, bf16x8 pb1, bf16x8 pb2, bf16x8 pb3) {
    const s16x4 l0 = tr_read<v_rd_off(D0, 0, 0)>(vb), h0 = tr_read<v_rd_off(D0, 0, 1)>(vb), l1 = tr_read<v_rd_off(D0, 1, 0)>(vb), h1 = tr_read<v_rd_off(D0, 1, 1)>(vb);
    const s16x4 l2 = tr_read<v_rd_off(D0, 2, 0)>(vb), h2 = tr_read<v_rd_off(D0, 2, 1)>(vb), l3 = tr_read<v_rd_off(D0, 3, 0)>(vb), h3 = tr_read<v_rd_off(D0, 3, 1)>(vb);
    asm volatile("s_waitcnt lgkmcnt(0)" ::: "memory"); __builtin_amdgcn_sched_barrier(0);
#define PKV(L, H) (bf16x8){L[0], L[1], L[2], L[3], H[0], H[1], H[2], H[3]}
    const bf16x8 v0 = PKV(l0, h0), v1 = PKV(l1, h1), v2 = PKV(l2, h2), v3 = PKV(l3, h3);
    oa = __builtin_amdgcn_mfma_f32_32x32x16_bf16(pa0, v0, oa, 0, 0, 0); ob = __builtin_amdgcn_mfma_f32_32x32x16_bf16(pb0, v0, ob, 0, 0, 0);
    oa = __builtin_amdgcn_mfma_f32_32x32x16_bf16(pa1, v1, oa, 0, 0, 0); ob = __builtin_amdgcn_mfma_f32_32x32x16_bf16(pb1, v1, ob, 0, 0, 0);
    oa = __builtin_amdgcn_mfma_f32_32x32x16_bf16(pa2, v2, oa, 0, 0, 0); ob = __builtin_amdgcn_mfma_f32_32x32x16_bf16(pb2, v2, ob, 0, 0, 0);
    oa = __builtin_amdgcn_mfma_f32_32x32x16_bf16(pa3, v3, oa, 0, 0, 0); ob = __builtin_amdgcn_mfma_f32_32x32x16_bf16(pb3, v3, ob, 0, 0, 0);
#undef PKV
}
#define KSWZ256(row, colB) ((row) * 256 + ((colB) ^ (((row) & 7) << 4)))
__device__ __forceinline__ void diff_attn_unit_v2(Frame& F, int a) {
    const int tid = opaque((int)threadIdx.x), lane = tid & 63, r32 = lane & 31, hh = lane >> 5, wid = F.wave;
    int b, h, q0, nkeys;
    if (a < 256) { b = a >> 5; h = (a >> 3) & 3; q0 = b * RPB + CTXL + (a & 7) * 256; nkeys = RPB; } else { const int a2 = a - 256; b = a2 >> 2; h = a2 & 3; q0 = b * RPB; nkeys = CTXL; }
    const bf16* Qd = (const bf16*)(F.big_() + B_QD); const bf16* Kd = (const bf16*)(F.big_() + B_KD); const bf16* Vd = (const bf16*)(F.big_() + B_VD);
    const int brow = b * RPB;
    LAS unsigned char* lds = F.lds;
    constexpr int BUF = 32768;
    LAS unsigned char* Qw = lds + 65536 + wid * 8192;
#pragma unroll
    for (int it = 0; it < 8; ++it) { const int row = it * 4 + (lane >> 4), ch = lane & 15;
        *(LAS bf16x8*)(Qw + KSWZ256(row, ch * 16)) = *(const bf16x8*)(Qd + (size_t)(q0 + wid * 32 + row) * 512 + h * 128 + ch * 8); }
    const int krow = tid >> 3, kch = tid & 7, sr = tid >> 4, sc = (tid & 15) * 8;
    const int kdst = KSWZ64(krow, kch * 16), vst0 = 16384 + v_st(sr, sc), vst1 = 16384 + v_st(32 + sr, sc);
    const int vb0 = (int)(unsigned)(uintptr_t)lds + 16384 + v_rd_base(lane);
    const int xs = (r32 & 7) << 4;
    int x4[4];
#pragma unroll
    for (int ks = 0; ks < 4; ++ks) x4[ks] = ((ks * 16 + hh * 8) * 2) ^ xs;
    const int qb_ = (int)(unsigned)(uintptr_t)Qw + r32 * 256, kb_ = (int)(unsigned)(uintptr_t)lds + r32 * 128;
    bf16x8 sk0, sk1, sv0, sv1;
    const bf16* kbase = Kd + (size_t)brow * 512 + h * 128; const bf16* vsrc = Vd + (size_t)brow * 512 + h * 128;
#define DLOAD(key0) do { sk0 = *(const bf16x8*)(kbase + (size_t)((key0) + krow) * 512 + kch * 8); sk1 = *(const bf16x8*)(kbase + 64 + (size_t)((key0) + krow) * 512 + kch * 8); \
        sv0 = *(const bf16x8*)(vsrc + (size_t)((key0) + sr) * 512 + sc); sv1 = *(const bf16x8*)(vsrc + (size_t)((key0) + 32 + sr) * 512 + sc); } while (0)
#define DWRITE(bi) do { LAS unsigned char* bb = lds + (bi) * BUF; *(LAS bf16x8*)(bb + kdst) = sk0; *(LAS bf16x8*)(bb + 8192 + kdst) = sk1; *(LAS bf16x8*)(bb + vst0) = sv0; *(LAS bf16x8*)(bb + vst1) = sv1; } while (0)
    f32x16 O0[4], O1[4];
#pragma unroll
    for (int d = 0; d < 4; ++d)
#pragma unroll
        for (int r = 0; r < 16; ++r) { O0[d][r] = 0.f; O1[d][r] = 0.f; }
    float l0 = 0.f, l1 = 0.f;
    const int NT = nkeys >> 6;
    DLOAD(0); DWRITE(0); __syncthreads();
    for (int t = 0; t < NT; ++t) {
        const int bi = t & 1;
        if (t + 1 < NT) DLOAD((t + 1) * 64);
        const int kbo = opaque(kb_ + bi * BUF), qbo = opaque(qb_);
        const int vb = vb0 + bi * BUF;
        __builtin_amdgcn_sched_barrier(0);
        {   f32x16 p0, p1; bf16x8 pa0, pa1, pa2, pa3;
#pragma unroll
            for (int r = 0; r < 16; ++r) { p0[r] = 0.f; p1[r] = 0.f; }
#pragma unroll
            for (int ks = 0; ks < 4; ++ks) {
                const bf16x8 qv = *(const LAS bf16x8*)(uintptr_t)(unsigned)(qbo + x4[ks]);
                const bf16x8 k0v = *(const LAS bf16x8*)(uintptr_t)(unsigned)(kbo + x4[ks]), k1v = *(const LAS bf16x8*)(uintptr_t)(unsigned)(kbo + x4[ks] + 4096);
                p0 = __builtin_amdgcn_mfma_f32_32x32x16_bf16(k0v, qv, p0, 0, 0, 0); p1 = __builtin_amdgcn_mfma_f32_32x32x16_bf16(k1v, qv, p1, 0, 0, 0); }
            float ps = 0.f;
#pragma unroll
            for (int r = 0; r < 16; ++r) { p0[r] = __builtin_amdgcn_exp2f(p0[r]); p1[r] = __builtin_amdgcn_exp2f(p1[r]); ps += p0[r] + p1[r]; }
            l0 += ps;
            PK4(p0, 0, pa0); PK4(p0, 8, pa1); PK4(p1, 0, pa2); PK4(p1, 8, pa3);
            pv_one<0>(O0[0], vb, pa0, pa1, pa2, pa3); pv_one<1>(O0[1], vb, pa0, pa1, pa2, pa3); pv_one<2>(O0[2], vb, pa0, pa1, pa2, pa3); pv_one<3>(O0[3], vb, pa0, pa1, pa2, pa3); }
        __builtin_amdgcn_sched_barrier(0);
        {   f32x16 p0, p1; bf16x8 pa0, pa1, pa2, pa3;
#pragma unroll
            for (int r = 0; r < 16; ++r) { p0[r] = 0.f; p1[r] = 0.f; }
#pragma unroll
            for (int ks = 0; ks < 4; ++ks) {
                const bf16x8 qv = *(const LAS bf16x8*)(uintptr_t)(unsigned)(qbo + x4[ks] + 128);
                const bf16x8 k0v = *(const LAS bf16x8*)(uintptr_t)(unsigned)(kbo + x4[ks] + 8192), k1v = *(const LAS bf16x8*)(uintptr_t)(unsigned)(kbo + x4[ks] + 8192 + 4096);
                p0 = __builtin_amdgcn_mfma_f32_32x32x16_bf16(k0v, qv, p0, 0, 0, 0); p1 = __builtin_amdgcn_mfma_f32_32x32x16_bf16(k1v, qv, p1, 0, 0, 0); }
            float ps = 0.f;
#pragma unroll
            for (int r = 0; r < 16; ++r) { p0[r] = __builtin_amdgcn_exp2f(p0[r]); p1[r] = __builtin_amdgcn_exp2f(p1[r]); ps += p0[r] + p1[r]; }
            l1 += ps;
            PK4(p0, 0, pa0); PK4(p0, 8, pa1); PK4(p1, 0, pa2); PK4(p1, 8, pa3);
            pv_one<0>(O1[0], vb, pa0, pa1, pa2, pa3); pv_one<1>(O1[1], vb, pa0, pa1, pa2, pa3); pv_one<2>(O1[2], vb, pa0, pa1, pa2, pa3); pv_one<3>(O1[3], vb, pa0, pa1, pa2, pa3); }
        __builtin_amdgcn_sched_barrier(0);
        if (t + 1 < NT) DWRITE(bi ^ 1);
        __syncthreads();
    }
#undef DLOAD
#undef DWRITE
    l0 += __shfl_xor(l0, 32); l1 += __shfl_xor(l1, 32);
    const float lam = F.lamv_()[0];
    const float* sg = F.ar->in[I_DSUBLN];
    float gsub[4];
#pragma unroll
    for (int d = 0; d < 4; ++d) gsub[d] = sg[d * 32 + r32] * 0.8f;
#pragma unroll
    for (int r = 0; r < 16; ++r) {
        const int qi = crow(r, hh);
        const float i0 = __builtin_amdgcn_rcpf(__shfl(l0, qi)), i1 = lam * __builtin_amdgcn_rcpf(__shfl(l1, qi));
        float o[4]; float s = 0.f;
#pragma unroll
        for (int d = 0; d < 4; ++d) { o[d] = O0[d][r] * i0 - O1[d][r] * i1; s += o[d] * o[d]; }
        s += __shfl_xor(s, 1); s += __shfl_xor(s, 2); s += __shfl_xor(s, 4); s += __shfl_xor(s, 8); s += __shfl_xor(s, 16);
        const float rstd = rsq_(s * (1.0f / 128.0f) + EPS);
        bf16* op = F.H_() + (size_t)(q0 + wid * 32 + qi) * D + h * 128 + r32;
#pragma unroll
        for (int d = 0; d < 4; ++d) op[d * 32] = (bf16)f2bf(o[d] * rstd * gsub[d]);
    }
}

__device__ __forceinline__ void mla_attn_unit_v1(Frame& F, int a) {
    const int lane = F.lane, r32 = lane & 31, hh = lane >> 5, wid = F.wave;
    const int b = a >> 6, h = (a >> 3) & 7, q0 = b * RPB + CTXL + (a & 7) * 256;
    const bf16* Q1 = (const bf16*)(F.big_() + B_Q1); const bf16* Kn = (const bf16*)(F.big_() + B_KN); const bf16* Kr = (const bf16*)(F.big_() + B_KR); const bf16* V1 = (const bf16*)(F.big_() + B_V1);
    const int tid_ = (int)threadIdx.x, krow_ = tid_ >> 3, kch_ = tid_ & 7, sr_ = tid_ >> 4, sc_ = (tid_ & 15) * 8;
    const bf16* knb = Kn + (size_t)b * RPB * 1024 + pil(krow_, h * 128 + kch_ * 8, 1024); const bf16* krb = Kr + (size_t)b * RPB * 64; const bf16* vb = V1 + (size_t)b * RPB * 1024 + pil(sr_, h * 128 + sc_, 1024);
    bf16x8 qf[12];
    { const bf16* qp = Q1 + (size_t)(q0 + wid * 32) * 1536;
#pragma unroll
        for (int ks = 0; ks < 12; ++ks) qf[ks] = *(const bf16x8*)(qp + pil(r32, h * 192 + ks * 16 + hh * 8, 1536)); }
    f32x16 o[4];
#pragma unroll
    for (int d = 0; d < 4; ++d)
#pragma unroll
        for (int r = 0; r < 16; ++r) o[d][r] = 0.f;
    float l0 = 0.f;
    attn_pass_v2<3, true>(o, l0, qf, knb, knb + 128, krb, 1024, 1024, 64, vb, 1024, RPB, F.lds);
    l0 += __shfl_xor(l0, 32);
#pragma unroll
    for (int r = 0; r < 16; ++r) { const int qi = crow(r, hh); const float i0 = 1.0f / __shfl(l0, qi);
        bf16* op = F.H_() + (size_t)(q0 + wid * 32 + qi) * D + h * 128 + r32;
#pragma unroll
        for (int d = 0; d < 4; ++d) op[d * 32] = (bf16)f2bf(o[d][r] * i0); }
}

constexpr int HL_LF = 0, HL_QR = 16384, HL_QT = 32768, HL_KT = 49152, HL_K2 = 65536, HL_VT = 81920, HL_S0 = 86016, HL_GC = 102400, HL_TOT = 102912, HL_PO = 104960;
__device__ __forceinline__ int tr_st(int k, int c, int NC) { const int kk = (k & ~0xC) | ((k & 4) << 1) | ((k & 8) >> 1); return ((kk >> 3) * NC + (c >> 5)) * 512 + ((kk & 7) * 32 + (c & 31)) * 2; }
constexpr int tr_off(int NC, int ks, int half) { return ((2 * ks + half) * NC) * 512; }
#define PKV2(L, H) (bf16x8){L[0], L[1], L[2], L[3], H[0], H[1], H[2], H[3]}
#define TRR(dst, vb, off) asm volatile("ds_read_b64_tr_b16 %0, %1 offset:%2" : "=&v"(dst) : "v"(vb), "i"(off) : "memory")
#define TRWAIT() do { asm volatile("s_waitcnt lgkmcnt(0)" ::: "memory"); __builtin_amdgcn_sched_barrier(0); } while (0)
template <int NC, int KS> __device__ __forceinline__ bf16x8 tr_frag(int vb) { const s16x4 l = tr_read<tr_off(NC, KS, 0)>(vb), h = tr_read<tr_off(NC, KS, 1)>(vb); asm volatile("s_waitcnt lgkmcnt(0)" ::: "memory"); __builtin_amdgcn_sched_barrier(0); return PKV2(l, h); }

__device__ __forceinline__ void hgrn_unit_v1(Frame& F, int a) {
    const int dvq = a & 3, dir = (a >> 2) & 1, h = (a >> 3) & 3, b = a >> 5;
    const bf16* Hq = (const bf16*)(F.big_() + B_HQ); const f16* Lf = (const f16*)(F.big_() + (dir ? B_LF1 : B_LF0)); const bf16* Hv = (const bf16*)(F.big_() + B_HV);
    bf16* Ho = (bf16*)(F.big_() + (dir ? B_HO1 : B_HO0));
    LAS unsigned char* L = F.lds;
    const int tid = opaque((int)threadIdx.x), lane = tid & 63, r32 = lane & 31, hh = lane >> 5, wid = F.wave;
    const int ldsb = (int)(unsigned)(uintptr_t)L;
    const int colo = h * 128;
    const int ltok0 = tid >> 4, lkch = tid & 15;
    const int vtok = tid >> 2, vch = tid & 3;
    const int sk = tid & 127, tq = tid >> 7;
    v4u rl0, rl1, rq0, rq1, rv;
    rv = (v4u){0u, 0u, 0u, 0u};
#define HG_ROW(p) ((size_t)b * RPB + (dir ? ((p) < CTXL ? CTXL - 1 - (p) : RPB + CTXL - 1 - (p)) : (p)))
#define HG_LOAD(n) do { const size_t R0 = HG_ROW((n) * 64 + ltok0), R1 = HG_ROW((n) * 64 + 32 + ltok0); \
        const int o0_ = pil((int)R0, colo + lkch * 8, 512), o1_ = pil((int)R1, colo + lkch * 8, 512); \
        rl0 = *(const v4u*)(Lf + o0_); rl1 = *(const v4u*)(Lf + o1_); rq0 = *(const v4u*)(Hq + o0_); rq1 = *(const v4u*)(Hq + o1_); \
        if (tid < 256) rv = *(const v4u*)(Hv + pil((int)HG_ROW((n) * 64 + vtok), colo + dvq * 32 + vch * 8, 512)); } while (0)
    f32x16 S;
#pragma unroll
    for (int r = 0; r < 16; ++r) S[r] = 0.f;
#define HG_FINISH2(nn) do { if (wid < 2) { const int ct_ = wid; const int pb_ = ((nn) & 1) ? LDS_XCH : HL_PO; f32x16 of_; \
        _Pragma("unroll") for (int g = 0; g < 4; ++g) { f32x4 p_ = *(const LAS f32x4*)(L + pb_ + ct_ * 4096 + lane * 64 + g * 16); p_ += *(const LAS f32x4*)(L + pb_ + (3 + ct_) * 4096 + lane * 64 + g * 16); \
            if (ct_) p_ += *(const LAS f32x4*)(L + pb_ + 2 * 4096 + lane * 64 + g * 16); of_[4 * g] = p_[0]; of_[4 * g + 1] = p_[1]; of_[4 * g + 2] = p_[2]; of_[4 * g + 3] = p_[3]; } \
        _Pragma("unroll") for (int r = 0; r < 16; ++r) { const int p = (nn) * 64 + 32 * ct_ + crow(r, hh); Ho[HG_ROW(p) * 512 + colo + dvq * 32 + r32] = (bf16)f2bf(of_[r]); } } } while (0)
    for (int e = tid; e < 512; e += NTHREADS) *(LAS v4u*)(L + HL_S0 + e * 16) = (v4u){0u, 0u, 0u, 0u};
    HG_LOAD(0);
    const int NCH = RPB / 64;
#define HG_SYNC() do { asm volatile("s_waitcnt lgkmcnt(0)" ::: "memory"); __builtin_amdgcn_s_barrier(); asm volatile("" ::: "memory"); } while (0)
    for (int n = 0; n < NCH; ++n) {
        SEC_BEGIN(1);
        *(LAS v4u*)(L + HL_LF + ltok0 * 256 + lkch * 16) = rl0; *(LAS v4u*)(L + HL_LF + (ltok0 + 32) * 256 + lkch * 16) = rl1;
        *(LAS v4u*)(L + HL_QR + ltok0 * 256 + lkch * 16) = rq0; *(LAS v4u*)(L + HL_QR + (ltok0 + 32) * 256 + lkch * 16) = rq1;
        HG_SYNC();
        float c[16], lf[16];
        { float run = 1.0f;
#pragma unroll
            for (int j = 0; j < 16; ++j) { lf[j] = (float)*(const LAS f16*)(L + HL_LF + (16 * tq + j) * 256 + sk * 2); run *= lf[j]; c[j] = run; }
            *(LAS float*)(L + HL_TOT + (tq * 128 + sk) * 4) = run; }
        HG_SYNC();
        {   const float t0 = *(const LAS float*)(L + HL_TOT + (0 * 128 + sk) * 4), t1 = *(const LAS float*)(L + HL_TOT + (1 * 128 + sk) * 4);
            const float t2 = *(const LAS float*)(L + HL_TOT + (2 * 128 + sk) * 4), t3 = *(const LAS float*)(L + HL_TOT + (3 * 128 + sk) * 4);
            const float off = (tq > 0 ? t0 : 1.0f) * (tq > 1 ? t1 : 1.0f) * (tq > 2 ? t2 : 1.0f), egC = (t0 * t1) * (t2 * t3);
            float qp[16], kp[16], k2[16];
#pragma unroll
            for (int j = 0; j < 16; ++j) { const float eg = off * c[j], kk = 1.0f - lf[j];
                const float q = bf2f(*(const LAS bf16*)(L + HL_QR + (16 * tq + j) * 256 + sk * 2));
                qp[j] = q * eg; kp[j] = kk * __builtin_amdgcn_rcpf(fmaxf(eg, 1.8e-35f)); k2[j] = kp[j] * egC; }
            const int to = tr_st(sk, 16 * tq, 2);
            *(LAS v4u*)(L + HL_QT + to) = (v4u){cvtpk_b(qp[0], qp[1]), cvtpk_b(qp[2], qp[3]), cvtpk_b(qp[4], qp[5]), cvtpk_b(qp[6], qp[7])};
            *(LAS v4u*)(L + HL_QT + to + 16) = (v4u){cvtpk_b(qp[8], qp[9]), cvtpk_b(qp[10], qp[11]), cvtpk_b(qp[12], qp[13]), cvtpk_b(qp[14], qp[15])};
            *(LAS v4u*)(L + HL_KT + to) = (v4u){cvtpk_b(kp[0], kp[1]), cvtpk_b(kp[2], kp[3]), cvtpk_b(kp[4], kp[5]), cvtpk_b(kp[6], kp[7])};
            *(LAS v4u*)(L + HL_KT + to + 16) = (v4u){cvtpk_b(kp[8], kp[9]), cvtpk_b(kp[10], kp[11]), cvtpk_b(kp[12], kp[13]), cvtpk_b(kp[14], kp[15])};
            *(LAS v4u*)(L + HL_K2 + KSWZ64(sk, 32 * tq)) = (v4u){cvtpk_b(k2[0], k2[1]), cvtpk_b(k2[2], k2[3]), cvtpk_b(k2[4], k2[5]), cvtpk_b(k2[6], k2[7])};
            *(LAS v4u*)(L + HL_K2 + KSWZ64(sk, 32 * tq + 16)) = (v4u){cvtpk_b(k2[8], k2[9]), cvtpk_b(k2[10], k2[11]), cvtpk_b(k2[12], k2[13]), cvtpk_b(k2[14], k2[15])};
            if (tq == 0) *(LAS float*)(L + HL_GC + sk * 4) = egC;
            if (tid < 256) *(LAS v4u*)(L + HL_VT + tr_st(vtok, vch * 8, 1)) = rv;
        }
        HG_SYNC();
        SEC_END(1);
        SEC_BEGIN(2);
        if (n + 1 < NCH) HG_LOAD(n + 1);
        const int sb = (n & 1) * 8192;
        const int pob = (n & 1) ? LDS_XCH : HL_PO;
        const int vbV = ldsb + HL_VT + v_rd_base(lane);
#define HG_STATE_TERM(ct) do { const int vbQ = ldsb + HL_QT + (ct) * 512 + v_rd_base(lane); \
                s16x4 l0, h0, l1, h1, l2, h2, l3, h3, l4, h4, l5, h5, l6, h6, l7, h7; \
                TRR(l0, vbQ, tr_off(2, 0, 0)); TRR(h0, vbQ, tr_off(2, 0, 1)); TRR(l1, vbQ, tr_off(2, 1, 0)); TRR(h1, vbQ, tr_off(2, 1, 1)); \
                TRR(l2, vbQ, tr_off(2, 2, 0)); TRR(h2, vbQ, tr_off(2, 2, 1)); TRR(l3, vbQ, tr_off(2, 3, 0)); TRR(h3, vbQ, tr_off(2, 3, 1)); \
                TRR(l4, vbQ, tr_off(2, 4, 0)); TRR(h4, vbQ, tr_off(2, 4, 1)); TRR(l5, vbQ, tr_off(2, 5, 0)); TRR(h5, vbQ, tr_off(2, 5, 1)); \
                TRR(l6, vbQ, tr_off(2, 6, 0)); TRR(h6, vbQ, tr_off(2, 6, 1)); TRR(l7, vbQ, tr_off(2, 7, 0)); TRR(h7, vbQ, tr_off(2, 7, 1)); \
                TRWAIT(); \
                f32x16 o; \
                _Pragma("unroll") for (int r = 0; r < 16; ++r) o[r] = 0.f; \
                o = __builtin_amdgcn_mfma_f32_32x32x16_bf16(PKV2(l0, h0), *(const LAS bf16x8*)(L + HL_S0 + sb + (0 * 64 + lane) * 16), o, 0, 0, 0); \
                o = __builtin_amdgcn_mfma_f32_32x32x16_bf16(PKV2(l1, h1), *(const LAS bf16x8*)(L + HL_S0 + sb + (1 * 64 + lane) * 16), o, 0, 0, 0); \
                o = __builtin_amdgcn_mfma_f32_32x32x16_bf16(PKV2(l2, h2), *(const LAS bf16x8*)(L + HL_S0 + sb + (2 * 64 + lane) * 16), o, 0, 0, 0); \
                o = __builtin_amdgcn_mfma_f32_32x32x16_bf16(PKV2(l3, h3), *(const LAS bf16x8*)(L + HL_S0 + sb + (3 * 64 + lane) * 16), o, 0, 0, 0); \
                o = __builtin_amdgcn_mfma_f32_32x32x16_bf16(PKV2(l4, h4), *(const LAS bf16x8*)(L + HL_S0 + sb + (4 * 64 + lane) * 16), o, 0, 0, 0); \
                o = __builtin_amdgcn_mfma_f32_32x32x16_bf16(PKV2(l5, h5), *(const LAS bf16x8*)(L + HL_S0 + sb + (5 * 64 + lane) * 16), o, 0, 0, 0); \
                o = __builtin_amdgcn_mfma_f32_32x32x16_bf16(PKV2(l6, h6), *(const LAS bf16x8*)(L + HL_S0 + sb + (6 * 64 + lane) * 16), o, 0, 0, 0); \
                o = __builtin_amdgcn_mfma_f32_32x32x16_bf16(PKV2(l7, h7), *(const LAS bf16x8*)(L + HL_S0 + sb + (7 * 64 + lane) * 16), o, 0, 0, 0); \
                _Pragma("unroll") for (int g = 0; g < 4; ++g) *(LAS f32x4*)(L + pob + (3 + (ct)) * 4096 + lane * 64 + g * 16) = (f32x4){o[4 * g], o[4 * g + 1], o[4 * g + 2], o[4 * g + 3]}; } while (0)
        if (wid < 4) {
            s16x4 vl0, vh0, vl1, vh1, vl2, vh2, vl3, vh3;
            TRR(vl0, vbV, tr_off(1, 0, 0)); TRR(vh0, vbV, tr_off(1, 0, 1)); TRR(vl1, vbV, tr_off(1, 1, 0)); TRR(vh1, vbV, tr_off(1, 1, 1));
            TRR(vl2, vbV, tr_off(1, 2, 0)); TRR(vh2, vbV, tr_off(1, 2, 1)); TRR(vl3, vbV, tr_off(1, 3, 0)); TRR(vh3, vbV, tr_off(1, 3, 1));
            const int krow = 32 * wid + r32;
            const bf16x8 a0 = *(const LAS bf16x8*)(L + HL_K2 + KSWZ64(krow, (0 + 8 * hh) * 2)), a1 = *(const LAS bf16x8*)(L + HL_K2 + KSWZ64(krow, (16 + 8 * hh) * 2));
            const bf16x8 a2 = *(const LAS bf16x8*)(L + HL_K2 + KSWZ64(krow, (32 + 8 * hh) * 2)), a3 = *(const LAS bf16x8*)(L + HL_K2 + KSWZ64(krow, (48 + 8 * hh) * 2));
#pragma unroll
            for (int g = 0; g < 4; ++g) { const f32x4 gv = *(const LAS f32x4*)(L + HL_GC + (32 * wid + 8 * g + 4 * hh) * 4);
#pragma unroll
                for (int e = 0; e < 4; ++e) S[4 * g + e] *= gv[e]; }
            TRWAIT();
            S = __builtin_amdgcn_mfma_f32_32x32x16_bf16(a0, PKV2(vl0, vh0), S, 0, 0, 0); S = __builtin_amdgcn_mfma_f32_32x32x16_bf16(a1, PKV2(vl1, vh1), S, 0, 0, 0);
            S = __builtin_amdgcn_mfma_f32_32x32x16_bf16(a2, PKV2(vl2, vh2), S, 0, 0, 0); S = __builtin_amdgcn_mfma_f32_32x32x16_bf16(a3, PKV2(vl3, vh3), S, 0, 0, 0);
            bf16x8 f0, f1; PK4B(S, 0, f0); PK4B(S, 8, f1);
            *(LAS bf16x8*)(L + HL_S0 + (sb ^ 8192) + ((2 * wid) * 64 + lane) * 16) = f0; *(LAS bf16x8*)(L + HL_S0 + (sb ^ 8192) + ((2 * wid + 1) * 64 + lane) * 16) = f1;
            if (wid == 3) HG_STATE_TERM(1);
            if (n > 0) HG_FINISH2(n - 1);
        } else if (wid < 7) {
            const int ct = wid > 4 ? 1 : 0, rt = wid == 6 ? 1 : 0;
            const int vbQ = ldsb + HL_QT + ct * 512 + v_rd_base(lane), vbKr = ldsb + HL_KT + rt * 512 + v_rd_base(lane), vbVr = vbV + rt * 2048;
            bf16x8 qf[8];
            f32x16 X, o;
#pragma unroll
            for (int r = 0; r < 16; ++r) { X[r] = 0.f; o[r] = 0.f; }
            { s16x4 q0l, q0h, q1l, q1h, q2l, q2h, q3l, q3h, q4l, q4h, q5l, q5h, q6l, q6h, q7l, q7h;
              s16x4 l0, h0, l1, h1, l2, h2, l3, h3, l4, h4, l5, h5, l6, h6, l7, h7, wl0, wh0, wl1, wh1;
                TRR(q0l, vbQ, tr_off(2, 0, 0)); TRR(q0h, vbQ, tr_off(2, 0, 1)); TRR(q1l, vbQ, tr_off(2, 1, 0)); TRR(q1h, vbQ, tr_off(2, 1, 1));
                TRR(q2l, vbQ, tr_off(2, 2, 0)); TRR(q2h, vbQ, tr_off(2, 2, 1)); TRR(q3l, vbQ, tr_off(2, 3, 0)); TRR(q3h, vbQ, tr_off(2, 3, 1));
                TRR(q4l, vbQ, tr_off(2, 4, 0)); TRR(q4h, vbQ, tr_off(2, 4, 1)); TRR(q5l, vbQ, tr_off(2, 5, 0)); TRR(q5h, vbQ, tr_off(2, 5, 1));
                TRR(q6l, vbQ, tr_off(2, 6, 0)); TRR(q6h, vbQ, tr_off(2, 6, 1)); TRR(q7l, vbQ, tr_off(2, 7, 0)); TRR(q7h, vbQ, tr_off(2, 7, 1));
                TRR(l0, vbKr, tr_off(2, 0, 0)); TRR(h0, vbKr, tr_off(2, 0, 1)); TRR(l1, vbKr, tr_off(2, 1, 0)); TRR(h1, vbKr, tr_off(2, 1, 1));
                TRR(l2, vbKr, tr_off(2, 2, 0)); TRR(h2, vbKr, tr_off(2, 2, 1)); TRR(l3, vbKr, tr_off(2, 3, 0)); TRR(h3, vbKr, tr_off(2, 3, 1));
                TRR(l4, vbKr, tr_off(2, 4, 0)); TRR(h4, vbKr, tr_off(2, 4, 1)); TRR(l5, vbKr, tr_off(2, 5, 0)); TRR(h5, vbKr, tr_off(2, 5, 1));
                TRR(l6, vbKr, tr_off(2, 6, 0)); TRR(h6, vbKr, tr_off(2, 6, 1)); TRR(l7, vbKr, tr_off(2, 7, 0)); TRR(h7, vbKr, tr_off(2, 7, 1));
                TRR(wl0, vbVr, tr_off(1, 0, 0)); TRR(wh0, vbVr, tr_off(1, 0, 1)); TRR(wl1, vbVr, tr_off(1, 1, 0)); TRR(wh1, vbVr, tr_off(1, 1, 1));
                TRWAIT();
                qf[0] = PKV2(q0l, q0h); qf[1] = PKV2(q1l, q1h); qf[2] = PKV2(q2l, q2h); qf[3] = PKV2(q3l, q3h); qf[4] = PKV2(q4l, q4h); qf[5] = PKV2(q5l, q5h); qf[6] = PKV2(q6l, q6h); qf[7] = PKV2(q7l, q7h);
                X = __builtin_amdgcn_mfma_f32_32x32x16_bf16(PKV2(l0, h0), qf[0], X, 0, 0, 0); X = __builtin_amdgcn_mfma_f32_32x32x16_bf16(PKV2(l1, h1), qf[1], X, 0, 0, 0);
                X = __builtin_amdgcn_mfma_f32_32x32x16_bf16(PKV2(l2, h2), qf[2], X, 0, 0, 0); X = __builtin_amdgcn_mfma_f32_32x32x16_bf16(PKV2(l3, h3), qf[3], X, 0, 0, 0);
                X = __builtin_amdgcn_mfma_f32_32x32x16_bf16(PKV2(l4, h4), qf[4], X, 0, 0, 0); X = __builtin_amdgcn_mfma_f32_32x32x16_bf16(PKV2(l5, h5), qf[5], X, 0, 0, 0);
                X = __builtin_amdgcn_mfma_f32_32x32x16_bf16(PKV2(l6, h6), qf[6], X, 0, 0, 0); X = __builtin_amdgcn_mfma_f32_32x32x16_bf16(PKV2(l7, h7), qf[7], X, 0, 0, 0);
                if (rt == ct) {
#pragma unroll
                    for (int r = 0; r < 16; ++r) X[r] = (crow(r, hh) <= r32) ? X[r] : 0.f; }
                bf16x8 pa0, pa1; PK4B(X, 0, pa0); PK4B(X, 8, pa1);
                o = __builtin_amdgcn_mfma_f32_32x32x16_bf16(pa0, PKV2(wl0, wh0), o, 0, 0, 0); o = __builtin_amdgcn_mfma_f32_32x32x16_bf16(pa1, PKV2(wl1, wh1), o, 0, 0, 0); }
#pragma unroll
            for (int g = 0; g < 4; ++g) *(LAS f32x4*)(L + pob + (wid - 4) * 4096 + lane * 64 + g * 16) = (f32x4){o[4 * g], o[4 * g + 1], o[4 * g + 2], o[4 * g + 3]};
        } else {
            HG_STATE_TERM(0);
        }
        SEC_END(2);
    }
    __syncthreads();
    HG_FINISH2(NCH - 1);
    __syncthreads();
#undef HG_FINISH2
#undef HG_SYNC
#undef HG_STATE_TERM
#undef HG_ROW
#undef HG_LOAD
}

constexpr int LDS_ROPE = LDS_XCH + 8192;
static_assert(LDS_ROPE + 1536 * 8 <= LDS_BYTES, "rope tables in LDS");
__device__ __forceinline__ const LAS f32x2* stage_rope(Frame& F) {
    LAS f32x2* rl = (LAS f32x2*)(F.lds + LDS_ROPE);
    for (int i = F.tid; i < 1536; i += NTHREADS) rl[i] = (i < 512) ? F.ropeR_()[i] : F.ropeC_()[i - 512];
    __syncthreads();
    return rl;
}

constexpr int NPHASES = 20;
__global__ void __launch_bounds__(NTHREADS, 2) mk_fwd(Args args) {
    extern __shared__ __attribute__((aligned(16))) unsigned char lds[];
    Frame F;
    F.lds = (LAS unsigned char*)lds;
    F.tid = threadIdx.x; F.lane = F.tid & 63; F.wave = __builtin_amdgcn_readfirstlane(F.tid >> 6); F.G = gridDim.x; F.bid = blockIdx.x;
    F.ar = &args; F.out = args.out; F.ws = args.ws; F.sec_acc = 0ull;

    volatile LAS unsigned* MISC = (volatile LAS unsigned*)(F.lds + LDS_MISC);
    for (int u = F.tid; u < 256; u += NTHREADS) MISC[u] = 0u;
    __syncthreads();
    XcdBarrier bar; bar.bar = (unsigned*)(F.ctl_() + CW_BAR); bar.x = 0; bar.st = nullptr;
    if (MK_N_LAUNCHES == 1) bar = xcd_barrier_post((unsigned*)(F.ctl_() + CW_BAR), MISC + 8);
    LAS float* xl = (LAS float*)(F.lds + LDS_XCH);

    const int lo = args.ph_lo, hi = args.ph_hi;
#ifdef DBG_ONLY
#define IN(k) ((k) == DBG_ONLY && lo <= (k) && (k) < hi)
#else
#define IN(k) (lo <= (k) && (k) < hi)
#endif
    unsigned long long amp_t0 = 0ull, amp_t1 = 0ull;
    if (PROBE_AMP_LO == 0) amp_t0 = __builtin_amdgcn_s_memrealtime();
#define SEAM(k) do { if (IN(k) && IN((k) + 1)) xcd_barrier(bar); if ((k) + 1 == PROBE_AMP_LO) amp_t0 = __builtin_amdgcn_s_memrealtime(); if ((k) == PROBE_AMP_HI) amp_t1 = __builtin_amdgcn_s_memrealtime(); } while (0)

    if (IN(0)) { REP(0) p0_prologue(F); } SEAM(0);
    if (IN(1)) { p0_convert_in0(F); p_norm0(F); } SEAM(1);
    if (IN(2)) { Gemm g{F.H_(), F.Win0_(), 1024, nullptr}; SchedGrid S{NT_ALL, 16, F.G, F.bid, false};
        const LAS f32x2* rl_ = stage_rope(F); EpiIn0 E{F.big_(), F.ar->in[I_DQG], F.ar->in[I_DKG], F.lbv_(), rl_, rl_ + 512}; p0_convert_mid(F, (NT_ALL * 16) % F.G); __syncthreads(); REP(2) run_gemm<0>(F, g, S, E); } SEAM(2);
    if (IN(3)) { REP(30) for (int a = F.bid; a < 256; a += F.G) hgrn_unit_v1(F, (F.G == 256) ? ((a & 7) * 32 + (a >> 3)) : a);

        REP(31) for (int a = F.bid; a < 256; a += F.G) diff_attn_unit_v2(F, (F.G == 256) ? ((a & 7) * 32 + (a >> 3)) : a); } SEAM(3);
    if (IN(4)) {
        const int nctx = F.G >= 64 ? 32 : 0;
        if (F.bid < nctx) diff_attn_unit_v2(F, 256 + F.bid); else if (nctx == 0) { for (int a = 256 + F.bid; a < 288; a += F.G) diff_attn_unit_v2(F, a); }
        REP(4) p_hgrn_post(F, nctx); } SEAM(4);
    if (IN(5)) { Gemm g{F.H_(), F.Wout0_(), 1024, nullptr}; SchedGrid S{NT_ALL, 4, F.G, F.bid, false}; EpiOut E{&F, 0, true}; run_gemm<1>(F, g, S, E); p0_convert_late(F, 0);
        { const int f5 = F.G > 32 ? 32 : 0; if (F.bid >= f5) for (int it = 96 + (F.bid - f5); it < 192; it += F.G - f5) p0_gemv_item(F, it); } } SEAM(5);
    if (IN(6)) { p_norm_route(F, 0, false); } SEAM(6);
    if (IN(7)) { p_lists(F, 0, false);
        Gemm g{F.H_(), F.Wgu_() + (size_t)(0 * 17 + 16) * 1024 * 1024, 1024, nullptr}; SchedGrid S{NT_ALL, 4, F.G, F.bid, false}; EpiGU E{(bf16*)(F.big_() + B_HS)}; run_gemm<2>(F, g, S, E); p0_convert_late(F, 1); } SEAM(7);
    if (IN(8)) { int rr8; { SchedRouted S; load_expoff(F, 0, S.eo); S.G = F.G; S.c = F.bid; rr8 = ((((S.eo.off[16] >> 8) * 4) % F.G) + 7) & ~7;     Gemm g{F.H_(), F.Wgu_() + (size_t)(0 * 17) * 1024 * 1024, 1024, (const int*)(F.ws + WS_SMALL + SM_ROWIDX)}; EpiGU E{(bf16*)(F.big_() + B_HE)}; run_gemm<3>(F, g, S, E); }
        { Gemm g{(const bf16*)(F.big_() + B_HS), F.Wd_() + (size_t)(0 * 17 + 16) * 1024 * 512, 512, nullptr}; const int nl8 = F.G - rr8, u8 = NT_ALL * 4; SchedGridL S{NT_ALL, 4, F.G, F.bid, rr8, false, 0, nl8 < u8 ? nl8 : u8, 1}; EpiDownS E{(bf16*)(F.big_() + B_YS)}; run_gemm<4>(F, g, S, E); } } SEAM(8);
    if (IN(9)) { SchedRouted S; load_expoff(F, 0, S.eo); S.G = F.G; S.c = F.bid; Gemm g{(const bf16*)(F.big_() + B_HE), F.Wd_() + (size_t)(0 * 17) * 1024 * 512, 512, nullptr}; EpiDownR E{(bf16*)(F.big_() + B_YE)}; run_gemm<5>(F, g, S, E);
        {
            const int rr9 = ((((S.eo.off[16] >> 8) * 4) % F.G) + 7) & ~7, nl9 = F.G - rr9, u9 = NT_ALL * 4;
            Gemm g2{(const bf16*)(F.big_() + B_HS), F.Wd_() + (size_t)(0 * 17 + 16) * 1024 * 512, 512, nullptr}; SchedGridL S2{NT_ALL, 4, F.G, F.bid, rr9, false, nl9 < u9 ? nl9 : u9, u9, 2}; EpiDownS E2{(bf16*)(F.big_() + B_YS)}; run_gemm<4>(F, g2, S2, E2); } } SEAM(9);
    if (IN(10)) { p_combine(F, 0, false, true); } SEAM(10);
    if (IN(11)) { Gemm g{F.H_(), F.Win1_(), 1024, nullptr}; SchedGrid S{NT_ALL, 3, F.G, F.bid, false}; const LAS f32x2* rl_ = stage_rope(F); EpiIn1 E{F.big_(), F.ssq_(), F.ar->in[I_KRG], rl_, rl_ + 512}; run_gemm<6>(F, g, S, E); } SEAM(11);
    if (IN(12)) { { Gemm g{(const bf16*)(F.big_() + B_CQ), F.Wuq_(), 384, nullptr}; SchedGrid S{NT_LAT, 6, F.G, F.bid, true};
            const LAS f32x2* rl_ = stage_rope(F); EpiUq E{(bf16*)(F.big_() + B_Q1), F.ssq_(), F.ar->in[I_QNG], F.ar->in[I_QRG], rl_, rl_ + 512, xl}; run_gemm<7>(F, g, S, E); }
        { Gemm g{(const bf16*)(F.big_() + B_CKV), F.Wukv_(), 256, nullptr}; SchedGrid S{NT_ALL, 8, F.G, (F.bid + F.G / 2) % F.G, false};
            EpiUkv E{(bf16*)(F.big_() + B_KN), (bf16*)(F.big_() + B_V1), F.ssq_(), F.ar->in[I_KNG], xl}; run_gemm<8>(F, g, S, E); } } SEAM(12);
    if (IN(13)) { REP(13) for (int a = F.bid; a < 512; a += F.G) mla_attn_unit_v1(F, (F.G == 256) ? ((a & 256) + (a & 7) * 32 + ((a & 255) >> 3)) : a); } SEAM(13);
    if (IN(14)) { Gemm g{F.H_(), F.Wout1_(), 1024, nullptr}; SchedGrid S{NT_LAT, 4, F.G, F.bid, true}; EpiOut E{&F, 1, false}; run_gemm<9>(F, g, S, E); } SEAM(14);
    if (IN(15)) { p_norm_route(F, 1, true); } SEAM(15);
    if (IN(16)) { p_lists(F, 1, true);
        Gemm g{F.H_(), F.Wgu_() + (size_t)(1 * 17 + 16) * 1024 * 1024, 1024, nullptr}; SchedGrid S{NT_LAT, 4, F.G, F.bid, true}; EpiGU E{(bf16*)(F.big_() + B_HS)}; run_gemm<10>(F, g, S, E); } SEAM(16);
    if (IN(17)) { int rr17; { SchedRouted S; load_expoff(F, 1, S.eo); S.G = F.G; S.c = F.bid; rr17 = ((((S.eo.off[16] >> 8) * 4) % F.G) + 7) & ~7; Gemm g{F.H_(), F.Wgu_() + (size_t)(1 * 17) * 1024 * 1024, 1024, (const int*)(F.ws + WS_SMALL + SM_ROWIDX)}; EpiGU E{(bf16*)(F.big_() + B_HE)}; run_gemm<11>(F, g, S, E); }
        { Gemm g{(const bf16*)(F.big_() + B_HS), F.Wd_() + (size_t)(1 * 17 + 16) * 1024 * 512, 512, nullptr}; const int nl17 = F.G - rr17, u17 = NT_LAT * 4; SchedGridL S{NT_LAT, 4, F.G, F.bid, rr17, true, 0, nl17 < u17 ? nl17 : u17, 1}; EpiDownS E{(bf16*)(F.big_() + B_YS)}; run_gemm<12>(F, g, S, E); } } SEAM(17);
    if (IN(18)) { SchedRouted S; load_expoff(F, 1, S.eo); S.G = F.G; S.c = F.bid; Gemm g{(const bf16*)(F.big_() + B_HE), F.Wd_() + (size_t)(1 * 17) * 1024 * 512, 512, nullptr}; EpiDownR E{(bf16*)(F.big_() + B_YE)}; run_gemm<13>(F, g, S, E);
        {   const int rr18 = ((((S.eo.off[16] >> 8) * 4) % F.G) + 7) & ~7, nl18 = F.G - rr18, u18 = NT_LAT * 4;
            Gemm g2{(const bf16*)(F.big_() + B_HS), F.Wd_() + (size_t)(1 * 17 + 16) * 1024 * 512, 512, nullptr}; SchedGridL S2{NT_LAT, 4, F.G, F.bid, rr18, true, nl18 < u18 ? nl18 : u18, u18, 2}; EpiDownS E2{(bf16*)(F.big_() + B_YS)}; run_gemm<12>(F, g2, S2, E2); } } SEAM(18);
    if (IN(19)) { p_combine(F, 1, true, false); }
    if (PROBE_SEC > 0) { const unsigned long long te = (unsigned long long)clock64(); while ((unsigned long long)clock64() - te < F.sec_acc) __builtin_amdgcn_s_sleep(8); }
    if (PROBE_AMP_LO >= 0) { __syncthreads(); if (PROBE_AMP_HI >= 19) amp_t1 = __builtin_amdgcn_s_memrealtime(); const unsigned long long te = __builtin_amdgcn_s_memrealtime(); while (__builtin_amdgcn_s_memrealtime() - te < amp_t1 - amp_t0) __builtin_amdgcn_s_sleep(8); }
#undef IN
#undef SEAM
}

extern "C" void kernel_launch(void* const* d_in, const int* in_sizes, int n_in, void* d_out, int out_size, void* d_ws, size_t ws_size, hipStream_t stream) {
    static int grid = 0;
    if (grid == 0) {
        if (n_in != 34 || in_sizes[0] != NB * SEQ * D || out_size != NB * SEQ * D || ws_size < WS_END) {
            fprintf(stderr, "kernel_launch: unexpected problem: n_in %d in0 %d out %d ws %zu (need %zu); nothing launched\n", n_in, n_in > 0 ? in_sizes[0] : -1, out_size, ws_size, (size_t)WS_END); grid = -1; return; }
        int dev = 0, cus = 0;
        if (hipGetDevice(&dev) != hipSuccess || hipDeviceGetAttribute(&cus, hipDeviceAttributeMultiprocessorCount, dev) != hipSuccess) { grid = -1; return; }
        if (hipFuncSetAttribute((const void*)mk_fwd, hipFuncAttributeMaxDynamicSharedMemorySize, LDS_BYTES) != hipSuccess) { fprintf(stderr, "kernel_launch: hipFuncSetAttribute failed\n"); grid = -1; return; }
        int per_cu = 0;
        if (hipOccupancyMaxActiveBlocksPerMultiprocessor(&per_cu, (const void*)mk_fwd, NTHREADS, LDS_BYTES) != hipSuccess || per_cu < 1) fprintf(stderr, "kernel_launch: note: occupancy query reports %d\n", per_cu);
        (void)hipGetLastError();
        grid = cus;
    }
    if (grid < 0) return;
    if (hipMemsetAsync((char*)d_ws + WS_CTL, 0, CTL_ZERO_BYTES, stream) != hipSuccess) { fprintf(stderr, "kernel_launch: memset failed\n"); return; }
    Args a{};
    for (int i = 0; i < 34; ++i) a.in[i] = (const float*)d_in[i];
    a.out = (float*)d_out; a.ws = (unsigned char*)d_ws;
    if (MK_N_LAUNCHES == 1) { a.ph_lo = 0; a.ph_hi = NPHASES; hipLaunchKernelGGL(mk_fwd, dim3(grid), dim3(NTHREADS), LDS_BYTES, stream, a); }
    else for (int p = 0; p < NPHASES; ++p) { a.ph_lo = p; a.ph_hi = p + 1; hipLaunchKernelGGL(mk_fwd, dim3(grid), dim3(NTHREADS), LDS_BYTES, stream, a); }
    const hipError_t le = hipPeekAtLastError();
    if (le != hipSuccess) fprintf(stderr, "kernel_launch: launch failed: %s\n", hipGetErrorName(le));
}
```
